# Optimizing an MI355X kernel written in HIP

```python
import math
import jax
import jax.numpy as jnp
from jax import lax
import numpy as np

D_MODEL = 1024
BATCH = 8
SEQ = 2048
DEPTH = 2
DEC_BATCH = 128
DEC_SEQ = 1
PAST_LEN = 16384
PAGE_SIZE = 128

N_EVEN = (DEPTH + 1) // 2
N_ODD = DEPTH // 2
SSM_D_INNER = D_MODEL
SSM_HEAD_DIM = 64
SSM_HEADS = SSM_D_INNER // SSM_HEAD_DIM
SSM_GROUPS = 2
SSM_STATE = 64
SSM_CONV = 4
SSM_CHUNK = 128
SSM_CONV_DIM = SSM_D_INNER + 2 * SSM_GROUPS * SSM_STATE
HG_HEADS = 8
HG_DIM = 128
HG_WIDTH = HG_HEADS * HG_DIM
HG_CHUNK = 16
AB_IN = SSM_D_INNER + SSM_CONV_DIM + SSM_HEADS + 4 * HG_WIDTH
AB_OUT = SSM_D_INNER + HG_WIDTH
S5_GROUP = 16
S5_GROUPS = D_MODEL // S5_GROUP
S5_STATE = 64
FFN_DIM = 2816
FFN_CONV = 3
EPS = 1e-6
F32 = jnp.float32

kernel_name = 'hybrid_ssd_hgrn2_s5_convffn_step'


def rmsnorm(x, w):
    xf = x.astype(F32)
    y = xf * lax.rsqrt(jnp.mean(xf * xf, axis=-1, keepdims=True) + EPS)
    return (y * w.astype(F32)).astype(x.dtype)


def causal_dwconv(x, buf, w, b):
    k_w = w.shape[0]
    n = x.shape[1]
    xp = jnp.concatenate([buf.astype(x.dtype), x], axis=1)
    y = b + xp[:, 0:n] * w[0]
    for k in range(1, k_w):
        y = y + xp[:, k:k + n] * w[k]
    return y, xp[:, xp.shape[1] - (k_w - 1):]


def to_chunks(a, c):
    b, n = a.shape[0], a.shape[1]
    return jnp.swapaxes(a.reshape((b, n // c, c) + a.shape[2:]), 0, 1)


def from_chunks(a):
    a = jnp.swapaxes(a, 0, 1)
    return a.reshape((a.shape[0], a.shape[1] * a.shape[2]) + a.shape[3:])


def ssd_scan(x, dt, a, bm, cm, h0):
    b, n, nh, p = x.shape
    g, ns = bm.shape[2], bm.shape[3]
    r = nh // g
    c = math.gcd(n, SSM_CHUNK)
    mask = jnp.tril(jnp.ones((c, c), dtype=bool))[None, :, :, None, None]
    a = a.reshape(g, r)

    def step(h, inp):
        xc, dtc, bc, cc = inp
        cum = jnp.cumsum(dtc * a, axis=1)
        seg = jnp.exp(jnp.where(mask, cum[:, :, None] - cum[:, None], -jnp.inf))
        cb = jnp.einsum('btgn,bsgn->bgts', cc, bc)
        wts = jnp.einsum('bgts,btsgr,bsgr->bgrts', cb, seg, dtc)
        y = jnp.einsum('bgrts,bsgrp->btgrp', wts, xc)
        y = y + jnp.einsum('btgn,bgrpn,btgr->btgrp', cc, h, jnp.exp(cum))
        last = cum[:, -1]
        to_end = jnp.exp(last[:, None] - cum) * dtc
        h = jnp.exp(last)[..., None, None] * h + jnp.einsum('bsgr,bsgn,bsgrp->bgrpn', to_end, bc, xc)
        return h, y

    xs = to_chunks(x.reshape(b, n, g, r, p), c)
    dts = to_chunks(dt.reshape(b, n, g, r), c)
    h, ys = lax.scan(step, h0.reshape(b, g, r, p, ns), (xs, dts, to_chunks(bm, c), to_chunks(cm, c)))
    return from_chunks(ys).reshape(b, n, nh, p), h.reshape(b, nh, p, ns)


def hgrn2_scan(q, logf, k, v, s0):
    n = q.shape[1]
    c = math.gcd(n, HG_CHUNK)
    mask = jnp.tril(jnp.ones((c, c), dtype=bool))[None, :, :, None, None]

    def step(s, inp):
        qc, gc, kc, vc = inp
        cum = jnp.cumsum(gc, axis=1)
        dec = jnp.exp(jnp.where(mask, cum[:, :, None] - cum[:, None], -jnp.inf))
        att = jnp.einsum('bthk,btshk,bshk->bhts', qc, dec, kc)
        o = jnp.einsum('bhts,bshv->bthv', att, vc) + jnp.einsum('bthk,bhkv->bthv', qc * jnp.exp(cum), s)
        last = cum[:, -1]
        s = jnp.exp(last)[..., None] * s + jnp.einsum('bshk,bshv->bhkv', jnp.exp(last[:, None] - cum) * kc, vc)
        return s, o

    s, o = lax.scan(step, s0, (to_chunks(q, c), to_chunks(logf, c), to_chunks(k, c), to_chunks(v, c)))
    return from_chunks(o), s


def complex_affine_combine(e1, e2):
    a1r, a1i, b1r, b1i = e1
    a2r, a2i, b2r, b2i = e2
    return (a2r * a1r - a2i * a1i,
            a2r * a1i + a2i * a1r,
            a2r * b1r - a2i * b1i + b2r,
            a2r * b1i + a2i * b1r + b2i)


def mixer_ab(h, conv_buf, ssm0, hg0, lb, in_w, conv_w, conv_b, dt_bias, a_log, d_skip, ssm_norm_w, hg_norm_w, out_w):
    b, n, _ = h.shape
    proj = h @ in_w
    cuts = np.cumsum([SSM_D_INNER, SSM_CONV_DIM, SSM_HEADS, HG_WIDTH, HG_WIDTH, HG_WIDTH]).tolist()
    z, xbc, dt_raw, q, f_raw, i_in, g = jnp.split(proj, cuts, axis=-1)
    xbc, conv_new = causal_dwconv(xbc, conv_buf, conv_w, conv_b)
    xbc = jax.nn.silu(xbc.astype(F32))
    xs, bm, cm = jnp.split(xbc, [SSM_D_INNER, SSM_D_INNER + SSM_GROUPS * SSM_STATE], axis=-1)
    xs = xs.reshape(b, n, SSM_HEADS, SSM_HEAD_DIM)
    bm = bm.reshape(b, n, SSM_GROUPS, SSM_STATE)
    cm = cm.reshape(b, n, SSM_GROUPS, SSM_STATE)
    dt = jax.nn.softplus(dt_raw.astype(F32) + dt_bias.astype(F32))
    a = -jnp.exp(a_log.astype(F32))
    y, ssm_new = ssd_scan(xs, dt, a, bm, cm, ssm0.astype(F32))
    y = y + d_skip.astype(F32)[:, None] * xs
    y = rmsnorm(y.reshape(b, n, SSM_D_INNER) * jax.nn.silu(z.astype(F32)), ssm_norm_w)
    f_raw = f_raw.astype(F32)
    logf = jnp.log(lb + (1.0 - lb) * jax.nn.sigmoid(f_raw))
    k = (1.0 - lb) * jax.nn.sigmoid(-f_raw)
    hs = (b, n, HG_HEADS, HG_DIM)
    qh = jax.nn.silu(q.astype(F32)).reshape(hs)
    o, hg_new = hgrn2_scan(qh, logf.reshape(hs), k.reshape(hs), i_in.astype(F32).reshape(hs), hg0.astype(F32))
    o = rmsnorm(o, hg_norm_w) * jax.nn.silu(g.astype(F32).reshape(hs))
    mixed = jnp.concatenate([y, o.reshape(b, n, HG_WIDTH)], axis=-1).astype(h.dtype)
    return mixed @ out_w, conv_new, ssm_new, hg_new


def mixer_c(h, s_re0, s_im0, lam_re, lam_im, log_step, b_re, b_im, c_re, c_im, d_skip, glu_w):
    b, n, _ = h.shape
    u = h.astype(F32).reshape(b, n, S5_GROUPS, S5_GROUP)
    lam_re = lam_re.astype(F32)
    lam_im = lam_im.astype(F32)
    step = jnp.exp(log_step.astype(F32))[:, None]
    mag = jnp.exp(lam_re * step)
    ab_re = mag * jnp.cos(lam_im * step)
    ab_im = mag * jnp.sin(lam_im * step)
    den = lam_re * lam_re + lam_im * lam_im
    nr = ab_re - 1.0
    coef_re = (nr * lam_re + ab_im * lam_im) / den
    coef_im = (ab_im * lam_re - nr * lam_im) / den
    b_re = b_re.astype(F32)
    b_im = b_im.astype(F32)
    bb_re = coef_re[..., None] * b_re - coef_im[..., None] * b_im
    bb_im = coef_re[..., None] * b_im + coef_im[..., None] * b_re
    bu_re = jnp.einsum('blgc,gnc->blgn', u, bb_re)
    bu_im = jnp.einsum('blgc,gnc->blgn', u, bb_im)
    s_re0 = s_re0.astype(F32)
    s_im0 = s_im0.astype(F32)
    bu_re = bu_re.at[:, 0].add(ab_re * s_re0 - ab_im * s_im0)
    bu_im = bu_im.at[:, 0].add(ab_re * s_im0 + ab_im * s_re0)
    a_re = jnp.broadcast_to(ab_re, bu_re.shape)
    a_im = jnp.broadcast_to(ab_im, bu_im.shape)
    _, _, x_re, x_im = lax.associative_scan(complex_affine_combine, (a_re, a_im, bu_re, bu_im), axis=1)
    y = (jnp.einsum('gcn,blgn->blgc', c_re.astype(F32), x_re)
         - jnp.einsum('gcn,blgn->blgc', c_im.astype(F32), x_im)
         + d_skip.astype(F32).reshape(S5_GROUPS, S5_GROUP) * u)
    zg = jax.nn.gelu(y.reshape(b, n, D_MODEL)).astype(h.dtype) @ glu_w
    val, gate = jnp.split(zg, 2, axis=-1)
    return val * jax.nn.sigmoid(gate), x_re[:, -1], x_im[:, -1]


def conv_ffn(h, buf, up_w, conv_w, conv_b, down_w):
    up = h @ up_w
    up, buf_new = causal_dwconv(up, buf, conv_w, conv_b)
    val, gate = jnp.split(up, 2, axis=-1)
    return (val * jax.nn.silu(gate)) @ down_w, buf_new


def trunk(x, ssm0, sconv0, hg0, s5r0, s5i0, fconv0, w):
    lbs = jnp.cumsum(jax.nn.softmax(w['hgrn_lb'].astype(F32), axis=0), axis=0)
    n_ssm, n_sconv, n_hg, n_s5r, n_s5i, n_fconv = [], [], [], [], [], []
    for l in range(DEPTH):
        e = l // 2
        hn = rmsnorm(x, w['norm_mix_pre'][l])
        if l % 2 == 0:
            m, sc, ss, sh = mixer_ab(hn, sconv0[e], ssm0[e], hg0[e], lbs[e],
                                     w['ab_in_w'][e], w['ssm_conv_w'][e], w['ssm_conv_b'][e],
                                     w['ssm_dt_bias'][e], w['ssm_a_log'][e], w['ssm_d'][e],
                                     w['ssm_norm_w'][e], w['hgrn_norm_w'][e], w['ab_out_w'][e])
            n_sconv.append(sc.astype(sconv0.dtype))
            n_ssm.append(ss.astype(ssm0.dtype))
            n_hg.append(sh.astype(hg0.dtype))
        else:
            m, sr, si = mixer_c(hn, s5r0[e], s5i0[e], w['s5_lam_re'][e], w['s5_lam_im'][e],
                                w['s5_log_step'][e], w['s5_b_re'][e], w['s5_b_im'][e],
                                w['s5_c_re'][e], w['s5_c_im'][e], w['s5_d'][e], w['s5_glu_w'][e])
            n_s5r.append(sr.astype(s5r0.dtype))
            n_s5i.append(si.astype(s5i0.dtype))
        x = x + rmsnorm(m, w['norm_mix_post'][l])
        hn = rmsnorm(x, w['norm_ffn_pre'][l])
        f, fc = conv_ffn(hn, fconv0[l], w['ffn_up_w'][l], w['ffn_conv_w'][l], w['ffn_conv_b'][l], w['ffn_down_w'][l])
        n_fconv.append(fc.astype(fconv0.dtype))
        x = x + rmsnorm(f, w['norm_ffn_post'][l])
    return x, (jnp.stack(n_ssm), jnp.stack(n_sconv), jnp.stack(n_hg),
               jnp.stack(n_s5r), jnp.stack(n_s5i), jnp.stack(n_fconv))


def setup_inputs(seed: int = 0) -> dict:
    key = jax.random.key(seed)
    ks = iter(jax.random.split(key, 64))

    def nrm(shape, scale):
        return jax.random.normal(next(ks), shape, F32) * scale

    def gain(shape):
        return 1.0 + nrm(shape, 0.05)

    def log_uniform(shape, lo, hi):
        return jax.random.uniform(next(ks), shape, F32, minval=math.log(lo), maxval=math.log(hi))

    x_prompt = nrm((BATCH, SEQ, D_MODEL), 1.0)
    x_sample = nrm((DEC_BATCH, DEC_SEQ, D_MODEL), 1.0)
    state_ssm = nrm((N_EVEN, DEC_BATCH, SSM_HEADS, SSM_HEAD_DIM, SSM_STATE), 0.5)
    state_ssm_conv = nrm((N_EVEN, DEC_BATCH, SSM_CONV - 1, SSM_CONV_DIM), 1.0)
    state_hgrn = nrm((N_EVEN, DEC_BATCH, HG_HEADS, HG_DIM, HG_DIM), 0.5)
    state_s5_re = nrm((N_ODD, DEC_BATCH, S5_GROUPS, S5_STATE), 0.3)
    state_s5_im = nrm((N_ODD, DEC_BATCH, S5_GROUPS, S5_STATE), 0.3)
    state_ffn_conv = nrm((DEPTH, DEC_BATCH, FFN_CONV - 1, 2 * FFN_DIM), 1.0)
    norm_mix_pre = gain((DEPTH, D_MODEL))
    norm_mix_post = gain((DEPTH, D_MODEL))
    norm_ffn_pre = gain((DEPTH, D_MODEL))
    norm_ffn_post = gain((DEPTH, D_MODEL))
    ab_in_w = nrm((N_EVEN, D_MODEL, AB_IN), D_MODEL ** -0.5)
    ssm_conv_w = nrm((N_EVEN, SSM_CONV, SSM_CONV_DIM), SSM_CONV ** -0.5)
    ssm_conv_b = nrm((N_EVEN, SSM_CONV_DIM), 0.02)
    dt0 = jnp.exp(log_uniform((N_EVEN, SSM_HEADS), 1e-3, 1e-1))
    ssm_dt_bias = dt0 + jnp.log(-jnp.expm1(-dt0))
    ssm_a_log = jnp.log(jax.random.uniform(next(ks), (N_EVEN, SSM_HEADS), F32, minval=1.0, maxval=16.0))
    ssm_d = gain((N_EVEN, SSM_HEADS))
    ssm_norm_w = gain((N_EVEN, SSM_D_INNER))
    hgrn_lb = nrm((N_EVEN + 1, HG_WIDTH), 1.0)
    hgrn_norm_w = gain((N_EVEN, HG_DIM))
    ab_out_w = nrm((N_EVEN, AB_OUT, D_MODEL), AB_OUT ** -0.5)
    s5_lam_re = -0.5 + nrm((N_ODD, S5_GROUPS, S5_STATE), 0.01)
    s5_lam_im = jnp.pi * jnp.arange(S5_STATE, dtype=F32) + nrm((N_ODD, S5_GROUPS, S5_STATE), 0.01)
    s5_log_step = log_uniform((N_ODD, S5_GROUPS), 1e-3, 1e-1)
    s5_b_re = nrm((N_ODD, S5_GROUPS, S5_STATE, S5_GROUP), (2 * S5_GROUP) ** -0.5)
    s5_b_im = nrm((N_ODD, S5_GROUPS, S5_STATE, S5_GROUP), (2 * S5_GROUP) ** -0.5)
    s5_c_re = nrm((N_ODD, S5_GROUPS, S5_GROUP, S5_STATE), (2 * S5_STATE) ** -0.5)
    s5_c_im = nrm((N_ODD, S5_GROUPS, S5_GROUP, S5_STATE), (2 * S5_STATE) ** -0.5)
    s5_d = nrm((N_ODD, D_MODEL), 1.0)
    s5_glu_w = nrm((N_ODD, D_MODEL, 2 * D_MODEL), D_MODEL ** -0.5)
    ffn_up_w = nrm((DEPTH, D_MODEL, 2 * FFN_DIM), D_MODEL ** -0.5)
    ffn_conv_w = nrm((DEPTH, FFN_CONV, 2 * FFN_DIM), FFN_CONV ** -0.5)
    ffn_conv_b = nrm((DEPTH, 2 * FFN_DIM), 0.02)
    ffn_down_w = nrm((DEPTH, FFN_DIM, D_MODEL), FFN_DIM ** -0.5)
    return {'x_prompt': x_prompt, 'x_sample': x_sample,
            'state_ssm': state_ssm, 'state_ssm_conv': state_ssm_conv, 'state_hgrn': state_hgrn,
            'state_s5_re': state_s5_re, 'state_s5_im': state_s5_im, 'state_ffn_conv': state_ffn_conv,
            'norm_mix_pre': norm_mix_pre, 'norm_mix_post': norm_mix_post,
            'norm_ffn_pre': norm_ffn_pre, 'norm_ffn_post': norm_ffn_post,
            'ab_in_w': ab_in_w, 'ssm_conv_w': ssm_conv_w, 'ssm_conv_b': ssm_conv_b,
            'ssm_dt_bias': ssm_dt_bias, 'ssm_a_log': ssm_a_log, 'ssm_d': ssm_d, 'ssm_norm_w': ssm_norm_w,
            'hgrn_lb': hgrn_lb, 'hgrn_norm_w': hgrn_norm_w, 'ab_out_w': ab_out_w,
            's5_lam_re': s5_lam_re, 's5_lam_im': s5_lam_im, 's5_log_step': s5_log_step,
            's5_b_re': s5_b_re, 's5_b_im': s5_b_im, 's5_c_re': s5_c_re, 's5_c_im': s5_c_im,
            's5_d': s5_d, 's5_glu_w': s5_glu_w,
            'ffn_up_w': ffn_up_w, 'ffn_conv_w': ffn_conv_w, 'ffn_conv_b': ffn_conv_b, 'ffn_down_w': ffn_down_w}


def reference(x_prompt, x_sample, state_ssm, state_ssm_conv, state_hgrn, state_s5_re, state_s5_im, state_ffn_conv,
              norm_mix_pre, norm_mix_post, norm_ffn_pre, norm_ffn_post,
              ab_in_w, ssm_conv_w, ssm_conv_b, ssm_dt_bias, ssm_a_log, ssm_d, ssm_norm_w,
              hgrn_lb, hgrn_norm_w, ab_out_w,
              s5_lam_re, s5_lam_im, s5_log_step, s5_b_re, s5_b_im, s5_c_re, s5_c_im, s5_d, s5_glu_w,
              ffn_up_w, ffn_conv_w, ffn_conv_b, ffn_down_w):
    w = dict(norm_mix_pre=norm_mix_pre, norm_mix_post=norm_mix_post,
             norm_ffn_pre=norm_ffn_pre, norm_ffn_post=norm_ffn_post,
             ab_in_w=ab_in_w, ssm_conv_w=ssm_conv_w, ssm_conv_b=ssm_conv_b, ssm_dt_bias=ssm_dt_bias,
             ssm_a_log=ssm_a_log, ssm_d=ssm_d, ssm_norm_w=ssm_norm_w,
             hgrn_lb=hgrn_lb, hgrn_norm_w=hgrn_norm_w, ab_out_w=ab_out_w,
             s5_lam_re=s5_lam_re, s5_lam_im=s5_lam_im, s5_log_step=s5_log_step,
             s5_b_re=s5_b_re, s5_b_im=s5_b_im, s5_c_re=s5_c_re, s5_c_im=s5_c_im, s5_d=s5_d, s5_glu_w=s5_glu_w,
             ffn_up_w=ffn_up_w, ffn_conv_w=ffn_conv_w, ffn_conv_b=ffn_conv_b, ffn_down_w=ffn_down_w)
    pd = x_prompt.dtype
    y_prompt, (p_ssm, p_sconv, p_hg, p_s5r, p_s5i, p_fconv) = trunk(
        x_prompt,
        jnp.zeros((N_EVEN, BATCH, SSM_HEADS, SSM_HEAD_DIM, SSM_STATE), pd),
        jnp.zeros((N_EVEN, BATCH, SSM_CONV - 1, SSM_CONV_DIM), pd),
        jnp.zeros((N_EVEN, BATCH, HG_HEADS, HG_DIM, HG_DIM), pd),
        jnp.zeros((N_ODD, BATCH, S5_GROUPS, S5_STATE), pd),
        jnp.zeros((N_ODD, BATCH, S5_GROUPS, S5_STATE), pd),
        jnp.zeros((DEPTH, BATCH, FFN_CONV - 1, 2 * FFN_DIM), pd),
        w)
    y_sample, (s_ssm, s_sconv, s_hg, s_s5r, s_s5i, s_fconv) = trunk(
        x_sample, state_ssm, state_ssm_conv, state_hgrn, state_s5_re, state_s5_im, state_ffn_conv, w)
    return (y_prompt, y_sample, p_ssm, p_sconv, p_hg, p_s5r, p_s5i, p_fconv,
            s_ssm, s_sconv, s_hg, s_s5r, s_s5i, s_fconv)
```

```cpp
#include <hip/hip_runtime.h>
#include <cstdio>
#include <cstdint>

#ifndef MK_ONE_LAUNCH
#define MK_ONE_LAUNCH 0
#endif

namespace pg8 {
#define PG8_LAS __attribute__((address_space(3)))
typedef unsigned short bf16_t;
typedef short bf16x8 __attribute__((ext_vector_type(8)));
typedef float f32x4 __attribute__((ext_vector_type(4)));
typedef unsigned u32x4 __attribute__((ext_vector_type(4)));
typedef float f32x2 __attribute__((ext_vector_type(2)));
constexpr int BM = 256, BK = 64, HALF = 128, HTB = HALF * BK * 2  , STAGE_BYTES = 8 * HTB, NXCD = 8, WGM = 8;

__host__ __device__ __forceinline__ int lds_byte(int r, int c) { const int st = (r >> 4) * 2 + (c >> 5), rr = r & 15, cc = c & 31, ob = rr * 64 + cc * 2; return st * 1024 + (ob ^ (((ob >> 9) & 1) << 5)); }
__host__ __device__ __forceinline__ void stage_rc(int b, int& R, int& C) { const int st = b / 1024, sb = b % 1024, swz = sb ^ (((sb >> 9) & 1) << 5); R = (st >> 1) * 16 + swz / 64; C = (st & 1) * 32 + (swz % 64) / 2; }
__host__ __device__ __forceinline__ int perm32(int rho) { const int n = rho >> 4, i = rho & 15; return 8 * (i >> 2) + 4 * n + (i & 3); }

struct Unit { int pm, pn; };
struct Gemm { const bf16_t* A; const bf16_t* Bt; int M, N, K; };

struct StaticOrder {
    int nM, nN, nwg, G, c;
    __host__ __device__ void init(int M, int N, int G_, int c_) { nM = M / BM; nN = N / BM; nwg = nM * nN; G = G_; c = c_; }
    __host__ __device__ bool next(int i, Unit& u) const {
        const long L = (long)i * G + c; if (L >= nwg) return false;
        int wgid = (int)L; { const int q = nwg / NXCD, r = nwg % NXCD, xcd = wgid % NXCD, off = wgid / NXCD; wgid = (xcd < r ? xcd * (q + 1) : r * (q + 1) + (xcd - r) * q) + off; }
        const int nig = WGM * nN, gid = wgid / nig, fm = gid * WGM, gsz = (nM - fm) < WGM ? (nM - fm) : WGM;
        u.pm = fm + ((wgid % nig) % gsz); u.pn = (wgid % nig) / gsz; return true;
    }
    __device__ __forceinline__ void a_ready(const Unit&) const {}
    __device__ __forceinline__ void done(const Unit&) const {}
};

__device__ __forceinline__ unsigned cvt_pk_bf16(float lo, float hi) { unsigned r; asm volatile("v_cvt_pk_bf16_f32 %0, %1, %2" : "=v"(r) : "v"(lo), "v"(hi)); return r; }

struct EpiF32 {
    static constexpr bool PERM = false, AFTER_DRAIN = false;
    float* C; int ldc;
    __device__ __forceinline__ void operator()(const f32x4 (&acc)[2][2][4][2], const Unit& u, int wr, int wc, int fr, int fq) const {
        const int row0 = u.pm * BM + wr * 64 + fr, col0 = u.pn * BM + wc * 32 + 4 * fq;
#pragma unroll
        for (int ai = 0; ai < 2; ++ai)
#pragma unroll
            for (int m = 0; m < 4; ++m) { float* rowp = C + (size_t)(row0 + ai * HALF + m * 16) * ldc + col0;
#pragma unroll
                for (int bj = 0; bj < 2; ++bj)
#pragma unroll
                    for (int n = 0; n < 2; ++n) *(f32x4*)(rowp + bj * HALF + n * 16) = acc[ai][bj][m][n]; }
    }
};
struct EpiBf16 {
    static constexpr bool PERM = true, AFTER_DRAIN = false;
    bf16_t* O; int ldc;
    __device__ __forceinline__ void operator()(const f32x4 (&acc)[2][2][4][2], const Unit& u, int wr, int wc, int fr, int fq) const {
        const int row0 = u.pm * BM + wr * 64 + fr, col0 = u.pn * BM + wc * 32 + 8 * fq;
#pragma unroll
        for (int ai = 0; ai < 2; ++ai)
#pragma unroll
            for (int m = 0; m < 4; ++m) { bf16_t* rowp = O + (size_t)(row0 + ai * HALF + m * 16) * ldc + col0;
#pragma unroll
                for (int bj = 0; bj < 2; ++bj) { const f32x4 v0 = acc[ai][bj][m][0], v1 = acc[ai][bj][m][1];
                    u32x4 w; w.x = cvt_pk_bf16(v0[0], v0[1]); w.y = cvt_pk_bf16(v0[2], v0[3]); w.z = cvt_pk_bf16(v1[0], v1[1]); w.w = cvt_pk_bf16(v1[2], v1[3]);
                    *(u32x4*)(rowp + bj * HALF) = w; } }
    }
};
struct EpiGlu {
    static constexpr bool PERM = false, AFTER_DRAIN = false;
    float* C; int ldc;
    __device__ __forceinline__ void operator()(const f32x4 (&acc)[2][2][4][2], const Unit& u, int wr, int wc, int fr, int fq) const {
        const int row0 = u.pm * BM + wr * 64 + fr, col0 = u.pn * HALF + wc * 32 + 4 * fq;
#pragma unroll
        for (int ai = 0; ai < 2; ++ai)
#pragma unroll
            for (int m = 0; m < 4; ++m) { float* rowp = C + (size_t)(row0 + ai * HALF + m * 16) * ldc + col0;
#pragma unroll
                for (int n = 0; n < 2; ++n) { const f32x4 v = acc[ai][0][m][n], g = acc[ai][1][m][n]; f32x4 o;
#pragma unroll
                    for (int j = 0; j < 4; ++j) o[j] = v[j] / (1.0f + __expf(-g[j]));
                    *(f32x4*)(rowp + n * 16) = o; } }
    }
};


struct EpiAny {
    static constexpr bool AFTER_DRAIN = false;
    int mode; bool perm; void* O; int ldc;
    __device__ __forceinline__ void operator()(const f32x4 (&acc)[2][2][4][2], const Unit& u, int wr, int wc, int fr, int fq) const {
        if (mode == 0) { EpiBf16 e{(bf16_t*)O, ldc}; e(acc, u, wr, wc, fr, fq); }
        else if (mode == 1) { EpiF32 e{(float*)O, ldc}; e(acc, u, wr, wc, fr, fq); }
        else { EpiGlu e{(float*)O, ldc}; e(acc, u, wr, wc, fr, fq); }
    }
};
template <class Epi, class Sched>
__device__ __forceinline__ void gemm_phase(PG8_LAS unsigned char* lds, const Gemm g, const Sched& S, const Epi& E, const int tid) {
    const int wid = __builtin_amdgcn_readfirstlane(tid >> 6), lane = tid & 63, wr = wid >> 2, wc = wid & 3, fr = lane & 15, fq = lane >> 4;
    const int K = g.K, nt = K / BK;
    unsigned voffA[2], voffB[2];
#pragma unroll
    for (int i = 0; i < 2; ++i) { int R, C; stage_rc(tid * 16 + i * 8192, R, C); const int Rb = E.perm ? ((R & ~31) + perm32(R & 31)) : R;
        voffA[i] = (unsigned)(R * K + C) * 2u; voffB[i] = (unsigned)(Rb * K + C) * 2u; }
    const size_t kstep = (size_t)(BK * 2);
    const size_t hstep = (size_t)HALF * K * 2;
    const size_t tstep = 2 * hstep;
    const unsigned ldsw = (unsigned)wid * 1024u;
    const int aoff = lds_byte(wr * 64 + fr, fq * 8), boff = lds_byte(wc * 32 + fr, fq * 8);
#define PG8_SA(b, h) (((b) * 2 + (h)) * HTB)
#define PG8_SB(b, h) ((4 + (b) * 2 + (h)) * HTB)
#define PG8_STAGE(bufoff, gbase, voff) do { _Pragma("unroll") for (int _i = 0; _i < 2; ++_i) \
        __builtin_amdgcn_global_load_lds((const unsigned*)((const char*)(gbase) + (voff)[_i]), (PG8_LAS unsigned*)(lds + (bufoff) + ldsw + _i * 8192), 16, 0, 0); } while (0)
#define PG8_LDA(dst, b, h) do { _Pragma("unroll") for (int m = 0; m < 4; ++m) _Pragma("unroll") for (int k = 0; k < 2; ++k) dst[m][k] = *(const PG8_LAS bf16x8*)(lds + PG8_SA(b, h) + aoff + m * 2048 + k * 1024); } while (0)
#define PG8_LDB(dst, b, h) do { _Pragma("unroll") for (int n = 0; n < 2; ++n) _Pragma("unroll") for (int k = 0; k < 2; ++k) dst[n][k] = *(const PG8_LAS bf16x8*)(lds + PG8_SB(b, h) + boff + n * 2048 + k * 1024); } while (0)
#define PG8_MMA(ai, bj, At, Bt) do { __builtin_amdgcn_s_setprio(1); _Pragma("unroll") for (int m = 0; m < 4; ++m) _Pragma("unroll") for (int n = 0; n < 2; ++n) _Pragma("unroll") for (int k = 0; k < 2; ++k) \
        acc[ai][bj][m][n] = __builtin_amdgcn_mfma_f32_16x16x32_bf16(Bt[n][k], At[m][k], acc[ai][bj][m][n], 0, 0, 0); __builtin_amdgcn_s_setprio(0); } while (0)
#define PG8_WAIT_V(n) asm volatile("s_waitcnt vmcnt(" #n ")" ::: "memory")
#define PG8_WAIT_L(n) asm volatile("s_waitcnt lgkmcnt(" #n ")" ::: "memory")
#define PG8_BAR __builtin_amdgcn_s_barrier()
#define PG8_SCHED __builtin_amdgcn_sched_barrier(0)
    Unit cur, nxt; int ui = 0;
    if (!S.next(0, cur)) return;
    f32x4 acc[2][2][4][2];
#pragma unroll
    for (int a = 0; a < 2; ++a)
#pragma unroll
        for (int b = 0; b < 2; ++b)
#pragma unroll
            for (int m = 0; m < 4; ++m)
#pragma unroll
                for (int n = 0; n < 2; ++n) acc[a][b][m][n] = (f32x4){0.f, 0.f, 0.f, 0.f};
    bf16x8 At[4][2], B0[2][2], B1[2][2];
    const char* cA = (const char*)g.A + (size_t)cur.pm * tstep; const char* cB = (const char*)g.Bt + (size_t)cur.pn * tstep;
    S.a_ready(cur);
    PG8_STAGE(PG8_SB(0, 0), cB, voffB); PG8_STAGE(PG8_SA(0, 0), cA, voffA); PG8_STAGE(PG8_SB(0, 1), cB + hstep, voffB); PG8_STAGE(PG8_SA(0, 1), cA + hstep, voffA);
    if (wr == 1) PG8_BAR;
    PG8_WAIT_V(4); PG8_BAR;
    PG8_STAGE(PG8_SB(1, 0), cB + kstep, voffB); PG8_STAGE(PG8_SA(1, 0), cA + kstep, voffA); PG8_STAGE(PG8_SB(1, 1), cB + hstep + kstep, voffB);
    PG8_WAIT_V(6); PG8_BAR;
    for (;;) {
        const bool has_next = S.next(ui + 1, nxt);
        const char* nA = has_next ? (const char*)g.A + (size_t)nxt.pm * tstep : cA; const char* nB = has_next ? (const char*)g.Bt + (size_t)nxt.pn * tstep : cB;
        for (int t = 0; t < nt; t += 2) {
            const bool last = (t == nt - 2);
            const char* a1 = cA + (size_t)(t + 1) * kstep;
            const char* a2 = last ? nA : cA + (size_t)(t + 2) * kstep; const char* b2 = last ? nB : cB + (size_t)(t + 2) * kstep;
            const char* a3 = a2 + kstep; const char* b3 = b2 + kstep;
            if (last && has_next) S.a_ready(nxt);
            PG8_LDB(B0, 0, 0); PG8_SCHED; PG8_LDA(At, 0, 0); PG8_STAGE(PG8_SA(1, 1), a1 + hstep, voffA);
            PG8_WAIT_L(8); PG8_BAR; PG8_WAIT_L(0); PG8_MMA(0, 0, At, B0); PG8_BAR; PG8_SCHED;
            PG8_LDB(B1, 0, 1); PG8_STAGE(PG8_SB(0, 0), b2, voffB);
            PG8_BAR; PG8_WAIT_L(0); PG8_MMA(0, 1, At, B1); PG8_BAR;
            PG8_LDA(At, 0, 1); PG8_STAGE(PG8_SA(0, 0), a2, voffA);
            PG8_BAR; PG8_WAIT_L(0); PG8_MMA(1, 0, At, B0); PG8_BAR; PG8_SCHED;
            PG8_STAGE(PG8_SB(0, 1), b2 + hstep, voffB);
            PG8_WAIT_V(6); PG8_BAR; PG8_MMA(1, 1, At, B1); PG8_BAR;
            PG8_LDB(B0, 1, 0); PG8_SCHED; PG8_LDA(At, 1, 0); PG8_STAGE(PG8_SA(0, 1), a2 + hstep, voffA);
            PG8_WAIT_L(8); PG8_BAR; PG8_WAIT_L(0); PG8_MMA(0, 0, At, B0); PG8_BAR; PG8_SCHED;
            PG8_LDB(B1, 1, 1); PG8_STAGE(PG8_SB(1, 0), b3, voffB);
            PG8_BAR; PG8_WAIT_L(0); PG8_MMA(0, 1, At, B1); PG8_BAR;
            PG8_LDA(At, 1, 1); PG8_STAGE(PG8_SA(1, 0), a3, voffA);
            PG8_BAR; PG8_WAIT_L(0); PG8_MMA(1, 0, At, B0); PG8_BAR; PG8_SCHED;
            PG8_STAGE(PG8_SB(1, 1), b3 + hstep, voffB);
            PG8_WAIT_V(6); PG8_BAR; PG8_MMA(1, 1, At, B1); PG8_BAR;
        }
        if constexpr (!Epi::AFTER_DRAIN) { E(acc, cur, wr, wc, fr, fq); S.done(cur); }
        if (!has_next) break;
#pragma unroll
        for (int a = 0; a < 2; ++a)
#pragma unroll
            for (int b = 0; b < 2; ++b)
#pragma unroll
                for (int m = 0; m < 4; ++m)
#pragma unroll
                    for (int n = 0; n < 2; ++n) acc[a][b][m][n] = (f32x4){0.f, 0.f, 0.f, 0.f};
        cur = nxt; cA = nA; cB = nB; ++ui;
    }
    PG8_WAIT_V(0);
    if (wr == 0) PG8_BAR;
    PG8_BAR;
    if constexpr (Epi::AFTER_DRAIN) { E.fused(acc, cur, wr, wc, fr, fq, lds, wid, lane); S.done(cur); }
#undef PG8_SA
#undef PG8_SB
#undef PG8_STAGE
#undef PG8_LDA
#undef PG8_LDB
#undef PG8_MMA
#undef PG8_WAIT_V
#undef PG8_WAIT_L
#undef PG8_BAR
#undef PG8_SCHED
}
}

constexpr int NWAVES = 8, NTHR = 512;
constexpr int D = 1024, NB = 8, SEQ = 2048, MP = NB * SEQ, MS = 128, MT = MP + MS;
constexpr int NA = 2560, NBH = 4096;
constexpr int WIN_ROWS = NA + NBH;
constexpr int XBC = 1280, ABIN = 6416;
constexpr int FF = 2816, FF2 = 5632, NFT = 22;
constexpr float EPS = 1e-6f;
constexpr int NPH = 30;

constexpr size_t O_YP = 0, O_YS = O_YP + (size_t)MP * D, O_PSSM = O_YS + (size_t)MS * D, O_PSCONV = O_PSSM + 8 * 16 * 64 * 64, O_PHG = O_PSCONV + 8 * 3 * XBC,
                 O_PS5R = O_PHG + 8 * 8 * 128 * 128, O_PS5I = O_PS5R + 8 * 64 * 64, O_PFC = O_PS5I + 8 * 64 * 64, O_SSSM = O_PFC + 2 * 8 * 2 * FF2,
                 O_SSCONV = O_SSSM + (size_t)MS * 16 * 64 * 64, O_SHG = O_SSCONV + (size_t)MS * 3 * XBC, O_SS5R = O_SHG + (size_t)MS * 8 * 128 * 128,
                 O_SS5I = O_SS5R + (size_t)MS * 64 * 64, O_SFC = O_SS5I + (size_t)MS * 64 * 64, O_END = O_SFC + (size_t)2 * MS * 2 * FF2;
static_assert(O_END == 48347136, "d_out size");

constexpr size_t al256(size_t x) { return (x + 255) & ~(size_t)255; }
constexpr size_t WS_CTL = 0, CTL_BYTES = 1u << 20;
constexpr size_t WS_WIN = CTL_BYTES;
constexpr size_t WS_WOUT = WS_WIN + (size_t)WIN_ROWS * D * 2;
constexpr size_t WS_WGLU = WS_WOUT + (size_t)D * 2048 * 2;
constexpr size_t WS_WUP = WS_WGLU + (size_t)2048 * D * 2;
constexpr size_t WS_WDN = WS_WUP + (size_t)2 * FF2 * D * 2;
constexpr size_t WS_XN = WS_WDN + (size_t)2 * D * FF * 2;
constexpr size_t WS_MIXS = WS_XN + (size_t)MT * D * 2;
constexpr size_t WS_BIG = al256(WS_MIXS + (size_t)MS * 2048 * 2);
constexpr size_t WS_END = (size_t)256 << 20;
constexpr size_t BIG_BYTES = WS_END - WS_BIG;
constexpr size_t B_PROJA = 0;
constexpr size_t B_Y2 = al256(B_PROJA + (size_t)MT * NA * 2);
constexpr size_t B_ORAW = 0;
constexpr size_t B_PROJB = al256(B_ORAW + (size_t)MT * D * 2);
constexpr size_t B_M1 = 0;
constexpr size_t B_UP = 0;
constexpr size_t B_ACT = al256((size_t)MT * 2048 * 2);
constexpr size_t B_GY = 0;
constexpr size_t B_PC = al256(B_GY + (size_t)MT * D * 2);
constexpr size_t B_XP = al256(B_PC + (size_t)1024 * 8192 * 4);
constexpr size_t B_M1G = al256(B_GY + (size_t)MT * D * 2);
constexpr size_t B_S5T = (size_t)120 << 20;
constexpr size_t S5T_KQ = 0, S5T_PM = S5T_KQ + (size_t)64 * 256 * 384 * 2, S5T_END = S5T_PM + (size_t)64 * 128 * 256 * 2;
static_assert(B_Y2 + (size_t)MT * D * 4 <= BIG_BYTES, "ssd stage");
static_assert(B_PROJB + (size_t)MT * NBH * 2 <= BIG_BYTES, "hgrn stage");
static_assert(B_ACT + (size_t)MT * FF * 2 <= BIG_BYTES, "ffn stage");
static_assert(B_XP + (size_t)1024 * 8192 * 2 <= B_S5T && B_M1G + (size_t)MT * D * 4 <= BIG_BYTES && B_S5T + S5T_END <= BIG_BYTES && B_S5T >= B_M1 + (size_t)MT * D * 4, "s5 stage");

#define GAS __attribute__((address_space(1)))
#define LAS __attribute__((address_space(3)))
typedef unsigned short bf16;
typedef unsigned v4u __attribute__((ext_vector_type(4)));
typedef unsigned v2u __attribute__((ext_vector_type(2)));
typedef float f32x4 __attribute__((ext_vector_type(4)));
typedef float f32x16 __attribute__((ext_vector_type(16)));
typedef short bf16x8 __attribute__((ext_vector_type(8)));
typedef GAS unsigned gu32;
#define RLX_AGENT __ATOMIC_RELAXED, __HIP_MEMORY_SCOPE_AGENT
#define LDS_WAIT() asm volatile("s_waitcnt lgkmcnt(0)" ::: "memory")
#define VM_WAIT() asm volatile("s_waitcnt vmcnt(0)" ::: "memory")
__device__ __forceinline__ unsigned f2bf(float f) { unsigned u = __builtin_bit_cast(unsigned, f); return (u + 0x7fffu + ((u >> 16) & 1u)) >> 16; }
__device__ __forceinline__ unsigned pk2(float lo, float hi) { return f2bf(lo) | (f2bf(hi) << 16); }
__device__ __forceinline__ float bf2f(unsigned short b) { return __builtin_bit_cast(float, (unsigned)b << 16); }
__device__ __forceinline__ float bflo(unsigned w) { return __builtin_bit_cast(float, w << 16); }
__device__ __forceinline__ float bfhi(unsigned w) { return __builtin_bit_cast(float, w & 0xffff0000u); }
__device__ __forceinline__ float sigmoidf_(float x) { return 1.0f / (1.0f + __expf(-x)); }
__device__ __forceinline__ float siluf_(float x) { return x / (1.0f + __expf(-x)); }
__device__ __forceinline__ float softplusf_(float x) { return x > 20.f ? x : log1pf(__expf(x)); }
__device__ __forceinline__ float gelu_tanh(float x) { const float u = 0.7978845608028654f * (x + 0.044715f * x * x * x); const float e = __expf(2.f * u); const float th = 1.f - 2.f / (e + 1.f); return 0.5f * x * (1.f + th); }
__device__ __forceinline__ float wave_sum(float v) {
#pragma unroll
    for (int o = 1; o < 64; o <<= 1) v += __shfl_xor(v, o);
    return v;
}

#define XB_TMO      128
#define XB_XCNT(j)  (256  + 64 * (j))
#define XB_XSUB(j)  (1280 + 64 * (j))
#define XB_XGEN(j)  (2304 + 64 * (j))
#define XB_TOP      3328
#define XB_TOPGEN   3392
#define XCD_BAR_WORDS 3456
#define XB_SPIN_CAP (1u << 18)
__device__ __forceinline__ unsigned xb_ld(unsigned* p)              { return __hip_atomic_load(p, __ATOMIC_RELAXED, __HIP_MEMORY_SCOPE_AGENT); }
__device__ __forceinline__ unsigned xb_add(unsigned* p, unsigned v) { return __hip_atomic_fetch_add(p, v, __ATOMIC_RELAXED, __HIP_MEMORY_SCOPE_AGENT); }
__device__ __forceinline__ unsigned xb_xcc_id() { return (unsigned)__builtin_amdgcn_s_getreg((3 << 11) | 20) & 0xFu; }
#define XB_SPIN(cond, bar) do { unsigned _sp = 0; while (cond) { __builtin_amdgcn_s_sleep(1); \
    if ((++_sp & 255u) == 0u) { if (xb_ld(&(bar)[XB_TMO])) break; if (_sp > XB_SPIN_CAP) { atomicAdd(&(bar)[XB_TMO], 1u); break; } } } } while (0)
struct XcdBarrier { unsigned* bar; unsigned x; volatile LAS unsigned* st; };
__device__ __forceinline__ XcdBarrier xcd_barrier_post(unsigned* bar, volatile LAS unsigned* st) {
    XcdBarrier b; b.bar = bar; b.x = xb_xcc_id(); b.st = st;
    if (threadIdx.x == 0) (void)xb_add(&bar[XB_XCNT(b.x)], 1u);
    return b;
}
__device__ __forceinline__ void xcd_barrier_complete(unsigned* bar, unsigned x, unsigned& nloc, unsigned& nx) {
    const unsigned G = gridDim.x * gridDim.y * gridDim.z;
    unsigned sum, cnt, mine, sp = 0u;
    for (;;) {
        sum = 0u; cnt = 0u; mine = 0u;
#pragma unroll
        for (unsigned j = 0; j < 16; ++j) { const unsigned c = xb_ld(&bar[XB_XCNT(j)]); sum += c; cnt += (c > 0u) ? 1u : 0u; mine = (j == x) ? c : mine; }
        if (sum == G) break;
        __builtin_amdgcn_s_sleep(1);
        if ((++sp & 255u) == 0u) { if (xb_ld(&bar[XB_TMO])) break; if (sp > XB_SPIN_CAP) { atomicAdd(&bar[XB_TMO], 1u); break; } }
    }
    nloc = mine > 0u ? mine : 1u; nx = cnt > 0u ? cnt : 1u;
}
__device__ __forceinline__ void xcd_barrier(const XcdBarrier& b) {
    asm volatile("s_waitcnt vmcnt(0)" ::: "memory");
    __syncthreads();
    if (threadIdx.x == 0) {
        unsigned* bar = b.bar;
        __builtin_amdgcn_s_waitcnt(0);
        unsigned nloc = b.st[0], nx = b.st[1];
        if (nloc == 0u) { xcd_barrier_complete(bar, b.x, nloc, nx); b.st[0] = nloc; b.st[1] = nx; }
        const unsigned old = xb_add(&bar[XB_XSUB(b.x)], 1u);
        const unsigned gen = old / nloc;
        if (old + 1u == (gen + 1u) * nloc) {
            __builtin_amdgcn_fence(__ATOMIC_RELEASE, "agent");
            asm volatile("s_waitcnt vmcnt(0)" ::: "memory");
            const unsigned og = xb_add(&bar[XB_TOP], 1u);
            const unsigned tg = og / nx;
            if (og + 1u == (tg + 1u) * nx) xb_add(&bar[XB_TOPGEN], 1u);
            else XB_SPIN(xb_ld(&bar[XB_TOPGEN]) == tg, bar);
            __builtin_amdgcn_fence(__ATOMIC_ACQUIRE, "agent");
            xb_add(&bar[XB_XGEN(b.x)], 1u);
            asm volatile("s_waitcnt vmcnt(0)" ::: "memory");
        } else {
            XB_SPIN(xb_ld(&bar[XB_XGEN(b.x)]) == gen, bar);
            __builtin_amdgcn_fence(__ATOMIC_ACQUIRE, "agent");
            asm volatile("s_waitcnt vmcnt(0)" ::: "memory");
        }
    }
    __syncthreads();
}

constexpr int RING_BYTES = 131072;
constexpr int LDSCTL_OFF = RING_BYTES, MISC_OFF = LDSCTL_OFF + 320;
constexpr int LDS_BYTES = 147456;

struct Args { const float* in[35]; float* out; unsigned char* ws; int ph_lo, ph_hi; };
static_assert(sizeof(Args) == 35 * 8 + 8 + 8 + 8, "Args has no padding");
#define CAS __attribute__((address_space(4)))
struct Frame {
    LAS unsigned char* lds;
    int tid, lane, wave, vcu, G;
    const CAS Args* a;
    float* out;
    unsigned char* ws;
};

enum { I_XP = 0, I_XS, I_SSSM, I_SSCONV, I_SHG, I_SS5R, I_SS5I, I_SFC, I_NMPRE, I_NMPOST, I_NFPRE, I_NFPOST, I_WIN, I_CONVW, I_CONVB, I_DTB, I_ALOG, I_SSMD, I_SSMNW,
       I_HGLB, I_HGNW, I_WOUT, I_LAMRE, I_LAMIM, I_LOGSTEP, I_BRE, I_BIM, I_CRE, I_CIM, I_S5D, I_WGLU, I_WUP, I_FCW, I_FCB, I_WDN, N_IN };

#define GW_ID(F) ((F).vcu * NWAVES + (F).wave)
#define GW_N(F) ((F).G * NWAVES)

__device__ __forceinline__ void p0_transpose_item(const float* W, int ldw, int K, int scol0, bf16* WT, int drow0, int kb, LAS float* scr, int lane) {
    const int k0 = 64 * kb;
#pragma unroll 8
    for (int i = 0; i < 32; ++i) { const int kk = 2 * i + (lane >> 5); scr[kk * 33 + (lane & 31)] = W[(size_t)(k0 + kk) * ldw + scol0 + (lane & 31)]; }
    LDS_WAIT(); asm volatile("" ::: "memory");
    const int c = lane & 7;
#pragma unroll
    for (int j = 0; j < 4; ++j) { const int n = (lane >> 3) + 8 * j; const LAS float* s = scr + (8 * c) * 33 + n;
        v4u o; o.x = pk2(s[0 * 33], s[1 * 33]); o.y = pk2(s[2 * 33], s[3 * 33]); o.z = pk2(s[4 * 33], s[5 * 33]); o.w = pk2(s[6 * 33], s[7 * 33]);
        *(GAS v4u*)(WT + (size_t)(drow0 + n) * K + k0 + 8 * c) = o; }
    LDS_WAIT(); asm volatile("" ::: "memory");
}
__device__ __forceinline__ void rms_row_to_bf16(const float* xrow, const float* w, bf16* orow, int lane) {
    const GAS f32x4* xr = (const GAS f32x4*)xrow + lane; const GAS f32x4* wr = (const GAS f32x4*)w + lane;
    f32x4 v[4]; float s = 0.f;
#pragma unroll
    for (int j = 0; j < 4; ++j) { v[j] = xr[64 * j]; s += (v[j].x * v[j].x + v[j].y * v[j].y) + (v[j].z * v[j].z + v[j].w * v[j].w); }
    const float rs = rsqrtf(wave_sum(s) * (1.f / D) + EPS);
    GAS v2u* o8 = (GAS v2u*)orow + lane;
#pragma unroll
    for (int j = 0; j < 4; ++j) { const f32x4 ww = wr[64 * j]; v2u o; o.x = pk2(v[j].x * rs * ww.x, v[j].y * rs * ww.y); o.y = pk2(v[j].z * rs * ww.z, v[j].w * rs * ww.w); o8[64 * j] = o; }
}
__device__ __forceinline__ const float* x_in_row(const Frame& F, int r) { return r < MP ? F.a->in[I_XP] + (size_t)r * D : F.a->in[I_XS] + (size_t)(r - MP) * D; }
__device__ __forceinline__ float* x_res_row(const Frame& F, int r) { return r < MP ? F.out + O_YP + (size_t)r * D : F.out + O_YS + (size_t)(r - MP) * D; }

__device__ __forceinline__ void p0_prologue(Frame& F) {
    LAS float* scr = (LAS float*)(F.lds + F.wave * 16384);
    const int gw = GW_ID(F), NGW = GW_N(F);
    bf16* WIN = (bf16*)(F.ws + WS_WIN); bf16* WOUT = (bf16*)(F.ws + WS_WOUT); bf16* WGLU = (bf16*)(F.ws + WS_WGLU); bf16* WUP = (bf16*)(F.ws + WS_WUP); bf16* WDN = (bf16*)(F.ws + WS_WDN);
    constexpr int I_IN = 16 * 200, I_OUT = 32 * 32, I_GLU = 16 * 64, I_UP = 16 * 176, I_DN = 44 * 32;
    constexpr int NITEMS = I_IN + I_OUT + I_GLU + 2 * I_UP + 2 * I_DN;
    for (int it = gw; it < NITEMS; it += NGW) {
        int r = it;
        if (r < I_IN) { const int kb = r / 200, nb = r % 200;
            const int sc = nb < 72 ? 32 * nb : 2320 + 32 * (nb - 72);
            const int dr = nb < 72 ? 32 * nb : NA + 32 * (nb - 72);
            p0_transpose_item(F.a->in[I_WIN], ABIN, D, sc, WIN, dr, kb, scr, F.lane); continue; }
        r -= I_IN;
        if (r < I_OUT) { p0_transpose_item(F.a->in[I_WOUT], D, 2048, 32 * (r % 32), WOUT, 32 * (r % 32), r / 32, scr, F.lane); continue; }
        r -= I_OUT;
        if (r < I_GLU) { const int kb = r / 64, nb = r % 64, d = 32 * nb, j = d >> 8, bj = (d >> 7) & 1, c = d & 127;
            p0_transpose_item(F.a->in[I_WGLU], 2048, D, 1024 * bj + 128 * j + c, WGLU, d, kb, scr, F.lane); continue; }
        r -= I_GLU;
        if (r < 2 * I_UP) { const int l = r / I_UP; r -= l * I_UP; const int kb = r / 176, nb = r % 176, d = 32 * nb, j = d >> 8, bj = (d >> 7) & 1, c = d & 127;
            p0_transpose_item(F.a->in[I_WUP] + (size_t)l * D * FF2, FF2, D, FF * bj + 128 * j + c, WUP + (size_t)l * FF2 * D, d, kb, scr, F.lane); continue; }
        r -= 2 * I_UP;
        { const int l = r / I_DN; r -= l * I_DN; p0_transpose_item(F.a->in[I_WDN] + (size_t)l * FF * D, D, FF, 32 * (r % 32), WDN + (size_t)l * D * FF, 32 * (r % 32), r / 32, scr, F.lane); }
    }
    { const int gt = (F.vcu * NTHR + F.tid), NT = F.G * NTHR;
      for (int i = gt; i < 16 * D; i += NT) { const int n = i >> 10, k = i & 1023; WIN[(size_t)(2304 + n) * D + k] = (bf16)f2bf(F.a->in[I_WIN][(size_t)k * ABIN + 2304 + n]); }
      for (int i = gt; i < 240 * D / 8; i += NT) ((GAS v4u*)(WIN + (size_t)2320 * D))[i] = (v4u){0u, 0u, 0u, 0u}; }
    bf16* XN = (bf16*)(F.ws + WS_XN);
    for (int m = gw; m < MT; m += NGW) rms_row_to_bf16(x_in_row(F, m), F.a->in[I_NMPRE], XN + (size_t)m * D, F.lane);
}

template <int NT, bool GLU, class Epi>
__device__ __forceinline__ void skinny_gemm(Frame& F, const bf16* A, int lda, const bf16* Bt, int K, int ncb, const Epi& epi) {
    LAS float* red = (LAS float*)F.lds;
    const int lane = F.lane, r = lane & 31, h = lane >> 5, w = F.wave;
    const int kper = K >> 3, kbeg = w * kper;
    const int ntask = 4 * ncb;
    for (int task = F.vcu; task < ntask; task += F.G) {
        const int rt = task & 3, ct = task >> 2;
        const int brow = GLU ? (256 * (ct >> 2) + 32 * (ct & 3)) : 32 * ct;
        const bf16* ap = A + (size_t)(rt * 32 + r) * lda + kbeg + 8 * h;
        const bf16* bp = Bt + (size_t)(brow + r) * K + kbeg + 8 * h;
        f32x16 acc[NT];
#pragma unroll
        for (int nt = 0; nt < NT; ++nt)
#pragma unroll
            for (int i = 0; i < 16; ++i) acc[nt][i] = 0.f;
#pragma unroll 2
        for (int k = 0; k < kper; k += 16) {
            const bf16x8 a = *(const bf16x8*)(ap + k);
#pragma unroll
            for (int nt = 0; nt < NT; ++nt) { const bf16x8 b = *(const bf16x8*)(bp + (size_t)nt * 128 * K + k); acc[nt] = __builtin_amdgcn_mfma_f32_32x32x16_bf16(a, b, acc[nt], 0, 0, 0); }
        }
#pragma unroll
        for (int nt = 0; nt < NT; ++nt)
#pragma unroll
            for (int i = 0; i < 16; ++i) red[((w * NT + nt) * 16 + i) * 64 + lane] = acc[nt][i];
        __syncthreads();
#pragma unroll
        for (int e0 = 0; e0 < 2; ++e0) { const int e = F.tid + 512 * e0, i = e >> 6, l = e & 63; float v[NT];
#pragma unroll
            for (int nt = 0; nt < NT; ++nt) { float s = 0.f;
#pragma unroll
                for (int ww = 0; ww < 8; ++ww) s += red[((ww * NT + nt) * 16 + i) * 64 + l];
                v[nt] = s; }
            epi(rt * 32 + (i & 3) + 8 * (i >> 2) + 4 * (l >> 5), ct * 32 + (l & 31), v); }
        __syncthreads();
    }
}
struct SkBf16 { bf16* O; int ld; __device__ __forceinline__ void operator()(int row, int col, const float (&v)[1]) const { O[(size_t)row * ld + col] = (bf16)f2bf(v[0]); } };
struct SkF32 { float* O; int ld; __device__ __forceinline__ void operator()(int row, int col, const float (&v)[1]) const { O[(size_t)row * ld + col] = v[0]; } };
struct SkGlu { float* O; int ld; __device__ __forceinline__ void operator()(int row, int col, const float (&v)[2]) const { O[(size_t)row * ld + col] = v[0] * sigmoidf_(v[1]); } };

__device__ __forceinline__ void resid_norm_rows(Frame& F, const float* msrc, const float* w_post, const float* w_pre, bool from_input) {
    const int gw = GW_ID(F), NGW = GW_N(F), lane = F.lane;
    bf16* XN = (bf16*)(F.ws + WS_XN);
    for (int r = gw; r < MT; r += NGW) {
        const GAS f32x4* mr = (const GAS f32x4*)(msrc + (size_t)r * D) + lane;
        const GAS f32x4* xr = (const GAS f32x4*)(from_input ? x_in_row(F, r) : (const float*)x_res_row(F, r)) + lane;
        GAS f32x4* xo = (GAS f32x4*)x_res_row(F, r) + lane;
        f32x4 m[4], x[4]; float s = 0.f;
#pragma unroll
        for (int j = 0; j < 4; ++j) { m[j] = mr[64 * j]; x[j] = xr[64 * j]; s += (m[j].x * m[j].x + m[j].y * m[j].y) + (m[j].z * m[j].z + m[j].w * m[j].w); }
        const float rs = rsqrtf(wave_sum(s) * (1.f / D) + EPS); float s2 = 0.f;
#pragma unroll
        for (int j = 0; j < 4; ++j) { const f32x4 wp = ((const GAS f32x4*)w_post + lane)[64 * j]; x[j] = x[j] + m[j] * rs * wp; xo[64 * j] = x[j];
            s2 += (x[j].x * x[j].x + x[j].y * x[j].y) + (x[j].z * x[j].z + x[j].w * x[j].w); }
        if (w_pre) { const float rs2 = rsqrtf(wave_sum(s2) * (1.f / D) + EPS); GAS v2u* o8 = (GAS v2u*)(XN + (size_t)r * D) + lane;
#pragma unroll
            for (int j = 0; j < 4; ++j) { const f32x4 ww = ((const GAS f32x4*)w_pre + lane)[64 * j]; v2u o; o.x = pk2(x[j].x * rs2 * ww.x, x[j].y * rs2 * ww.y); o.y = pk2(x[j].z * rs2 * ww.z, x[j].w * rs2 * ww.w); o8[64 * j] = o; } }
    }
}
__device__ __forceinline__ bf16* mixed_row(const Frame& F, int r) { return r < MP ? (bf16*)(F.out + O_YP) + (size_t)r * 2048 : (bf16*)(F.ws + WS_MIXS) + (size_t)(r - MP) * 2048; }
__device__ __forceinline__ void mix_norm_a(Frame& F) {
    const int gw = GW_ID(F), NGW = GW_N(F), lane = F.lane; const float* Y2 = (const float*)(F.ws + WS_BIG + B_Y2);
    for (int r = gw; r < MT; r += NGW) rms_row_to_bf16(Y2 + (size_t)r * D, F.a->in[I_SSMNW], mixed_row(F, r), lane);
}
__device__ __forceinline__ void mix_norm_b(Frame& F) {
    const int gw = GW_ID(F), NGW = GW_N(F), lane = F.lane; const bf16* OR = (const bf16*)(F.ws + WS_BIG + B_ORAW); const bf16* PB = (const bf16*)(F.ws + WS_BIG + B_PROJB);
    const f32x4 nw = ((const GAS f32x4*)F.a->in[I_HGNW])[lane & 31];
    for (int r = gw; r < MT; r += NGW) {
        const GAS v2u* orow = (const GAS v2u*)(OR + (size_t)r * D) + lane; const GAS v2u* grow = (const GAS v2u*)(PB + (size_t)r * NBH + 3072) + lane;
        GAS v2u* mo = (GAS v2u*)(mixed_row(F, r) + 1024) + lane;
#pragma unroll
        for (int j = 0; j < 4; ++j) {
            const v2u ow = orow[64 * j], gwv = grow[64 * j];
            const float o0 = bflo(ow.x), o1 = bfhi(ow.x), o2 = bflo(ow.y), o3 = bfhi(ow.y);
            float s = (o0 * o0 + o1 * o1) + (o2 * o2 + o3 * o3);
#pragma unroll
            for (int o = 1; o < 32; o <<= 1) s += __shfl_xor(s, o);
            const float rs = rsqrtf(s * (1.f / 128.f) + EPS);
            v2u w; w.x = pk2(o0 * rs * nw.x * siluf_(bflo(gwv.x)), o1 * rs * nw.y * siluf_(bfhi(gwv.x))); w.y = pk2(o2 * rs * nw.z * siluf_(bflo(gwv.y)), o3 * rs * nw.w * siluf_(bfhi(gwv.y)));
            mo[64 * j] = w; }
    }
}
__device__ __forceinline__ void ffn_gate(Frame& F, int l, int j0, int j1) {
    const bf16* UP = (const bf16*)(F.ws + WS_BIG + B_UP); bf16* ACT = (bf16*)(F.ws + WS_BIG + B_ACT);
    const int ldu = 256 * (j1 - j0), noct = 16 * (j1 - j0);
    const float* cw = F.a->in[I_FCW] + (size_t)l * 3 * FF2; const float* cb = F.a->in[I_FCB] + (size_t)l * FF2;
    const float* st = F.a->in[I_SFC] + (size_t)l * MS * 2 * FF2;
    float* pfc = F.out + O_PFC + (size_t)l * 8 * 2 * FF2; float* sfc = F.out + O_SFC + (size_t)l * MS * 2 * FF2;
    const long total = (long)MT * noct;
    for (long it = (long)F.vcu * NTHR + F.tid; it < total; it += (long)F.G * NTHR) {
        const int r = (int)(it / noct), oc = (int)(it % noct), jl = oc >> 4, c8 = (oc & 15) * 8, j = j0 + jl;
        const int chv = 128 * j + c8, chg = FF + chv;
        float v[3][8], g[3][8];
        const bf16* up_r = UP + (size_t)r * ldu + 256 * jl + c8;
        const int t = r < MP ? (r & (SEQ - 1)) : 2;
#pragma unroll
        for (int k = 0; k < 3; ++k) {
            const int back = 2 - k;
            if (r >= MP && back > 0) { const float* sp = st + ((size_t)(r - MP) * 2 + (k)) * FF2;
#pragma unroll
                for (int e = 0; e < 8; ++e) { v[k][e] = sp[chv + e]; g[k][e] = sp[chg + e]; } }
            else if (t - back < 0) {
#pragma unroll
                for (int e = 0; e < 8; ++e) { v[k][e] = 0.f; g[k][e] = 0.f; } }
            else { const v4u a = *(const GAS v4u*)(up_r - (size_t)back * ldu), b = *(const GAS v4u*)(up_r - (size_t)back * ldu + 128);
                v[k][0] = bflo(a.x); v[k][1] = bfhi(a.x); v[k][2] = bflo(a.y); v[k][3] = bfhi(a.y); v[k][4] = bflo(a.z); v[k][5] = bfhi(a.z); v[k][6] = bflo(a.w); v[k][7] = bfhi(a.w);
                g[k][0] = bflo(b.x); g[k][1] = bfhi(b.x); g[k][2] = bflo(b.y); g[k][3] = bfhi(b.y); g[k][4] = bflo(b.z); g[k][5] = bfhi(b.z); g[k][6] = bflo(b.w); g[k][7] = bfhi(b.w); }
        }
        float o[8];
#pragma unroll
        for (int e = 0; e < 8; ++e) {
            const float vc = cb[chv + e] + cw[chv + e] * v[0][e] + cw[FF2 + chv + e] * v[1][e] + cw[2 * FF2 + chv + e] * v[2][e];
            const float gc = cb[chg + e] + cw[chg + e] * g[0][e] + cw[FF2 + chg + e] * g[1][e] + cw[2 * FF2 + chg + e] * g[2][e];
            o[e] = vc * siluf_(gc); }
        v4u w; w.x = pk2(o[0], o[1]); w.y = pk2(o[2], o[3]); w.z = pk2(o[4], o[5]); w.w = pk2(o[6], o[7]);
        *(GAS v4u*)(ACT + (size_t)r * FF + chv) = w;
        if (r < MP) { if (t >= SEQ - 2) { float* p = pfc + ((size_t)(r >> 11) * 2 + (t - (SEQ - 2))) * FF2;
#pragma unroll
                for (int e = 0; e < 8; ++e) { p[chv + e] = v[2][e]; p[chg + e] = g[2][e]; } } }
        else { float* p = sfc + (size_t)(r - MP) * 2 * FF2;
#pragma unroll
            for (int e = 0; e < 8; ++e) { p[chv + e] = v[1][e]; p[chg + e] = g[1][e]; p[FF2 + chv + e] = v[2][e]; p[FF2 + chg + e] = g[2][e]; } }
    }
}

__device__ __forceinline__ void ssd_prompt_item(Frame& F, int b, int h) {
    const bf16* PA = (const bf16*)(F.ws + WS_BIG + B_PROJA); float* Y2 = (float*)(F.ws + WS_BIG + B_Y2);
    LAS float* raw = (LAS float*)F.lds;
    LAS float* act = raw + 67 * 192;
    LAS float* dts = act + 64 * 192;
    LAS float* ys = dts + 128;
    const int tid = F.tid, g = h >> 3, p = tid >> 3, nq = tid & 7;
    const float A = -__expf(F.a->in[I_ALOG][h]), Dh = F.a->in[I_SSMD][h], dtb = F.a->in[I_DTB][h];
    const float* cw = F.a->in[I_CONVW]; const float* cbias = F.a->in[I_CONVB];
    float hs[8];
#pragma unroll
    for (int i = 0; i < 8; ++i) hs[i] = 0.f;
    for (int t0 = 0; t0 < SEQ; t0 += 64) {
        for (int e = tid; e < 67 * 192; e += NTHR) { const int rr = e / 192, c = e % 192, t = t0 - 3 + rr;
            const int col = c < 64 ? 1024 + h * 64 + c : (c < 128 ? 2048 + g * 64 + (c - 64) : 2176 + g * 64 + (c - 128));
            raw[e] = t >= 0 ? bf2f(PA[(size_t)(b * SEQ + t) * NA + col]) : 0.f; }
        if (tid < 64) { const float d = softplusf_(bf2f(PA[(size_t)(b * SEQ + t0 + tid) * NA + 2304 + h]) + dtb); dts[tid] = d; dts[64 + tid] = __expf(d * A); }
        __syncthreads();
        for (int e = tid; e < 64 * 192; e += NTHR) { const int tt = e / 192, c = e % 192;
            const int ch = c < 64 ? h * 64 + c : (c < 128 ? 1024 + g * 64 + (c - 64) : 1152 + g * 64 + (c - 128));
            float v = cbias[ch];
#pragma unroll
            for (int k = 0; k < 4; ++k) v += cw[k * XBC + ch] * raw[(tt + k) * 192 + c];
            act[e] = siluf_(v); }
        __syncthreads();
        for (int tt = 0; tt < 64; ++tt) {
            const float dec = dts[64 + tt], dtx = dts[tt] * act[tt * 192 + p];
            const f32x4 b0 = *(const LAS f32x4*)(act + tt * 192 + 64 + 8 * nq), b1 = *(const LAS f32x4*)(act + tt * 192 + 64 + 8 * nq + 4);
            const f32x4 c0 = *(const LAS f32x4*)(act + tt * 192 + 128 + 8 * nq), c1 = *(const LAS f32x4*)(act + tt * 192 + 128 + 8 * nq + 4);
            float a = 0.f;
#pragma unroll
            for (int i = 0; i < 4; ++i) { hs[i] = dec * hs[i] + dtx * b0[i]; a += hs[i] * c0[i]; hs[4 + i] = dec * hs[4 + i] + dtx * b1[i]; a += hs[4 + i] * c1[i]; }
            a += __shfl_xor(a, 1); a += __shfl_xor(a, 2); a += __shfl_xor(a, 4);
            if (nq == 0) ys[tt * 64 + p] = a;
        }
        __syncthreads();
        for (int e = tid; e < 64 * 64; e += NTHR) { const int tt = e >> 6, pp = e & 63; const size_t row = (size_t)(b * SEQ + t0 + tt);
            const float z = bf2f(PA[row * NA + h * 64 + pp]);
            Y2[row * D + h * 64 + pp] = (ys[e] + Dh * act[tt * 192 + pp]) * siluf_(z); }
        __syncthreads();
    }
    float* ps = F.out + O_PSSM + ((size_t)(b * 16 + h) * 64 + p) * 64 + 8 * nq;
#pragma unroll
    for (int i = 0; i < 8; ++i) ps[i] = hs[i];
    { float* pc = F.out + O_PSCONV + (size_t)b * 3 * XBC;
      for (int e = tid; e < 3 * 192; e += NTHR) { const int k = e / 192, c = e % 192; if (c >= 64 && (h & 7) != 0) continue;
          const int ch = c < 64 ? h * 64 + c : (c < 128 ? 1024 + g * 64 + (c - 64) : 1152 + g * 64 + (c - 128));
          pc[k * XBC + ch] = bf2f(PA[(size_t)(b * SEQ + SEQ - 3 + k) * NA + 1024 + ch]); } }
}
__device__ __forceinline__ void ssd_sample_item(Frame& F, int j) {
    const bf16* PA = (const bf16*)(F.ws + WS_BIG + B_PROJA) + (size_t)(MP + j) * NA; float* Y2 = (float*)(F.ws + WS_BIG + B_Y2) + (size_t)(MP + j) * D;
    LAS float* act = (LAS float*)F.lds;
    LAS float* dts = act + XBC;
    const int tid = F.tid;
    const float* cw = F.a->in[I_CONVW]; const float* cbias = F.a->in[I_CONVB]; const float* st = F.a->in[I_SSCONV] + (size_t)j * 3 * XBC; float* so = F.out + O_SSCONV + (size_t)j * 3 * XBC;
    for (int ch = tid; ch < XBC; ch += NTHR) { const float nw = bf2f(PA[1024 + ch]); const float s0 = st[ch], s1 = st[XBC + ch], s2 = st[2 * XBC + ch];
        act[ch] = siluf_(cbias[ch] + cw[ch] * s0 + cw[XBC + ch] * s1 + cw[2 * XBC + ch] * s2 + cw[3 * XBC + ch] * nw);
        so[ch] = s1; so[XBC + ch] = s2; so[2 * XBC + ch] = nw; }
    if (tid < 16) { const float d = softplusf_(bf2f(PA[2304 + tid]) + F.a->in[I_DTB][tid]); dts[tid] = d; dts[16 + tid] = __expf(-__expf(F.a->in[I_ALOG][tid]) * d); }
    __syncthreads();
    const float* S0 = F.a->in[I_SSSM] + (size_t)j * 65536; float* S1 = F.out + O_SSSM + (size_t)j * 65536;
    for (int it = 0; it < 32; ++it) { const int v = it * NTHR + tid, n4 = v & 15, p = (v >> 4) & 63, h = v >> 10, g = h >> 3;
        const f32x4 s = *(const GAS f32x4*)(S0 + (size_t)v * 4);
        const f32x4 bb = *(const LAS f32x4*)(act + 1024 + g * 64 + 4 * n4), cc = *(const LAS f32x4*)(act + 1152 + g * 64 + 4 * n4);
        const float x = act[h * 64 + p], dtx = dts[h] * x, dec = dts[16 + h];
        f32x4 nn; float a = 0.f;
#pragma unroll
        for (int i = 0; i < 4; ++i) { nn[i] = dec * s[i] + dtx * bb[i]; a += nn[i] * cc[i]; }
        *(GAS f32x4*)(S1 + (size_t)v * 4) = nn;
        a += __shfl_xor(a, 1); a += __shfl_xor(a, 2); a += __shfl_xor(a, 4); a += __shfl_xor(a, 8);
        if (n4 == 0) Y2[h * 64 + p] = (a + F.a->in[I_SSMD][h] * x) * siluf_(bf2f(PA[h * 64 + p])); }
    __syncthreads();
}
__device__ __forceinline__ void ssd_phase(Frame& F) {
    for (int it = F.vcu; it < 128 + MS; it += F.G) { if (it < 128) ssd_prompt_item(F, it >> 4, it & 15); else ssd_sample_item(F, it - 128); }
}

__device__ __forceinline__ float hg_lb(const Frame& F, int c) { return 1.f / (1.f + __expf(F.a->in[I_HGLB][1024 + c] - F.a->in[I_HGLB][c])); }
__device__ __forceinline__ void hg_prompt_item(Frame& F, int b, int h, int vq) {
    const bf16* PB = (const bf16*)(F.ws + WS_BIG + B_PROJB); bf16* OR = (bf16*)(F.ws + WS_BIG + B_ORAW);
    LAS float* fS = (LAS float*)F.lds;
    LAS float* kS = fS + 32 * 128;
    LAS float* qS = kS + 32 * 128;
    LAS float* vS = qS + 32 * 128;
    LAS float* oP = vS + 32 * 32;
    const int tid = F.tid, vl = tid & 31, kg = tid >> 5, k0 = kg * 8;
    float S[8];
#pragma unroll
    for (int i = 0; i < 8; ++i) S[i] = 0.f;
    const float lbk = hg_lb(F, h * 128 + (tid & 127));
    for (int t0 = 0; t0 < SEQ; t0 += 32) {
        for (int e = tid; e < 32 * 128; e += NTHR) { const int tt = e >> 7, k = e & 127; const size_t row = (size_t)(b * SEQ + t0 + tt) * NBH;
            const float sg = sigmoidf_(bf2f(PB[row + 1024 + h * 128 + k]));
            fS[e] = lbk + (1.f - lbk) * sg; kS[e] = (1.f - lbk) * (1.f - sg); qS[e] = siluf_(bf2f(PB[row + h * 128 + k])); }
        for (int e = tid; e < 32 * 32; e += NTHR) { const int tt = e >> 5, v = e & 31; vS[e] = bf2f(PB[(size_t)(b * SEQ + t0 + tt) * NBH + 2048 + h * 128 + vq * 32 + v]); }
        __syncthreads();
        for (int tt = 0; tt < 32; ++tt) {
            const float vv = vS[tt * 32 + vl];
            const f32x4 f0 = *(const LAS f32x4*)(fS + tt * 128 + k0), f1 = *(const LAS f32x4*)(fS + tt * 128 + k0 + 4);
            const f32x4 kk0 = *(const LAS f32x4*)(kS + tt * 128 + k0), kk1 = *(const LAS f32x4*)(kS + tt * 128 + k0 + 4);
            const f32x4 q0 = *(const LAS f32x4*)(qS + tt * 128 + k0), q1 = *(const LAS f32x4*)(qS + tt * 128 + k0 + 4);
            float a = 0.f;
#pragma unroll
            for (int i = 0; i < 4; ++i) { S[i] = f0[i] * S[i] + kk0[i] * vv; a += S[i] * q0[i]; S[4 + i] = f1[i] * S[4 + i] + kk1[i] * vv; a += S[4 + i] * q1[i]; }
            oP[(tt * 16 + kg) * 32 + vl] = a;
        }
        __syncthreads();
        for (int e = tid; e < 32 * 32; e += NTHR) { const int tt = e >> 5, v = e & 31; float a = 0.f;
#pragma unroll
            for (int q = 0; q < 16; ++q) a += oP[(tt * 16 + q) * 32 + v];
            OR[(size_t)(b * SEQ + t0 + tt) * D + h * 128 + vq * 32 + v] = (bf16)f2bf(a); }
        __syncthreads();
    }
    float* ps = F.out + O_PHG + ((size_t)(b * 8 + h) * 128 + k0) * 128 + vq * 32 + vl;
#pragma unroll
    for (int i = 0; i < 8; ++i) ps[(size_t)i * 128] = S[i];
}
__device__ __forceinline__ void hg_sample_item(Frame& F, int j) {
    const bf16* PB = (const bf16*)(F.ws + WS_BIG + B_PROJB) + (size_t)(MP + j) * NBH; bf16* OR = (bf16*)(F.ws + WS_BIG + B_ORAW) + (size_t)(MP + j) * D;
    LAS float* fS = (LAS float*)F.lds;
    LAS float* kS = fS + 1024; LAS float* qS = kS + 1024; LAS float* vS = qS + 1024; LAS float* oP = vS + 1024;
    const int tid = F.tid;
    for (int c = tid; c < 1024; c += NTHR) { const float lb = hg_lb(F, c), sg = sigmoidf_(bf2f(PB[1024 + c]));
        fS[c] = lb + (1.f - lb) * sg; kS[c] = (1.f - lb) * (1.f - sg); qS[c] = siluf_(bf2f(PB[c])); vS[c] = bf2f(PB[2048 + c]); }
    __syncthreads();
    const int v = tid & 127, kq = tid >> 7;
    const float* S0 = F.a->in[I_SHG] + (size_t)j * 131072; float* S1 = F.out + O_SHG + (size_t)j * 131072;
    for (int h = 0; h < 8; ++h) { const float vv = vS[h * 128 + v]; float a = 0.f;
#pragma unroll 8
        for (int kk = 0; kk < 32; ++kk) { const int k = kq * 32 + kk; const size_t idx = ((size_t)h * 128 + k) * 128 + v;
            const float sn = fS[h * 128 + k] * S0[idx] + kS[h * 128 + k] * vv; S1[idx] = sn; a += sn * qS[h * 128 + k]; }
        oP[kq * 1024 + h * 128 + v] = a; }
    __syncthreads();
    for (int c = tid; c < 1024; c += NTHR) OR[c] = (bf16)f2bf(oP[c] + oP[1024 + c] + oP[2048 + c] + oP[3072 + c]);
    __syncthreads();
}
__device__ __forceinline__ void hg_phase(Frame& F) {
    for (int it = F.vcu; it < 256 + MS; it += F.G) { if (it < 256) hg_prompt_item(F, it >> 5, (it >> 2) & 7, it & 3); else hg_sample_item(F, it - 256); }
}

__device__ __forceinline__ void s5_lambda(const Frame& F, int g, int n, float& abr, float& abi, float& cfr, float& cfi) {
    const float lr = F.a->in[I_LAMRE][g * 64 + n], li = F.a->in[I_LAMIM][g * 64 + n], step = expf(F.a->in[I_LOGSTEP][g]);
    const float mag = expf(lr * step); float sn, cs; sincosf(li * step, &sn, &cs);
    abr = mag * cs; abi = mag * sn;
    const float den = lr * lr + li * li, nr = abr - 1.0f;
    cfr = (nr * lr + abi * li) / den; cfi = (abi * lr - nr * li) / den;
}
__device__ __forceinline__ void s5_tables_item(Frame& F, int g) {
    LAS float* POW = (LAS float*)F.lds;
    LAS float* CC = POW + 17 * 128;
    LAS float* BB = CC + 16 * 128;
    LAS float* KS = BB + 64 * 32;
    const int tid = F.tid;
    bf16* KQ = (bf16*)(F.ws + WS_BIG + B_S5T + S5T_KQ) + (size_t)g * 256 * 384; bf16* PM = (bf16*)(F.ws + WS_BIG + B_S5T + S5T_PM) + (size_t)g * 128 * 256;
    if (tid < 64) { const int n = tid; float abr, abi, cfr, cfi; s5_lambda(F, g, n, abr, abi, cfr, cfi);
        float pr = 1.f, pi = 0.f;
        for (int t = 0; t <= 16; ++t) { POW[(t * 64 + n) * 2] = pr; POW[(t * 64 + n) * 2 + 1] = pi; const float nr = pr * abr - pi * abi, ni = pr * abi + pi * abr; pr = nr; pi = ni; }
        const float* br = F.a->in[I_BRE] + (size_t)(g * 64 + n) * 16; const float* bi = F.a->in[I_BIM] + (size_t)(g * 64 + n) * 16;
        for (int c = 0; c < 16; ++c) { BB[(n * 16 + c) * 2] = cfr * br[c] - cfi * bi[c]; BB[(n * 16 + c) * 2 + 1] = cfr * bi[c] + cfi * br[c]; } }
    for (int e = tid; e < 1024; e += NTHR) { CC[e * 2] = F.a->in[I_CRE][(size_t)g * 1024 + e]; CC[e * 2 + 1] = F.a->in[I_CIM][(size_t)g * 1024 + e]; }
    __syncthreads();
    { const int cc = tid & 255, cp = cc >> 4, c = cc & 15, th = tid >> 8; float a[8];
#pragma unroll
      for (int i = 0; i < 8; ++i) a[i] = 0.f;
      for (int n = 0; n < 64; ++n) { const float cr = CC[(cp * 64 + n) * 2], ci = CC[(cp * 64 + n) * 2 + 1], br = BB[(n * 16 + c) * 2], bi = BB[(n * 16 + c) * 2 + 1];
          const float xr = cr * br - ci * bi, xi = cr * bi + ci * br;
#pragma unroll
          for (int i = 0; i < 8; ++i) { const int t = th + 2 * i; a[i] += xr * POW[(t * 64 + n) * 2] - xi * POW[(t * 64 + n) * 2 + 1]; } }
#pragma unroll
      for (int i = 0; i < 8; ++i) KS[(th + 2 * i) * 256 + cc] = a[i]; }
    __syncthreads();
    for (int e2 = tid; e2 < 256 * 192; e2 += NTHR) { const int row = e2 / 192, col0 = (e2 % 192) * 2, t = row >> 4, cp = row & 15; float v[2];
#pragma unroll
        for (int q = 0; q < 2; ++q) { const int col = col0 + q;
            if (col < 256) { const int s = col >> 4, c = col & 15; v[q] = s <= t ? KS[(t - s) * 256 + cp * 16 + c] : 0.f; }
            else { const int np = col - 256, n = np & 63; const float pr = POW[((t + 1) * 64 + n) * 2], pi = POW[((t + 1) * 64 + n) * 2 + 1], cr = CC[(cp * 64 + n) * 2], ci = CC[(cp * 64 + n) * 2 + 1];
                v[q] = np < 64 ? cr * pr - ci * pi : -(cr * pi + ci * pr); } }
        *(GAS unsigned*)(KQ + (size_t)row * 384 + col0) = pk2(v[0], v[1]); }
    for (int e2 = tid; e2 < 128 * 128; e2 += NTHR) { const int np = e2 >> 7, col0 = (e2 & 127) * 2, n = np & 63; float v[2];
#pragma unroll
        for (int q = 0; q < 2; ++q) { const int col = col0 + q, s = col >> 4, c = col & 15; const float pr = POW[((15 - s) * 64 + n) * 2], pi = POW[((15 - s) * 64 + n) * 2 + 1], br = BB[(n * 16 + c) * 2], bi = BB[(n * 16 + c) * 2 + 1];
            v[q] = np < 64 ? pr * br - pi * bi : pr * bi + pi * br; }
        *(GAS unsigned*)(PM + (size_t)np * 256 + col0) = pk2(v[0], v[1]); }
    __syncthreads();
}
__device__ __forceinline__ void s5_chunk_states(Frame& F) {
    const bf16* HN = (const bf16*)(F.ws + WS_XN); const bf16* PM = (const bf16*)(F.ws + WS_BIG + B_S5T + S5T_PM); float* PC = (float*)(F.ws + WS_BIG + B_PC);
    const int lane = F.lane, r = lane & 31, h = lane >> 5;
    for (int task = GW_ID(F); task < 64 * 32; task += GW_N(F)) { const int g = task >> 5, m0 = (task & 31) * 32;
        f32x16 acc[4];
#pragma unroll
        for (int nt = 0; nt < 4; ++nt)
#pragma unroll
            for (int i = 0; i < 16; ++i) acc[nt][i] = 0.f;
        const bf16* ap = HN + (size_t)(16 * (m0 + r)) * D + 16 * g + 8 * h; const bf16* bp = PM + (size_t)(g * 128 + r) * 256 + 8 * h;
#pragma unroll 4
        for (int s = 0; s < 16; ++s) { const bf16x8 a = *(const bf16x8*)(ap + (size_t)s * D);
#pragma unroll
            for (int nt = 0; nt < 4; ++nt) { const bf16x8 b = *(const bf16x8*)(bp + (size_t)nt * 32 * 256 + 16 * s); acc[nt] = __builtin_amdgcn_mfma_f32_32x32x16_bf16(a, b, acc[nt], 0, 0, 0); } }
#pragma unroll
        for (int nt = 0; nt < 4; ++nt)
#pragma unroll
            for (int i = 0; i < 16; ++i) { const int m = m0 + (i & 3) + 8 * (i >> 2) + 4 * h; PC[((size_t)m * 64 + g) * 128 + nt * 32 + r] = acc[nt][i]; }
    }
}
__device__ __forceinline__ void s5_sample(Frame& F) {
    const bf16* HN = (const bf16*)(F.ws + WS_XN) + (size_t)MP * D; bf16* GY = (bf16*)(F.ws + WS_BIG + B_GY) + (size_t)MP * D;
    const int n = F.lane;
    for (int task = GW_ID(F); task < MS * 64; task += GW_N(F)) { const int j = task >> 6, g = task & 63;
        float abr, abi, cfr, cfi; s5_lambda(F, g, n, abr, abi, cfr, cfi);
        const v4u u0 = *(const GAS v4u*)(HN + (size_t)j * D + 16 * g), u1 = *(const GAS v4u*)(HN + (size_t)j * D + 16 * g + 8);
        float u[16]; u[0] = bflo(u0.x); u[1] = bfhi(u0.x); u[2] = bflo(u0.y); u[3] = bfhi(u0.y); u[4] = bflo(u0.z); u[5] = bfhi(u0.z); u[6] = bflo(u0.w); u[7] = bfhi(u0.w);
        u[8] = bflo(u1.x); u[9] = bfhi(u1.x); u[10] = bflo(u1.y); u[11] = bfhi(u1.y); u[12] = bflo(u1.z); u[13] = bfhi(u1.z); u[14] = bflo(u1.w); u[15] = bfhi(u1.w);
        const float* br = F.a->in[I_BRE] + (size_t)(g * 64 + n) * 16; const float* bi = F.a->in[I_BIM] + (size_t)(g * 64 + n) * 16;
        float bur = 0.f, bui = 0.f;
#pragma unroll
        for (int c = 0; c < 16; ++c) { const float b0 = br[c], b1 = bi[c]; bur += (cfr * b0 - cfi * b1) * u[c]; bui += (cfr * b1 + cfi * b0) * u[c]; }
        const size_t si = ((size_t)j * 64 + g) * 64 + n; const float sr = F.a->in[I_SS5R][si], sim = F.a->in[I_SS5I][si];
        const float xr = abr * sr - abi * sim + bur, xi = abr * sim + abi * sr + bui;
        F.out[O_SS5R + si] = xr; F.out[O_SS5I + si] = xi;
        float ymine = 0.f;
#pragma unroll
        for (int cp = 0; cp < 16; ++cp) { const float part = F.a->in[I_CRE][((size_t)g * 16 + cp) * 64 + n] * xr - F.a->in[I_CIM][((size_t)g * 16 + cp) * 64 + n] * xi; const float tot = wave_sum(part); if (n == cp) ymine = tot; }
        if (n < 16) { float uu = 0.f;
#pragma unroll
            for (int c = 0; c < 16; ++c) uu = (n == c) ? u[c] : uu;
            GY[(size_t)j * D + 16 * g + n] = (bf16)f2bf(gelu_tanh(ymine + F.a->in[I_S5D][16 * g + n] * uu)); }
    }
}
__device__ __forceinline__ void s5_scan(Frame& F) {
    const float* PC = (const float*)(F.ws + WS_BIG + B_PC); bf16* XP = (bf16*)(F.ws + WS_BIG + B_XP);
    if (F.tid >= 128) return;
    for (int idx = F.vcu * 128 + F.tid; idx < 8 * 4096; idx += F.G * 128) { const int b = idx >> 12, g = (idx >> 6) & 63, n = idx & 63;
        float abr, abi, cfr, cfi; s5_lambda(F, g, n, abr, abi, cfr, cfi);
#pragma unroll
        for (int q = 0; q < 4; ++q) { const float nr = abr * abr - abi * abi, ni = 2.f * abr * abi; abr = nr; abi = ni; }
        float xr = 0.f, xi = 0.f;
#pragma unroll 8
        for (int ch = 0; ch < 128; ++ch) { const size_t o = ((size_t)(b * 128 + ch) * 64 + g) * 128 + n;
            XP[o] = (bf16)f2bf(xr); XP[o + 64] = (bf16)f2bf(xi);
            const float pr = PC[o], pi = PC[o + 64]; const float nr = abr * xr - abi * xi + pr, ni = abr * xi + abi * xr + pi; xr = nr; xi = ni; }
        F.out[O_PS5R + idx] = xr; F.out[O_PS5I + idx] = xi; }
}
__device__ __forceinline__ void s5_outputs(Frame& F) {
    const bf16* HN = (const bf16*)(F.ws + WS_XN); const bf16* KQ = (const bf16*)(F.ws + WS_BIG + B_S5T + S5T_KQ); const bf16* XP = (const bf16*)(F.ws + WS_BIG + B_XP); bf16* GY = (bf16*)(F.ws + WS_BIG + B_GY);
    const int lane = F.lane, r = lane & 31, h = lane >> 5;
    for (int task = GW_ID(F); task < 64 * 32 * 2; task += GW_N(F)) { const int g = task >> 6, m0 = ((task >> 1) & 31) * 32, ch0 = (task & 1) * 128;
        f32x16 acc[4];
#pragma unroll
        for (int nt = 0; nt < 4; ++nt)
#pragma unroll
            for (int i = 0; i < 16; ++i) acc[nt][i] = 0.f;
        const bf16* ap = HN + (size_t)(16 * (m0 + r)) * D + 16 * g + 8 * h; const bf16* ax = XP + ((size_t)(m0 + r) * 64 + g) * 128 + 8 * h;
        const bf16* bp = KQ + (size_t)(g * 256 + ch0 + r) * 384 + 8 * h;
#pragma unroll 4
        for (int s = 0; s < 24; ++s) { const bf16x8 a = s < 16 ? *(const bf16x8*)(ap + (size_t)s * D) : *(const bf16x8*)(ax + 16 * (s - 16));
#pragma unroll
            for (int nt = 0; nt < 4; ++nt) { const bf16x8 b = *(const bf16x8*)(bp + (size_t)nt * 32 * 384 + 16 * s); acc[nt] = __builtin_amdgcn_mfma_f32_32x32x16_bf16(a, b, acc[nt], 0, 0, 0); } }
#pragma unroll
        for (int nt = 0; nt < 4; ++nt) { const int col = ch0 + nt * 32 + r, t = col >> 4, cp = col & 15; const float dsk = F.a->in[I_S5D][16 * g + cp];
#pragma unroll
            for (int i = 0; i < 16; ++i) { const int m = m0 + (i & 3) + 8 * (i >> 2) + 4 * h; const size_t o = (size_t)(16 * m + t) * D + 16 * g + cp;
                GY[o] = (bf16)f2bf(gelu_tanh(acc[nt][i] + dsk * bf2f(HN[o]))); } }
    }
}

constexpr int CW_BAR = 4096;

struct SkAny { int mode; void* O; int ld;
    __device__ __forceinline__ void operator()(int row, int col, const float (&v)[1]) const { if (mode == 0) ((bf16*)O)[(size_t)row * ld + col] = (bf16)f2bf(v[0]); else ((float*)O)[(size_t)row * ld + col] = v[0]; } };

__global__ void __launch_bounds__(NTHR, 2) fwd_kernel(Args args) {
    extern __shared__ __attribute__((aligned(16))) unsigned char lds[];
    Frame F;
    F.lds = (LAS unsigned char*)lds;
    F.tid = threadIdx.x;
    F.out = args.out; F.ws = args.ws;
    volatile LAS unsigned* MISC = (volatile LAS unsigned*)(F.lds + MISC_OFF);
    for (int u = F.tid; u < (LDS_BYTES - LDSCTL_OFF) / 4; u += NTHR) ((LAS unsigned*)(F.lds + LDSCTL_OFF))[u] = 0u;
    __syncthreads();
    const int lo = args.ph_lo, hi = args.ph_hi;
    XcdBarrier bar; bar.bar = (unsigned*)(F.ws + WS_CTL) + CW_BAR; bar.x = 0; bar.st = nullptr;
    if (hi - lo > 1) bar = xcd_barrier_post((unsigned*)(F.ws + WS_CTL) + CW_BAR, MISC + 8);
#pragma unroll 1
    for (int ph = lo; ph < hi; ++ph) {
        { int t_ = threadIdx.x; asm volatile("" : "+v"(t_)); F.tid = t_; F.lane = t_ & 63; F.wave = __builtin_amdgcn_readfirstlane(t_ >> 6); }
        { int g_ = gridDim.x, b_ = blockIdx.x; asm volatile("" : "+s"(g_), "+s"(b_)); F.G = g_; F.vcu = (g_ % 8 == 0) ? (b_ % 8) * (g_ / 8) + b_ / 8 : b_; }
        { const CAS Args* ap_ = (const CAS Args*)__builtin_amdgcn_kernarg_segment_ptr(); asm volatile("" : "+s"(ap_)); F.a = ap_; }
        { float* o_ = args.out; unsigned char* w_ = args.ws; asm volatile("" : "+s"(o_), "+s"(w_)); F.out = o_; F.ws = w_; }
        unsigned char* BIG = F.ws + WS_BIG; bf16* XN = (bf16*)(F.ws + WS_XN); bf16* WIN = (bf16*)(F.ws + WS_WIN);
        const bf16* gA = nullptr; const bf16* gAs = nullptr; const bf16* gB = nullptr; int gN = 0, gK = 0, gmode = 0, gld = 0; void* gO = nullptr; void* gOs = nullptr;
        const int l = ph >= 22 ? 1 : 0, pf = ph - (l ? 22 : 9);
        const bool in_ffn = (ph >= 9 && ph <= 15) || (ph >= 22 && ph <= 28);
        if (in_ffn) {
            const int part = pf >> 1, j0 = part == 0 ? 0 : (part == 1 ? 8 : 15), j1 = part == 0 ? 8 : (part == 1 ? 15 : 22);
            if (pf == 6) { gA = (const bf16*)(BIG + B_ACT); gAs = gA + (size_t)MP * FF; gB = (const bf16*)(F.ws + WS_WDN) + (size_t)l * D * FF; gN = D; gK = FF; gmode = 1; gld = D; gO = BIG + B_M1; gOs = (float*)gO + (size_t)MP * D; }
            else if ((pf & 1) == 0) { const int ldu = 256 * (j1 - j0); gA = XN; gAs = XN + (size_t)MP * D; gB = (const bf16*)(F.ws + WS_WUP) + (size_t)l * FF2 * D + (size_t)j0 * 256 * D; gN = ldu; gK = D; gmode = 0; gld = ldu; gO = BIG + B_UP; gOs = (bf16*)gO + (size_t)MP * ldu; }
            else ffn_gate(F, l, j0, j1);
        } else switch (ph) {
            case 0: p0_prologue(F); break;
            case 1: gA = XN; gAs = XN + (size_t)MP * D; gB = WIN; gN = NA; gK = D; gmode = 0; gld = NA; gO = BIG + B_PROJA; gOs = (bf16*)gO + (size_t)MP * NA; break;
            case 2: ssd_phase(F); break;
            case 3: mix_norm_a(F); break;
            case 4: gA = XN; gAs = XN + (size_t)MP * D; gB = WIN + (size_t)NA * D; gN = NBH; gK = D; gmode = 0; gld = NBH; gO = BIG + B_PROJB; gOs = (bf16*)gO + (size_t)MP * NBH; break;
            case 5: hg_phase(F); break;
            case 6: mix_norm_b(F); break;
            case 7: gA = (const bf16*)(F.out + O_YP); gAs = (const bf16*)(F.ws + WS_MIXS); gB = (const bf16*)(F.ws + WS_WOUT); gN = D; gK = 2048; gmode = 1; gld = D; gO = BIG + B_M1; gOs = (float*)gO + (size_t)MP * D; break;
            case 8: resid_norm_rows(F, (const float*)(BIG + B_M1), F.a->in[I_NMPOST], F.a->in[I_NFPRE], true); break;
            case 16: resid_norm_rows(F, (const float*)(BIG + B_M1), F.a->in[I_NFPOST], F.a->in[I_NMPRE] + D, false);
                     for (int g = F.vcu; g < 64; g += F.G) s5_tables_item(F, g);
                     break;
            case 17: s5_chunk_states(F); s5_sample(F); break;
            case 18: s5_scan(F); break;
            case 19: s5_outputs(F); break;
            case 20: gA = (const bf16*)(BIG + B_GY); gAs = gA + (size_t)MP * D; gB = (const bf16*)(F.ws + WS_WGLU); gN = 2048; gK = D; gmode = 2; gld = D; gO = BIG + B_M1G; gOs = (float*)gO + (size_t)MP * D; break;
            case 21: resid_norm_rows(F, (const float*)(BIG + B_M1G), F.a->in[I_NMPOST] + D, F.a->in[I_NFPRE] + D, false); break;
            case 29: resid_norm_rows(F, (const float*)(BIG + B_M1), F.a->in[I_NFPOST] + D, nullptr, false); break;
            default: break;
        }
        if (gA) {
            pg8::Gemm g{gA, gB, MP, gN, gK}; pg8::StaticOrder S; S.init(MP, gN, F.G, (int)blockIdx.x);
            pg8::gemm_phase<pg8::EpiAny, pg8::StaticOrder>(F.lds, g, S, pg8::EpiAny{gmode, gmode == 0, gO, gld}, F.tid);
            __syncthreads();
            if (gmode == 2) skinny_gemm<2, true>(F, gAs, gK, gB, gK, D / 32, SkGlu{(float*)gOs, gld});
            else skinny_gemm<1, false>(F, gAs, gK, gB, gK, gN / 32, SkAny{gmode, gOs, gld});
        }
        if (ph + 1 < hi) xcd_barrier(bar);
    }
}

extern "C" void kernel_launch(void* const* d_in, const int* in_sizes, int n_in, void* d_out, int out_size, void* d_ws, size_t ws_size, hipStream_t stream) {
    static int grid = 0;
    if (grid == 0) {
        if (n_in != N_IN || out_size != (int)O_END || ws_size < WS_END) { fprintf(stderr, "kernel_launch: unexpected shapes (n_in %d, out %d, ws %zu)\n", n_in, out_size, ws_size); grid = -1; return; }
        int dev = 0, cus = 0, per_cu = 0;
        if (hipGetDevice(&dev) != hipSuccess || hipDeviceGetAttribute(&cus, hipDeviceAttributeMultiprocessorCount, dev) != hipSuccess) { grid = -1; return; }
        if (hipFuncSetAttribute((const void*)fwd_kernel, hipFuncAttributeMaxDynamicSharedMemorySize, LDS_BYTES) != hipSuccess) { fprintf(stderr, "kernel_launch: hipFuncSetAttribute failed\n"); grid = -1; return; }
        if (hipOccupancyMaxActiveBlocksPerMultiprocessor(&per_cu, (const void*)fwd_kernel, NTHR, LDS_BYTES) != hipSuccess || per_cu < 1) fprintf(stderr, "kernel_launch: occupancy query says %d\n", per_cu);
        (void)hipGetLastError();
        grid = cus;
    }
    if (grid < 0) return;
    (void)hipMemsetAsync((char*)d_ws + WS_CTL, 0, CTL_BYTES, stream);
    Args a{};
    for (int i = 0; i < 35; ++i) a.in[i] = (const float*)d_in[i];
    a.out = (float*)d_out; a.ws = (unsigned char*)d_ws;
#if MK_ONE_LAUNCH
    a.ph_lo = 0; a.ph_hi = NPH;
    hipLaunchKernelGGL(fwd_kernel, dim3(grid), dim3(NTHR), LDS_BYTES, stream, a);
#else
    for (int p = 0; p < NPH; ++p) { a.ph_lo = p; a.ph_hi = p + 1; hipLaunchKernelGGL(fwd_kernel, dim3(grid), dim3(NTHR), LDS_BYTES, stream, a); }
#endif
}
```

```cpp
#include <hip/hip_runtime.h>
#include <cstdio>
#include <cstdint>

#ifndef PROBE_PH
#define PROBE_PH -1
#endif
#ifndef PROBE_REPS
#define PROBE_REPS 1
#endif
#ifndef MK_ONE_LAUNCH
#define MK_ONE_LAUNCH 1
#endif

__device__ __forceinline__ float dpp_add_(float v, const int ctrl_sel) {
    const int b = __builtin_bit_cast(int, v); int r;
    if (ctrl_sel == 0) r = __builtin_amdgcn_update_dpp(0, b, 0xB1, 0xf, 0xf, true); else if (ctrl_sel == 1) r = __builtin_amdgcn_update_dpp(0, b, 0x4E, 0xf, 0xf, true);
    else if (ctrl_sel == 2) r = __builtin_amdgcn_update_dpp(0, b, 0x141, 0xf, 0xf, true); else r = __builtin_amdgcn_update_dpp(0, b, 0x140, 0xf, 0xf, true);
    return v + __builtin_bit_cast(float, r); }
__device__ __forceinline__ float row16_sum(float v) { v = dpp_add_(v, 0); v = dpp_add_(v, 1); v = dpp_add_(v, 2); v = dpp_add_(v, 3); return v; }
__device__ __forceinline__ float wave_sum(float v) {
    v = row16_sum(v);
    v += __builtin_bit_cast(float, __builtin_amdgcn_update_dpp(0, __builtin_bit_cast(int, v), 0x142, 0xa, 0xf, false));
    v += __builtin_bit_cast(float, __builtin_amdgcn_update_dpp(0, __builtin_bit_cast(int, v), 0x143, 0xc, 0xf, false));
    return __builtin_bit_cast(float, __builtin_amdgcn_readlane(__builtin_bit_cast(int, v), 63)); }
__device__ __forceinline__ int lane_op_() { int l = __builtin_amdgcn_mbcnt_hi(-1, __builtin_amdgcn_mbcnt_lo(-1, 0)); asm volatile("" : "+v"(l)); return l; }
__device__ __forceinline__ float shx_(float v, int o, int l) { return __builtin_bit_cast(float, __builtin_amdgcn_ds_bpermute((l ^ o) << 2, __builtin_bit_cast(int, v))); }
__device__ __forceinline__ float shup_(float v, int off, int width, int l) { const int src = ((l & (width - 1)) >= off) ? l - off : l; return __builtin_bit_cast(float, __builtin_amdgcn_ds_bpermute(src << 2, __builtin_bit_cast(int, v))); }
__device__ __forceinline__ float shidx_(float v, int src, int width, int l) { return __builtin_bit_cast(float, __builtin_amdgcn_ds_bpermute(((l & ~(width - 1)) + src) << 2, __builtin_bit_cast(int, v))); }
namespace pg8 {
#define PG8_LAS __attribute__((address_space(3)))
typedef unsigned short bf16_t;
typedef short bf16x8 __attribute__((ext_vector_type(8)));
typedef float f32x4 __attribute__((ext_vector_type(4)));
typedef unsigned u32x4 __attribute__((ext_vector_type(4)));
typedef float f32x2 __attribute__((ext_vector_type(2)));
constexpr int BM = 256, BK = 64, HALF = 128, HTB = HALF * BK * 2  , STAGE_BYTES = 8 * HTB, NXCD = 8, WGM = 8;

__host__ __device__ __forceinline__ int lds_byte(int r, int c) { const int st = (r >> 4) * 2 + (c >> 5), rr = r & 15, cc = c & 31, ob = rr * 64 + cc * 2; return st * 1024 + (ob ^ (((ob >> 9) & 1) << 5)); }
__host__ __device__ __forceinline__ void stage_rc(int b, int& R, int& C) { const int st = b / 1024, sb = b % 1024, swz = sb ^ (((sb >> 9) & 1) << 5); R = (st >> 1) * 16 + swz / 64; C = (st & 1) * 32 + (swz % 64) / 2; }
__host__ __device__ __forceinline__ int perm32(int rho) { const int n = rho >> 4, i = rho & 15; return 8 * (i >> 2) + 4 * n + (i & 3); }

struct Unit { int pm, pn; };
struct Gemm { const bf16_t* A; const bf16_t* Bt; int M, N, K; };

struct StaticOrder {
    int nM, nN, nwg, G, c;
    __host__ __device__ void init(int M, int N, int G_, int c_) { nM = M / BM; nN = N / BM; nwg = nM * nN; G = G_; c = c_; }
    __host__ __device__ bool next(int i, Unit& u) const {
        const long L = (long)i * G + c; if (L >= nwg) return false;
        int wgid = (int)L; { const int q = nwg / NXCD, r = nwg % NXCD, xcd = wgid % NXCD, off = wgid / NXCD; wgid = (xcd < r ? xcd * (q + 1) : r * (q + 1) + (xcd - r) * q) + off; }
        const int nig = WGM * nN, gid = wgid / nig, fm = gid * WGM, gsz = (nM - fm) < WGM ? (nM - fm) : WGM;
        u.pm = fm + ((wgid % nig) % gsz); u.pn = (wgid % nig) / gsz; return true;
    }
    __device__ __forceinline__ void a_ready(const Unit&) const {}
    __device__ __forceinline__ void done(const Unit&) const {}
};

__device__ __forceinline__ unsigned cvt_pk_bf16(float lo, float hi) { unsigned r; asm volatile("v_cvt_pk_bf16_f32 %0, %1, %2" : "=v"(r) : "v"(lo), "v"(hi)); return r; }

struct EpiF32 {
    static constexpr bool PERM = false, AFTER_DRAIN = false;
    float* C; int ldc;
    __device__ __forceinline__ void operator()(const f32x4 (&acc)[2][2][4][2], const Unit& u, int wr, int wc, int fr, int fq) const {
        const int row0 = u.pm * BM + wr * 64 + fr, col0 = u.pn * BM + wc * 32 + 4 * fq;
#pragma unroll
        for (int ai = 0; ai < 2; ++ai)
#pragma unroll
            for (int m = 0; m < 4; ++m) { float* rowp = C + (size_t)(row0 + ai * HALF + m * 16) * ldc + col0;
#pragma unroll
                for (int bj = 0; bj < 2; ++bj)
#pragma unroll
                    for (int n = 0; n < 2; ++n) *(f32x4*)(rowp + bj * HALF + n * 16) = acc[ai][bj][m][n]; }
    }
};
struct EpiBf16 {
    static constexpr bool PERM = true, AFTER_DRAIN = false;
    bf16_t* O; int ldc;
    __device__ __forceinline__ void operator()(const f32x4 (&acc)[2][2][4][2], const Unit& u, int wr, int wc, int fr, int fq) const {
        const int row0 = u.pm * BM + wr * 64 + fr, col0 = u.pn * BM + wc * 32 + 8 * fq;
#pragma unroll
        for (int ai = 0; ai < 2; ++ai)
#pragma unroll
            for (int m = 0; m < 4; ++m) { bf16_t* rowp = O + (size_t)(row0 + ai * HALF + m * 16) * ldc + col0;
#pragma unroll
                for (int bj = 0; bj < 2; ++bj) { const f32x4 v0 = acc[ai][bj][m][0], v1 = acc[ai][bj][m][1];
                    u32x4 w; w.x = cvt_pk_bf16(v0[0], v0[1]); w.y = cvt_pk_bf16(v0[2], v0[3]); w.z = cvt_pk_bf16(v1[0], v1[1]); w.w = cvt_pk_bf16(v1[2], v1[3]);
                    *(u32x4*)(rowp + bj * HALF) = w; } }
    }
};
struct EpiGlu {
    static constexpr bool PERM = false, AFTER_DRAIN = false;
    bf16_t* C; int ldc;
    __device__ __forceinline__ void operator()(const f32x4 (&acc)[2][2][4][2], const Unit& u, int wr, int wc, int fr, int fq) const {
        const int row0 = u.pm * BM + wr * 64 + fr, col0 = u.pn * HALF + wc * 32 + 4 * fq;
        typedef unsigned u32x2g __attribute__((ext_vector_type(2)));
#pragma unroll
        for (int ai = 0; ai < 2; ++ai)
#pragma unroll
            for (int m = 0; m < 4; ++m) { bf16_t* rowp = C + (size_t)(row0 + ai * HALF + m * 16) * ldc + col0;
#pragma unroll
                for (int n = 0; n < 2; ++n) { const f32x4 v = acc[ai][0][m][n], g = acc[ai][1][m][n]; float o[4];
#pragma unroll
                    for (int j = 0; j < 4; ++j) o[j] = v[j] * __builtin_amdgcn_rcpf(1.0f + __expf(-g[j]));
                    u32x2g w; w.x = cvt_pk_bf16(o[0], o[1]); w.y = cvt_pk_bf16(o[2], o[3]); *(u32x2g*)(rowp + n * 16) = w; } }
    }
};


__device__ __forceinline__ float dpp_shr1(float old, float src) { return __builtin_bit_cast(float, __builtin_amdgcn_update_dpp(__builtin_bit_cast(int, old), __builtin_bit_cast(int, src), 0x111, 0xf, 0xf, false)); }
__device__ __forceinline__ float dpp_shr2(float old, float src) { return __builtin_bit_cast(float, __builtin_amdgcn_update_dpp(__builtin_bit_cast(int, old), __builtin_bit_cast(int, src), 0x112, 0xf, 0xf, false)); }
__device__ __forceinline__ float dpp_ror1(float src) { return __builtin_bit_cast(float, __builtin_amdgcn_update_dpp(0, __builtin_bit_cast(int, src), 0x121, 0xf, 0xf, false)); }
__device__ __forceinline__ float dpp_ror2(float src) { return __builtin_bit_cast(float, __builtin_amdgcn_update_dpp(0, __builtin_bit_cast(int, src), 0x122, 0xf, 0xf, false)); }
struct EpiConvGate {
    bf16_t* ACT; const float* cw; const float* cb; float* HEAD; float* TAIL; PG8_LAS float* HALO; float* PFC;
    __device__ __forceinline__ void operator()(const f32x4 (&acc)[2][2][4][2], const Unit& u, int wr, int wc, int fr, int fq) const {
        constexpr int FF_ = 2816, FF2_ = 5632;
        asm volatile("" : "+v"(fr), "+v"(fq));
        const int colt = wc * 32 + 8 * fq;
        if (fr >= 14) {
#pragma unroll
            for (int ai = 0; ai < 2; ++ai)
#pragma unroll
                for (int bj = 0; bj < 2; ++bj)
#pragma unroll
                    for (int n = 0; n < 2; ++n) { *(PG8_LAS f32x4*)(HALO + ((ai * 2 + wr) * 2 + (fr - 14)) * 256 + bj * 128 + colt + 4 * n) = acc[ai][bj][3][n];
                        if (ai == 1 && wr == 1) { *(f32x4*)(TAIL + ((size_t)u.pm * 2 + (fr - 14)) * FF2_ + bj * FF_ + u.pn * 128 + colt + 4 * n) = acc[1][bj][3][n];
                            if ((u.pm & 7) == 7) *(f32x4*)(PFC + ((size_t)(u.pm >> 3) * 2 + (fr - 14)) * FF2_ + bj * FF_ + u.pn * 128 + colt + 4 * n) = acc[1][bj][3][n]; } } }
        if (fr < 2 && wr == 0) {
#pragma unroll
            for (int bj = 0; bj < 2; ++bj)
#pragma unroll
                for (int n = 0; n < 2; ++n) *(f32x4*)(HEAD + ((size_t)u.pm * 2 + fr) * FF2_ + bj * FF_ + u.pn * 128 + colt + 4 * n) = acc[0][bj][0][n]; }
        asm volatile("s_waitcnt lgkmcnt(0)" ::: "memory"); __builtin_amdgcn_s_barrier(); asm volatile("" ::: "memory");
        const auto wrs = __builtin_amdgcn_make_buffer_rsrc((void*)cw, 0, 3 * FF2_ * 4, 0x00020000); const auto brs = __builtin_amdgcn_make_buffer_rsrc((void*)cb, 0, FF2_ * 4, 0x00020000);
        typedef unsigned u32x2 __attribute__((ext_vector_type(2)));
#pragma unroll
        for (int ai = 0; ai < 2; ++ai) {
            const int pred = wr == 1 ? (ai * 2 + 0) : (0 * 2 + 1);
            const bool nohist = (ai == 0 && wr == 0);
            const int row0 = u.pm * BM + ai * HALF + wr * 64 + fr;
#pragma unroll
            for (int n = 0; n < 2; ++n) {
                unsigned pk[4][2];
#pragma unroll
                for (int jp = 0; jp < 2; ++jp) {
                    float gsil[4][2];
                    const int voff = (colt + 4 * n + 2 * jp) * 4;
#pragma unroll
                    for (int bj = 1; bj >= 0; --bj) { const int so = (bj * FF_ + u.pn * 128) * 4;
                        const f32x2 w0 = __builtin_bit_cast(f32x2, __builtin_amdgcn_raw_buffer_load_b64(wrs, voff, so, 0)), w1 = __builtin_bit_cast(f32x2, __builtin_amdgcn_raw_buffer_load_b64(wrs, voff, so + FF2_ * 4, 0)),
                                    w2 = __builtin_bit_cast(f32x2, __builtin_amdgcn_raw_buffer_load_b64(wrs, voff, so + 2 * FF2_ * 4, 0)), bb = __builtin_bit_cast(f32x2, __builtin_amdgcn_raw_buffer_load_b64(brs, voff, so, 0));
                        const f32x2 h0 = *(const PG8_LAS f32x2*)(HALO + (pred * 2 + 0) * 256 + bj * 128 + colt + 4 * n + 2 * jp), h1 = *(const PG8_LAS f32x2*)(HALO + (pred * 2 + 1) * 256 + bj * 128 + colt + 4 * n + 2 * jp);
#pragma unroll
                        for (int m = 0; m < 4; ++m) { float r[2];
#pragma unroll
                            for (int jj = 0; jj < 2; ++jj) { const int j = 2 * jp + jj; const float cur = acc[ai][bj][m][n][j];
                                const float x1 = m == 0 ? h1[jj] : dpp_ror1(acc[ai][bj][m == 0 ? 0 : m - 1][n][j]);
                                const float x2 = m == 0 ? (fr == 0 ? h0[jj] : h1[jj]) : dpp_ror2(acc[ai][bj][m == 0 ? 0 : m - 1][n][j]);
                                const float p1 = dpp_shr1(x1, cur), p2 = dpp_shr2(x2, cur);
                                r[jj] = bb[jj] + w0[jj] * p2 + w1[jj] * p1 + w2[jj] * cur; }
                            if (bj == 1) { gsil[m][0] = r[0] * __builtin_amdgcn_rcpf(1.0f + __expf(-r[0])); gsil[m][1] = r[1] * __builtin_amdgcn_rcpf(1.0f + __expf(-r[1])); }
                            else pk[m][jp] = cvt_pk_bf16(r[0] * gsil[m][0], r[1] * gsil[m][1]); }
                    }
                }
#pragma unroll
                for (int m = 0; m < 4; ++m) { if (nohist && m == 0 && fr < 2) continue;
                    u32x2 w; w.x = pk[m][0]; w.y = pk[m][1]; *(u32x2*)(ACT + (size_t)(row0 + m * 16) * FF_ + u.pn * 128 + colt + 4 * n) = w; }
                asm volatile("" ::: "memory");
            }
        }
    }
};
struct EpiAny {
    static constexpr bool AFTER_DRAIN = false;
    int mode; bool perm; void* O; int ldc; EpiConvGate cg;
    __device__ __forceinline__ void operator()(const f32x4 (&acc)[2][2][4][2], const Unit& u, int wr, int wc, int fr, int fq) const {
        if (mode == 0) { EpiBf16 e{(bf16_t*)O, ldc}; e(acc, u, wr, wc, fr, fq); }
        else if (mode == 1) { EpiF32 e{(float*)O, ldc}; e(acc, u, wr, wc, fr, fq); }
        else if (mode == 2) { EpiGlu e{(bf16_t*)O, ldc}; e(acc, u, wr, wc, fr, fq); }
        else cg(acc, u, wr, wc, fr, fq);
    }
};
template <class Epi, class Sched, bool ALIGN_EPI = false, bool SP2 = false>
__device__ __forceinline__ void gemm_phase(PG8_LAS unsigned char* lds, const Gemm g, const Sched& S, const Epi& E, const int tid) {
    const int wid = __builtin_amdgcn_readfirstlane(tid >> 6), lane = tid & 63, wr = wid >> 2, wc = wid & 3, fr = lane & 15, fq = lane >> 4;
    const int K = g.K, nt = K / BK;
    unsigned voffA[2], voffB[2];
#pragma unroll
    for (int i = 0; i < 2; ++i) { int R, C; stage_rc(tid * 16 + i * 8192, R, C); const int Rb = E.perm ? ((R & ~31) + perm32(R & 31)) : R;
        voffA[i] = (unsigned)(R * K + C) * 2u; voffB[i] = (unsigned)(Rb * K + C) * 2u; }
    const size_t kstep = (size_t)(BK * 2);
    const size_t hstep = (size_t)HALF * K * 2;
    const size_t tstep = 2 * hstep;
    const unsigned ldsw = (unsigned)wid * 1024u;
    const int aoff = lds_byte(wr * 64 + fr, fq * 8), boff = lds_byte(wc * 32 + fr, fq * 8);
#define PG8_SA(b, h) (((b) * 2 + (h)) * HTB)
#define PG8_SB(b, h) ((4 + (b) * 2 + (h)) * HTB)
#define PG8_STAGE(bufoff, gbase, voff) do { _Pragma("unroll") for (int _i = 0; _i < 2; ++_i) \
        __builtin_amdgcn_global_load_lds((const unsigned*)((const char*)(gbase) + (voff)[_i]), (PG8_LAS unsigned*)(lds + (bufoff) + ldsw + _i * 8192), 16, 0, 0); } while (0)
#define PG8_LDA(dst, b, h) do { _Pragma("unroll") for (int m = 0; m < 4; ++m) _Pragma("unroll") for (int k = 0; k < 2; ++k) dst[m][k] = *(const PG8_LAS bf16x8*)(lds + PG8_SA(b, h) + aoff + m * 2048 + k * 1024); } while (0)
#define PG8_LDB(dst, b, h) do { _Pragma("unroll") for (int n = 0; n < 2; ++n) _Pragma("unroll") for (int k = 0; k < 2; ++k) dst[n][k] = *(const PG8_LAS bf16x8*)(lds + PG8_SB(b, h) + boff + n * 2048 + k * 1024); } while (0)
#define PG8_MMA(ai, bj, At, Bt) do { __builtin_amdgcn_s_setprio(1); _Pragma("unroll") for (int m = 0; m < 4; ++m) _Pragma("unroll") for (int n = 0; n < 2; ++n) _Pragma("unroll") for (int k = 0; k < 2; ++k) \
        acc[ai][bj][m][n] = __builtin_amdgcn_mfma_f32_16x16x32_bf16(Bt[n][k], At[m][k], acc[ai][bj][m][n], 0, 0, 0); __builtin_amdgcn_s_setprio(0); } while (0)
#define PG8_WAIT_V(n) asm volatile("s_waitcnt vmcnt(" #n ")" ::: "memory")
#define PG8_WAIT_L(n) asm volatile("s_waitcnt lgkmcnt(" #n ")" ::: "memory")
#define PG8_BAR __builtin_amdgcn_s_barrier()
#define PG8_SCHED __builtin_amdgcn_sched_barrier(0)
    Unit cur, nxt; int ui = 0;
    if (!S.next(0, cur)) return;
    f32x4 acc[2][2][4][2];
#pragma unroll
    for (int a = 0; a < 2; ++a)
#pragma unroll
        for (int b = 0; b < 2; ++b)
#pragma unroll
            for (int m = 0; m < 4; ++m)
#pragma unroll
                for (int n = 0; n < 2; ++n) acc[a][b][m][n] = (f32x4){0.f, 0.f, 0.f, 0.f};
    bf16x8 At[4][2], B0[2][2], B1[2][2];
    const char* cA = (const char*)g.A + (size_t)cur.pm * tstep; const char* cB = (const char*)g.Bt + (size_t)cur.pn * tstep;
    S.a_ready(cur);
    if constexpr (SP2) {
        PG8_STAGE(PG8_SB(0, 0), cB, voffB); PG8_STAGE(PG8_SB(0, 1), cB + hstep, voffB); PG8_STAGE(PG8_SA(0, 0), cA, voffA); PG8_STAGE(PG8_SA(0, 1), cA + hstep, voffA);
        if (wr == 1) PG8_BAR;
        PG8_WAIT_V(2); PG8_BAR;
        PG8_STAGE(PG8_SB(1, 0), cB + kstep, voffB); PG8_STAGE(PG8_SA(1, 0), cA + kstep, voffA); PG8_STAGE(PG8_SB(1, 1), cB + hstep + kstep, voffB);
        PG8_WAIT_V(6); PG8_BAR;
    } else {
        PG8_STAGE(PG8_SB(0, 0), cB, voffB); PG8_STAGE(PG8_SA(0, 0), cA, voffA); PG8_STAGE(PG8_SB(0, 1), cB + hstep, voffB); PG8_STAGE(PG8_SA(0, 1), cA + hstep, voffA);
        if (wr == 1) PG8_BAR;
        PG8_WAIT_V(4); PG8_BAR;
        PG8_STAGE(PG8_SB(1, 0), cB + kstep, voffB); PG8_STAGE(PG8_SA(1, 0), cA + kstep, voffA); PG8_STAGE(PG8_SB(1, 1), cB + hstep + kstep, voffB);
        PG8_WAIT_V(6); PG8_BAR;
    }
    for (;;) {
        const bool has_next = S.next(ui + 1, nxt);
        const char* nA = has_next ? (const char*)g.A + (size_t)nxt.pm * tstep : cA; const char* nB = has_next ? (const char*)g.Bt + (size_t)nxt.pn * tstep : cB;
        for (int t = 0; t < nt; t += 2) {
            const bool last = (t == nt - 2);
            const char* a1 = cA + (size_t)(t + 1) * kstep;
            const char* a2 = last ? nA : cA + (size_t)(t + 2) * kstep; const char* b2 = last ? nB : cB + (size_t)(t + 2) * kstep;
            const char* a3 = a2 + kstep; const char* b3 = b2 + kstep;
            if (last && has_next) S.a_ready(nxt);
            if constexpr (SP2) {
            PG8_LDB(B0, 0, 0); PG8_LDB(B1, 0, 1); PG8_SCHED; PG8_LDA(At, 0, 0); PG8_STAGE(PG8_SA(1, 1), a1 + hstep, voffA);
            PG8_WAIT_V(8); PG8_WAIT_L(0); PG8_BAR; PG8_MMA(0, 0, At, B0); PG8_MMA(0, 1, At, B1); PG8_BAR; PG8_SCHED;
            PG8_LDA(At, 0, 1); PG8_STAGE(PG8_SB(0, 0), b2, voffB); PG8_STAGE(PG8_SB(0, 1), b2 + hstep, voffB); PG8_STAGE(PG8_SA(0, 0), a2, voffA);
            PG8_WAIT_V(8); PG8_WAIT_L(0); PG8_BAR; PG8_MMA(1, 0, At, B0); PG8_MMA(1, 1, At, B1); PG8_BAR; PG8_SCHED;
            PG8_LDB(B0, 1, 0); PG8_LDB(B1, 1, 1); PG8_SCHED; PG8_LDA(At, 1, 0); PG8_STAGE(PG8_SA(0, 1), a2 + hstep, voffA);
            PG8_WAIT_V(8); PG8_WAIT_L(0); PG8_BAR; PG8_MMA(0, 0, At, B0); PG8_MMA(0, 1, At, B1); PG8_BAR; PG8_SCHED;
            PG8_LDA(At, 1, 1); PG8_STAGE(PG8_SB(1, 0), b3, voffB); PG8_STAGE(PG8_SB(1, 1), b3 + hstep, voffB); PG8_STAGE(PG8_SA(1, 0), a3, voffA);
            PG8_WAIT_V(8); PG8_WAIT_L(0); PG8_BAR; PG8_MMA(1, 0, At, B0); PG8_MMA(1, 1, At, B1); PG8_BAR; PG8_SCHED;
            } else {
            PG8_LDB(B0, 0, 0); PG8_SCHED; PG8_LDA(At, 0, 0); PG8_STAGE(PG8_SA(1, 1), a1 + hstep, voffA);
            PG8_WAIT_L(8); PG8_BAR; PG8_WAIT_L(0); PG8_MMA(0, 0, At, B0); PG8_BAR; PG8_SCHED;
            PG8_LDB(B1, 0, 1); PG8_STAGE(PG8_SB(0, 0), b2, voffB);
            PG8_BAR; PG8_WAIT_L(0); PG8_MMA(0, 1, At, B1); PG8_BAR;
            PG8_LDA(At, 0, 1); PG8_STAGE(PG8_SA(0, 0), a2, voffA);
            PG8_BAR; PG8_WAIT_L(0); PG8_MMA(1, 0, At, B0); PG8_BAR; PG8_SCHED;
            PG8_STAGE(PG8_SB(0, 1), b2 + hstep, voffB);
            PG8_WAIT_V(6); PG8_BAR; PG8_MMA(1, 1, At, B1); PG8_BAR;
            PG8_LDB(B0, 1, 0); PG8_SCHED; PG8_LDA(At, 1, 0); PG8_STAGE(PG8_SA(0, 1), a2 + hstep, voffA);
            PG8_WAIT_L(8); PG8_BAR; PG8_WAIT_L(0); PG8_MMA(0, 0, At, B0); PG8_BAR; PG8_SCHED;
            PG8_LDB(B1, 1, 1); PG8_STAGE(PG8_SB(1, 0), b3, voffB);
            PG8_BAR; PG8_WAIT_L(0); PG8_MMA(0, 1, At, B1); PG8_BAR;
            PG8_LDA(At, 1, 1); PG8_STAGE(PG8_SA(1, 0), a3, voffA);
            PG8_BAR; PG8_WAIT_L(0); PG8_MMA(1, 0, At, B0); PG8_BAR; PG8_SCHED;
            PG8_STAGE(PG8_SB(1, 1), b3 + hstep, voffB);
            PG8_WAIT_V(6); PG8_BAR; PG8_MMA(1, 1, At, B1); PG8_BAR;
            }
        }
        if constexpr (ALIGN_EPI) { if (wr == 0) PG8_BAR; }
        if constexpr (!Epi::AFTER_DRAIN) { E(acc, cur, wr, wc, fr, fq); S.done(cur); }
        if (!has_next) break;
#pragma unroll
        for (int a = 0; a < 2; ++a)
#pragma unroll
            for (int b = 0; b < 2; ++b)
#pragma unroll
                for (int m = 0; m < 4; ++m)
#pragma unroll
                    for (int n = 0; n < 2; ++n) acc[a][b][m][n] = (f32x4){0.f, 0.f, 0.f, 0.f};
        cur = nxt; cA = nA; cB = nB; ++ui;
        if constexpr (ALIGN_EPI) { if (wr == 1) PG8_BAR; }
    }
    PG8_WAIT_V(0);
    if constexpr (!ALIGN_EPI) { if (wr == 0) PG8_BAR; }
    PG8_BAR;
    if constexpr (Epi::AFTER_DRAIN) { E.fused(acc, cur, wr, wc, fr, fq, lds, wid, lane); S.done(cur); }
#undef PG8_SA
#undef PG8_SB
#undef PG8_STAGE
#undef PG8_LDA
#undef PG8_LDB
#undef PG8_MMA
#undef PG8_WAIT_V
#undef PG8_WAIT_L
#undef PG8_BAR
#undef PG8_SCHED
}
}

constexpr int NWAVES = 8, NTHR = 512;
constexpr int D = 1024, NB = 8, SEQ = 2048, MP = NB * SEQ, MS = 128, MT = MP + MS;
constexpr int NA = 2560, NBH = 4096;
constexpr int WIN_ROWS = NA + NBH;
constexpr int XBC = 1280, ABIN = 6416;
constexpr int FF = 2816, FF2 = 5632, NFT = 22;
constexpr float EPS = 1e-6f;
constexpr int NPH = 18;

constexpr size_t O_YP = 0, O_YS = O_YP + (size_t)MP * D, O_PSSM = O_YS + (size_t)MS * D, O_PSCONV = O_PSSM + 8 * 16 * 64 * 64, O_PHG = O_PSCONV + 8 * 3 * XBC,
                 O_PS5R = O_PHG + 8 * 8 * 128 * 128, O_PS5I = O_PS5R + 8 * 64 * 64, O_PFC = O_PS5I + 8 * 64 * 64, O_SSSM = O_PFC + 2 * 8 * 2 * FF2,
                 O_SSCONV = O_SSSM + (size_t)MS * 16 * 64 * 64, O_SHG = O_SSCONV + (size_t)MS * 3 * XBC, O_SS5R = O_SHG + (size_t)MS * 8 * 128 * 128,
                 O_SS5I = O_SS5R + (size_t)MS * 64 * 64, O_SFC = O_SS5I + (size_t)MS * 64 * 64, O_END = O_SFC + (size_t)2 * MS * 2 * FF2;
static_assert(O_END == 48347136, "d_out size");

constexpr size_t al256(size_t x) { return (x + 255) & ~(size_t)255; }
constexpr size_t WS_CTL = 0, CTL_BYTES = 1u << 20;
constexpr size_t WS_WIN = CTL_BYTES;
constexpr size_t WS_WOUT = WS_WIN + (size_t)WIN_ROWS * D * 2;
constexpr size_t WS_WGLU = WS_WOUT + (size_t)D * 2048 * 2;
constexpr size_t WS_WUP = WS_WGLU + (size_t)2048 * D * 2;
constexpr size_t WS_WDN = WS_WUP + (size_t)2 * FF2 * D * 2;
constexpr size_t WS_XN = WS_WDN + (size_t)2 * D * FF * 2;
constexpr size_t WS_MIXS = WS_XN + (size_t)MT * D * 2;
constexpr size_t WS_BIG = al256(WS_MIXS + (size_t)MS * 2048 * 2);
constexpr size_t WS_END = (size_t)256 << 20;
constexpr size_t BIG_BYTES = WS_END - WS_BIG;
constexpr size_t B_PROJA = 0;
constexpr size_t B_Y2 = al256(B_PROJA + (size_t)MT * NA * 2);
constexpr size_t B_ORAW = 0;
constexpr size_t B_PROJB = al256(B_ORAW + (size_t)MT * D * 2);
constexpr size_t B_M1 = 0;
constexpr size_t B_UP = 0;
constexpr size_t B_ACT = al256((size_t)MT * 2048 * 2);
constexpr size_t B_GY = 0;
constexpr size_t B_PC = al256(B_GY + (size_t)MT * D * 2);
constexpr size_t B_XP = al256(B_PC + (size_t)1024 * 8192 * 4);
constexpr size_t B_M1G = (size_t)100 << 20;
constexpr size_t B_S5T = (size_t)120 << 20;
constexpr size_t S5T_KQ = 0, S5T_PM = S5T_KQ + (size_t)64 * 256 * 384 * 2, S5T_END = S5T_PM + (size_t)64 * 128 * 256 * 2;
static_assert(B_Y2 + (size_t)MT * D * 4 <= BIG_BYTES, "ssd stage");
static_assert(B_PROJB + (size_t)MT * NBH * 2 <= BIG_BYTES, "hgrn stage");
static_assert(B_ACT + (size_t)MT * FF * 2 <= BIG_BYTES, "ffn stage");
static_assert(B_XP + (size_t)1024 * 8192 * 2 <= B_S5T && B_M1G + (size_t)MT * D * 4 <= BIG_BYTES && B_S5T + S5T_END <= BIG_BYTES && B_S5T >= B_M1 + (size_t)MT * D * 4, "s5 stage");

#define GAS __attribute__((address_space(1)))
#define LAS __attribute__((address_space(3)))
typedef unsigned short bf16;
typedef unsigned v4u __attribute__((ext_vector_type(4)));
typedef unsigned v2u __attribute__((ext_vector_type(2)));
typedef float f32x4 __attribute__((ext_vector_type(4)));
typedef float f32x16 __attribute__((ext_vector_type(16)));
typedef short bf16x8 __attribute__((ext_vector_type(8)));
typedef GAS unsigned gu32;
#define RLX_AGENT __ATOMIC_RELAXED, __HIP_MEMORY_SCOPE_AGENT
#define LDS_WAIT() asm volatile("s_waitcnt lgkmcnt(0)" ::: "memory")
#define VM_WAIT() asm volatile("s_waitcnt vmcnt(0)" ::: "memory")
__device__ __forceinline__ unsigned f2bf(float f) { unsigned u = __builtin_bit_cast(unsigned, f); return (u + 0x7fffu + ((u >> 16) & 1u)) >> 16; }
__device__ __forceinline__ unsigned pk2(float lo, float hi) { return f2bf(lo) | (f2bf(hi) << 16); }
__device__ __forceinline__ float bf2f(unsigned short b) { return __builtin_bit_cast(float, (unsigned)b << 16); }
__device__ __forceinline__ float bflo(unsigned w) { return __builtin_bit_cast(float, w << 16); }
__device__ __forceinline__ float bfhi(unsigned w) { return __builtin_bit_cast(float, w & 0xffff0000u); }
__device__ __forceinline__ float sigmoidf_(float x) { return __builtin_amdgcn_rcpf(1.0f + __expf(-x)); }
__device__ __forceinline__ float siluf_(float x) { return x * __builtin_amdgcn_rcpf(1.0f + __expf(-x)); }
__device__ __forceinline__ float softplusf_(float x) { return x > 20.f ? x : log1pf(__expf(x)); }
__device__ __forceinline__ float gelu_tanh(float x) { const float u = 0.7978845608028654f * (x + 0.044715f * x * x * x); const float e = __expf(2.f * u); const float th = 1.f - 2.f / (e + 1.f); return 0.5f * x * (1.f + th); }

#define XB_TMO      128
#define XB_XCNT(j)  (256  + 64 * (j))
#define XB_XSUB(j)  (1280 + 64 * (j))
#define XB_XGEN(j)  (2304 + 64 * (j))
#define XB_TOP      3328
#define XB_TOPGEN   3392
#define XCD_BAR_WORDS 3456
#define XB_SPIN_CAP (1u << 18)
__device__ __forceinline__ unsigned xb_ld(unsigned* p)              { return __hip_atomic_load(p, __ATOMIC_RELAXED, __HIP_MEMORY_SCOPE_AGENT); }
__device__ __forceinline__ unsigned xb_add(unsigned* p, unsigned v) { return __hip_atomic_fetch_add(p, v, __ATOMIC_RELAXED, __HIP_MEMORY_SCOPE_AGENT); }
__device__ __forceinline__ unsigned xb_xcc_id() { return (unsigned)__builtin_amdgcn_s_getreg((3 << 11) | 20) & 0xFu; }
#define XB_SPIN(cond, bar) do { unsigned _sp = 0; while (cond) { __builtin_amdgcn_s_sleep(1); \
    if ((++_sp & 255u) == 0u) { if (xb_ld(&(bar)[XB_TMO])) break; if (_sp > XB_SPIN_CAP) { atomicAdd(&(bar)[XB_TMO], 1u); break; } } } } while (0)
struct XcdBarrier { unsigned* bar; unsigned x; volatile LAS unsigned* st; };
__device__ __forceinline__ XcdBarrier xcd_barrier_post(unsigned* bar, volatile LAS unsigned* st) {
    XcdBarrier b; b.bar = bar; b.x = xb_xcc_id(); b.st = st;
    if (threadIdx.x == 0) (void)xb_add(&bar[XB_XCNT(b.x)], 1u);
    return b;
}
__device__ __forceinline__ void xcd_barrier_complete(unsigned* bar, unsigned x, unsigned& nloc, unsigned& nx) {
    const unsigned G = gridDim.x * gridDim.y * gridDim.z;
    unsigned sum, cnt, mine, sp = 0u;
    for (;;) {
        sum = 0u; cnt = 0u; mine = 0u;
#pragma unroll
        for (unsigned j = 0; j < 16; ++j) { const unsigned c = xb_ld(&bar[XB_XCNT(j)]); sum += c; cnt += (c > 0u) ? 1u : 0u; mine = (j == x) ? c : mine; }
        if (sum == G) break;
        __builtin_amdgcn_s_sleep(1);
        if ((++sp & 255u) == 0u) { if (xb_ld(&bar[XB_TMO])) break; if (sp > XB_SPIN_CAP) { atomicAdd(&bar[XB_TMO], 1u); break; } }
    }
    nloc = mine > 0u ? mine : 1u; nx = cnt > 0u ? cnt : 1u;
}
__device__ __forceinline__ void xcd_barrier(const XcdBarrier& b) {
    asm volatile("s_waitcnt vmcnt(0)" ::: "memory");
    __syncthreads();
    if (threadIdx.x == 0) {
        unsigned* bar = b.bar;
        __builtin_amdgcn_s_waitcnt(0);
        unsigned nloc = b.st[0], nx = b.st[1];
        if (nloc == 0u) { xcd_barrier_complete(bar, b.x, nloc, nx); b.st[0] = nloc; b.st[1] = nx; }
        const unsigned old = xb_add(&bar[XB_XSUB(b.x)], 1u);
        const unsigned gen = old / nloc;
        if (old + 1u == (gen + 1u) * nloc) {
            __builtin_amdgcn_fence(__ATOMIC_RELEASE, "agent");
            asm volatile("s_waitcnt vmcnt(0)" ::: "memory");
            const unsigned og = xb_add(&bar[XB_TOP], 1u);
            const unsigned tg = og / nx;
            if (og + 1u == (tg + 1u) * nx) xb_add(&bar[XB_TOPGEN], 1u);
            else XB_SPIN(xb_ld(&bar[XB_TOPGEN]) == tg, bar);
            __builtin_amdgcn_fence(__ATOMIC_ACQUIRE, "agent");
            xb_add(&bar[XB_XGEN(b.x)], 1u);
            asm volatile("s_waitcnt vmcnt(0)" ::: "memory");
        } else {
            XB_SPIN(xb_ld(&bar[XB_XGEN(b.x)]) == gen, bar);
            __builtin_amdgcn_fence(__ATOMIC_ACQUIRE, "agent");
            asm volatile("s_waitcnt vmcnt(0)" ::: "memory");
        }
    }
    __syncthreads();
}

constexpr int RING_BYTES = 131072;
constexpr int LDSCTL_OFF = RING_BYTES, MISC_OFF = LDSCTL_OFF + 320, HALO_OFF = RING_BYTES + 1024;
constexpr int LDS_BYTES = 147456;

struct Args { const float* in[35]; float* out; unsigned char* ws; int ph_lo, ph_hi, li, pad; };
static_assert(sizeof(Args) == 35 * 8 + 8 + 8 + 16, "Args has no padding");
#define CAS __attribute__((address_space(4)))
struct Frame {
    LAS unsigned char* lds;
    int tid, lane, wave, vcu, G;
    const CAS Args* a;
    float* out;
    unsigned char* ws;
};

enum { I_XP = 0, I_XS, I_SSSM, I_SSCONV, I_SHG, I_SS5R, I_SS5I, I_SFC, I_NMPRE, I_NMPOST, I_NFPRE, I_NFPOST, I_WIN, I_CONVW, I_CONVB, I_DTB, I_ALOG, I_SSMD, I_SSMNW,
       I_HGLB, I_HGNW, I_WOUT, I_LAMRE, I_LAMIM, I_LOGSTEP, I_BRE, I_BIM, I_CRE, I_CIM, I_S5D, I_WGLU, I_WUP, I_FCW, I_FCB, I_WDN, N_IN };

#define GW_ID(F) ((F).vcu * NWAVES + (F).wave)
#define GW_N(F) ((F).G * NWAVES)

__device__ __forceinline__ void p0_transpose_item(const float* W, int ldw, int K, int scol0, bf16* WT, int drow0, int kb, LAS float* scr, int lane) {
    const int k0 = 64 * kb;
#pragma unroll 8
    for (int i = 0; i < 32; ++i) { const int kk = 2 * i + (lane >> 5); scr[kk * 33 + (lane & 31)] = W[(size_t)(k0 + kk) * ldw + scol0 + (lane & 31)]; }
    LDS_WAIT(); asm volatile("" ::: "memory");
    const int c = lane & 7;
#pragma unroll
    for (int j = 0; j < 4; ++j) { const int n = (lane >> 3) + 8 * j; const LAS float* s = scr + (8 * c) * 33 + n;
        v4u o; o.x = pk2(s[0 * 33], s[1 * 33]); o.y = pk2(s[2 * 33], s[3 * 33]); o.z = pk2(s[4 * 33], s[5 * 33]); o.w = pk2(s[6 * 33], s[7 * 33]);
        *(GAS v4u*)(WT + (size_t)(drow0 + n) * K + k0 + 8 * c) = o; }
    LDS_WAIT(); asm volatile("" ::: "memory");
}
__device__ __forceinline__ void rms_row_to_bf16(const float* xrow, const float* w, bf16* orow, int lane) {
    const GAS f32x4* xr = (const GAS f32x4*)xrow + lane; const GAS f32x4* wr = (const GAS f32x4*)w + lane;
    f32x4 v[4]; float s = 0.f;
#pragma unroll
    for (int j = 0; j < 4; ++j) { v[j] = xr[64 * j]; s += (v[j].x * v[j].x + v[j].y * v[j].y) + (v[j].z * v[j].z + v[j].w * v[j].w); }
    const float rs = rsqrtf(wave_sum(s) * (1.f / D) + EPS);
    GAS v2u* o8 = (GAS v2u*)orow + lane;
#pragma unroll
    for (int j = 0; j < 4; ++j) { const f32x4 ww = wr[64 * j]; v2u o; o.x = pk2(v[j].x * rs * ww.x, v[j].y * rs * ww.y); o.y = pk2(v[j].z * rs * ww.z, v[j].w * rs * ww.w); o8[64 * j] = o; }
}
__device__ __forceinline__ const float* x_in_row(const Frame& F, int r) { return r < MP ? F.a->in[I_XP] + (size_t)r * D : F.a->in[I_XS] + (size_t)(r - MP) * D; }
__device__ __forceinline__ float* x_res_row(const Frame& F, int r) { return r < MP ? F.out + O_YP + (size_t)r * D : F.out + O_YS + (size_t)(r - MP) * D; }

__device__ __forceinline__ void wconv_items(Frame& F, int it_lo, int it_hi, int gw, int NGW) {
    LAS float* scr = (LAS float*)(F.lds + F.wave * 16384);
    bf16* WIN = (bf16*)(F.ws + WS_WIN); bf16* WOUT = (bf16*)(F.ws + WS_WOUT); bf16* WGLU = (bf16*)(F.ws + WS_WGLU); bf16* WUP = (bf16*)(F.ws + WS_WUP); bf16* WDN = (bf16*)(F.ws + WS_WDN);
    constexpr int I_IN = 16 * 200, I_OUT = 32 * 32, I_GLU = 16 * 64, I_UP = 16 * 176, I_DN = 44 * 32;
    constexpr int NITEMS = I_IN + I_OUT + I_GLU + 2 * I_UP + 2 * I_DN;
    (void)NITEMS;
    for (int it = it_lo + gw; it < it_hi; it += NGW) {
        int r = it;
        if (r < I_IN) { const int kb = r / 200, nb = r % 200;
            const int sc = nb < 72 ? 32 * nb : 2320 + 32 * (nb - 72);
            const int dr = nb < 72 ? 32 * nb : NA + 32 * (nb - 72);
            p0_transpose_item(F.a->in[I_WIN], ABIN, D, sc, WIN, dr, kb, scr, F.lane); continue; }
        r -= I_IN;
        if (r < I_OUT) { p0_transpose_item(F.a->in[I_WOUT], D, 2048, 32 * (r % 32), WOUT, 32 * (r % 32), r / 32, scr, F.lane); continue; }
        r -= I_OUT;
        if (r < I_GLU) { const int kb = r / 64, nb = r % 64, d = 32 * nb, j = d >> 8, bj = (d >> 7) & 1, c = d & 127;
            p0_transpose_item(F.a->in[I_WGLU], 2048, D, 1024 * bj + 128 * j + c, WGLU, d, kb, scr, F.lane); continue; }
        r -= I_GLU;
        if (r < 2 * I_UP) { const int l = r / I_UP; r -= l * I_UP; const int kb = r / 176, nb = r % 176, d = 32 * nb, j = d >> 8, bj = (d >> 7) & 1, c = d & 127;
            p0_transpose_item(F.a->in[I_WUP] + (size_t)l * D * FF2, FF2, D, FF * bj + 128 * j + c, WUP + (size_t)l * FF2 * D, d, kb, scr, F.lane); continue; }
        r -= 2 * I_UP;
        { const int l = r / I_DN; r -= l * I_DN; p0_transpose_item(F.a->in[I_WDN] + (size_t)l * FF * D, D, FF, 32 * (r % 32), WDN + (size_t)l * D * FF, 32 * (r % 32), r / 32, scr, F.lane); }
    }
}
constexpr int WC_EARLY = 16 * 200 + 32 * 32, WC_ALL = 16 * 200 + 32 * 32 + 16 * 64 + 2 * 16 * 176 + 2 * 44 * 32;
__device__ __forceinline__ void p0_prologue(Frame& F) {
    const int gw = GW_ID(F), NGW = GW_N(F);
    bf16* WIN = (bf16*)(F.ws + WS_WIN);
    wconv_items(F, 0, F.G > 128 ? WC_EARLY : WC_ALL, gw, NGW);
    { const int gt = (F.vcu * NTHR + F.tid), NT = F.G * NTHR;
      for (int i = gt; i < 16 * D; i += NT) { const int n = i >> 10, k = i & 1023; WIN[(size_t)(2304 + n) * D + k] = (bf16)f2bf(F.a->in[I_WIN][(size_t)k * ABIN + 2304 + n]); }
      unsigned z_ = 0u; asm volatile("" : "+v"(z_));
      for (int i = gt; i < 240 * D / 8; i += NT) ((GAS v4u*)(WIN + (size_t)2320 * D))[i] = (v4u){z_, z_, z_, z_}; }
    bf16* XN = (bf16*)(F.ws + WS_XN);
    for (int m = gw; m < MT; m += NGW) rms_row_to_bf16(x_in_row(F, m), F.a->in[I_NMPRE], XN + (size_t)m * D, F.lane);
}

template <int NT, bool GLU, class Epi>
__device__ __forceinline__ void skinny_gemm(Frame& F, const bf16* A, int lda, const bf16* Bt, int K, int ncb, const Epi& epi, int tb, int tstride) {
    LAS float* red = (LAS float*)F.lds;
    const int lane = F.lane, r = lane & 31, h = lane >> 5, w = F.wave;
    const int kper = K >> 3, kbeg = w * kper;
    const int ntask = 4 * ncb;
    if (tb < 0) return;
    for (int task = tb; task < ntask; task += tstride) {
        const int rt = task & 3, ct = task >> 2;
        const int brow = GLU ? (256 * (ct >> 2) + 32 * (ct & 3)) : 32 * ct;
        const bf16* ap = A + (size_t)(rt * 32 + r) * lda + kbeg + 8 * h;
        const bf16* bp = Bt + (size_t)(brow + r) * K + kbeg + 8 * h;
        f32x16 acc[NT];
#pragma unroll
        for (int nt = 0; nt < NT; ++nt)
#pragma unroll
            for (int i = 0; i < 16; ++i) acc[nt][i] = 0.f;
#pragma unroll 2
        for (int k = 0; k < kper; k += 16) {
            const bf16x8 a = *(const bf16x8*)(ap + k);
#pragma unroll
            for (int nt = 0; nt < NT; ++nt) { const bf16x8 b = *(const bf16x8*)(bp + (size_t)nt * 128 * K + k); acc[nt] = __builtin_amdgcn_mfma_f32_32x32x16_bf16(a, b, acc[nt], 0, 0, 0); }
        }
#pragma unroll
        for (int nt = 0; nt < NT; ++nt)
#pragma unroll
            for (int i = 0; i < 16; ++i) red[((w * NT + nt) * 16 + i) * 64 + lane] = acc[nt][i];
        __syncthreads();
#pragma unroll
        for (int e0 = 0; e0 < 2; ++e0) { const int e = F.tid + 512 * e0, i = e >> 6, l = e & 63; float v[NT];
#pragma unroll
            for (int nt = 0; nt < NT; ++nt) { float s = 0.f;
#pragma unroll
                for (int ww = 0; ww < 8; ++ww) s += red[((ww * NT + nt) * 16 + i) * 64 + l];
                v[nt] = s; }
            epi(rt * 32 + (i & 3) + 8 * (i >> 2) + 4 * (l >> 5), ct * 32 + (l & 31), v); }
        __syncthreads();
    }
}
struct SkBf16 { bf16* O; int ld; __device__ __forceinline__ void operator()(int row, int col, const float (&v)[1]) const { O[(size_t)row * ld + col] = (bf16)f2bf(v[0]); } };
struct SkF32 { float* O; int ld; __device__ __forceinline__ void operator()(int row, int col, const float (&v)[1]) const { O[(size_t)row * ld + col] = v[0]; } };
struct SkGlu { bf16* O; int ld; __device__ __forceinline__ void operator()(int row, int col, const float (&v)[2]) const { O[(size_t)row * ld + col] = (bf16)f2bf(v[0] * sigmoidf_(v[1])); } };

constexpr size_t B_XR = al256((size_t)MT * D * 2);
__device__ __forceinline__ void resid_norm_rows(Frame& F, const bf16* msrc, const float* w_post, const float* w_pre, int mode) {
    const int gw = GW_ID(F), NGW = GW_N(F), lane = F.lane;
    bf16* XN = (bf16*)(F.ws + WS_XN); bf16* XR = (bf16*)(F.ws + WS_BIG + B_XR);
    for (int r = gw; r < MT; r += NGW) {
        const GAS v2u* mr = (const GAS v2u*)(msrc + (size_t)r * D) + lane;
        f32x4 m[4], x[4]; float s = 0.f;
#pragma unroll
        for (int j = 0; j < 4; ++j) { const v2u mw = mr[64 * j]; m[j] = (f32x4){bflo(mw.x), bfhi(mw.x), bflo(mw.y), bfhi(mw.y)};
            if (mode == 0) x[j] = ((const GAS f32x4*)x_in_row(F, r) + lane)[64 * j];
            else { const v2u xw = ((const GAS v2u*)(XR + (size_t)r * D) + lane)[64 * j]; x[j] = (f32x4){bflo(xw.x), bfhi(xw.x), bflo(xw.y), bfhi(xw.y)}; }
            s += (m[j].x * m[j].x + m[j].y * m[j].y) + (m[j].z * m[j].z + m[j].w * m[j].w); }
        const float rs = rsqrtf(wave_sum(s) * (1.f / D) + EPS); float s2 = 0.f;
#pragma unroll
        for (int j = 0; j < 4; ++j) { const f32x4 wp = ((const GAS f32x4*)w_post + lane)[64 * j]; x[j] = x[j] + m[j] * rs * wp;
            if (mode == 2) ((GAS f32x4*)x_res_row(F, r) + lane)[64 * j] = x[j];
            else { v2u o; o.x = pk2(x[j].x, x[j].y); o.y = pk2(x[j].z, x[j].w); ((GAS v2u*)(XR + (size_t)r * D) + lane)[64 * j] = o; }
            s2 += (x[j].x * x[j].x + x[j].y * x[j].y) + (x[j].z * x[j].z + x[j].w * x[j].w); }
        if (mode != 2) { const float rs2 = rsqrtf(wave_sum(s2) * (1.f / D) + EPS); GAS v2u* o8 = (GAS v2u*)(XN + (size_t)r * D) + lane;
#pragma unroll
            for (int j = 0; j < 4; ++j) { const f32x4 ww = ((const GAS f32x4*)w_pre + lane)[64 * j]; v2u o; o.x = pk2(x[j].x * rs2 * ww.x, x[j].y * rs2 * ww.y); o.y = pk2(x[j].z * rs2 * ww.z, x[j].w * rs2 * ww.w); o8[64 * j] = o; } }
    }
}
__device__ __forceinline__ bf16* mixed_row(const Frame& F, int r) { return r < MP ? (bf16*)(F.out + O_YP) + (size_t)r * 2048 : (bf16*)(F.ws + WS_MIXS) + (size_t)(r - MP) * 2048; }
constexpr size_t B_HEAD = al256(B_ACT + (size_t)MT * FF * 2), B_TAIL = B_HEAD + (size_t)64 * 2 * FF2 * 4;
static_assert(B_TAIL + (size_t)64 * 2 * FF2 * 4 <= BIG_BYTES, "ffn side buffers");
__device__ __forceinline__ void ffn_fix_rows(Frame& F, int l, int pm) {
    const float* HEAD = (const float*)(F.ws + WS_BIG + B_HEAD); const float* TAIL = (const float*)(F.ws + WS_BIG + B_TAIL); bf16* ACT = (bf16*)(F.ws + WS_BIG + B_ACT);
    const float* cw = F.a->in[I_FCW] + (size_t)l * 3 * FF2; const float* cb = F.a->in[I_FCB] + (size_t)l * FF2;
    for (int c = F.tid; c < FF; c += NTHR) { float r0[2], r1[2];
#pragma unroll
        for (int x = 0; x < 2; ++x) { const int ch = x * FF + c; const float h0 = HEAD[((size_t)pm * 2) * FF2 + ch], h1 = HEAD[((size_t)pm * 2 + 1) * FF2 + ch];
            const float t0 = (pm & 7) ? TAIL[((size_t)(pm - 1) * 2) * FF2 + ch] : 0.f, t1 = (pm & 7) ? TAIL[((size_t)(pm - 1) * 2 + 1) * FF2 + ch] : 0.f;
            const float w0 = cw[ch], w1 = cw[FF2 + ch], w2 = cw[2 * FF2 + ch], bb = cb[ch];
            r0[x] = bb + w0 * t0 + w1 * t1 + w2 * h0; r1[x] = bb + w0 * t1 + w1 * h0 + w2 * h1; }
        ACT[(size_t)(256 * pm) * FF + c] = (bf16)f2bf(r0[0] * siluf_(r0[1])); ACT[(size_t)(256 * pm + 1) * FF + c] = (bf16)f2bf(r1[0] * siluf_(r1[1])); }
}
struct SkConvGate { bf16* ACTs; const float* cw; const float* cb; const float* st; float* sfc;
    __device__ __forceinline__ void operator()(int row, int col, const float (&v)[2]) const {
        const float* s0 = st + ((size_t)row * 2) * FF2; const float* s1 = s0 + FF2; float* p = sfc + (size_t)row * 2 * FF2; const int chv = col, chg = FF + col;
        const float v0 = s0[chv], v1 = s1[chv], g0 = s0[chg], g1 = s1[chg];
        const float vc = cb[chv] + cw[chv] * v0 + cw[FF2 + chv] * v1 + cw[2 * FF2 + chv] * v[0];
        const float gc = cb[chg] + cw[chg] * g0 + cw[FF2 + chg] * g1 + cw[2 * FF2 + chg] * v[1];
        ACTs[(size_t)row * FF + col] = (bf16)f2bf(vc * siluf_(gc)); p[chv] = v1; p[chg] = g1; p[FF2 + chv] = v[0]; p[FF2 + chg] = v[1]; } };

constexpr size_t B_HB = al256(B_PROJA + (size_t)MT * NA * 2);
static_assert(B_HB + (size_t)8 * 64 * 16 * 4096 * 2 <= BIG_BYTES, "ssd state buffer");
typedef float f32x2_t __attribute__((ext_vector_type(2)));

__device__ __forceinline__ void ssd_conv4(const Frame& F, const bf16* PA, int b, int t, int ch0, float (&out)[8][4]) {
    const float* cw = F.a->in[I_CONVW] + ch0; const float* cbias = F.a->in[I_CONVB] + ch0;
    float raw[7][8];
#pragma unroll
    for (int rr = 0; rr < 7; ++rr) { const int tt = t - 3 + rr;
        if (tt >= 0) { const v4u q = *(const GAS v4u*)(PA + (size_t)(b * SEQ + tt) * NA + 1024 + ch0);
            raw[rr][0] = bflo(q.x); raw[rr][1] = bfhi(q.x); raw[rr][2] = bflo(q.y); raw[rr][3] = bfhi(q.y); raw[rr][4] = bflo(q.z); raw[rr][5] = bfhi(q.z); raw[rr][6] = bflo(q.w); raw[rr][7] = bfhi(q.w); }
        else {
#pragma unroll
            for (int e = 0; e < 8; ++e) raw[rr][e] = 0.f; } }
    float w[4][8], bs[8];
#pragma unroll
    for (int k = 0; k < 4; ++k) { const f32x4 a = *(const GAS f32x4*)(cw + k * XBC), c = *(const GAS f32x4*)(cw + k * XBC + 4);
        w[k][0] = a.x; w[k][1] = a.y; w[k][2] = a.z; w[k][3] = a.w; w[k][4] = c.x; w[k][5] = c.y; w[k][6] = c.z; w[k][7] = c.w; }
    { const f32x4 a = *(const GAS f32x4*)cbias, c = *(const GAS f32x4*)(cbias + 4); bs[0] = a.x; bs[1] = a.y; bs[2] = a.z; bs[3] = a.w; bs[4] = c.x; bs[5] = c.y; bs[6] = c.z; bs[7] = c.w; }
#pragma unroll
    for (int e = 0; e < 8; ++e)
#pragma unroll
        for (int j = 0; j < 4; ++j) { float v = bs[e];
#pragma unroll
            for (int k = 0; k < 4; ++k) v += w[k][e] * raw[j + k][e];
            out[e][j] = siluf_(v); }
}

__device__ __forceinline__ void ssd_state_item(Frame& F, int b, int h) {
    const bf16* PA = (const bf16*)(F.ws + WS_BIG + B_PROJA); bf16* HB = (bf16*)(F.ws + WS_BIG + B_HB);
    constexpr int TP = 80, TBUF = 128 * TP;
    LAS unsigned char* T0 = F.lds; LAS float* WG = (LAS float*)(F.lds + 2 * TBUF); LAS float* DEC = WG + SEQ;
    int tid = F.tid; asm volatile("" : "+v"(tid));
    const int lane = tid & 63, wave = __builtin_amdgcn_readfirstlane(tid >> 6), g = h >> 3, r = lane & 31, hh = lane >> 5;
    { const float A = -__expf(F.a->in[I_ALOG][h]), dtb = F.a->in[I_DTB][h];
      float dt[4], cum[4]; float run = 0.f;
#pragma unroll
      for (int j = 0; j < 4; ++j) { dt[j] = softplusf_(bf2f(PA[(size_t)(b * SEQ + 4 * tid + j) * NA + 2304 + h]) + dtb); run += dt[j] * A; cum[j] = run; }
      float incl = run;
      const int ln_ = lane_op_();
#pragma unroll
      for (int off = 1; off < 8; off <<= 1) { const float v = shup_(incl, off, 8, ln_); if ((tid & 7) >= off) incl += v; }
      const float excl = incl - run, last = shidx_(incl, 7, 8, ln_);
#pragma unroll
      for (int j = 0; j < 4; ++j) WG[4 * tid + j] = dt[j] * __expf(last - (excl + cum[j]));
      if ((tid & 7) == 0) DEC[tid >> 3] = __expf(last); }
    __syncthreads();
    if (wave < 4) {
        const int o = tid >> 4, tp = tid & 15, ch0 = o < 8 ? h * 64 + 8 * o : 1024 + g * 64 + 8 * (o - 8);
        float w[4][8], bs[8];
        { const float* cw = F.a->in[I_CONVW] + ch0; const float* cbias = F.a->in[I_CONVB] + ch0;
#pragma unroll
          for (int k = 0; k < 4; ++k) { const f32x4 a = *(const GAS f32x4*)(cw + k * XBC), c4 = *(const GAS f32x4*)(cw + k * XBC + 4);
              w[k][0] = a.x; w[k][1] = a.y; w[k][2] = a.z; w[k][3] = a.w; w[k][4] = c4.x; w[k][5] = c4.y; w[k][6] = c4.z; w[k][7] = c4.w; }
          const f32x4 a = *(const GAS f32x4*)cbias, c4 = *(const GAS f32x4*)(cbias + 4); bs[0] = a.x; bs[1] = a.y; bs[2] = a.z; bs[3] = a.w; bs[4] = c4.x; bs[5] = c4.y; bs[6] = c4.z; bs[7] = c4.w; }
        const bf16* xrow = PA + (size_t)(b * SEQ + 2 * tp) * NA + 1024 + ch0;
        v4u pre[5];
#pragma unroll
        for (int k = 0; k < 5; ++k) { const int rr = 2 * tp - 3 + k < 0 ? 0 : 2 * tp - 3 + k; pre[k] = *(const GAS v4u*)(xrow + (ptrdiff_t)(rr - 2 * tp) * NA); }
        for (int c = 0; c < 64; ++c) {
            LAS unsigned char* T = T0 + (c & 1) * TBUF;
            v4u cur[5];
#pragma unroll
            for (int k = 0; k < 5; ++k) cur[k] = pre[k];
            if (c + 1 < 64) { const bf16* xn = xrow + (size_t)(32 * (c + 1)) * NA;
#pragma unroll
                for (int k = 0; k < 5; ++k) pre[k] = *(const GAS v4u*)(xn + (ptrdiff_t)(k - 3) * NA); }
            const f32x2_t wq = *(const LAS f32x2_t*)(WG + 32 * c + 2 * tp);
            const float w0 = o < 8 ? wq.x : 1.0f, w1 = o < 8 ? wq.y : 1.0f;
            float x8[5][8];
#pragma unroll
            for (int k = 0; k < 5; ++k) { const v4u qv = cur[k]; const float mk = (c == 0 && 2 * tp - 3 + k < 0) ? 0.f : 1.f;
                x8[k][0] = bflo(qv.x) * mk; x8[k][1] = bfhi(qv.x) * mk; x8[k][2] = bflo(qv.y) * mk; x8[k][3] = bfhi(qv.y) * mk; x8[k][4] = bflo(qv.z) * mk; x8[k][5] = bfhi(qv.z) * mk; x8[k][6] = bflo(qv.w) * mk; x8[k][7] = bfhi(qv.w) * mk; }
#pragma unroll
            for (int e = 0; e < 8; ++e) { float v0 = bs[e], v1 = bs[e];
#pragma unroll
                for (int k = 0; k < 4; ++k) { v0 += w[k][e] * x8[k][e]; v1 += w[k][e] * x8[k + 1][e]; }
                *(LAS unsigned*)(T + (8 * o + e) * TP + 4 * tp) = pk2(siluf_(v0) * w0, siluf_(v1) * w1); }
            asm volatile("s_waitcnt lgkmcnt(0)" ::: "memory"); __builtin_amdgcn_s_barrier(); asm volatile("" ::: "memory");
        }
    } else {
        f32x16 acc;
#pragma unroll
        for (int i = 0; i < 16; ++i) acc[i] = 0.f;
        const int q = wave - 4, pt = q >> 1, nt = q & 1;
        for (int c = 0; c < 64; ++c) {
            LAS unsigned char* T = T0 + (c & 1) * TBUF;
            bf16* hb = HB + ((((size_t)b * 64 + c) * 16 + h) * 64 + pt * 32) * 64 + nt * 32 + r;
#pragma unroll
            for (int i = 0; i < 16; ++i) hb[(size_t)((i & 3) + 8 * (i >> 2) + 4 * hh) * 64] = (bf16)f2bf(acc[i]);
            const float dec = DEC[c];
#pragma unroll
            for (int i = 0; i < 16; ++i) acc[i] *= dec;
            asm volatile("s_waitcnt lgkmcnt(0)" ::: "memory"); __builtin_amdgcn_s_barrier(); asm volatile("" ::: "memory");
#pragma unroll
            for (int ks = 0; ks < 2; ++ks) { const bf16x8 a = *(const LAS bf16x8*)(T + (pt * 32 + r) * TP + 32 * ks + 16 * hh), bb = *(const LAS bf16x8*)(T + (64 + nt * 32 + r) * TP + 32 * ks + 16 * hh);
                acc = __builtin_amdgcn_mfma_f32_32x32x16_bf16(a, bb, acc, 0, 0, 0); }
        }
        float* ps = F.out + O_PSSM + ((size_t)(b * 16 + h) * 64 + pt * 32) * 64 + nt * 32 + r;
#pragma unroll
        for (int i = 0; i < 16; ++i) ps[(size_t)((i & 3) + 8 * (i >> 2) + 4 * hh) * 64] = acc[i];
    }
    { float* pc = F.out + O_PSCONV + (size_t)b * 3 * XBC;
      for (int e = tid; e < 3 * 192; e += NTHR) { const int k = e / 192, cc = e % 192; if (cc >= 64 && (h & 7) != 0) continue;
          const int ch = cc < 64 ? h * 64 + cc : (cc < 128 ? 1024 + g * 64 + (cc - 64) : 1152 + g * 64 + (cc - 128));
          pc[k * XBC + ch] = bf2f(PA[(size_t)(b * SEQ + SEQ - 3 + k) * NA + 1024 + ch]); } }
    __syncthreads();
}

__device__ __forceinline__ void ssd_sample_item(Frame& F, int j) {
    const bf16* PA = (const bf16*)(F.ws + WS_BIG + B_PROJA) + (size_t)(MP + j) * NA; bf16* MX = (bf16*)(F.ws + WS_MIXS) + (size_t)j * 2048;
    LAS float* act = (LAS float*)F.lds;
    LAS float* dts = act + XBC;
    LAS float* y2 = dts + 32;
    LAS float* red = y2 + 1024;
    const int tid = F.tid;
    const float* cw = F.a->in[I_CONVW]; const float* cbias = F.a->in[I_CONVB]; const float* st = F.a->in[I_SSCONV] + (size_t)j * 3 * XBC; float* so = F.out + O_SSCONV + (size_t)j * 3 * XBC;
    for (int ch = tid; ch < XBC; ch += NTHR) { const float nw = bf2f(PA[1024 + ch]); const float s0 = st[ch], s1 = st[XBC + ch], s2 = st[2 * XBC + ch];
        act[ch] = siluf_(cbias[ch] + cw[ch] * s0 + cw[XBC + ch] * s1 + cw[2 * XBC + ch] * s2 + cw[3 * XBC + ch] * nw);
        so[ch] = s1; so[XBC + ch] = s2; so[2 * XBC + ch] = nw; }
    if (tid < 16) { const float d = softplusf_(bf2f(PA[2304 + tid]) + F.a->in[I_DTB][tid]); dts[tid] = d; dts[16 + tid] = __expf(-__expf(F.a->in[I_ALOG][tid]) * d); }
    __syncthreads();
    const float* S0 = F.a->in[I_SSSM] + (size_t)j * 65536; float* S1 = F.out + O_SSSM + (size_t)j * 65536;
    float ssq = 0.f;
#pragma unroll 1
    for (int it8 = 0; it8 < 4; ++it8) { f32x4 sv[8];
#pragma unroll
      for (int u = 0; u < 8; ++u) sv[u] = *(const GAS f32x4*)(S0 + (size_t)((it8 * 8 + u) * NTHR + tid) * 4);
#pragma unroll
      for (int u = 0; u < 8; ++u) { const int it = it8 * 8 + u; const int v = it * NTHR + tid, n4 = v & 15, p = (v >> 4) & 63, h = v >> 10, g = h >> 3;
        const f32x4 s = sv[u];
        const f32x4 bb = *(const LAS f32x4*)(act + 1024 + g * 64 + 4 * n4), cc = *(const LAS f32x4*)(act + 1152 + g * 64 + 4 * n4);
        const float x = act[h * 64 + p], dtx = dts[h] * x, dec = dts[16 + h];
        f32x4 nn; float a = 0.f;
#pragma unroll
        for (int i = 0; i < 4; ++i) { nn[i] = dec * s[i] + dtx * bb[i]; a += nn[i] * cc[i]; }
        *(GAS f32x4*)(S1 + (size_t)v * 4) = nn;
        a = row16_sum(a);
        if (n4 == 0) { const float yy = (a + F.a->in[I_SSMD][h] * x) * siluf_(bf2f(PA[h * 64 + p])); y2[h * 64 + p] = yy; ssq += yy * yy; } } }
    ssq = wave_sum(ssq); if (F.lane == 0) red[F.wave] = ssq;
    __syncthreads();
    float tot = 0.f;
#pragma unroll
    for (int w = 0; w < 8; ++w) tot += red[w];
    const float rs = rsqrtf(tot * (1.f / D) + EPS);
    for (int c = tid; c < 1024; c += NTHR) MX[c] = (bf16)f2bf(y2[c] * rs * F.a->in[I_SSMNW][c]);
    __syncthreads();
}
__device__ __forceinline__ void ssd_state_phase(Frame& F) {
    for (int it = F.vcu; it < 128 + MS; it += F.G) { if (it < 128) ssd_state_item(F, it >> 4, it & 15); else ssd_sample_item(F, it - 128); }
    if (F.G > 128 && F.vcu >= 128) { __syncthreads(); wconv_items(F, WC_EARLY, WC_ALL, (F.vcu - 128) * NWAVES + F.wave, (F.G - 128) * NWAVES); }
}

__device__ __forceinline__ void ssd_conv4_lds(const bf16* PA, const LAS float* CWL, int b, int t, int ch0, float (&out)[8][4]) {
    float raw[7][8];
#pragma unroll
    for (int rr = 0; rr < 7; ++rr) { const int tt = t - 3 + rr;
        if (tt >= 0) { const v4u q = *(const GAS v4u*)(PA + (size_t)(b * SEQ + tt) * NA + 1024 + ch0);
            raw[rr][0] = bflo(q.x); raw[rr][1] = bfhi(q.x); raw[rr][2] = bflo(q.y); raw[rr][3] = bfhi(q.y); raw[rr][4] = bflo(q.z); raw[rr][5] = bfhi(q.z); raw[rr][6] = bflo(q.w); raw[rr][7] = bfhi(q.w); }
        else {
#pragma unroll
            for (int e = 0; e < 8; ++e) raw[rr][e] = 0.f; } }
    float w[4][8], bs[8];
#pragma unroll
    for (int k = 0; k < 5; ++k) { const f32x4 a = *(const LAS f32x4*)(CWL + k * XBC + ch0), c = *(const LAS f32x4*)(CWL + k * XBC + ch0 + 4);
        if (k < 4) { w[k][0] = a.x; w[k][1] = a.y; w[k][2] = a.z; w[k][3] = a.w; w[k][4] = c.x; w[k][5] = c.y; w[k][6] = c.z; w[k][7] = c.w; }
        else { bs[0] = a.x; bs[1] = a.y; bs[2] = a.z; bs[3] = a.w; bs[4] = c.x; bs[5] = c.y; bs[6] = c.z; bs[7] = c.w; } }
#pragma unroll
    for (int e = 0; e < 8; ++e)
#pragma unroll
        for (int j = 0; j < 4; ++j) { float v = bs[e];
#pragma unroll
            for (int k = 0; k < 4; ++k) v += w[k < 4 ? k : 0][e] * raw[j + k][e];
            out[e][j] = siluf_(v); }
}
constexpr int SSDO_CWL = 16 * 64 * 80 + 2 * (2 * 32 * 144) + (512 + 512 + 256) * 4;
static_assert(SSDO_CWL + 5 * XBC * 4 <= RING_BYTES, "ssd_out LDS map");
__device__ __forceinline__ void ssd_out_item(Frame& F, int b, int c) {
    const bf16* PA = (const bf16*)(F.ws + WS_BIG + B_PROJA); const bf16* HB = (const bf16*)(F.ws + WS_BIG + B_HB);
    constexpr int XP_ = 80, BP_ = 144;
    LAS unsigned char* XT = F.lds;
    LAS unsigned char* BS = XT + 16 * 64 * XP_;
    LAS unsigned char* CS = BS + 2 * 32 * BP_;
    LAS float* DT = (LAS float*)(CS + 2 * 32 * BP_);
    LAS float* CUM = DT + 512;
    LAS float* SSQ = CUM + 512;
    const LAS float* CWL = (const LAS float*)(F.lds + SSDO_CWL);
    int tid = F.tid; asm volatile("" : "+v"(tid));
    const int t0 = 32 * c;
    v4u zq[8];
#pragma unroll
    for (int q = 0; q < 8; ++q) zq[q] = *(const GAS v4u*)(PA + (size_t)(b * SEQ + t0 + (tid >> 7) + 4 * q) * NA + 8 * (tid & 127));
#pragma unroll 1
    for (int task = tid; task < 160 * 8; task += NTHR) { const int o = task >> 3, run = task & 7;
        float act[8][4]; ssd_conv4_lds(PA, CWL, b, t0 + 4 * run, 8 * o, act);
        if (o < 128) { const int h = o >> 3, p0 = (o & 7) * 8;
#pragma unroll
            for (int e = 0; e < 8; ++e) { v2u pk; pk.x = pk2(act[e][0], act[e][1]); pk.y = pk2(act[e][2], act[e][3]); *(LAS v2u*)(XT + (h * 64 + p0 + e) * XP_ + 8 * run) = pk; } }
        else { const int oo = o - 128, isC = oo >> 4, g = (oo >> 3) & 1, n0 = (oo & 7) * 8; LAS unsigned char* dst = (isC ? CS : BS) + g * 32 * BP_;
#pragma unroll
            for (int jx = 0; jx < 4; ++jx) { v4u pk; pk.x = pk2(act[0][jx], act[1][jx]); pk.y = pk2(act[2][jx], act[3][jx]); pk.z = pk2(act[4][jx], act[5][jx]); pk.w = pk2(act[6][jx], act[7][jx]);
                *(LAS v4u*)(dst + (4 * run + jx) * BP_ + 2 * n0) = pk; } }
    }
    { const int h = tid >> 5, t = tid & 31;
      const float dt = softplusf_(bf2f(PA[(size_t)(b * SEQ + t0 + t) * NA + 2304 + h]) + F.a->in[I_DTB][h]);
      float cum = -__expf(F.a->in[I_ALOG][h]) * dt;
      const int ln_ = lane_op_();
#pragma unroll
      for (int off = 1; off < 32; off <<= 1) { const float v = shup_(cum, off, 32, ln_); if (t >= off) cum += v; }
      DT[tid] = dt; CUM[tid] = cum; }
    __syncthreads();
    asm volatile("" : "+v"(tid));
    const int lane = tid & 63, wave = __builtin_amdgcn_readfirstlane(tid >> 6), r = lane & 31, hh = lane >> 5;
    const int g = wave >> 2;
    f32x16 gt;
#pragma unroll
    for (int i = 0; i < 16; ++i) gt[i] = 0.f;
#pragma unroll
    for (int ks = 0; ks < 4; ++ks) { const bf16x8 a = *(const LAS bf16x8*)(BS + (g * 32 + r) * BP_ + 32 * ks + 16 * hh), bb = *(const LAS bf16x8*)(CS + (g * 32 + r) * BP_ + 32 * ks + 16 * hh);
        gt = __builtin_amdgcn_mfma_f32_32x32x16_bf16(a, bb, gt, 0, 0, 0); }
#pragma unroll 1
    for (int hi = 0; hi < 2; ++hi) { const int h = 2 * wave + hi;
        const float cum_t = CUM[h * 32 + r];
        bf16x8 am[2];
#pragma unroll
        for (int ks = 0; ks < 2; ++ks) { unsigned mf[4];
#pragma unroll
            for (int i2 = 0; i2 < 4; ++i2) { float m2[2];
#pragma unroll
                for (int q = 0; q < 2; ++q) { const int i = 8 * ks + 2 * i2 + q, s = (i & 3) + 8 * (i >> 2) + 4 * hh;
                    const float e_ = gt[i] * __expf(fminf(cum_t - CUM[h * 32 + s], 0.f)) * DT[h * 32 + s]; m2[q] = s <= r ? e_ : 0.f; }
                mf[i2] = pk2(m2[0], m2[1]); }
            v4u t4; t4.x = mf[0]; t4.y = mf[1]; t4.z = mf[2]; t4.w = mf[3]; am[ks] = __builtin_bit_cast(bf16x8, t4); }
        const float dsk = F.a->in[I_SSMD][h];
        f32x16 yv[2];
#pragma unroll
        for (int pt = 0; pt < 2; ++pt) {
            f32x16 yi;
#pragma unroll
            for (int i = 0; i < 16; ++i) { yv[pt][i] = 0.f; yi[i] = 0.f; }
            const LAS unsigned char* xrow = XT + (h * 64 + pt * 32 + r) * XP_;
#pragma unroll
            for (int ks = 0; ks < 2; ++ks) { const v2u lo = *(const LAS v2u*)(xrow + 2 * (16 * ks + 4 * hh)), hi2 = *(const LAS v2u*)(xrow + 2 * (16 * ks + 8 + 4 * hh));
                v4u t4; t4.x = lo.x; t4.y = lo.y; t4.z = hi2.x; t4.w = hi2.y;
                yv[pt] = __builtin_amdgcn_mfma_f32_32x32x16_bf16(am[ks], __builtin_bit_cast(bf16x8, t4), yv[pt], 0, 0, 0); }
            const bf16* hb = HB + ((((size_t)b * 64 + c) * 16 + h) * 64 + pt * 32 + r) * 64 + 8 * hh;
#pragma unroll
            for (int ks = 0; ks < 4; ++ks) { const bf16x8 a = *(const LAS bf16x8*)(CS + (g * 32 + r) * BP_ + 32 * ks + 16 * hh), bb = *(const GAS bf16x8*)(hb + 16 * ks);
                yi = __builtin_amdgcn_mfma_f32_32x32x16_bf16(a, bb, yi, 0, 0, 0); }
#pragma unroll
            for (int i4 = 0; i4 < 4; ++i4) { const int tb = 8 * i4 + 4 * hh; const v2u xv = *(const LAS v2u*)(xrow + 2 * tb);
                const float xs[4] = {bflo(xv.x), bfhi(xv.x), bflo(xv.y), bfhi(xv.y)};
#pragma unroll
                for (int q = 0; q < 4; ++q) { const int i = 4 * i4 + q, t = tb + q; yv[pt][i] = yv[pt][i] + __expf(CUM[h * 32 + t]) * yi[i] + dsk * xs[q]; } }
        }
        LAS unsigned char* yb = XT + h * 64 * XP_;
#pragma unroll
        for (int pt = 0; pt < 2; ++pt)
#pragma unroll
            for (int i = 0; i < 16; ++i) { const int t = (i & 3) + 8 * (i >> 2) + 4 * hh; *(LAS unsigned short*)(yb + t * 128 + 2 * (pt * 32 + r)) = (unsigned short)f2bf(yv[pt][i]); }
    }
    __syncthreads();
    { const int c8 = (tid & 127) * 8, h = c8 >> 6, pp = c8 & 63; float gv[8][8], ss[8];
#pragma unroll
      for (int q = 0; q < 8; ++q) { const int t = (tid >> 7) + 4 * q; const v4u yq = *(const LAS v4u*)(XT + h * 64 * XP_ + t * 128 + 2 * pp); const v4u z = zq[q];
          gv[q][0] = bflo(yq.x) * siluf_(bflo(z.x)); gv[q][1] = bfhi(yq.x) * siluf_(bfhi(z.x)); gv[q][2] = bflo(yq.y) * siluf_(bflo(z.y)); gv[q][3] = bfhi(yq.y) * siluf_(bfhi(z.y));
          gv[q][4] = bflo(yq.z) * siluf_(bflo(z.z)); gv[q][5] = bfhi(yq.z) * siluf_(bfhi(z.z)); gv[q][6] = bflo(yq.w) * siluf_(bflo(z.w)); gv[q][7] = bfhi(yq.w) * siluf_(bfhi(z.w));
          float a = 0.f;
#pragma unroll
          for (int e = 0; e < 8; ++e) a += gv[q][e] * gv[q][e];
          ss[q] = wave_sum(a); }
      if ((tid & 63) == 0) {
#pragma unroll
          for (int q = 0; q < 8; ++q) SSQ[(tid >> 6) * 8 + q] = ss[q]; }
      __syncthreads();
      const f32x4 w0 = *(const GAS f32x4*)(F.a->in[I_SSMNW] + c8), w1 = *(const GAS f32x4*)(F.a->in[I_SSMNW] + c8 + 4);
      bf16* MX = (bf16*)(F.out + O_YP) + (size_t)(b * SEQ + t0) * 2048;
#pragma unroll
      for (int q = 0; q < 8; ++q) { const int t = (tid >> 7) + 4 * q; const float rs = rsqrtf((SSQ[((tid >> 7) * 2) * 8 + q] + SSQ[((tid >> 7) * 2 + 1) * 8 + q]) * (1.f / D) + EPS);
          v4u o; o.x = pk2(gv[q][0] * rs * w0.x, gv[q][1] * rs * w0.y); o.y = pk2(gv[q][2] * rs * w0.z, gv[q][3] * rs * w0.w); o.z = pk2(gv[q][4] * rs * w1.x, gv[q][5] * rs * w1.y); o.w = pk2(gv[q][6] * rs * w1.z, gv[q][7] * rs * w1.w);
          *(GAS v4u*)(MX + (size_t)t * 2048 + c8) = o; } }
    __syncthreads();
}
__device__ __forceinline__ void ssd_out_phase(Frame& F) {
    { LAS float* CWL = (LAS float*)(F.lds + SSDO_CWL);
      for (int e = F.tid; e < 5 * XBC; e += NTHR) CWL[e] = e < 4 * XBC ? F.a->in[I_CONVW][e] : F.a->in[I_CONVB][e - 4 * XBC]; }
    __syncthreads();
    for (int it = F.vcu; it < 8 * 64; it += F.G) ssd_out_item(F, it >> 6, it & 63);
}

constexpr size_t B_SB = 0;
static_assert(B_SB + (size_t)8 * 16 * 8 * 16384 * 2 <= B_PROJB, "hgrn state buffer");
__device__ __forceinline__ float hg_lb(const Frame& F, int c) { return __builtin_amdgcn_rcpf(1.f + __expf(F.a->in[I_HGLB][1024 + c] - F.a->in[I_HGLB][c])); }

__device__ __forceinline__ void hg_state_item(Frame& F, int b, int h, int vq, int sj, int sh) {
    const bf16* PB = (const bf16*)(F.ws + WS_BIG + B_PROJB); bf16* SB = (bf16*)(F.ws + WS_BIG + B_SB);
    constexpr int KP = 272;
    LAS unsigned char* KT0 = F.lds;
    LAS unsigned char* VT0 = KT0 + 2 * 128 * KP;
    LAS unsigned char* RAW = VT0 + 2 * 32 * KP;
    LAS float* EL = (LAS float*)(RAW + 128 * KP);
    LAS float* SEG = EL + 256;
    int tid = F.tid; asm volatile("" : "+v"(tid));
    const int lane = tid & 63, wave = __builtin_amdgcn_readfirstlane(tid >> 6), r = lane & 31, hh = lane >> 5;
    const int kcol = tid & 127, seg = tid >> 7;
    const float lb = hg_lb(F, h * 128 + kcol);
    const int vs = tid >> 2, voc = tid & 3;
    const bf16* fsrc = PB + (size_t)(b * SEQ + (tid >> 4)) * NBH + 1024 + h * 128 + 8 * (tid & 15);
    const bf16* vsrc = PB + (size_t)(b * SEQ + vs) * NBH + 2048 + h * 128 + vq * 32 + 8 * voc;
    v4u pf[4], pv;
#pragma unroll
    for (int q = 0; q < 4; ++q) pf[q] = *(const GAS v4u*)(fsrc + (size_t)(32 * q) * NBH);
    pv = *(const GAS v4u*)vsrc;
    LAS float* SM = (LAS float*)(F.lds + HALO_OFF); LAS float* OW = SM + 1024; LAS float* OH = OW + 1024;
    const bf16* PS = PB + (size_t)(MP + sj) * NBH + 512 * sh;
    const float* S0 = F.a->in[I_SHG] + (size_t)sj * 131072 + (size_t)sh * 65536; float* S1 = F.out + O_SHG + (size_t)sj * 131072 + (size_t)sh * 65536;
    const int ln_ = lane_op_();
    f32x4 oacc = {0.f, 0.f, 0.f, 0.f};
    const int kt = wave - 4;
    f32x16 acc;
#pragma unroll
    for (int i = 0; i < 16; ++i) acc[i] = 0.f;
#pragma unroll 1
    for (int cc = 0; cc < 16; ++cc) {
        LAS unsigned char* KT = KT0 + (cc & 1) * 128 * KP; LAS unsigned char* VT = VT0 + (cc & 1) * 32 * KP;
        const int hl = cc >> 2, si0 = cc * 1024 + tid, si1 = si0 + 512;
        const f32x4 sv0 = *(const GAS f32x4*)(S0 + (size_t)si0 * 4), sv1 = *(const GAS f32x4*)(S0 + (size_t)si1 * 4);
        if ((cc & 3) == 0 && tid < 128) { LAS float* sm = SM + (hl & 1) * 512; const int c = hl * 128 + tid; const float lbs = hg_lb(F, 512 * sh + c), sg = sigmoidf_(bf2f(PS[1024 + c]));
            sm[tid] = lbs + (1.f - lbs) * sg; sm[128 + tid] = (1.f - lbs) * (1.f - sg); sm[256 + tid] = siluf_(bf2f(PS[c])); sm[384 + tid] = bf2f(PS[2048 + c]); }
#pragma unroll
        for (int q = 0; q < 4; ++q) *(LAS v4u*)(RAW + ((tid >> 4) + 32 * q) * KP + 16 * (tid & 15)) = pf[q];
        { const unsigned ww[4] = {pv.x, pv.y, pv.z, pv.w};
#pragma unroll
          for (int e = 0; e < 4; ++e) { *(LAS unsigned short*)(VT + (8 * voc + 2 * e) * KP + 2 * vs) = (unsigned short)(ww[e] & 0xffffu); *(LAS unsigned short*)(VT + (8 * voc + 2 * e + 1) * KP + 2 * vs) = (unsigned short)(ww[e] >> 16); } }
        if (cc + 1 < 16) {
#pragma unroll
            for (int q = 0; q < 4; ++q) pf[q] = *(const GAS v4u*)(fsrc + (size_t)(128 * (cc + 1) + 32 * q) * NBH);
            pv = *(const GAS v4u*)(vsrc + (size_t)(128 * (cc + 1)) * NBH); }
        if (wave >= 4) {
            bf16* sb = SB + ((((size_t)b * 16 + cc) * 8 + h) * 128 + vq * 32) * 128 + kt * 32 + r;
#pragma unroll
            for (int i = 0; i < 16; ++i) sb[(size_t)((i & 3) + 8 * (i >> 2) + 4 * hh) * 128] = (bf16)f2bf(acc[i]); }
        asm volatile("s_waitcnt lgkmcnt(0)" ::: "memory"); __builtin_amdgcn_s_barrier(); asm volatile("" ::: "memory");
        float kp[32];
        { float run = 1.f;
#pragma unroll
          for (int j = 31; j >= 0; --j) { const float sg = sigmoidf_(bf2f(*(const LAS unsigned short*)(RAW + (32 * seg + j) * KP + 2 * kcol))); kp[j] = (1.f - lb) * (1.f - sg) * run; run *= lb + (1.f - lb) * sg; }
          SEG[seg * 128 + kcol] = run; }
        asm volatile("s_waitcnt lgkmcnt(0)" ::: "memory"); __builtin_amdgcn_s_barrier(); asm volatile("" ::: "memory");
        { const float t0 = SEG[kcol], t1 = SEG[128 + kcol], t2 = SEG[256 + kcol], t3 = SEG[384 + kcol];
          const float R = seg == 3 ? 1.f : (seg == 2 ? t3 : (seg == 1 ? t2 * t3 : t1 * t2 * t3));
          if (seg == 0) EL[(cc & 1) * 128 + kcol] = (t0 * t1) * (t2 * t3);
#pragma unroll
          for (int j8 = 0; j8 < 4; ++j8) { v4u p;
              p.x = pk2(kp[8 * j8] * R, kp[8 * j8 + 1] * R); p.y = pk2(kp[8 * j8 + 2] * R, kp[8 * j8 + 3] * R); p.z = pk2(kp[8 * j8 + 4] * R, kp[8 * j8 + 5] * R); p.w = pk2(kp[8 * j8 + 6] * R, kp[8 * j8 + 7] * R);
              *(LAS v4u*)(KT + kcol * KP + 2 * (32 * seg + 8 * j8)) = p; } }
        asm volatile("s_waitcnt lgkmcnt(0)" ::: "memory"); __builtin_amdgcn_s_barrier(); asm volatile("" ::: "memory");
        if (wave >= 4) {
            const float el = EL[(cc & 1) * 128 + kt * 32 + r];
#pragma unroll
            for (int i = 0; i < 16; ++i) acc[i] *= el;
#pragma unroll
            for (int ks = 0; ks < 8; ++ks) { const bf16x8 a = *(const LAS bf16x8*)(VT + r * KP + 32 * ks + 16 * hh), bb = *(const LAS bf16x8*)(KT + (kt * 32 + r) * KP + 32 * ks + 16 * hh);
                acc = __builtin_amdgcn_mfma_f32_32x32x16_bf16(a, bb, acc, 0, 0, 0); }
        }
        { const LAS float* sm = SM + (hl & 1) * 512; const int v4 = (tid & 31) * 4; const f32x4 vv = *(const LAS f32x4*)(sm + 384 + v4);
          const int k0 = (si0 >> 5) & 127, k1 = (si1 >> 5) & 127;
          const f32x4 n0 = sv0 * sm[k0] + vv * sm[128 + k0], n1 = sv1 * sm[k1] + vv * sm[128 + k1];
          *(GAS f32x4*)(S1 + (size_t)si0 * 4) = n0; *(GAS f32x4*)(S1 + (size_t)si1 * 4) = n1;
          oacc += n0 * sm[256 + k0] + n1 * sm[256 + k1];
          if ((cc & 3) == 3) {
              f32x4 t; t[0] = oacc[0] + shx_(oacc[0], 32, ln_); t[1] = oacc[1] + shx_(oacc[1], 32, ln_); t[2] = oacc[2] + shx_(oacc[2], 32, ln_); t[3] = oacc[3] + shx_(oacc[3], 32, ln_);
              if (lane < 32) *(LAS f32x4*)(OW + wave * 128 + v4) = t;
              oacc = (f32x4){0.f, 0.f, 0.f, 0.f}; } }
        if ((cc & 3) == 0 && cc > 0 && tid < 128) { float o = 0.f;
#pragma unroll
            for (int w = 0; w < 8; ++w) o += OW[w * 128 + tid];
            OH[(hl - 1) * 128 + tid] = o; }
    }
    __syncthreads();
    if (tid < 128) { float o = 0.f;
#pragma unroll
        for (int w = 0; w < 8; ++w) o += OW[w * 128 + tid];
        OH[3 * 128 + tid] = o; }
    __syncthreads();
    { const int c = tid; const float o = OH[c]; const float ss = wave_sum(o * o); if (lane == 0) SM[wave] = ss;
      __syncthreads();
      const float rs = rsqrtf((SM[(tid >> 7) * 2] + SM[(tid >> 7) * 2 + 1]) * (1.f / 128.f) + EPS);
      ((bf16*)(F.ws + WS_MIXS) + (size_t)sj * 2048 + 1024 + 512 * sh)[c] = (bf16)f2bf(o * rs * F.a->in[I_HGNW][c & 127] * siluf_(bf2f(PS[3072 + c]))); }
    if (wave >= 4) { float* ps = F.out + O_PHG + ((size_t)(b * 8 + h) * 128 + kt * 32 + r) * 128 + vq * 32;
#pragma unroll
        for (int i = 0; i < 16; ++i) ps[(i & 3) + 8 * (i >> 2) + 4 * hh] = acc[i]; }
    __syncthreads();
}

__device__ __forceinline__ void hg_out_phase(Frame& F) {
    const bf16* PB = (const bf16*)(F.ws + WS_BIG + B_PROJB); const bf16* SB = (const bf16*)(F.ws + WS_BIG + B_SB);
    constexpr int KP = 272, SP = 80, OP = 528;
    LAS unsigned char* QH = F.lds;
    LAS unsigned char* Q1 = QH + 32 * KP;
    LAS unsigned char* KA = Q1 + 16 * KP;
    LAS unsigned char* KB = KA + 16 * KP;
    LAS unsigned char* KHT = KB + 32 * KP;
    LAS unsigned char* VT = KHT + 128 * SP;
    LAS float* CSEG = (LAS float*)(VT + 128 * SP);
    LAS float* EL = CSEG + 512;
    LAS float* SSQ = EL + 128;
    LAS unsigned char* OF = (LAS unsigned char*)(SSQ + 256);
    LAS unsigned char* RQ = OF + 32 * OP;
    LAS unsigned char* RF = RQ + 32 * KP;
    int tid = F.tid; asm volatile("" : "+v"(tid));
    const int lane = tid & 63, wave = __builtin_amdgcn_readfirstlane(tid >> 6), fr = lane & 15, q4 = lane >> 4;
    const int kcol = tid & 127, seg = tid >> 7;
    const int NITEM = 8 * 16 * 8;
    const int nit = F.vcu < NITEM ? (NITEM - 1 - F.vcu) / F.G + 1 : 0, NIT = 4 * nit;
    v4u pq, pf, pv, pg;
#define HG_ROW0(n) ((((F.vcu + ((n) >> 2) * F.G) >> 7) * SEQ) + 128 * (((F.vcu + ((n) >> 2) * F.G) >> 3) & 15) + 32 * ((n) & 3))
#define HG_HEAD(n) ((F.vcu + ((n) >> 2) * F.G) & 7)
#define HG_PREFETCH(n) do { const int T0_ = HG_ROW0(n), h_ = HG_HEAD(n); const bf16* rp_ = PB + (size_t)(T0_ + (tid >> 4)) * NBH + h_ * 128 + 8 * (tid & 15); \
        pq = *(const GAS v4u*)rp_; pf = *(const GAS v4u*)(rp_ + 1024); pv = *(const GAS v4u*)(rp_ + 2048); pg = *(const GAS v4u*)(rp_ + 3072); } while (0)
    if (NIT > 0) HG_PREFETCH(0);
    f32x4 S[8];
    float lb = 0.f;
#pragma unroll 1
    for (int n = 0; n < NIT; ++n) {
        const int item = F.vcu + (n >> 2) * F.G, b = item >> 7, cc = (item >> 3) & 15, h = item & 7, fc = n & 3;
        const int T0 = b * SEQ + 128 * cc + 32 * fc;
        const v4u vv = pv, gv = pg;
        *(LAS v4u*)(RQ + (tid >> 4) * KP + 16 * (tid & 15)) = pq; *(LAS v4u*)(RF + (tid >> 4) * KP + 16 * (tid & 15)) = pf;
        if (n + 1 < NIT) HG_PREFETCH(n + 1);
        if (fc == 0) {
            lb = hg_lb(F, h * 128 + kcol);
            const bf16* sb = SB + ((((size_t)b * 16 + cc) * 8 + h) * 128 + 16 * wave + fr) * 128 + 4 * q4;
#pragma unroll
            for (int kt = 0; kt < 8; ++kt) { const v2u u = *(const GAS v2u*)(sb + 16 * kt); S[kt][0] = bflo(u.x); S[kt][1] = bfhi(u.x); S[kt][2] = bflo(u.y); S[kt][3] = bfhi(u.y); } }
        asm volatile("s_waitcnt lgkmcnt(0)" ::: "memory"); __builtin_amdgcn_s_barrier(); asm volatile("" ::: "memory");
        float cl[8], kk[8], qs[8];
        { float a = 0.f;
#pragma unroll
          for (int j = 0; j < 8; ++j) { const float sg = sigmoidf_(bf2f(*(const LAS unsigned short*)(RF + (8 * seg + j) * KP + 2 * kcol)));
              a += __logf(lb + (1.f - lb) * sg); cl[j] = a; kk[j] = (1.f - lb) * (1.f - sg); qs[j] = siluf_(bf2f(*(const LAS unsigned short*)(RQ + (8 * seg + j) * KP + 2 * kcol))); }
          CSEG[seg * 128 + kcol] = a; }
        { const int s = tid >> 4, oc = tid & 15; const unsigned ww[4] = {vv.x, vv.y, vv.z, vv.w};
#pragma unroll
          for (int e = 0; e < 4; ++e) { *(LAS unsigned short*)(VT + (8 * oc + 2 * e) * SP + 2 * s) = (unsigned short)(ww[e] & 0xffffu); *(LAS unsigned short*)(VT + (8 * oc + 2 * e + 1) * SP + 2 * s) = (unsigned short)(ww[e] >> 16); } }
        asm volatile("s_waitcnt lgkmcnt(0)" ::: "memory"); __builtin_amdgcn_s_barrier(); asm volatile("" ::: "memory");
        { const float t0 = CSEG[kcol], t1 = CSEG[128 + kcol], t2 = CSEG[256 + kcol], t3 = CSEG[384 + kcol];
          const float off = seg == 0 ? 0.f : (seg == 1 ? t0 : (seg == 2 ? t0 + t1 : t0 + t1 + t2)), c15 = t0 + t1, last = (t0 + t1) + (t2 + t3);
          if (seg == 0) EL[kcol] = __expf(last);
#pragma unroll
          for (int j = 0; j < 8; ++j) { const int t = 8 * seg + j; const float cum = off + cl[j];
              *(LAS unsigned short*)(QH + t * KP + 2 * kcol) = (unsigned short)f2bf(qs[j] * __expf(cum));
              if (seg >= 2) *(LAS unsigned short*)(Q1 + (t - 16) * KP + 2 * kcol) = (unsigned short)f2bf(qs[j] * __expf(cum - c15));
              else *(LAS unsigned short*)(KA + t * KP + 2 * kcol) = (unsigned short)f2bf(kk[j] * __expf(fminf(-cum, 80.f)));
              *(LAS unsigned short*)(KB + t * KP + 2 * kcol) = (unsigned short)f2bf(kk[j] * __expf(fminf(c15 - cum, 80.f)));
              *(LAS unsigned short*)(KHT + kcol * SP + 2 * t) = (unsigned short)f2bf(kk[j] * __expf(last - cum)); } }
        asm volatile("s_waitcnt lgkmcnt(0)" ::: "memory"); __builtin_amdgcn_s_barrier(); asm volatile("" ::: "memory");
        f32x4 at00 = {0.f, 0.f, 0.f, 0.f}, at01 = at00, at11 = at00;
#pragma unroll
        for (int ks = 0; ks < 4; ++ks) { const int kb = 64 * ks + 16 * q4;
            const bf16x8 ka = *(const LAS bf16x8*)(KA + fr * KP + kb), kb0 = *(const LAS bf16x8*)(KB + fr * KP + kb), kb1 = *(const LAS bf16x8*)(KB + (16 + fr) * KP + kb);
            const bf16x8 qh = *(const LAS bf16x8*)(QH + fr * KP + kb), q1 = *(const LAS bf16x8*)(Q1 + fr * KP + kb);
            at00 = __builtin_amdgcn_mfma_f32_16x16x32_bf16(ka, qh, at00, 0, 0, 0);
            at01 = __builtin_amdgcn_mfma_f32_16x16x32_bf16(kb0, q1, at01, 0, 0, 0);
            at11 = __builtin_amdgcn_mfma_f32_16x16x32_bf16(kb1, q1, at11, 0, 0, 0); }
#pragma unroll
        for (int e = 0; e < 4; ++e) { const bool keep = (4 * q4 + e) <= fr; at00[e] = keep ? at00[e] : 0.f; at11[e] = keep ? at11[e] : 0.f; }
        v4u pa0, pa1;
        pa0.x = pk2(at00[0], at00[1]); pa0.y = pk2(at00[2], at00[3]); pa0.z = 0u; pa0.w = 0u;
        pa1.x = pk2(at01[0], at01[1]); pa1.y = pk2(at01[2], at01[3]); pa1.z = pk2(at11[0], at11[1]); pa1.w = pk2(at11[2], at11[3]);
        f32x4 o0 = {0.f, 0.f, 0.f, 0.f}, o1 = o0;
        { const LAS unsigned char* vrow = VT + (16 * wave + fr) * SP; const v2u lo = *(const LAS v2u*)(vrow + 8 * q4), hi = *(const LAS v2u*)(vrow + 32 + 8 * q4);
          v4u bv; bv.x = lo.x; bv.y = lo.y; bv.z = hi.x; bv.w = hi.y;
          o0 = __builtin_amdgcn_mfma_f32_16x16x32_bf16(__builtin_bit_cast(bf16x8, pa0), __builtin_bit_cast(bf16x8, bv), o0, 0, 0, 0);
          o1 = __builtin_amdgcn_mfma_f32_16x16x32_bf16(__builtin_bit_cast(bf16x8, pa1), __builtin_bit_cast(bf16x8, bv), o1, 0, 0, 0); }
#pragma unroll
        for (int ks = 0; ks < 4; ++ks) { v4u bs; bs.x = pk2(S[2 * ks][0], S[2 * ks][1]); bs.y = pk2(S[2 * ks][2], S[2 * ks][3]); bs.z = pk2(S[2 * ks + 1][0], S[2 * ks + 1][1]); bs.w = pk2(S[2 * ks + 1][2], S[2 * ks + 1][3]);
            const int kb = 64 * ks + 8 * q4;
            const v2u a0l = *(const LAS v2u*)(QH + fr * KP + kb), a0h = *(const LAS v2u*)(QH + fr * KP + kb + 32), a1l = *(const LAS v2u*)(QH + (16 + fr) * KP + kb), a1h = *(const LAS v2u*)(QH + (16 + fr) * KP + kb + 32);
            v4u a0; a0.x = a0l.x; a0.y = a0l.y; a0.z = a0h.x; a0.w = a0h.y; v4u a1; a1.x = a1l.x; a1.y = a1l.y; a1.z = a1h.x; a1.w = a1h.y;
            o0 = __builtin_amdgcn_mfma_f32_16x16x32_bf16(__builtin_bit_cast(bf16x8, a0), __builtin_bit_cast(bf16x8, bs), o0, 0, 0, 0);
            o1 = __builtin_amdgcn_mfma_f32_16x16x32_bf16(__builtin_bit_cast(bf16x8, a1), __builtin_bit_cast(bf16x8, bs), o1, 0, 0, 0); }
#pragma unroll
        for (int e = 0; e < 4; ++e) { const int t0r = 4 * q4 + e; *(LAS float*)(OF + t0r * OP + 4 * (16 * wave + fr)) = o0[e]; *(LAS float*)(OF + (16 + t0r) * OP + 4 * (16 * wave + fr)) = o1[e];
            const float s0 = row16_sum(o0[e] * o0[e]), s1 = row16_sum(o1[e] * o1[e]);
            if (fr == 0) { SSQ[wave * 32 + t0r] = s0; SSQ[wave * 32 + 16 + t0r] = s1; } }
        { const bf16x8 bv = *(const LAS bf16x8*)(VT + (16 * wave + fr) * SP + 16 * q4);
#pragma unroll
          for (int kt = 0; kt < 8; ++kt) { const f32x4 el = *(const LAS f32x4*)(EL + 16 * kt + 4 * q4); const bf16x8 ak = *(const LAS bf16x8*)(KHT + (16 * kt + fr) * SP + 16 * q4);
              S[kt] = __builtin_amdgcn_mfma_f32_16x16x32_bf16(ak, bv, S[kt] * el, 0, 0, 0); } }
        asm volatile("s_waitcnt lgkmcnt(0)" ::: "memory"); __builtin_amdgcn_s_barrier(); asm volatile("" ::: "memory");
        { const int t = tid >> 4, v8 = (tid & 15) * 8; float tot = 0.f;
#pragma unroll
          for (int w = 0; w < 8; ++w) tot += SSQ[w * 32 + t];
          const float rs = rsqrtf(tot * (1.f / 128.f) + EPS);
          const f32x4 oa = *(const LAS f32x4*)(OF + t * OP + 4 * v8), ob = *(const LAS f32x4*)(OF + t * OP + 4 * v8 + 16);
          const f32x4 wa = *(const GAS f32x4*)(F.a->in[I_HGNW] + v8), wb = *(const GAS f32x4*)(F.a->in[I_HGNW] + v8 + 4);
          v4u o; o.x = pk2(oa.x * rs * wa.x * siluf_(bflo(gv.x)), oa.y * rs * wa.y * siluf_(bfhi(gv.x))); o.y = pk2(oa.z * rs * wa.z * siluf_(bflo(gv.y)), oa.w * rs * wa.w * siluf_(bfhi(gv.y)));
          o.z = pk2(ob.x * rs * wb.x * siluf_(bflo(gv.z)), ob.y * rs * wb.y * siluf_(bfhi(gv.z))); o.w = pk2(ob.z * rs * wb.z * siluf_(bflo(gv.w)), ob.w * rs * wb.w * siluf_(bfhi(gv.w)));
          *(GAS v4u*)((bf16*)(F.out + O_YP) + (size_t)(T0 + t) * 2048 + 1024 + h * 128 + v8) = o; }
    }
#undef HG_ROW0
#undef HG_HEAD
#undef HG_PREFETCH
    __syncthreads();
}

__device__ __forceinline__ void hg_sample_item(Frame& F, int j, int half) {
    const bf16* PB = (const bf16*)(F.ws + WS_BIG + B_PROJB) + (size_t)(MP + j) * NBH + 512 * half; bf16* MX = (bf16*)(F.ws + WS_MIXS) + (size_t)j * 2048 + 1024 + 512 * half;
    LAS float* fS = (LAS float*)F.lds;
    LAS float* kS = fS + 512; LAS float* qS = kS + 512; LAS float* vS = qS + 512; LAS float* oP = vS + 512;
    int tid = F.tid; asm volatile("" : "+v"(tid));
    { const int c = tid; const float lb = hg_lb(F, 512 * half + c), sg = sigmoidf_(bf2f(PB[1024 + c]));
      fS[c] = lb + (1.f - lb) * sg; kS[c] = (1.f - lb) * (1.f - sg); qS[c] = siluf_(bf2f(PB[c])); vS[c] = bf2f(PB[2048 + c]); }
    __syncthreads();
    const int v4 = (tid & 31) * 4, krow = tid >> 5;
    const float* S0 = F.a->in[I_SHG] + (size_t)j * 131072 + (size_t)half * 65536; float* S1 = F.out + O_SHG + (size_t)j * 131072 + (size_t)half * 65536;
#pragma unroll 1
    for (int hl = 0; hl < 4; ++hl) { const f32x4 vv = *(const LAS f32x4*)(vS + hl * 128 + v4); f32x4 a = {0.f, 0.f, 0.f, 0.f};
        f32x4 sv[8];
#pragma unroll
        for (int kb = 0; kb < 8; ++kb) sv[kb] = *(const GAS f32x4*)(S0 + ((size_t)hl * 128 + krow + 16 * kb) * 128 + v4);
#pragma unroll
        for (int kb = 0; kb < 8; ++kb) { const int k = krow + 16 * kb; const f32x4 sn = sv[kb] * fS[hl * 128 + k] + vv * kS[hl * 128 + k];
            *(GAS f32x4*)(S1 + ((size_t)hl * 128 + k) * 128 + v4) = sn; a += sn * qS[hl * 128 + k]; }
        *(LAS f32x4*)(oP + krow * 512 + hl * 128 + v4) = a; }
    __syncthreads();
    { const int c = tid; float o = 0.f;
#pragma unroll
      for (int q = 0; q < 16; ++q) o += oP[q * 512 + c];
      float ss = wave_sum(o * o); if ((tid & 63) == 0) fS[tid >> 6] = ss;
      __syncthreads();
      const float tot = fS[(tid >> 7) * 2] + fS[(tid >> 7) * 2 + 1];
      const float rs = rsqrtf(tot * (1.f / 128.f) + EPS);
      MX[c] = (bf16)f2bf(o * rs * F.a->in[I_HGNW][c & 127] * siluf_(bf2f(PB[3072 + c]))); }
    __syncthreads();
}
__device__ __forceinline__ void hg_state_phase(Frame& F) {
    for (int it = F.vcu; it < 256; it += F.G) hg_state_item(F, it >> 5, (it >> 2) & 7, it & 3, it >> 1, it & 1);
}

__device__ __forceinline__ void s5_lambda(const Frame& F, int g, int n, float& abr, float& abi, float& cfr, float& cfi) {
    const float lr = F.a->in[I_LAMRE][g * 64 + n], li = F.a->in[I_LAMIM][g * 64 + n], step = expf(F.a->in[I_LOGSTEP][g]);
    const float mag = expf(lr * step); float sn, cs; sincosf(li * step, &sn, &cs);
    abr = mag * cs; abi = mag * sn;
    const float den = lr * lr + li * li, nr = abr - 1.0f;
    cfr = (nr * lr + abi * li) / den; cfi = (abi * lr - nr * li) / den;
}
__device__ __forceinline__ void s5_tables_item(Frame& F, int g) {
    LAS float* POW = (LAS float*)F.lds;
    LAS float* CC = POW + 17 * 128;
    LAS float* BB = CC + 16 * 128;
    LAS float* KS = BB + 64 * 32;
    const int tid = F.tid;
    bf16* KQ = (bf16*)(F.ws + WS_BIG + B_S5T + S5T_KQ) + (size_t)g * 256 * 384; bf16* PM = (bf16*)(F.ws + WS_BIG + B_S5T + S5T_PM) + (size_t)g * 128 * 256;
    if (tid < 64) { const int n = tid; float abr, abi, cfr, cfi; s5_lambda(F, g, n, abr, abi, cfr, cfi);
        float pr = 1.f, pi = 0.f;
        for (int t = 0; t <= 16; ++t) { POW[(t * 64 + n) * 2] = pr; POW[(t * 64 + n) * 2 + 1] = pi; const float nr = pr * abr - pi * abi, ni = pr * abi + pi * abr; pr = nr; pi = ni; }
        const float* br = F.a->in[I_BRE] + (size_t)(g * 64 + n) * 16; const float* bi = F.a->in[I_BIM] + (size_t)(g * 64 + n) * 16;
        for (int c = 0; c < 16; ++c) { BB[(n * 16 + c) * 2] = cfr * br[c] - cfi * bi[c]; BB[(n * 16 + c) * 2 + 1] = cfr * bi[c] + cfi * br[c]; } }
    for (int e = tid; e < 1024; e += NTHR) { CC[e * 2] = F.a->in[I_CRE][(size_t)g * 1024 + e]; CC[e * 2 + 1] = F.a->in[I_CIM][(size_t)g * 1024 + e]; }
    __syncthreads();
    { const int cc = tid & 255, cp = cc >> 4, c = cc & 15, th = tid >> 8; float a[8];
#pragma unroll
      for (int i = 0; i < 8; ++i) a[i] = 0.f;
      for (int n = 0; n < 64; ++n) { const float cr = CC[(cp * 64 + n) * 2], ci = CC[(cp * 64 + n) * 2 + 1], br = BB[(n * 16 + c) * 2], bi = BB[(n * 16 + c) * 2 + 1];
          const float xr = cr * br - ci * bi, xi = cr * bi + ci * br;
#pragma unroll
          for (int i = 0; i < 8; ++i) { const int t = th + 2 * i; a[i] += xr * POW[(t * 64 + n) * 2] - xi * POW[(t * 64 + n) * 2 + 1]; } }
#pragma unroll
      for (int i = 0; i < 8; ++i) KS[(th + 2 * i) * 256 + cc] = a[i]; }
    __syncthreads();
    for (int e2 = tid; e2 < 256 * 192; e2 += NTHR) { const int row = e2 / 192, col0 = (e2 % 192) * 2, t = row >> 4, cp = row & 15; float v[2];
#pragma unroll
        for (int q = 0; q < 2; ++q) { const int col = col0 + q;
            if (col < 256) { const int s = col >> 4, c = col & 15; v[q] = s <= t ? KS[(t - s) * 256 + cp * 16 + c] : 0.f; }
            else { const int np = col - 256, n = np & 63; const float pr = POW[((t + 1) * 64 + n) * 2], pi = POW[((t + 1) * 64 + n) * 2 + 1], cr = CC[(cp * 64 + n) * 2], ci = CC[(cp * 64 + n) * 2 + 1];
                v[q] = np < 64 ? cr * pr - ci * pi : -(cr * pi + ci * pr); } }
        *(GAS unsigned*)(KQ + (size_t)row * 384 + col0) = pk2(v[0], v[1]); }
    for (int e2 = tid; e2 < 128 * 128; e2 += NTHR) { const int np = e2 >> 7, col0 = (e2 & 127) * 2, n = np & 63; float v[2];
#pragma unroll
        for (int q = 0; q < 2; ++q) { const int col = col0 + q, s = col >> 4, c = col & 15; const float pr = POW[((15 - s) * 64 + n) * 2], pi = POW[((15 - s) * 64 + n) * 2 + 1], br = BB[(n * 16 + c) * 2], bi = BB[(n * 16 + c) * 2 + 1];
            v[q] = np < 64 ? pr * br - pi * bi : pr * bi + pi * br; }
        *(GAS unsigned*)(PM + (size_t)np * 256 + col0) = pk2(v[0], v[1]); }
    __syncthreads();
}
__device__ __forceinline__ void s5_fused_item(Frame& F, int b, int g) {
    const bf16* HN = (const bf16*)(F.ws + WS_XN); const bf16* PM = (const bf16*)(F.ws + WS_BIG + B_S5T + S5T_PM) + (size_t)g * 128 * 256; const bf16* KQ = (const bf16*)(F.ws + WS_BIG + B_S5T + S5T_KQ) + (size_t)g * 256 * 384;
    bf16* GY = (bf16*)(F.ws + WS_BIG + B_GY);
    constexpr int UP_ = 528, PP = 132, XPP = 272, KQP = 784;
    LAS unsigned char* UL = F.lds;
    LAS unsigned char* XL = UL;
    LAS unsigned char* BL = UL + 128 * XPP;
    LAS float* PL = (LAS float*)BL;
    LAS float* SE = (LAS float*)(BL + 128 * UP_);
    static_assert(64 * UP_ <= 128 * XPP && 128 * PP * 4 <= 128 * UP_ && 64 * KQP <= 128 * UP_ && 128 * XPP + 128 * UP_ + 4096 <= RING_BYTES, "s5 LDS map");
    int tid = F.tid; asm volatile("" : "+v"(tid));
    const int lane = tid & 63, wave = __builtin_amdgcn_readfirstlane(tid >> 6), r = lane & 31, hh = lane >> 5, mt = wave >> 1, ch = wave & 1;
    for (int e = tid; e < 128 * 32; e += NTHR) { const int row = e >> 5, c16 = e & 31; *(LAS v4u*)(BL + row * UP_ + 16 * c16) = *(const GAS v4u*)(PM + (size_t)row * 256 + 8 * c16); }
    bf16x8 au[16];
#pragma unroll
    for (int half = 0; half < 2; ++half) {
        for (int e = tid; e < 64 * 32; e += NTHR) { const int tok = e >> 1, pc = e & 1, m = tok >> 4, s2 = tok & 15;
            *(LAS v4u*)(UL + m * UP_ + 32 * s2 + 16 * pc) = *(const GAS v4u*)(HN + (size_t)(b * SEQ + 1024 * half + tok) * D + 16 * g + 8 * pc); }
        __syncthreads();
        if ((mt >> 1) == half) {
#pragma unroll
            for (int s2 = 0; s2 < 16; ++s2) au[s2] = *(const LAS bf16x8*)(UL + (32 * (mt & 1) + r) * UP_ + 32 * s2 + 16 * hh); }
        __syncthreads();
    }
    { f32x16 acc[2];
#pragma unroll
      for (int nt = 0; nt < 2; ++nt)
#pragma unroll
          for (int i = 0; i < 16; ++i) acc[nt][i] = 0.f;
#pragma unroll
      for (int s2 = 0; s2 < 16; ++s2)
#pragma unroll
          for (int nt = 0; nt < 2; ++nt) { const bf16x8 bb = *(const LAS bf16x8*)(BL + (64 * ch + 32 * nt + r) * UP_ + 32 * s2 + 16 * hh); acc[nt] = __builtin_amdgcn_mfma_f32_32x32x16_bf16(au[s2], bb, acc[nt], 0, 0, 0); }
      __syncthreads();
#pragma unroll
      for (int nt = 0; nt < 2; ++nt)
#pragma unroll
          for (int i = 0; i < 16; ++i) PL[(32 * mt + (i & 3) + 8 * (i >> 2) + 4 * hh) * PP + 64 * ch + 32 * nt + r] = acc[nt][i]; }
    __syncthreads();
    { const int n = lane, seg = wave; float abr, abi, cfr, cfi; s5_lambda(F, g, n, abr, abi, cfr, cfi);
#pragma unroll
      for (int q = 0; q < 4; ++q) { const float nr = abr * abr - abi * abi, ni = 2.f * abr * abi; abr = nr; abi = ni; }
      float yr[16], yi[16];
      { float xr = 0.f, xi = 0.f;
#pragma unroll
        for (int i = 0; i < 16; ++i) { const float pr = PL[(16 * seg + i) * PP + n], pi = PL[(16 * seg + i) * PP + 64 + n]; const float nr = abr * xr - abi * xi + pr, ni = abr * xi + abi * xr + pi; xr = nr; xi = ni; yr[i] = xr; yi[i] = xi; }
        SE[seg * 128 + n] = xr; SE[seg * 128 + 64 + n] = xi; }
      float a16r = abr, a16i = abi;
#pragma unroll
      for (int q = 0; q < 4; ++q) { const float nr = a16r * a16r - a16i * a16i, ni = 2.f * a16r * a16i; a16r = nr; a16i = ni; }
      __syncthreads();
      float cr = 0.f, ci = 0.f;
      for (int s2 = 0; s2 < seg; ++s2) { const float er = SE[s2 * 128 + n], ei = SE[s2 * 128 + 64 + n]; const float nr = a16r * cr - a16i * ci + er, ni = a16r * ci + a16i * cr + ei; cr = nr; ci = ni; }
      float pwr = 1.f, pwi = 0.f;
#pragma unroll
      for (int i = 0; i < 16; ++i) { const float xr = (i == 0 ? 0.f : yr[i == 0 ? 0 : i - 1]) + pwr * cr - pwi * ci, xi = (i == 0 ? 0.f : yi[i == 0 ? 0 : i - 1]) + pwr * ci + pwi * cr;
          *(LAS unsigned short*)(XL + (16 * seg + i) * XPP + 2 * n) = (unsigned short)f2bf(xr); *(LAS unsigned short*)(XL + (16 * seg + i) * XPP + 2 * (64 + n)) = (unsigned short)f2bf(xi);
          const float nr = pwr * abr - pwi * abi, ni = pwr * abi + pwi * abr; pwr = nr; pwi = ni; }
      if (seg == 7) { const float xr = yr[15] + pwr * cr - pwi * ci, xi = yi[15] + pwr * ci + pwi * cr;
          F.out[O_PS5R + (size_t)(b * 64 + g) * 64 + n] = xr; F.out[O_PS5I + (size_t)(b * 64 + g) * 64 + n] = xi; } }
    __syncthreads();
    bf16x8 ax[8];
#pragma unroll
    for (int s2 = 0; s2 < 8; ++s2) ax[s2] = *(const LAS bf16x8*)(XL + (32 * mt + r) * XPP + 32 * s2 + 16 * hh);
    v4u kq[6];
#pragma unroll
    for (int q = 0; q < 6; ++q) { const int e = tid + NTHR * q, row = e / 48, c16 = e % 48; kq[q] = *(const GAS v4u*)(KQ + (size_t)row * 384 + 8 * c16); }
#pragma unroll 1
    for (int p = 0; p < 4; ++p) {
#pragma unroll
        for (int q = 0; q < 6; ++q) { const int e = tid + NTHR * q, row = e / 48, c16 = e % 48; *(LAS v4u*)(BL + row * KQP + 16 * c16) = kq[q]; }
        if (p < 3) {
#pragma unroll
            for (int q = 0; q < 6; ++q) { const int e = tid + NTHR * q, row = e / 48, c16 = e % 48; kq[q] = *(const GAS v4u*)(KQ + (size_t)(64 * (p + 1) + row) * 384 + 8 * c16); } }
        v4u uq[2];
#pragma unroll
        for (int q = 0; q < 2; ++q) { const int e = tid + NTHR * q, m = e >> 3, tl = (e >> 1) & 3, hf = e & 1; uq[q] = *(const GAS v4u*)(HN + (size_t)(b * SEQ + 16 * m + 4 * p + tl) * D + 16 * g + 8 * hf); }
        __syncthreads();
        f32x16 acc;
#pragma unroll
        for (int i = 0; i < 16; ++i) acc[i] = 0.f;
        const LAS unsigned char* brow = BL + (32 * ch + r) * KQP + 16 * hh;
#pragma unroll
        for (int s2 = 0; s2 < 16; ++s2) acc = __builtin_amdgcn_mfma_f32_32x32x16_bf16(au[s2], *(const LAS bf16x8*)(brow + 32 * s2), acc, 0, 0, 0);
#pragma unroll
        for (int s2 = 0; s2 < 8; ++s2) acc = __builtin_amdgcn_mfma_f32_32x32x16_bf16(ax[s2], *(const LAS bf16x8*)(brow + 512 + 32 * s2), acc, 0, 0, 0);
        { LAS float* OL = (LAS float*)XL;
#pragma unroll
          for (int i = 0; i < 16; ++i) OL[(32 * mt + (i & 3) + 8 * (i >> 2) + 4 * hh) * 68 + 32 * ch + r] = acc[i]; }
        __syncthreads();
#pragma unroll
        for (int q = 0; q < 2; ++q) { const int e = tid + NTHR * q, m = e >> 3, tl = (e >> 1) & 3, hf = e & 1; const LAS float* ol = (const LAS float*)XL + m * 68 + 16 * tl + 8 * hf;
            const f32x4 o0 = *(const LAS f32x4*)ol, o1 = *(const LAS f32x4*)(ol + 4);
            const size_t o = (size_t)(b * SEQ + 16 * m + 4 * p + tl) * D + 16 * g + 8 * hf;
            const v4u uu = uq[q]; const f32x4 d0 = *(const GAS f32x4*)(F.a->in[I_S5D] + 16 * g + 8 * hf), d1 = *(const GAS f32x4*)(F.a->in[I_S5D] + 16 * g + 8 * hf + 4);
            v4u w; w.x = pk2(gelu_tanh(o0.x + d0.x * bflo(uu.x)), gelu_tanh(o0.y + d0.y * bfhi(uu.x))); w.y = pk2(gelu_tanh(o0.z + d0.z * bflo(uu.y)), gelu_tanh(o0.w + d0.w * bfhi(uu.y)));
            w.z = pk2(gelu_tanh(o1.x + d1.x * bflo(uu.z)), gelu_tanh(o1.y + d1.y * bfhi(uu.z))); w.w = pk2(gelu_tanh(o1.z + d1.z * bflo(uu.w)), gelu_tanh(o1.w + d1.w * bfhi(uu.w)));
            *(GAS v4u*)(GY + o) = w; }
        __syncthreads();
    }
}
__device__ __forceinline__ void s5_fused_phase(Frame& F) {
    for (int it = F.vcu; it < 8 * 64; it += F.G) s5_fused_item(F, it >> 6, it & 63);
}
__device__ __forceinline__ void s5_sample(Frame& F) {
    const bf16* HN = (const bf16*)(F.ws + WS_XN) + (size_t)MP * D; bf16* GY = (bf16*)(F.ws + WS_BIG + B_GY) + (size_t)MP * D;
    const int n = F.lane;
    const int ntk = (MS * 64 + GW_N(F) - 1) / GW_N(F);
#pragma unroll 4
    for (int tq = 0; tq < ntk; ++tq) { const int task = GW_ID(F) + tq * GW_N(F); if (task >= MS * 64) break; const int j = task >> 6, g = task & 63;
        float abr, abi, cfr, cfi; s5_lambda(F, g, n, abr, abi, cfr, cfi);
        const v4u u0 = *(const GAS v4u*)(HN + (size_t)j * D + 16 * g), u1 = *(const GAS v4u*)(HN + (size_t)j * D + 16 * g + 8);
        float u[16]; u[0] = bflo(u0.x); u[1] = bfhi(u0.x); u[2] = bflo(u0.y); u[3] = bfhi(u0.y); u[4] = bflo(u0.z); u[5] = bfhi(u0.z); u[6] = bflo(u0.w); u[7] = bfhi(u0.w);
        u[8] = bflo(u1.x); u[9] = bfhi(u1.x); u[10] = bflo(u1.y); u[11] = bfhi(u1.y); u[12] = bflo(u1.z); u[13] = bfhi(u1.z); u[14] = bflo(u1.w); u[15] = bfhi(u1.w);
        const float* br = F.a->in[I_BRE] + (size_t)(g * 64 + n) * 16; const float* bi = F.a->in[I_BIM] + (size_t)(g * 64 + n) * 16;
        float bur = 0.f, bui = 0.f;
#pragma unroll
        for (int c = 0; c < 16; ++c) { const float b0 = br[c], b1 = bi[c]; bur += (cfr * b0 - cfi * b1) * u[c]; bui += (cfr * b1 + cfi * b0) * u[c]; }
        const size_t si = ((size_t)j * 64 + g) * 64 + n; const float sr = F.a->in[I_SS5R][si], sim = F.a->in[I_SS5I][si];
        const float xr = abr * sr - abi * sim + bur, xi = abr * sim + abi * sr + bui;
        F.out[O_SS5R + si] = xr; F.out[O_SS5I + si] = xi;
        float ymine = 0.f;
#pragma unroll
        for (int cp = 0; cp < 16; ++cp) { const float part = F.a->in[I_CRE][((size_t)g * 16 + cp) * 64 + n] * xr - F.a->in[I_CIM][((size_t)g * 16 + cp) * 64 + n] * xi; const float tot = wave_sum(part); if (n == cp) ymine = tot; }
        if (n < 16) { float uu = 0.f;
#pragma unroll
            for (int c = 0; c < 16; ++c) uu = (n == c) ? u[c] : uu;
            GY[(size_t)j * D + 16 * g + n] = (bf16)f2bf(gelu_tanh(ymine + F.a->in[I_S5D][16 * g + n] * uu)); }
    }
}

constexpr int CW_BAR = 4096;

struct SkAny { int mode; void* O; int ld;
    __device__ __forceinline__ void operator()(int row, int col, const float (&v)[1]) const { if (mode == 0) ((bf16*)O)[(size_t)row * ld + col] = (bf16)f2bf(v[0]); else ((float*)O)[(size_t)row * ld + col] = v[0]; } };

__global__ void __launch_bounds__(NTHR, 2) fwd_kernel(Args args) {
    extern __shared__ __attribute__((aligned(16))) unsigned char lds[];
    Frame F;
    F.lds = (LAS unsigned char*)lds;
    F.tid = threadIdx.x;
    F.out = args.out; F.ws = args.ws;
    volatile LAS unsigned* MISC = (volatile LAS unsigned*)(F.lds + MISC_OFF);
    for (int u = F.tid; u < (LDS_BYTES - LDSCTL_OFF) / 4; u += NTHR) ((LAS unsigned*)(F.lds + LDSCTL_OFF))[u] = 0u;
    __syncthreads();
    const int lo = args.ph_lo, hi = args.ph_hi;
    if (hi - lo > 1) (void)xcd_barrier_post((unsigned*)(args.ws + WS_CTL) + CW_BAR + args.li * XCD_BAR_WORDS, MISC + 8);
#pragma unroll 1
    for (int ph = lo; ph < hi; ++ph) {
        { int t_ = threadIdx.x; asm volatile("" : "+v"(t_)); F.tid = t_; F.lane = t_ & 63; F.wave = __builtin_amdgcn_readfirstlane(t_ >> 6); }
        { int g_ = gridDim.x, b_ = blockIdx.x; asm volatile("" : "+s"(g_), "+s"(b_)); F.G = g_; F.vcu = (g_ % 8 == 0) ? (b_ % 8) * (g_ / 8) + b_ / 8 : b_; }
        { const CAS Args* ap_ = (const CAS Args*)__builtin_amdgcn_kernarg_segment_ptr(); asm volatile("" : "+s"(ap_)); F.a = ap_; }
        { float* o_ = args.out; unsigned char* w_ = args.ws; asm volatile("" : "+s"(o_), "+s"(w_)); F.out = o_; F.ws = w_; }
        unsigned char* BIG = F.ws + WS_BIG; bf16* XN = (bf16*)(F.ws + WS_XN); bf16* WIN = (bf16*)(F.ws + WS_WIN);
        const bf16* gA = nullptr; const bf16* gAs = nullptr; const bf16* gB = nullptr; int gN = 0, gK = 0, gmode = 0, gld = 0; void* gO = nullptr; void* gOs = nullptr;
        int l = 0, fixl = -1;
        switch (ph) {
            case 0: p0_prologue(F); break;
            case 1: gA = XN; gAs = XN + (size_t)MP * D; gB = WIN; gN = NA; gK = D; gmode = 0; gld = NA; gO = BIG + B_PROJA; gOs = (bf16*)gO + (size_t)MP * NA; break;
            case 2: ssd_state_phase(F); break;
            case 3: ssd_out_phase(F); break;
            case 4: gA = XN; gAs = XN + (size_t)MP * D; gB = WIN + (size_t)NA * D; gN = NBH; gK = D; gmode = 0; gld = NBH; gO = BIG + B_PROJB; gOs = (bf16*)gO + (size_t)MP * NBH; break;
            case 5: hg_state_phase(F); break;
            case 6: hg_out_phase(F); break;
            case 7: gA = (const bf16*)(F.out + O_YP); gAs = (const bf16*)(F.ws + WS_MIXS); gB = (const bf16*)(F.ws + WS_WOUT); gN = D; gK = 2048; gmode = 0; gld = D; gO = BIG + B_M1; gOs = (bf16*)gO + (size_t)MP * D; break;
            case 8: resid_norm_rows(F, (const bf16*)(BIG + B_M1), F.a->in[I_NMPOST], F.a->in[I_NFPRE], 0); break;
            case 15: l = 1; [[fallthrough]];
            case 9: gA = XN; gAs = XN + (size_t)MP * D; gB = (const bf16*)(F.ws + WS_WUP) + (size_t)l * FF2 * D; gN = FF2; gK = D; gmode = 3; gld = FF2; gO = BIG + B_ACT; gOs = BIG + B_ACT; break;
            case 16: l = 1; [[fallthrough]];
            case 10: gA = (const bf16*)(BIG + B_ACT); gAs = gA + (size_t)MP * FF; gB = (const bf16*)(F.ws + WS_WDN) + (size_t)l * D * FF; gN = D; gK = FF; gmode = 0; gld = D; gO = BIG + B_M1; gOs = (bf16*)gO + (size_t)MP * D; fixl = l; break;
            case 11: resid_norm_rows(F, (const bf16*)(BIG + B_M1), F.a->in[I_NFPOST], F.a->in[I_NMPRE] + D, 1);
                     for (int g = F.vcu; g < 64; g += F.G) s5_tables_item(F, g);
                     break;
            case 12: s5_fused_phase(F); s5_sample(F); break;
            case 13: gA = (const bf16*)(BIG + B_GY); gAs = gA + (size_t)MP * D; gB = (const bf16*)(F.ws + WS_WGLU); gN = 2048; gK = D; gmode = 2; gld = D; gO = BIG + B_M1G; gOs = (bf16*)gO + (size_t)MP * D; break;
            case 14: resid_norm_rows(F, (const bf16*)(BIG + B_M1G), F.a->in[I_NMPOST] + D, F.a->in[I_NFPRE] + D, 1); break;
            case 17: resid_norm_rows(F, (const bf16*)(BIG + B_M1), F.a->in[I_NFPOST] + D, nullptr, 2); break;
            default: break;
        }
        if (gA) {
            pg8::Gemm g{gA, gB, MP, gN, gK}; pg8::StaticOrder S; S.init(MP, gN, F.G, (int)blockIdx.x);
            if (fixl >= 0) { pg8::Unit u0; for (int i = 0; S.next(i, u0); ++i) ffn_fix_rows(F, fixl, u0.pm);
                asm volatile("s_waitcnt vmcnt(0)" ::: "memory"); __syncthreads(); }
            pg8::EpiConvGate cg{(pg8::bf16_t*)(BIG + B_ACT), F.a->in[I_FCW] + (size_t)l * 3 * FF2, F.a->in[I_FCB] + (size_t)l * FF2, (float*)(BIG + B_HEAD), (float*)(BIG + B_TAIL), (PG8_LAS float*)(F.lds + HALO_OFF), F.out + O_PFC + (size_t)l * 8 * 2 * FF2};
            pg8::gemm_phase<pg8::EpiAny, pg8::StaticOrder, true, true>(F.lds, g, S, pg8::EpiAny{gmode, gmode == 0 || gmode == 3, gO, gld, cg}, F.tid);
            __syncthreads();
            const int nrem = ((MP / 256) * (gN / 256)) % F.G, tb = nrem ? (int)blockIdx.x - nrem : (int)blockIdx.x, tstr = nrem ? F.G - nrem : F.G;
            if (gmode == 2) skinny_gemm<2, true>(F, gAs, gK, gB, gK, D / 32, SkGlu{(bf16*)gOs, gld}, tb, tstr);
            else if (gmode == 3) skinny_gemm<2, true>(F, gAs, gK, gB, gK, FF / 32, SkConvGate{(bf16*)(BIG + B_ACT) + (size_t)MP * FF, F.a->in[I_FCW] + (size_t)l * 3 * FF2, F.a->in[I_FCB] + (size_t)l * FF2, F.a->in[I_SFC] + (size_t)l * MS * 2 * FF2, F.out + O_SFC + (size_t)l * MS * 2 * FF2}, tb, tstr);
            else skinny_gemm<1, false>(F, gAs, gK, gB, gK, gN / 32, SkAny{gmode, gOs, gld}, tb, tstr);
        }
        if (ph + 1 < hi) { XcdBarrier b2; b2.bar = (unsigned*)(F.ws + WS_CTL) + CW_BAR + F.a->li * XCD_BAR_WORDS; b2.x = xb_xcc_id(); b2.st = (volatile LAS unsigned*)(F.lds + MISC_OFF) + 8; xcd_barrier(b2); }
    }
}

extern "C" void kernel_launch(void* const* d_in, const int* in_sizes, int n_in, void* d_out, int out_size, void* d_ws, size_t ws_size, hipStream_t stream) {
    static int grid = 0;
    if (grid == 0) {
        if (n_in != N_IN || out_size != (int)O_END || ws_size < WS_END) { fprintf(stderr, "kernel_launch: unexpected shapes (n_in %d, out %d, ws %zu)\n", n_in, out_size, ws_size); grid = -1; return; }
        int dev = 0, cus = 0, per_cu = 0;
        if (hipGetDevice(&dev) != hipSuccess || hipDeviceGetAttribute(&cus, hipDeviceAttributeMultiprocessorCount, dev) != hipSuccess) { grid = -1; return; }
        if (hipFuncSetAttribute((const void*)fwd_kernel, hipFuncAttributeMaxDynamicSharedMemorySize, LDS_BYTES) != hipSuccess) { fprintf(stderr, "kernel_launch: hipFuncSetAttribute failed\n"); grid = -1; return; }
        if (hipOccupancyMaxActiveBlocksPerMultiprocessor(&per_cu, (const void*)fwd_kernel, NTHR, LDS_BYTES) != hipSuccess || per_cu < 1) fprintf(stderr, "kernel_launch: occupancy query says %d\n", per_cu);
        (void)hipGetLastError();
        if (per_cu < 1) { fprintf(stderr, "kernel_launch: the kernel does not fit a CU\n"); grid = -1; return; }
        grid = cus;
    }
    if (grid < 0) return;
    (void)hipMemsetAsync((char*)d_ws + WS_CTL, 0, CTL_BYTES, stream);
    Args a{};
    for (int i = 0; i < 35; ++i) a.in[i] = (const float*)d_in[i];
    a.out = (float*)d_out; a.ws = (unsigned char*)d_ws;
#if PROBE_PH >= 0
    a.ph_lo = 0; a.ph_hi = PROBE_PH + 1; a.li = 0; hipLaunchKernelGGL(fwd_kernel, dim3(grid), dim3(NTHR), LDS_BYTES, stream, a);
    for (int rep = 0; rep < PROBE_REPS; ++rep) { a.ph_lo = PROBE_PH; a.ph_hi = PROBE_PH + 1; a.li = 1; hipLaunchKernelGGL(fwd_kernel, dim3(grid), dim3(NTHR), LDS_BYTES, stream, a); }
    if (PROBE_PH + 1 < NPH) { a.ph_lo = PROBE_PH + 1; a.ph_hi = NPH; a.li = 2; hipLaunchKernelGGL(fwd_kernel, dim3(grid), dim3(NTHR), LDS_BYTES, stream, a); }
#elif MK_ONE_LAUNCH
    a.ph_lo = 0; a.ph_hi = NPH; a.li = 0;
    { void* kargs[] = {&a};
      if (hipLaunchCooperativeKernel((const void*)fwd_kernel, dim3(grid), dim3(NTHR), kargs, LDS_BYTES, stream) != hipSuccess) { (void)hipGetLastError(); fprintf(stderr, "kernel_launch: cooperative launch refused\n"); } }
#else
    for (int p = 0; p < NPH; ++p) { a.ph_lo = p; a.ph_hi = p + 1; a.li = 0; hipLaunchKernelGGL(fwd_kernel, dim3(grid), dim3(NTHR), LDS_BYTES, stream, a); }
#endif
}
```

```cpp
#include <hip/hip_runtime.h>
#include <cstdio>
#include <cstdint>

#ifndef PROBE_PH
#define PROBE_PH -1
#endif
#ifndef PROBE_REPS
#define PROBE_REPS 1
#endif
#ifndef MK_ONE_LAUNCH
#define MK_ONE_LAUNCH 1
#endif

__device__ __forceinline__ float dpp_add_(float v, const int ctrl_sel) {
    const int b = __builtin_bit_cast(int, v); int r;
    if (ctrl_sel == 0) r = __builtin_amdgcn_update_dpp(0, b, 0xB1, 0xf, 0xf, true); else if (ctrl_sel == 1) r = __builtin_amdgcn_update_dpp(0, b, 0x4E, 0xf, 0xf, true);
    else if (ctrl_sel == 2) r = __builtin_amdgcn_update_dpp(0, b, 0x141, 0xf, 0xf, true); else r = __builtin_amdgcn_update_dpp(0, b, 0x140, 0xf, 0xf, true);
    return v + __builtin_bit_cast(float, r); }
__device__ __forceinline__ float row16_sum(float v) { v = dpp_add_(v, 0); v = dpp_add_(v, 1); v = dpp_add_(v, 2); v = dpp_add_(v, 3); return v; }
__device__ __forceinline__ float wave_sum(float v) {
    v = row16_sum(v);
    v += __builtin_bit_cast(float, __builtin_amdgcn_update_dpp(0, __builtin_bit_cast(int, v), 0x142, 0xa, 0xf, false));
    v += __builtin_bit_cast(float, __builtin_amdgcn_update_dpp(0, __builtin_bit_cast(int, v), 0x143, 0xc, 0xf, false));
    return __builtin_bit_cast(float, __builtin_amdgcn_readlane(__builtin_bit_cast(int, v), 63)); }
__device__ __forceinline__ int lane_op_() { int l = __builtin_amdgcn_mbcnt_hi(-1, __builtin_amdgcn_mbcnt_lo(-1, 0)); asm volatile("" : "+v"(l)); return l; }
__device__ __forceinline__ float shx_(float v, int o, int l) { return __builtin_bit_cast(float, __builtin_amdgcn_ds_bpermute((l ^ o) << 2, __builtin_bit_cast(int, v))); }
__device__ __forceinline__ float shup_(float v, int off, int width, int l) { const int src = ((l & (width - 1)) >= off) ? l - off : l; return __builtin_bit_cast(float, __builtin_amdgcn_ds_bpermute(src << 2, __builtin_bit_cast(int, v))); }
__device__ __forceinline__ float shidx_(float v, int src, int width, int l) { return __builtin_bit_cast(float, __builtin_amdgcn_ds_bpermute(((l & ~(width - 1)) + src) << 2, __builtin_bit_cast(int, v))); }
namespace pg8 {
#define PG8_LAS __attribute__((address_space(3)))
typedef unsigned short bf16_t;
typedef short bf16x8 __attribute__((ext_vector_type(8)));
typedef float f32x4 __attribute__((ext_vector_type(4)));
typedef unsigned u32x4 __attribute__((ext_vector_type(4)));
typedef float f32x2 __attribute__((ext_vector_type(2)));
constexpr int BM = 256, BK = 64, HALF = 128, HTB = HALF * BK * 2  , STAGE_BYTES = 8 * HTB, NXCD = 8, WGM = 8;

__host__ __device__ __forceinline__ int lds_byte(int r, int c) { const int st = (r >> 4) * 2 + (c >> 5), rr = r & 15, cc = c & 31, ob = rr * 64 + cc * 2; return st * 1024 + (ob ^ (((ob >> 9) & 1) << 5)); }
__host__ __device__ __forceinline__ void stage_rc(int b, int& R, int& C) { const int st = b / 1024, sb = b % 1024, swz = sb ^ (((sb >> 9) & 1) << 5); R = (st >> 1) * 16 + swz / 64; C = (st & 1) * 32 + (swz % 64) / 2; }
__host__ __device__ __forceinline__ int perm32(int rho) { const int n = rho >> 4, i = rho & 15; return 8 * (i >> 2) + 4 * n + (i & 3); }

struct Unit { int pm, pn; };
struct Gemm { const bf16_t* A; const bf16_t* Bt; int M, N, K; };

struct StaticOrder {
    int nM, nN, nwg, G, c;
    __host__ __device__ void init(int M, int N, int G_, int c_) { nM = M / BM; nN = N / BM; nwg = nM * nN; G = G_; c = c_; }
    __host__ __device__ bool next(int i, Unit& u) const {
        const long L = (long)i * G + c; if (L >= nwg) return false;
        int wgid = (int)L; { const int q = nwg / NXCD, r = nwg % NXCD, xcd = wgid % NXCD, off = wgid / NXCD; wgid = (xcd < r ? xcd * (q + 1) : r * (q + 1) + (xcd - r) * q) + off; }
        const int nig = WGM * nN, gid = wgid / nig, fm = gid * WGM, gsz = (nM - fm) < WGM ? (nM - fm) : WGM;
        u.pm = fm + ((wgid % nig) % gsz); u.pn = (wgid % nig) / gsz; return true;
    }
    __device__ __forceinline__ void a_ready(const Unit&) const {}
    __device__ __forceinline__ void done(const Unit&) const {}
};

__device__ __forceinline__ unsigned cvt_pk_bf16(float lo, float hi) { unsigned r; asm volatile("v_cvt_pk_bf16_f32 %0, %1, %2" : "=v"(r) : "v"(lo), "v"(hi)); return r; }

struct EpiF32 {
    static constexpr bool PERM = false, AFTER_DRAIN = false;
    float* C; int ldc;
    __device__ __forceinline__ void operator()(const f32x4 (&acc)[2][2][4][2], const Unit& u, int wr, int wc, int fr, int fq) const {
        const int row0 = u.pm * BM + wr * 64 + fr, col0 = u.pn * BM + wc * 32 + 4 * fq;
#pragma unroll
        for (int ai = 0; ai < 2; ++ai)
#pragma unroll
            for (int m = 0; m < 4; ++m) { float* rowp = C + (size_t)(row0 + ai * HALF + m * 16) * ldc + col0;
#pragma unroll
                for (int bj = 0; bj < 2; ++bj)
#pragma unroll
                    for (int n = 0; n < 2; ++n) *(f32x4*)(rowp + bj * HALF + n * 16) = acc[ai][bj][m][n]; }
    }
};
struct EpiBf16 {
    static constexpr bool PERM = true, AFTER_DRAIN = false;
    bf16_t* O; int ldc;
    __device__ __forceinline__ void operator()(const f32x4 (&acc)[2][2][4][2], const Unit& u, int wr, int wc, int fr, int fq) const {
        const int row0 = u.pm * BM + wr * 64 + fr, col0 = u.pn * BM + wc * 32 + 8 * fq;
#pragma unroll
        for (int ai = 0; ai < 2; ++ai)
#pragma unroll
            for (int m = 0; m < 4; ++m) { bf16_t* rowp = O + (size_t)(row0 + ai * HALF + m * 16) * ldc + col0;
#pragma unroll
                for (int bj = 0; bj < 2; ++bj) { const f32x4 v0 = acc[ai][bj][m][0], v1 = acc[ai][bj][m][1];
                    u32x4 w; w.x = cvt_pk_bf16(v0[0], v0[1]); w.y = cvt_pk_bf16(v0[2], v0[3]); w.z = cvt_pk_bf16(v1[0], v1[1]); w.w = cvt_pk_bf16(v1[2], v1[3]);
                    *(u32x4*)(rowp + bj * HALF) = w; } }
    }
};
struct EpiGlu {
    static constexpr bool PERM = false, AFTER_DRAIN = false;
    bf16_t* C; int ldc;
    __device__ __forceinline__ void operator()(const f32x4 (&acc)[2][2][4][2], const Unit& u, int wr, int wc, int fr, int fq) const {
        const int row0 = u.pm * BM + wr * 64 + fr, col0 = u.pn * HALF + wc * 32 + 4 * fq;
        typedef unsigned u32x2g __attribute__((ext_vector_type(2)));
#pragma unroll
        for (int ai = 0; ai < 2; ++ai)
#pragma unroll
            for (int m = 0; m < 4; ++m) { bf16_t* rowp = C + (size_t)(row0 + ai * HALF + m * 16) * ldc + col0;
#pragma unroll
                for (int n = 0; n < 2; ++n) { const f32x4 v = acc[ai][0][m][n], g = acc[ai][1][m][n]; float o[4];
#pragma unroll
                    for (int j = 0; j < 4; ++j) o[j] = v[j] * __builtin_amdgcn_rcpf(1.0f + __expf(-g[j]));
                    u32x2g w; w.x = cvt_pk_bf16(o[0], o[1]); w.y = cvt_pk_bf16(o[2], o[3]); *(u32x2g*)(rowp + n * 16) = w; } }
    }
};


__device__ __forceinline__ float dpp_shr1(float old, float src) { return __builtin_bit_cast(float, __builtin_amdgcn_update_dpp(__builtin_bit_cast(int, old), __builtin_bit_cast(int, src), 0x111, 0xf, 0xf, false)); }
__device__ __forceinline__ float dpp_shr2(float old, float src) { return __builtin_bit_cast(float, __builtin_amdgcn_update_dpp(__builtin_bit_cast(int, old), __builtin_bit_cast(int, src), 0x112, 0xf, 0xf, false)); }
__device__ __forceinline__ float dpp_ror1(float src) { return __builtin_bit_cast(float, __builtin_amdgcn_update_dpp(0, __builtin_bit_cast(int, src), 0x121, 0xf, 0xf, false)); }
__device__ __forceinline__ float dpp_ror2(float src) { return __builtin_bit_cast(float, __builtin_amdgcn_update_dpp(0, __builtin_bit_cast(int, src), 0x122, 0xf, 0xf, false)); }
struct EpiConvGate {
    bf16_t* ACT; const float* cw; const float* cb; float* HEAD; float* TAIL; PG8_LAS float* HALO; float* PFC;
    __device__ __forceinline__ void operator()(const f32x4 (&acc)[2][2][4][2], const Unit& u, int wr, int wc, int fr, int fq) const {
        constexpr int FF_ = 2816, FF2_ = 5632;
        asm volatile("" : "+v"(fr), "+v"(fq));
        const int colt = wc * 32 + 8 * fq;
        if (fr >= 14) {
#pragma unroll
            for (int ai = 0; ai < 2; ++ai)
#pragma unroll
                for (int bj = 0; bj < 2; ++bj)
#pragma unroll
                    for (int n = 0; n < 2; ++n) { *(PG8_LAS f32x4*)(HALO + ((ai * 2 + wr) * 2 + (fr - 14)) * 256 + bj * 128 + colt + 4 * n) = acc[ai][bj][3][n];
                        if (ai == 1 && wr == 1) { *(f32x4*)(TAIL + ((size_t)u.pm * 2 + (fr - 14)) * FF2_ + bj * FF_ + u.pn * 128 + colt + 4 * n) = acc[1][bj][3][n];
                            if ((u.pm & 7) == 7) *(f32x4*)(PFC + ((size_t)(u.pm >> 3) * 2 + (fr - 14)) * FF2_ + bj * FF_ + u.pn * 128 + colt + 4 * n) = acc[1][bj][3][n]; } } }
        if (fr < 2 && wr == 0) {
#pragma unroll
            for (int bj = 0; bj < 2; ++bj)
#pragma unroll
                for (int n = 0; n < 2; ++n) *(f32x4*)(HEAD + ((size_t)u.pm * 2 + fr) * FF2_ + bj * FF_ + u.pn * 128 + colt + 4 * n) = acc[0][bj][0][n]; }
        { PG8_LAS float* WL = HALO + 2048;
          const int tid_ = (wr * 4 + wc) * 64 + fq * 16 + fr, e = 2 * tid_, arr = e >> 8, c = e & 255;
          const float* src = (arr < 3 ? cw + arr * FF2_ : cb) + (c < 128 ? u.pn * 128 + c : FF_ + u.pn * 128 + (c - 128));
          *(PG8_LAS f32x2*)(WL + e) = *(const __attribute__((address_space(1))) f32x2*)src; }
        asm volatile("s_waitcnt vmcnt(0) lgkmcnt(0)" ::: "memory"); __builtin_amdgcn_s_barrier(); asm volatile("" ::: "memory");
        const PG8_LAS float* WL = HALO + 2048;
        typedef unsigned u32x2 __attribute__((ext_vector_type(2)));
#pragma unroll
        for (int ai = 0; ai < 2; ++ai) {
            const int pred = wr == 1 ? (ai * 2 + 0) : (0 * 2 + 1);
            const bool nohist = (ai == 0 && wr == 0);
            const int row0 = u.pm * BM + ai * HALF + wr * 64 + fr;
#pragma unroll
            for (int n = 0; n < 2; ++n) {
                unsigned pk[4][2];
#pragma unroll
                for (int jp = 0; jp < 2; ++jp) {
                    float gsil[4][2];
#pragma unroll
                    for (int bj = 1; bj >= 0; --bj) { const int wc_ = bj * 128 + colt + 4 * n + 2 * jp;
                        const f32x2 w0 = *(const PG8_LAS f32x2*)(WL + wc_), w1 = *(const PG8_LAS f32x2*)(WL + 256 + wc_), w2 = *(const PG8_LAS f32x2*)(WL + 512 + wc_), bb = *(const PG8_LAS f32x2*)(WL + 768 + wc_);
                        const f32x2 h0 = *(const PG8_LAS f32x2*)(HALO + (pred * 2 + 0) * 256 + bj * 128 + colt + 4 * n + 2 * jp), h1 = *(const PG8_LAS f32x2*)(HALO + (pred * 2 + 1) * 256 + bj * 128 + colt + 4 * n + 2 * jp);
#pragma unroll
                        for (int m = 0; m < 4; ++m) { float r[2];
#pragma unroll
                            for (int jj = 0; jj < 2; ++jj) { const int j = 2 * jp + jj; const float cur = acc[ai][bj][m][n][j];
                                const float x1 = m == 0 ? h1[jj] : dpp_ror1(acc[ai][bj][m == 0 ? 0 : m - 1][n][j]);
                                const float x2 = m == 0 ? (fr == 0 ? h0[jj] : h1[jj]) : dpp_ror2(acc[ai][bj][m == 0 ? 0 : m - 1][n][j]);
                                const float p1 = dpp_shr1(x1, cur), p2 = dpp_shr2(x2, cur);
                                r[jj] = bb[jj] + w0[jj] * p2 + w1[jj] * p1 + w2[jj] * cur; }
                            if (bj == 1) { gsil[m][0] = r[0] * __builtin_amdgcn_rcpf(1.0f + __expf(-r[0])); gsil[m][1] = r[1] * __builtin_amdgcn_rcpf(1.0f + __expf(-r[1])); }
                            else pk[m][jp] = cvt_pk_bf16(r[0] * gsil[m][0], r[1] * gsil[m][1]); }
                    }
                }
#pragma unroll
                for (int m = 0; m < 4; ++m) { if (nohist && m == 0 && fr < 2) continue;
                    u32x2 w; w.x = pk[m][0]; w.y = pk[m][1]; *(u32x2*)(ACT + (size_t)(row0 + m * 16) * FF_ + u.pn * 128 + colt + 4 * n) = w; }
                asm volatile("" ::: "memory");
            }
        }
    }
};
struct EpiAny {
    static constexpr bool AFTER_DRAIN = false;
    int mode; bool perm; void* O; int ldc; EpiConvGate cg;
    __device__ __forceinline__ void operator()(const f32x4 (&acc)[2][2][4][2], const Unit& u, int wr, int wc, int fr, int fq) const {
        if (mode == 0) { EpiBf16 e{(bf16_t*)O, ldc}; e(acc, u, wr, wc, fr, fq); }
        else if (mode == 1) { EpiF32 e{(float*)O, ldc}; e(acc, u, wr, wc, fr, fq); }
        else if (mode == 2) { EpiGlu e{(bf16_t*)O, ldc}; e(acc, u, wr, wc, fr, fq); }
        else cg(acc, u, wr, wc, fr, fq);
    }
};
template <class Epi, class Sched, bool ALIGN_EPI = false, bool SP2 = false>
__device__ __forceinline__ void gemm_phase(PG8_LAS unsigned char* lds, const Gemm g, const Sched& S, const Epi& E, const int tid) {
    const int wid = __builtin_amdgcn_readfirstlane(tid >> 6), lane = tid & 63, wr = wid >> 2, wc = wid & 3, fr = lane & 15, fq = lane >> 4;
    const int K = g.K, nt = K / BK;
    unsigned voffA[2], voffB[2];
#pragma unroll
    for (int i = 0; i < 2; ++i) { int R, C; stage_rc(tid * 16 + i * 8192, R, C); const int Rb = E.perm ? ((R & ~31) + perm32(R & 31)) : R;
        voffA[i] = (unsigned)(R * K + C) * 2u; voffB[i] = (unsigned)(Rb * K + C) * 2u; }
    const size_t kstep = (size_t)(BK * 2);
    const size_t hstep = (size_t)HALF * K * 2;
    const size_t tstep = 2 * hstep;
    const unsigned ldsw = (unsigned)wid * 1024u;
    const int aoff = lds_byte(wr * 64 + fr, fq * 8), boff = lds_byte(wc * 32 + fr, fq * 8);
#define PG8_SA(b, h) (((b) * 2 + (h)) * HTB)
#define PG8_SB(b, h) ((4 + (b) * 2 + (h)) * HTB)
#define PG8_STAGE(bufoff, gbase, voff) do { _Pragma("unroll") for (int _i = 0; _i < 2; ++_i) \
        __builtin_amdgcn_global_load_lds((const unsigned*)((const char*)(gbase) + (voff)[_i]), (PG8_LAS unsigned*)(lds + (bufoff) + ldsw + _i * 8192), 16, 0, 0); } while (0)
#define PG8_LDA(dst, b, h) do { _Pragma("unroll") for (int m = 0; m < 4; ++m) _Pragma("unroll") for (int k = 0; k < 2; ++k) dst[m][k] = *(const PG8_LAS bf16x8*)(lds + PG8_SA(b, h) + aoff + m * 2048 + k * 1024); } while (0)
#define PG8_LDB(dst, b, h) do { _Pragma("unroll") for (int n = 0; n < 2; ++n) _Pragma("unroll") for (int k = 0; k < 2; ++k) dst[n][k] = *(const PG8_LAS bf16x8*)(lds + PG8_SB(b, h) + boff + n * 2048 + k * 1024); } while (0)
#define PG8_MMA(ai, bj, At, Bt) do { __builtin_amdgcn_s_setprio(1); _Pragma("unroll") for (int m = 0; m < 4; ++m) _Pragma("unroll") for (int n = 0; n < 2; ++n) _Pragma("unroll") for (int k = 0; k < 2; ++k) \
        acc[ai][bj][m][n] = __builtin_amdgcn_mfma_f32_16x16x32_bf16(Bt[n][k], At[m][k], acc[ai][bj][m][n], 0, 0, 0); __builtin_amdgcn_s_setprio(0); } while (0)
#define PG8_WAIT_V(n) asm volatile("s_waitcnt vmcnt(" #n ")" ::: "memory")
#define PG8_WAIT_L(n) asm volatile("s_waitcnt lgkmcnt(" #n ")" ::: "memory")
#define PG8_BAR __builtin_amdgcn_s_barrier()
#define PG8_SCHED __builtin_amdgcn_sched_barrier(0)
    Unit cur, nxt; int ui = 0;
    if (!S.next(0, cur)) return;
    f32x4 acc[2][2][4][2];
#pragma unroll
    for (int a = 0; a < 2; ++a)
#pragma unroll
        for (int b = 0; b < 2; ++b)
#pragma unroll
            for (int m = 0; m < 4; ++m)
#pragma unroll
                for (int n = 0; n < 2; ++n) acc[a][b][m][n] = (f32x4){0.f, 0.f, 0.f, 0.f};
    bf16x8 At[4][2], B0[2][2], B1[2][2];
    const char* cA = (const char*)g.A + (size_t)cur.pm * tstep; const char* cB = (const char*)g.Bt + (size_t)cur.pn * tstep;
    S.a_ready(cur);
    if constexpr (SP2) {
        PG8_STAGE(PG8_SB(0, 0), cB, voffB); PG8_STAGE(PG8_SB(0, 1), cB + hstep, voffB); PG8_STAGE(PG8_SA(0, 0), cA, voffA); PG8_STAGE(PG8_SA(0, 1), cA + hstep, voffA);
        if (wr == 1) PG8_BAR;
        PG8_WAIT_V(2); PG8_BAR;
        PG8_STAGE(PG8_SB(1, 0), cB + kstep, voffB); PG8_STAGE(PG8_SA(1, 0), cA + kstep, voffA); PG8_STAGE(PG8_SB(1, 1), cB + hstep + kstep, voffB);
        PG8_WAIT_V(6); PG8_BAR;
    } else {
        PG8_STAGE(PG8_SB(0, 0), cB, voffB); PG8_STAGE(PG8_SA(0, 0), cA, voffA); PG8_STAGE(PG8_SB(0, 1), cB + hstep, voffB); PG8_STAGE(PG8_SA(0, 1), cA + hstep, voffA);
        if (wr == 1) PG8_BAR;
        PG8_WAIT_V(4); PG8_BAR;
        PG8_STAGE(PG8_SB(1, 0), cB + kstep, voffB); PG8_STAGE(PG8_SA(1, 0), cA + kstep, voffA); PG8_STAGE(PG8_SB(1, 1), cB + hstep + kstep, voffB);
        PG8_WAIT_V(6); PG8_BAR;
    }
    for (;;) {
        const bool has_next = S.next(ui + 1, nxt);
        const char* nA = has_next ? (const char*)g.A + (size_t)nxt.pm * tstep : cA; const char* nB = has_next ? (const char*)g.Bt + (size_t)nxt.pn * tstep : cB;
        for (int t = 0; t < nt; t += 2) {
            const bool last = (t == nt - 2);
            const char* a1 = cA + (size_t)(t + 1) * kstep;
            const char* a2 = last ? nA : cA + (size_t)(t + 2) * kstep; const char* b2 = last ? nB : cB + (size_t)(t + 2) * kstep;
            const char* a3 = a2 + kstep; const char* b3 = b2 + kstep;
            if (last && has_next) S.a_ready(nxt);
            if constexpr (SP2) {
            PG8_LDB(B0, 0, 0); PG8_LDB(B1, 0, 1); PG8_SCHED; PG8_LDA(At, 0, 0); PG8_STAGE(PG8_SA(1, 1), a1 + hstep, voffA);
            PG8_WAIT_V(8); PG8_WAIT_L(0); PG8_BAR; PG8_MMA(0, 0, At, B0); PG8_MMA(0, 1, At, B1); PG8_BAR; PG8_SCHED;
            PG8_LDA(At, 0, 1); PG8_STAGE(PG8_SB(0, 0), b2, voffB); PG8_STAGE(PG8_SB(0, 1), b2 + hstep, voffB); PG8_STAGE(PG8_SA(0, 0), a2, voffA);
            PG8_WAIT_V(8); PG8_WAIT_L(0); PG8_BAR; PG8_MMA(1, 0, At, B0); PG8_MMA(1, 1, At, B1); PG8_BAR; PG8_SCHED;
            PG8_LDB(B0, 1, 0); PG8_LDB(B1, 1, 1); PG8_SCHED; PG8_LDA(At, 1, 0); PG8_STAGE(PG8_SA(0, 1), a2 + hstep, voffA);
            PG8_WAIT_V(8); PG8_WAIT_L(0); PG8_BAR; PG8_MMA(0, 0, At, B0); PG8_MMA(0, 1, At, B1); PG8_BAR; PG8_SCHED;
            PG8_LDA(At, 1, 1); PG8_STAGE(PG8_SB(1, 0), b3, voffB); PG8_STAGE(PG8_SB(1, 1), b3 + hstep, voffB); PG8_STAGE(PG8_SA(1, 0), a3, voffA);
            PG8_WAIT_V(8); PG8_WAIT_L(0); PG8_BAR; PG8_MMA(1, 0, At, B0); PG8_MMA(1, 1, At, B1); PG8_BAR; PG8_SCHED;
            } else {
            PG8_LDB(B0, 0, 0); PG8_SCHED; PG8_LDA(At, 0, 0); PG8_STAGE(PG8_SA(1, 1), a1 + hstep, voffA);
            PG8_WAIT_L(8); PG8_BAR; PG8_WAIT_L(0); PG8_MMA(0, 0, At, B0); PG8_BAR; PG8_SCHED;
            PG8_LDB(B1, 0, 1); PG8_STAGE(PG8_SB(0, 0), b2, voffB);
            PG8_BAR; PG8_WAIT_L(0); PG8_MMA(0, 1, At, B1); PG8_BAR;
            PG8_LDA(At, 0, 1); PG8_STAGE(PG8_SA(0, 0), a2, voffA);
            PG8_BAR; PG8_WAIT_L(0); PG8_MMA(1, 0, At, B0); PG8_BAR; PG8_SCHED;
            PG8_STAGE(PG8_SB(0, 1), b2 + hstep, voffB);
            PG8_WAIT_V(6); PG8_BAR; PG8_MMA(1, 1, At, B1); PG8_BAR;
            PG8_LDB(B0, 1, 0); PG8_SCHED; PG8_LDA(At, 1, 0); PG8_STAGE(PG8_SA(0, 1), a2 + hstep, voffA);
            PG8_WAIT_L(8); PG8_BAR; PG8_WAIT_L(0); PG8_MMA(0, 0, At, B0); PG8_BAR; PG8_SCHED;
            PG8_LDB(B1, 1, 1); PG8_STAGE(PG8_SB(1, 0), b3, voffB);
            PG8_BAR; PG8_WAIT_L(0); PG8_MMA(0, 1, At, B1); PG8_BAR;
            PG8_LDA(At, 1, 1); PG8_STAGE(PG8_SA(1, 0), a3, voffA);
            PG8_BAR; PG8_WAIT_L(0); PG8_MMA(1, 0, At, B0); PG8_BAR; PG8_SCHED;
            PG8_STAGE(PG8_SB(1, 1), b3 + hstep, voffB);
            PG8_WAIT_V(6); PG8_BAR; PG8_MMA(1, 1, At, B1); PG8_BAR;
            }
        }
        if constexpr (ALIGN_EPI) { if (wr == 0) PG8_BAR; }
        if constexpr (!Epi::AFTER_DRAIN) { E(acc, cur, wr, wc, fr, fq); S.done(cur); }
        if (!has_next) break;
#pragma unroll
        for (int a = 0; a < 2; ++a)
#pragma unroll
            for (int b = 0; b < 2; ++b)
#pragma unroll
                for (int m = 0; m < 4; ++m)
#pragma unroll
                    for (int n = 0; n < 2; ++n) acc[a][b][m][n] = (f32x4){0.f, 0.f, 0.f, 0.f};
        cur = nxt; cA = nA; cB = nB; ++ui;
        if constexpr (ALIGN_EPI) { if (wr == 1) PG8_BAR; }
    }
    PG8_WAIT_V(0);
    if constexpr (!ALIGN_EPI) { if (wr == 0) PG8_BAR; }
    PG8_BAR;
    if constexpr (Epi::AFTER_DRAIN) { E.fused(acc, cur, wr, wc, fr, fq, lds, wid, lane); S.done(cur); }
#undef PG8_SA
#undef PG8_SB
#undef PG8_STAGE
#undef PG8_LDA
#undef PG8_LDB
#undef PG8_MMA
#undef PG8_WAIT_V
#undef PG8_WAIT_L
#undef PG8_BAR
#undef PG8_SCHED
}
}

constexpr int NWAVES = 8, NTHR = 512;
constexpr int D = 1024, NB = 8, SEQ = 2048, MP = NB * SEQ, MS = 128, MT = MP + MS;
constexpr int NA = 2560, NBH = 4096;
constexpr int WIN_ROWS = NA + NBH;
constexpr int XBC = 1280, ABIN = 6416;
constexpr int FF = 2816, FF2 = 5632, NFT = 22;
constexpr float EPS = 1e-6f;
constexpr int NPH = 18;

constexpr size_t O_YP = 0, O_YS = O_YP + (size_t)MP * D, O_PSSM = O_YS + (size_t)MS * D, O_PSCONV = O_PSSM + 8 * 16 * 64 * 64, O_PHG = O_PSCONV + 8 * 3 * XBC,
                 O_PS5R = O_PHG + 8 * 8 * 128 * 128, O_PS5I = O_PS5R + 8 * 64 * 64, O_PFC = O_PS5I + 8 * 64 * 64, O_SSSM = O_PFC + 2 * 8 * 2 * FF2,
                 O_SSCONV = O_SSSM + (size_t)MS * 16 * 64 * 64, O_SHG = O_SSCONV + (size_t)MS * 3 * XBC, O_SS5R = O_SHG + (size_t)MS * 8 * 128 * 128,
                 O_SS5I = O_SS5R + (size_t)MS * 64 * 64, O_SFC = O_SS5I + (size_t)MS * 64 * 64, O_END = O_SFC + (size_t)2 * MS * 2 * FF2;
static_assert(O_END == 48347136, "d_out size");

constexpr size_t al256(size_t x) { return (x + 255) & ~(size_t)255; }
constexpr size_t WS_CTL = 0, CTL_BYTES = 1u << 20;
constexpr size_t WS_WIN = CTL_BYTES;
constexpr size_t WS_WOUT = WS_WIN + (size_t)WIN_ROWS * D * 2;
constexpr size_t WS_WGLU = WS_WOUT + (size_t)D * 2048 * 2;
constexpr size_t WS_WUP = WS_WGLU + (size_t)2048 * D * 2;
constexpr size_t WS_WDN = WS_WUP + (size_t)2 * FF2 * D * 2;
constexpr size_t WS_XN = WS_WDN + (size_t)2 * D * FF * 2;
constexpr size_t WS_MIXS = WS_XN + (size_t)MT * D * 2;
constexpr size_t WS_BIG = al256(WS_MIXS + (size_t)MS * 2048 * 2);
constexpr size_t WS_END = (size_t)256 << 20;
constexpr size_t BIG_BYTES = WS_END - WS_BIG;
constexpr size_t B_PROJA = 0;
constexpr size_t B_Y2 = al256(B_PROJA + (size_t)MT * NA * 2);
constexpr size_t B_ORAW = 0;
constexpr size_t B_PROJB = al256(B_ORAW + (size_t)MT * D * 2);
constexpr size_t B_M1 = 0;
constexpr size_t B_UP = 0;
constexpr size_t B_ACT = al256((size_t)MT * 2048 * 2);
constexpr size_t B_GY = 0;
constexpr size_t B_PC = al256(B_GY + (size_t)MT * D * 2);
constexpr size_t B_XP = al256(B_PC + (size_t)1024 * 8192 * 4);
constexpr size_t B_M1G = (size_t)100 << 20;
constexpr size_t B_S5T = (size_t)120 << 20;
constexpr size_t S5T_KQ = 0, S5T_PM = S5T_KQ + (size_t)64 * 256 * 384 * 2, S5T_END = S5T_PM + (size_t)64 * 128 * 256 * 2;
static_assert(B_Y2 + (size_t)MT * D * 4 <= BIG_BYTES, "ssd stage");
static_assert(B_PROJB + (size_t)MT * NBH * 2 <= BIG_BYTES, "hgrn stage");
static_assert(B_ACT + (size_t)MT * FF * 2 <= BIG_BYTES, "ffn stage");
static_assert(B_XP + (size_t)1024 * 8192 * 2 <= B_S5T && B_M1G + (size_t)MT * D * 4 <= BIG_BYTES && B_S5T + S5T_END <= BIG_BYTES && B_S5T >= B_M1 + (size_t)MT * D * 4, "s5 stage");

#define GAS __attribute__((address_space(1)))
#define LAS __attribute__((address_space(3)))
typedef unsigned short bf16;
typedef unsigned v4u __attribute__((ext_vector_type(4)));
typedef unsigned v2u __attribute__((ext_vector_type(2)));
typedef float f32x4 __attribute__((ext_vector_type(4)));
typedef float f32x16 __attribute__((ext_vector_type(16)));
typedef short bf16x8 __attribute__((ext_vector_type(8)));
typedef GAS unsigned gu32;
#define RLX_AGENT __ATOMIC_RELAXED, __HIP_MEMORY_SCOPE_AGENT
#define LDS_WAIT() asm volatile("s_waitcnt lgkmcnt(0)" ::: "memory")
#define VM_WAIT() asm volatile("s_waitcnt vmcnt(0)" ::: "memory")
__device__ __forceinline__ unsigned f2bf(float f) { unsigned u = __builtin_bit_cast(unsigned, f); return (u + 0x7fffu + ((u >> 16) & 1u)) >> 16; }
__device__ __forceinline__ unsigned pk2(float lo, float hi) { return f2bf(lo) | (f2bf(hi) << 16); }
__device__ __forceinline__ float bf2f(unsigned short b) { return __builtin_bit_cast(float, (unsigned)b << 16); }
__device__ __forceinline__ float bflo(unsigned w) { return __builtin_bit_cast(float, w << 16); }
__device__ __forceinline__ float bfhi(unsigned w) { return __builtin_bit_cast(float, w & 0xffff0000u); }
__device__ __forceinline__ float sigmoidf_(float x) { return __builtin_amdgcn_rcpf(1.0f + __expf(-x)); }
__device__ __forceinline__ float siluf_(float x) { return x * __builtin_amdgcn_rcpf(1.0f + __expf(-x)); }
__device__ __forceinline__ float softplusf_(float x) { return x > 20.f ? x : log1pf(__expf(x)); }
__device__ __forceinline__ float gelu_tanh(float x) { const float u = 0.7978845608028654f * (x + 0.044715f * x * x * x); const float e = __expf(2.f * u); const float th = 1.f - 2.f / (e + 1.f); return 0.5f * x * (1.f + th); }

#define XB_TMO      128
#define XB_XCNT(j)  (256  + 64 * (j))
#define XB_XSUB(j)  (1280 + 64 * (j))
#define XB_XGEN(j)  (2304 + 64 * (j))
#define XB_TOP      3328
#define XB_TOPGEN   3392
#define XCD_BAR_WORDS 3456
#define XB_SPIN_CAP (1u << 18)
__device__ __forceinline__ unsigned xb_ld(unsigned* p)              { return __hip_atomic_load(p, __ATOMIC_RELAXED, __HIP_MEMORY_SCOPE_AGENT); }
__device__ __forceinline__ unsigned xb_add(unsigned* p, unsigned v) { return __hip_atomic_fetch_add(p, v, __ATOMIC_RELAXED, __HIP_MEMORY_SCOPE_AGENT); }
__device__ __forceinline__ unsigned xb_xcc_id() { return (unsigned)__builtin_amdgcn_s_getreg((3 << 11) | 20) & 0xFu; }
#define XB_SPIN(cond, bar) do { unsigned _sp = 0; while (cond) { __builtin_amdgcn_s_sleep(1); \
    if ((++_sp & 255u) == 0u) { if (xb_ld(&(bar)[XB_TMO])) break; if (_sp > XB_SPIN_CAP) { atomicAdd(&(bar)[XB_TMO], 1u); break; } } } } while (0)
struct XcdBarrier { unsigned* bar; unsigned x; volatile LAS unsigned* st; };
__device__ __forceinline__ XcdBarrier xcd_barrier_post(unsigned* bar, volatile LAS unsigned* st) {
    XcdBarrier b; b.bar = bar; b.x = xb_xcc_id(); b.st = st;
    if (threadIdx.x == 0) (void)xb_add(&bar[XB_XCNT(b.x)], 1u);
    return b;
}
__device__ __forceinline__ void xcd_barrier_complete(unsigned* bar, unsigned x, unsigned& nloc, unsigned& nx) {
    const unsigned G = gridDim.x * gridDim.y * gridDim.z;
    unsigned sum, cnt, mine, sp = 0u;
    for (;;) {
        sum = 0u; cnt = 0u; mine = 0u;
#pragma unroll
        for (unsigned j = 0; j < 16; ++j) { const unsigned c = xb_ld(&bar[XB_XCNT(j)]); sum += c; cnt += (c > 0u) ? 1u : 0u; mine = (j == x) ? c : mine; }
        if (sum == G) break;
        __builtin_amdgcn_s_sleep(1);
        if ((++sp & 255u) == 0u) { if (xb_ld(&bar[XB_TMO])) break; if (sp > XB_SPIN_CAP) { atomicAdd(&bar[XB_TMO], 1u); break; } }
    }
    nloc = mine > 0u ? mine : 1u; nx = cnt > 0u ? cnt : 1u;
}
__device__ __forceinline__ void xcd_barrier(const XcdBarrier& b) {
    asm volatile("s_waitcnt vmcnt(0)" ::: "memory");
    __syncthreads();
    if (threadIdx.x == 0) {
        unsigned* bar = b.bar;
        __builtin_amdgcn_s_waitcnt(0);
        unsigned nloc = b.st[0], nx = b.st[1];
        if (nloc == 0u) { xcd_barrier_complete(bar, b.x, nloc, nx); b.st[0] = nloc; b.st[1] = nx; }
        const unsigned old = xb_add(&bar[XB_XSUB(b.x)], 1u);
        const unsigned gen = old / nloc;
        if (old + 1u == (gen + 1u) * nloc) {
            __builtin_amdgcn_fence(__ATOMIC_RELEASE, "agent");
            asm volatile("s_waitcnt vmcnt(0)" ::: "memory");
            const unsigned og = xb_add(&bar[XB_TOP], 1u);
            const unsigned tg = og / nx;
            if (og + 1u == (tg + 1u) * nx) xb_add(&bar[XB_TOPGEN], 1u);
            else XB_SPIN(xb_ld(&bar[XB_TOPGEN]) == tg, bar);
            __builtin_amdgcn_fence(__ATOMIC_ACQUIRE, "agent");
            xb_add(&bar[XB_XGEN(b.x)], 1u);
            asm volatile("s_waitcnt vmcnt(0)" ::: "memory");
        } else {
            XB_SPIN(xb_ld(&bar[XB_XGEN(b.x)]) == gen, bar);
            __builtin_amdgcn_fence(__ATOMIC_ACQUIRE, "agent");
            asm volatile("s_waitcnt vmcnt(0)" ::: "memory");
        }
    }
    __syncthreads();
}

constexpr int RING_BYTES = 131072;
constexpr int LDSCTL_OFF = RING_BYTES, MISC_OFF = LDSCTL_OFF + 320, HALO_OFF = RING_BYTES + 1024;
constexpr int LDS_BYTES = 147456;

struct Args { const float* in[35]; float* out; unsigned char* ws; int ph_lo, ph_hi, li, pad; };
static_assert(sizeof(Args) == 35 * 8 + 8 + 8 + 16, "Args has no padding");
#define CAS __attribute__((address_space(4)))
struct Frame {
    LAS unsigned char* lds;
    int tid, lane, wave, vcu, G;
    const CAS Args* a;
    float* out;
    unsigned char* ws;
};

enum { I_XP = 0, I_XS, I_SSSM, I_SSCONV, I_SHG, I_SS5R, I_SS5I, I_SFC, I_NMPRE, I_NMPOST, I_NFPRE, I_NFPOST, I_WIN, I_CONVW, I_CONVB, I_DTB, I_ALOG, I_SSMD, I_SSMNW,
       I_HGLB, I_HGNW, I_WOUT, I_LAMRE, I_LAMIM, I_LOGSTEP, I_BRE, I_BIM, I_CRE, I_CIM, I_S5D, I_WGLU, I_WUP, I_FCW, I_FCB, I_WDN, N_IN };

#define GW_ID(F) ((F).vcu * NWAVES + (F).wave)
#define GW_N(F) ((F).G * NWAVES)

__device__ __forceinline__ void p0_transpose_item(const float* W, int ldw, int K, int scol0, bf16* WT, int drow0, int kb, LAS float* scr, int lane) {
    const int k0 = 64 * kb;
    f32x4 v[8];
#pragma unroll
    for (int i = 0; i < 8; ++i) v[i] = *(const GAS f32x4*)(W + (size_t)(k0 + (lane >> 3) + 8 * i) * ldw + scol0 + 4 * (lane & 7));
#pragma unroll
    for (int i = 0; i < 8; ++i) { LAS float* d = scr + ((lane >> 3) + 8 * i) * 33 + 4 * (lane & 7); d[0] = v[i].x; d[1] = v[i].y; d[2] = v[i].z; d[3] = v[i].w; }
    LDS_WAIT(); asm volatile("" ::: "memory");
    const int c = lane & 7;
#pragma unroll
    for (int j = 0; j < 4; ++j) { const int n = (lane >> 3) + 8 * j; const LAS float* s = scr + (8 * c) * 33 + n;
        v4u o; o.x = pk2(s[0 * 33], s[1 * 33]); o.y = pk2(s[2 * 33], s[3 * 33]); o.z = pk2(s[4 * 33], s[5 * 33]); o.w = pk2(s[6 * 33], s[7 * 33]);
        *(GAS v4u*)(WT + (size_t)(drow0 + n) * K + k0 + 8 * c) = o; }
    LDS_WAIT(); asm volatile("" ::: "memory");
}
__device__ __forceinline__ void rms_row_to_bf16(const float* xrow, const float* w, bf16* orow, int lane) {
    const GAS f32x4* xr = (const GAS f32x4*)xrow + lane; const GAS f32x4* wr = (const GAS f32x4*)w + lane;
    f32x4 v[4]; float s = 0.f;
#pragma unroll
    for (int j = 0; j < 4; ++j) { v[j] = xr[64 * j]; s += (v[j].x * v[j].x + v[j].y * v[j].y) + (v[j].z * v[j].z + v[j].w * v[j].w); }
    const float rs = rsqrtf(wave_sum(s) * (1.f / D) + EPS);
    GAS v2u* o8 = (GAS v2u*)orow + lane;
#pragma unroll
    for (int j = 0; j < 4; ++j) { const f32x4 ww = wr[64 * j]; v2u o; o.x = pk2(v[j].x * rs * ww.x, v[j].y * rs * ww.y); o.y = pk2(v[j].z * rs * ww.z, v[j].w * rs * ww.w); o8[64 * j] = o; }
}
__device__ __forceinline__ const float* x_in_row(const Frame& F, int r) { return r < MP ? F.a->in[I_XP] + (size_t)r * D : F.a->in[I_XS] + (size_t)(r - MP) * D; }
__device__ __forceinline__ float* x_res_row(const Frame& F, int r) { return r < MP ? F.out + O_YP + (size_t)r * D : F.out + O_YS + (size_t)(r - MP) * D; }

__device__ __forceinline__ void wconv_items(Frame& F, int it_lo, int it_hi, int gw, int NGW) {
    LAS float* scr = (LAS float*)(F.lds + F.wave * 16384);
    bf16* WIN = (bf16*)(F.ws + WS_WIN); bf16* WOUT = (bf16*)(F.ws + WS_WOUT); bf16* WGLU = (bf16*)(F.ws + WS_WGLU); bf16* WUP = (bf16*)(F.ws + WS_WUP); bf16* WDN = (bf16*)(F.ws + WS_WDN);
    constexpr int I_IN = 16 * 200, I_OUT = 32 * 32, I_GLU = 16 * 64, I_UP = 16 * 176, I_DN = 44 * 32;
    constexpr int NITEMS = I_IN + I_OUT + I_GLU + 2 * I_UP + 2 * I_DN;
    (void)NITEMS;
    for (int it = it_lo + gw; it < it_hi; it += NGW) {
        int r = it;
        if (r < I_IN) { const int kb = r / 200, nb = r % 200;
            const int sc = nb < 72 ? 32 * nb : 2320 + 32 * (nb - 72);
            const int dr = nb < 72 ? 32 * nb : NA + 32 * (nb - 72);
            p0_transpose_item(F.a->in[I_WIN], ABIN, D, sc, WIN, dr, kb, scr, F.lane); continue; }
        r -= I_IN;
        if (r < I_OUT) { p0_transpose_item(F.a->in[I_WOUT], D, 2048, 32 * (r % 32), WOUT, 32 * (r % 32), r / 32, scr, F.lane); continue; }
        r -= I_OUT;
        if (r < I_GLU) { const int kb = r / 64, nb = r % 64, d = 32 * nb, j = d >> 8, bj = (d >> 7) & 1, c = d & 127;
            p0_transpose_item(F.a->in[I_WGLU], 2048, D, 1024 * bj + 128 * j + c, WGLU, d, kb, scr, F.lane); continue; }
        r -= I_GLU;
        if (r < 2 * I_UP) { const int l = r / I_UP; r -= l * I_UP; const int kb = r / 176, nb = r % 176, d = 32 * nb, j = d >> 8, bj = (d >> 7) & 1, c = d & 127;
            p0_transpose_item(F.a->in[I_WUP] + (size_t)l * D * FF2, FF2, D, FF * bj + 128 * j + c, WUP + (size_t)l * FF2 * D, d, kb, scr, F.lane); continue; }
        r -= 2 * I_UP;
        { const int l = r / I_DN; r -= l * I_DN; p0_transpose_item(F.a->in[I_WDN] + (size_t)l * FF * D, D, FF, 32 * (r % 32), WDN + (size_t)l * D * FF, 32 * (r % 32), r / 32, scr, F.lane); }
    }
}
constexpr int WC_EARLY = 16 * 200 + 32 * 32, WC_ALL = 16 * 200 + 32 * 32 + 16 * 64 + 2 * 16 * 176 + 2 * 44 * 32;
__device__ __forceinline__ void p0_prologue(Frame& F) {
    const int gw = GW_ID(F), NGW = GW_N(F);
    bf16* WIN = (bf16*)(F.ws + WS_WIN);
    wconv_items(F, 0, F.G > 128 ? WC_EARLY : WC_ALL, gw, NGW);
    { const int gt = (F.vcu * NTHR + F.tid), NT = F.G * NTHR;
      for (int i = gt; i < 16 * D; i += NT) { const int n = i >> 10, k = i & 1023; WIN[(size_t)(2304 + n) * D + k] = (bf16)f2bf(F.a->in[I_WIN][(size_t)k * ABIN + 2304 + n]); }
      unsigned z_ = 0u; asm volatile("" : "+v"(z_));
      for (int i = gt; i < 240 * D / 8; i += NT) ((GAS v4u*)(WIN + (size_t)2320 * D))[i] = (v4u){z_, z_, z_, z_}; }
    bf16* XN = (bf16*)(F.ws + WS_XN);
    { const int lane = F.lane; f32x4 nx[4];
      if (gw < MT) {
#pragma unroll
          for (int j = 0; j < 4; ++j) nx[j] = ((const GAS f32x4*)x_in_row(F, gw) + lane)[64 * j]; }
      for (int m = gw; m < MT; m += NGW) { f32x4 v[4]; float s = 0.f;
#pragma unroll
          for (int j = 0; j < 4; ++j) { v[j] = nx[j]; s += (v[j].x * v[j].x + v[j].y * v[j].y) + (v[j].z * v[j].z + v[j].w * v[j].w); }
          if (m + NGW < MT) {
#pragma unroll
              for (int j = 0; j < 4; ++j) nx[j] = ((const GAS f32x4*)x_in_row(F, m + NGW) + lane)[64 * j]; }
          const float rs = rsqrtf(wave_sum(s) * (1.f / D) + EPS); GAS v2u* o8 = (GAS v2u*)(XN + (size_t)m * D) + lane;
#pragma unroll
          for (int j = 0; j < 4; ++j) { const f32x4 ww = ((const GAS f32x4*)F.a->in[I_NMPRE] + lane)[64 * j]; v2u o; o.x = pk2(v[j].x * rs * ww.x, v[j].y * rs * ww.y); o.y = pk2(v[j].z * rs * ww.z, v[j].w * rs * ww.w); o8[64 * j] = o; } } }
}

template <int NT, bool GLU, class Epi>
__device__ __forceinline__ void skinny_gemm(Frame& F, const bf16* A, int lda, const bf16* Bt, int K, int ncb, const Epi& epi, int tb, int tstride) {
    LAS float* red = (LAS float*)F.lds;
    const int lane = F.lane, r = lane & 31, h = lane >> 5, w = F.wave;
    const int kper = K >> 3, kbeg = w * kper;
    const int ntask = 4 * ncb;
    if (tb < 0) return;
    for (int task = tb; task < ntask; task += tstride) {
        const int rt = task & 3, ct = task >> 2;
        const int brow = GLU ? (256 * (ct >> 2) + 32 * (ct & 3)) : 32 * ct;
        const bf16* ap = A + (size_t)(rt * 32 + r) * lda + kbeg + 8 * h;
        const bf16* bp = Bt + (size_t)(brow + r) * K + kbeg + 8 * h;
        f32x16 acc[NT];
#pragma unroll
        for (int nt = 0; nt < NT; ++nt)
#pragma unroll
            for (int i = 0; i < 16; ++i) acc[nt][i] = 0.f;
#pragma unroll 8
        for (int k = 0; k < kper; k += 16) {
            const bf16x8 a = *(const bf16x8*)(ap + k);
#pragma unroll
            for (int nt = 0; nt < NT; ++nt) { const bf16x8 b = *(const bf16x8*)(bp + (size_t)nt * 128 * K + k); acc[nt] = __builtin_amdgcn_mfma_f32_32x32x16_bf16(a, b, acc[nt], 0, 0, 0); }
        }
#pragma unroll
        for (int nt = 0; nt < NT; ++nt)
#pragma unroll
            for (int i = 0; i < 16; ++i) red[((w * NT + nt) * 16 + i) * 64 + lane] = acc[nt][i];
        __syncthreads();
#pragma unroll
        for (int e0 = 0; e0 < 2; ++e0) { const int e = F.tid + 512 * e0, i = e >> 6, l = e & 63; float v[NT];
#pragma unroll
            for (int nt = 0; nt < NT; ++nt) { float s = 0.f;
#pragma unroll
                for (int ww = 0; ww < 8; ++ww) s += red[((ww * NT + nt) * 16 + i) * 64 + l];
                v[nt] = s; }
            epi(rt * 32 + (i & 3) + 8 * (i >> 2) + 4 * (l >> 5), ct * 32 + (l & 31), v); }
        __syncthreads();
    }
}
struct SkBf16 { bf16* O; int ld; __device__ __forceinline__ void operator()(int row, int col, const float (&v)[1]) const { O[(size_t)row * ld + col] = (bf16)f2bf(v[0]); } };
struct SkF32 { float* O; int ld; __device__ __forceinline__ void operator()(int row, int col, const float (&v)[1]) const { O[(size_t)row * ld + col] = v[0]; } };
struct SkGlu { bf16* O; int ld; __device__ __forceinline__ void operator()(int row, int col, const float (&v)[2]) const { O[(size_t)row * ld + col] = (bf16)f2bf(v[0] * sigmoidf_(v[1])); } };

constexpr size_t B_XR = al256((size_t)MT * D * 2);
__device__ __forceinline__ void resid_norm_rows(Frame& F, const bf16* msrc, const float* w_post, const float* w_pre, int mode) {
    const int gw = GW_ID(F), NGW = GW_N(F), lane = F.lane;
    bf16* XN = (bf16*)(F.ws + WS_XN); bf16* XR = (bf16*)(F.ws + WS_BIG + B_XR);
    v2u pm[4]; f32x4 pxf[4]; v2u pxb[4];
#define RN_LOAD(r_) do { const GAS v2u* mr_ = (const GAS v2u*)(msrc + (size_t)(r_) * D) + lane; \
        _Pragma("unroll") for (int j = 0; j < 4; ++j) { pm[j] = mr_[64 * j]; if (mode == 0) pxf[j] = ((const GAS f32x4*)x_in_row(F, (r_)) + lane)[64 * j]; else pxb[j] = ((const GAS v2u*)(XR + (size_t)(r_) * D) + lane)[64 * j]; } } while (0)
    if (gw < MT) RN_LOAD(gw);
    for (int r = gw; r < MT; r += NGW) {
        f32x4 m[4], x[4]; float s = 0.f;
#pragma unroll
        for (int j = 0; j < 4; ++j) { const v2u mw = pm[j]; m[j] = (f32x4){bflo(mw.x), bfhi(mw.x), bflo(mw.y), bfhi(mw.y)};
            if (mode == 0) x[j] = pxf[j]; else { const v2u xw = pxb[j]; x[j] = (f32x4){bflo(xw.x), bfhi(xw.x), bflo(xw.y), bfhi(xw.y)}; }
            s += (m[j].x * m[j].x + m[j].y * m[j].y) + (m[j].z * m[j].z + m[j].w * m[j].w); }
        if (r + NGW < MT) RN_LOAD(r + NGW);
        const float rs = rsqrtf(wave_sum(s) * (1.f / D) + EPS); float s2 = 0.f;
#pragma unroll
        for (int j = 0; j < 4; ++j) { const f32x4 wp = ((const GAS f32x4*)w_post + lane)[64 * j]; x[j] = x[j] + m[j] * rs * wp;
            if (mode == 2) ((GAS f32x4*)x_res_row(F, r) + lane)[64 * j] = x[j];
            else { v2u o; o.x = pk2(x[j].x, x[j].y); o.y = pk2(x[j].z, x[j].w); ((GAS v2u*)(XR + (size_t)r * D) + lane)[64 * j] = o; }
            s2 += (x[j].x * x[j].x + x[j].y * x[j].y) + (x[j].z * x[j].z + x[j].w * x[j].w); }
        if (mode != 2) { const float rs2 = rsqrtf(wave_sum(s2) * (1.f / D) + EPS); GAS v2u* o8 = (GAS v2u*)(XN + (size_t)r * D) + lane;
#pragma unroll
            for (int j = 0; j < 4; ++j) { const f32x4 ww = ((const GAS f32x4*)w_pre + lane)[64 * j]; v2u o; o.x = pk2(x[j].x * rs2 * ww.x, x[j].y * rs2 * ww.y); o.y = pk2(x[j].z * rs2 * ww.z, x[j].w * rs2 * ww.w); o8[64 * j] = o; } }
    }
#undef RN_LOAD
}
__device__ __forceinline__ bf16* mixed_row(const Frame& F, int r) { return r < MP ? (bf16*)(F.out + O_YP) + (size_t)r * 2048 : (bf16*)(F.ws + WS_MIXS) + (size_t)(r - MP) * 2048; }
constexpr size_t B_HEAD = al256(B_ACT + (size_t)MT * FF * 2), B_TAIL = B_HEAD + (size_t)64 * 2 * FF2 * 4;
static_assert(B_TAIL + (size_t)64 * 2 * FF2 * 4 <= BIG_BYTES, "ffn side buffers");
__device__ __forceinline__ void ffn_fix_rows(Frame& F, int l, int pm) {
    const float* HEAD = (const float*)(F.ws + WS_BIG + B_HEAD); const float* TAIL = (const float*)(F.ws + WS_BIG + B_TAIL); bf16* ACT = (bf16*)(F.ws + WS_BIG + B_ACT);
    const float* cw = F.a->in[I_FCW] + (size_t)l * 3 * FF2; const float* cb = F.a->in[I_FCB] + (size_t)l * FF2;
    for (int c = F.tid; c < FF; c += NTHR) { float r0[2], r1[2];
#pragma unroll
        for (int x = 0; x < 2; ++x) { const int ch = x * FF + c; const float h0 = HEAD[((size_t)pm * 2) * FF2 + ch], h1 = HEAD[((size_t)pm * 2 + 1) * FF2 + ch];
            const float t0 = (pm & 7) ? TAIL[((size_t)(pm - 1) * 2) * FF2 + ch] : 0.f, t1 = (pm & 7) ? TAIL[((size_t)(pm - 1) * 2 + 1) * FF2 + ch] : 0.f;
            const float w0 = cw[ch], w1 = cw[FF2 + ch], w2 = cw[2 * FF2 + ch], bb = cb[ch];
            r0[x] = bb + w0 * t0 + w1 * t1 + w2 * h0; r1[x] = bb + w0 * t1 + w1 * h0 + w2 * h1; }
        ACT[(size_t)(256 * pm) * FF + c] = (bf16)f2bf(r0[0] * siluf_(r0[1])); ACT[(size_t)(256 * pm + 1) * FF + c] = (bf16)f2bf(r1[0] * siluf_(r1[1])); }
}
struct SkConvGate { bf16* ACTs; const float* cw; const float* cb; const float* st; float* sfc;
    __device__ __forceinline__ void operator()(int row, int col, const float (&v)[2]) const {
        const float* s0 = st + ((size_t)row * 2) * FF2; const float* s1 = s0 + FF2; float* p = sfc + (size_t)row * 2 * FF2; const int chv = col, chg = FF + col;
        const float v0 = s0[chv], v1 = s1[chv], g0 = s0[chg], g1 = s1[chg];
        const float vc = cb[chv] + cw[chv] * v0 + cw[FF2 + chv] * v1 + cw[2 * FF2 + chv] * v[0];
        const float gc = cb[chg] + cw[chg] * g0 + cw[FF2 + chg] * g1 + cw[2 * FF2 + chg] * v[1];
        ACTs[(size_t)row * FF + col] = (bf16)f2bf(vc * siluf_(gc)); p[chv] = v1; p[chg] = g1; p[FF2 + chv] = v[0]; p[FF2 + chg] = v[1]; } };

constexpr size_t B_HB = al256(B_PROJA + (size_t)MT * NA * 2);
static_assert(B_HB + (size_t)8 * 64 * 16 * 4096 * 2 <= BIG_BYTES, "ssd state buffer");
typedef float f32x2_t __attribute__((ext_vector_type(2)));

__device__ __forceinline__ void ssd_conv4(const Frame& F, const bf16* PA, int b, int t, int ch0, float (&out)[8][4]) {
    const float* cw = F.a->in[I_CONVW] + ch0; const float* cbias = F.a->in[I_CONVB] + ch0;
    float raw[7][8];
#pragma unroll
    for (int rr = 0; rr < 7; ++rr) { const int tt = t - 3 + rr;
        if (tt >= 0) { const v4u q = *(const GAS v4u*)(PA + (size_t)(b * SEQ + tt) * NA + 1024 + ch0);
            raw[rr][0] = bflo(q.x); raw[rr][1] = bfhi(q.x); raw[rr][2] = bflo(q.y); raw[rr][3] = bfhi(q.y); raw[rr][4] = bflo(q.z); raw[rr][5] = bfhi(q.z); raw[rr][6] = bflo(q.w); raw[rr][7] = bfhi(q.w); }
        else {
#pragma unroll
            for (int e = 0; e < 8; ++e) raw[rr][e] = 0.f; } }
    float w[4][8], bs[8];
#pragma unroll
    for (int k = 0; k < 4; ++k) { const f32x4 a = *(const GAS f32x4*)(cw + k * XBC), c = *(const GAS f32x4*)(cw + k * XBC + 4);
        w[k][0] = a.x; w[k][1] = a.y; w[k][2] = a.z; w[k][3] = a.w; w[k][4] = c.x; w[k][5] = c.y; w[k][6] = c.z; w[k][7] = c.w; }
    { const f32x4 a = *(const GAS f32x4*)cbias, c = *(const GAS f32x4*)(cbias + 4); bs[0] = a.x; bs[1] = a.y; bs[2] = a.z; bs[3] = a.w; bs[4] = c.x; bs[5] = c.y; bs[6] = c.z; bs[7] = c.w; }
#pragma unroll
    for (int e = 0; e < 8; ++e)
#pragma unroll
        for (int j = 0; j < 4; ++j) { float v = bs[e];
#pragma unroll
            for (int k = 0; k < 4; ++k) v += w[k][e] * raw[j + k][e];
            out[e][j] = siluf_(v); }
}

__device__ __forceinline__ void ssd_state_item(Frame& F, int b, int h) {
    const bf16* PA = (const bf16*)(F.ws + WS_BIG + B_PROJA); bf16* HB = (bf16*)(F.ws + WS_BIG + B_HB);
    constexpr int TP = 80, TBUF = 128 * TP;
    LAS unsigned char* T0 = F.lds; LAS float* WG = (LAS float*)(F.lds + 2 * TBUF); LAS float* DEC = WG + SEQ;
    int tid = F.tid; asm volatile("" : "+v"(tid));
    const int lane = tid & 63, wave = __builtin_amdgcn_readfirstlane(tid >> 6), g = h >> 3, r = lane & 31, hh = lane >> 5;
    { const float A = -__expf(F.a->in[I_ALOG][h]), dtb = F.a->in[I_DTB][h];
      float dt[4], cum[4]; float run = 0.f;
#pragma unroll
      for (int j = 0; j < 4; ++j) { dt[j] = softplusf_(bf2f(PA[(size_t)(b * SEQ + 4 * tid + j) * NA + 2304 + h]) + dtb); run += dt[j] * A; cum[j] = run; }
      float incl = run;
      const int ln_ = lane_op_();
#pragma unroll
      for (int off = 1; off < 8; off <<= 1) { const float v = shup_(incl, off, 8, ln_); if ((tid & 7) >= off) incl += v; }
      const float excl = incl - run, last = shidx_(incl, 7, 8, ln_);
#pragma unroll
      for (int j = 0; j < 4; ++j) WG[4 * tid + j] = dt[j] * __expf(last - (excl + cum[j]));
      if ((tid & 7) == 0) DEC[tid >> 3] = __expf(last); }
    __syncthreads();
    if (wave < 4) {
        const int o = tid >> 4, tp = tid & 15, ch0 = o < 8 ? h * 64 + 8 * o : 1024 + g * 64 + 8 * (o - 8);
        float w[4][8], bs[8];
        { const float* cw = F.a->in[I_CONVW] + ch0; const float* cbias = F.a->in[I_CONVB] + ch0;
#pragma unroll
          for (int k = 0; k < 4; ++k) { const f32x4 a = *(const GAS f32x4*)(cw + k * XBC), c4 = *(const GAS f32x4*)(cw + k * XBC + 4);
              w[k][0] = a.x; w[k][1] = a.y; w[k][2] = a.z; w[k][3] = a.w; w[k][4] = c4.x; w[k][5] = c4.y; w[k][6] = c4.z; w[k][7] = c4.w; }
          const f32x4 a = *(const GAS f32x4*)cbias, c4 = *(const GAS f32x4*)(cbias + 4); bs[0] = a.x; bs[1] = a.y; bs[2] = a.z; bs[3] = a.w; bs[4] = c4.x; bs[5] = c4.y; bs[6] = c4.z; bs[7] = c4.w; }
        const bf16* xrow = PA + (size_t)(b * SEQ + 2 * tp) * NA + 1024 + ch0;
        v4u pre[5];
#pragma unroll
        for (int k = 0; k < 5; ++k) { const int rr = 2 * tp - 3 + k < 0 ? 0 : 2 * tp - 3 + k; pre[k] = *(const GAS v4u*)(xrow + (ptrdiff_t)(rr - 2 * tp) * NA); }
        for (int c = 0; c < 64; ++c) {
            LAS unsigned char* T = T0 + (c & 1) * TBUF;
            v4u cur[5];
#pragma unroll
            for (int k = 0; k < 5; ++k) cur[k] = pre[k];
            if (c + 1 < 64) { const bf16* xn = xrow + (size_t)(32 * (c + 1)) * NA;
#pragma unroll
                for (int k = 0; k < 5; ++k) pre[k] = *(const GAS v4u*)(xn + (ptrdiff_t)(k - 3) * NA); }
            const f32x2_t wq = *(const LAS f32x2_t*)(WG + 32 * c + 2 * tp);
            const float w0 = o < 8 ? wq.x : 1.0f, w1 = o < 8 ? wq.y : 1.0f;
            float x8[5][8];
#pragma unroll
            for (int k = 0; k < 5; ++k) { const v4u qv = cur[k]; const float mk = (c == 0 && 2 * tp - 3 + k < 0) ? 0.f : 1.f;
                x8[k][0] = bflo(qv.x) * mk; x8[k][1] = bfhi(qv.x) * mk; x8[k][2] = bflo(qv.y) * mk; x8[k][3] = bfhi(qv.y) * mk; x8[k][4] = bflo(qv.z) * mk; x8[k][5] = bfhi(qv.z) * mk; x8[k][6] = bflo(qv.w) * mk; x8[k][7] = bfhi(qv.w) * mk; }
#pragma unroll
            for (int e = 0; e < 8; ++e) { float v0 = bs[e], v1 = bs[e];
#pragma unroll
                for (int k = 0; k < 4; ++k) { v0 += w[k][e] * x8[k][e]; v1 += w[k][e] * x8[k + 1][e]; }
                *(LAS unsigned*)(T + (8 * o + e) * TP + 4 * tp) = pk2(siluf_(v0) * w0, siluf_(v1) * w1); }
            asm volatile("s_waitcnt lgkmcnt(0)" ::: "memory"); __builtin_amdgcn_s_barrier(); asm volatile("" ::: "memory");
        }
    } else {
        f32x16 acc;
#pragma unroll
        for (int i = 0; i < 16; ++i) acc[i] = 0.f;
        const int q = wave - 4, pt = q >> 1, nt = q & 1;
        for (int c = 0; c < 64; ++c) {
            LAS unsigned char* T = T0 + (c & 1) * TBUF;
            bf16* hb = HB + ((((size_t)b * 64 + c) * 16 + h) * 64 + pt * 32) * 64 + nt * 32 + r;
#pragma unroll
            for (int i = 0; i < 16; ++i) hb[(size_t)((i & 3) + 8 * (i >> 2) + 4 * hh) * 64] = (bf16)f2bf(acc[i]);
            const float dec = DEC[c];
#pragma unroll
            for (int i = 0; i < 16; ++i) acc[i] *= dec;
            asm volatile("s_waitcnt lgkmcnt(0)" ::: "memory"); __builtin_amdgcn_s_barrier(); asm volatile("" ::: "memory");
#pragma unroll
            for (int ks = 0; ks < 2; ++ks) { const bf16x8 a = *(const LAS bf16x8*)(T + (pt * 32 + r) * TP + 32 * ks + 16 * hh), bb = *(const LAS bf16x8*)(T + (64 + nt * 32 + r) * TP + 32 * ks + 16 * hh);
                acc = __builtin_amdgcn_mfma_f32_32x32x16_bf16(a, bb, acc, 0, 0, 0); }
        }
        float* ps = F.out + O_PSSM + ((size_t)(b * 16 + h) * 64 + pt * 32) * 64 + nt * 32 + r;
#pragma unroll
        for (int i = 0; i < 16; ++i) ps[(size_t)((i & 3) + 8 * (i >> 2) + 4 * hh) * 64] = acc[i];
    }
    { float* pc = F.out + O_PSCONV + (size_t)b * 3 * XBC;
      for (int e = tid; e < 3 * 192; e += NTHR) { const int k = e / 192, cc = e % 192; if (cc >= 64 && (h & 7) != 0) continue;
          const int ch = cc < 64 ? h * 64 + cc : (cc < 128 ? 1024 + g * 64 + (cc - 64) : 1152 + g * 64 + (cc - 128));
          pc[k * XBC + ch] = bf2f(PA[(size_t)(b * SEQ + SEQ - 3 + k) * NA + 1024 + ch]); } }
    __syncthreads();
}

__device__ __forceinline__ void ssd_sample_item(Frame& F, int j) {
    const bf16* PA = (const bf16*)(F.ws + WS_BIG + B_PROJA) + (size_t)(MP + j) * NA; bf16* MX = (bf16*)(F.ws + WS_MIXS) + (size_t)j * 2048;
    LAS float* act = (LAS float*)F.lds;
    LAS float* dts = act + XBC;
    LAS float* y2 = dts + 32;
    LAS float* red = y2 + 1024;
    const int tid = F.tid;
    const float* cw = F.a->in[I_CONVW]; const float* cbias = F.a->in[I_CONVB]; const float* st = F.a->in[I_SSCONV] + (size_t)j * 3 * XBC; float* so = F.out + O_SSCONV + (size_t)j * 3 * XBC;
    for (int ch = tid; ch < XBC; ch += NTHR) { const float nw = bf2f(PA[1024 + ch]); const float s0 = st[ch], s1 = st[XBC + ch], s2 = st[2 * XBC + ch];
        act[ch] = siluf_(cbias[ch] + cw[ch] * s0 + cw[XBC + ch] * s1 + cw[2 * XBC + ch] * s2 + cw[3 * XBC + ch] * nw);
        so[ch] = s1; so[XBC + ch] = s2; so[2 * XBC + ch] = nw; }
    if (tid < 16) { const float d = softplusf_(bf2f(PA[2304 + tid]) + F.a->in[I_DTB][tid]); dts[tid] = d; dts[16 + tid] = __expf(-__expf(F.a->in[I_ALOG][tid]) * d); }
    __syncthreads();
    const float* S0 = F.a->in[I_SSSM] + (size_t)j * 65536; float* S1 = F.out + O_SSSM + (size_t)j * 65536;
    float ssq = 0.f;
#pragma unroll 1
    for (int it8 = 0; it8 < 4; ++it8) { f32x4 sv[8];
#pragma unroll
      for (int u = 0; u < 8; ++u) sv[u] = *(const GAS f32x4*)(S0 + (size_t)((it8 * 8 + u) * NTHR + tid) * 4);
#pragma unroll
      for (int u = 0; u < 8; ++u) { const int it = it8 * 8 + u; const int v = it * NTHR + tid, n4 = v & 15, p = (v >> 4) & 63, h = v >> 10, g = h >> 3;
        const f32x4 s = sv[u];
        const f32x4 bb = *(const LAS f32x4*)(act + 1024 + g * 64 + 4 * n4), cc = *(const LAS f32x4*)(act + 1152 + g * 64 + 4 * n4);
        const float x = act[h * 64 + p], dtx = dts[h] * x, dec = dts[16 + h];
        f32x4 nn; float a = 0.f;
#pragma unroll
        for (int i = 0; i < 4; ++i) { nn[i] = dec * s[i] + dtx * bb[i]; a += nn[i] * cc[i]; }
        *(GAS f32x4*)(S1 + (size_t)v * 4) = nn;
        a = row16_sum(a);
        if (n4 == 0) { const float yy = (a + F.a->in[I_SSMD][h] * x) * siluf_(bf2f(PA[h * 64 + p])); y2[h * 64 + p] = yy; ssq += yy * yy; } } }
    ssq = wave_sum(ssq); if (F.lane == 0) red[F.wave] = ssq;
    __syncthreads();
    float tot = 0.f;
#pragma unroll
    for (int w = 0; w < 8; ++w) tot += red[w];
    const float rs = rsqrtf(tot * (1.f / D) + EPS);
    for (int c = tid; c < 1024; c += NTHR) MX[c] = (bf16)f2bf(y2[c] * rs * F.a->in[I_SSMNW][c]);
    __syncthreads();
}
__device__ __forceinline__ void ssd_state_phase(Frame& F) {
    for (int it = F.vcu; it < 128 + MS; it += F.G) { if (it < 128) ssd_state_item(F, it >> 4, it & 15); else ssd_sample_item(F, it - 128); }
    if (F.G > 128 && F.vcu >= 128) { __syncthreads(); wconv_items(F, WC_EARLY, WC_ALL, (F.vcu - 128) * NWAVES + F.wave, (F.G - 128) * NWAVES); }
}

__device__ __forceinline__ void ssd_rows7(const bf16* PA, int b, int t, int ch0, v4u (&rw)[7]) {
#pragma unroll
    for (int rr = 0; rr < 7; ++rr) { const int tt = t - 3 + rr < 0 ? 0 : t - 3 + rr; rw[rr] = *(const GAS v4u*)(PA + (size_t)(b * SEQ + tt) * NA + 1024 + ch0); }
}
__device__ __forceinline__ void ssd_conv4_lds(const v4u (&rw)[7], const LAS float* CWL, int t, int ch0, float (&out)[8][4]) {
    float raw[7][8];
#pragma unroll
    for (int rr = 0; rr < 7; ++rr) { const v4u q = rw[rr]; const float mk = (t - 3 + rr >= 0) ? 1.f : 0.f;
        raw[rr][0] = bflo(q.x) * mk; raw[rr][1] = bfhi(q.x) * mk; raw[rr][2] = bflo(q.y) * mk; raw[rr][3] = bfhi(q.y) * mk; raw[rr][4] = bflo(q.z) * mk; raw[rr][5] = bfhi(q.z) * mk; raw[rr][6] = bflo(q.w) * mk; raw[rr][7] = bfhi(q.w) * mk; }
    float w[4][8], bs[8];
#pragma unroll
    for (int k = 0; k < 5; ++k) { const f32x4 a = *(const LAS f32x4*)(CWL + k * XBC + ch0), c = *(const LAS f32x4*)(CWL + k * XBC + ch0 + 4);
        if (k < 4) { w[k < 4 ? k : 0][0] = a.x; w[k < 4 ? k : 0][1] = a.y; w[k < 4 ? k : 0][2] = a.z; w[k < 4 ? k : 0][3] = a.w; w[k < 4 ? k : 0][4] = c.x; w[k < 4 ? k : 0][5] = c.y; w[k < 4 ? k : 0][6] = c.z; w[k < 4 ? k : 0][7] = c.w; }
        else { bs[0] = a.x; bs[1] = a.y; bs[2] = a.z; bs[3] = a.w; bs[4] = c.x; bs[5] = c.y; bs[6] = c.z; bs[7] = c.w; } }
#pragma unroll
    for (int e = 0; e < 8; ++e)
#pragma unroll
        for (int j = 0; j < 4; ++j) { float v = bs[e];
#pragma unroll
            for (int k = 0; k < 4; ++k) v += w[k][e] * raw[j + k][e];
            out[e][j] = siluf_(v); }
}
constexpr int SSDO_CWL = 16 * 64 * 80 + 2 * (2 * 32 * 144) + (512 + 512 + 256) * 4;
static_assert(SSDO_CWL + 5 * XBC * 4 <= RING_BYTES, "ssd_out LDS map");
__device__ __forceinline__ void ssd_out_item(Frame& F, int b, int c) {
    const bf16* PA = (const bf16*)(F.ws + WS_BIG + B_PROJA); const bf16* HB = (const bf16*)(F.ws + WS_BIG + B_HB);
    constexpr int XP_ = 80, BP_ = 144;
    LAS unsigned char* XT = F.lds;
    LAS unsigned char* BS = XT + 16 * 64 * XP_;
    LAS unsigned char* CS = BS + 2 * 32 * BP_;
    LAS float* DT = (LAS float*)(CS + 2 * 32 * BP_);
    LAS float* CUM = DT + 512;
    LAS float* SSQ = CUM + 512;
    const LAS float* CWL = (const LAS float*)(F.lds + SSDO_CWL);
    int tid = F.tid; asm volatile("" : "+v"(tid));
    const int t0 = 32 * c;
    v4u zq[8];
#pragma unroll
    for (int q = 0; q < 8; ++q) zq[q] = *(const GAS v4u*)(PA + (size_t)(b * SEQ + t0 + (tid >> 7) + 4 * q) * NA + 8 * (tid & 127));
    v4u rwn[7]; ssd_rows7(PA, b, t0 + 4 * (tid & 7), 8 * (tid >> 3), rwn);
#pragma unroll 1
    for (int task = tid; task < 160 * 8; task += NTHR) { const int o = task >> 3, run = task & 7;
        v4u rwc[7];
#pragma unroll
        for (int rr = 0; rr < 7; ++rr) rwc[rr] = rwn[rr];
        if (task + NTHR < 160 * 8) ssd_rows7(PA, b, t0 + 4 * ((task + NTHR) & 7), 8 * ((task + NTHR) >> 3), rwn);
        float act[8][4]; ssd_conv4_lds(rwc, CWL, t0 + 4 * run, 8 * o, act);
        if (o < 128) { const int h = o >> 3, p0 = (o & 7) * 8;
#pragma unroll
            for (int e = 0; e < 8; ++e) { v2u pk; pk.x = pk2(act[e][0], act[e][1]); pk.y = pk2(act[e][2], act[e][3]); *(LAS v2u*)(XT + (h * 64 + p0 + e) * XP_ + 8 * run) = pk; } }
        else { const int oo = o - 128, isC = oo >> 4, g = (oo >> 3) & 1, n0 = (oo & 7) * 8; LAS unsigned char* dst = (isC ? CS : BS) + g * 32 * BP_;
#pragma unroll
            for (int jx = 0; jx < 4; ++jx) { v4u pk; pk.x = pk2(act[0][jx], act[1][jx]); pk.y = pk2(act[2][jx], act[3][jx]); pk.z = pk2(act[4][jx], act[5][jx]); pk.w = pk2(act[6][jx], act[7][jx]);
                *(LAS v4u*)(dst + (4 * run + jx) * BP_ + 2 * n0) = pk; } }
    }
    { const int h = tid >> 5, t = tid & 31;
      const float dt = softplusf_(bf2f(PA[(size_t)(b * SEQ + t0 + t) * NA + 2304 + h]) + F.a->in[I_DTB][h]);
      float cum = -__expf(F.a->in[I_ALOG][h]) * dt;
      const int ln_ = lane_op_();
#pragma unroll
      for (int off = 1; off < 32; off <<= 1) { const float v = shup_(cum, off, 32, ln_); if (t >= off) cum += v; }
      DT[tid] = dt; CUM[tid] = cum; }
    __syncthreads();
    asm volatile("" : "+v"(tid));
    const int lane = tid & 63, wave = __builtin_amdgcn_readfirstlane(tid >> 6), r = lane & 31, hh = lane >> 5;
    const int g = wave >> 2;
    f32x16 gt;
#pragma unroll
    for (int i = 0; i < 16; ++i) gt[i] = 0.f;
#pragma unroll
    for (int ks = 0; ks < 4; ++ks) { const bf16x8 a = *(const LAS bf16x8*)(BS + (g * 32 + r) * BP_ + 32 * ks + 16 * hh), bb = *(const LAS bf16x8*)(CS + (g * 32 + r) * BP_ + 32 * ks + 16 * hh);
        gt = __builtin_amdgcn_mfma_f32_32x32x16_bf16(a, bb, gt, 0, 0, 0); }
#pragma unroll 1
    for (int hi = 0; hi < 2; ++hi) { const int h = 2 * wave + hi;
        bf16x8 hbf[2][4];
        { const bf16* hb0 = HB + ((((size_t)b * 64 + c) * 16 + h) * 64 + r) * 64 + 8 * hh;
#pragma unroll
          for (int pt = 0; pt < 2; ++pt)
#pragma unroll
              for (int ks = 0; ks < 4; ++ks) hbf[pt][ks] = *(const GAS bf16x8*)(hb0 + (size_t)pt * 32 * 64 + 16 * ks); }
        const float cum_t = CUM[h * 32 + r];
        bf16x8 am[2];
#pragma unroll
        for (int ks = 0; ks < 2; ++ks) { unsigned mf[4];
#pragma unroll
            for (int i2 = 0; i2 < 4; ++i2) { float m2[2];
#pragma unroll
                for (int q = 0; q < 2; ++q) { const int i = 8 * ks + 2 * i2 + q, s = (i & 3) + 8 * (i >> 2) + 4 * hh;
                    const float e_ = gt[i] * __expf(fminf(cum_t - CUM[h * 32 + s], 0.f)) * DT[h * 32 + s]; m2[q] = s <= r ? e_ : 0.f; }
                mf[i2] = pk2(m2[0], m2[1]); }
            v4u t4; t4.x = mf[0]; t4.y = mf[1]; t4.z = mf[2]; t4.w = mf[3]; am[ks] = __builtin_bit_cast(bf16x8, t4); }
        const float dsk = F.a->in[I_SSMD][h];
        f32x16 yv[2];
#pragma unroll
        for (int pt = 0; pt < 2; ++pt) {
            f32x16 yi;
#pragma unroll
            for (int i = 0; i < 16; ++i) { yv[pt][i] = 0.f; yi[i] = 0.f; }
            const LAS unsigned char* xrow = XT + (h * 64 + pt * 32 + r) * XP_;
#pragma unroll
            for (int ks = 0; ks < 2; ++ks) { const v2u lo = *(const LAS v2u*)(xrow + 2 * (16 * ks + 4 * hh)), hi2 = *(const LAS v2u*)(xrow + 2 * (16 * ks + 8 + 4 * hh));
                v4u t4; t4.x = lo.x; t4.y = lo.y; t4.z = hi2.x; t4.w = hi2.y;
                yv[pt] = __builtin_amdgcn_mfma_f32_32x32x16_bf16(am[ks], __builtin_bit_cast(bf16x8, t4), yv[pt], 0, 0, 0); }
#pragma unroll
            for (int ks = 0; ks < 4; ++ks) { const bf16x8 a = *(const LAS bf16x8*)(CS + (g * 32 + r) * BP_ + 32 * ks + 16 * hh), bb = hbf[pt][ks];
                yi = __builtin_amdgcn_mfma_f32_32x32x16_bf16(a, bb, yi, 0, 0, 0); }
#pragma unroll
            for (int i4 = 0; i4 < 4; ++i4) { const int tb = 8 * i4 + 4 * hh; const v2u xv = *(const LAS v2u*)(xrow + 2 * tb);
                const float xs[4] = {bflo(xv.x), bfhi(xv.x), bflo(xv.y), bfhi(xv.y)};
#pragma unroll
                for (int q = 0; q < 4; ++q) { const int i = 4 * i4 + q, t = tb + q; yv[pt][i] = yv[pt][i] + __expf(CUM[h * 32 + t]) * yi[i] + dsk * xs[q]; } }
        }
        LAS unsigned char* yb = XT + h * 64 * XP_;
#pragma unroll
        for (int pt = 0; pt < 2; ++pt)
#pragma unroll
            for (int i = 0; i < 16; ++i) { const int t = (i & 3) + 8 * (i >> 2) + 4 * hh; *(LAS unsigned short*)(yb + t * 128 + 2 * (pt * 32 + r)) = (unsigned short)f2bf(yv[pt][i]); }
    }
    __syncthreads();
    { const int c8 = (tid & 127) * 8, h = c8 >> 6, pp = c8 & 63; float gv[8][8], ss[8];
#pragma unroll
      for (int q = 0; q < 8; ++q) { const int t = (tid >> 7) + 4 * q; const v4u yq = *(const LAS v4u*)(XT + h * 64 * XP_ + t * 128 + 2 * pp); const v4u z = zq[q];
          gv[q][0] = bflo(yq.x) * siluf_(bflo(z.x)); gv[q][1] = bfhi(yq.x) * siluf_(bfhi(z.x)); gv[q][2] = bflo(yq.y) * siluf_(bflo(z.y)); gv[q][3] = bfhi(yq.y) * siluf_(bfhi(z.y));
          gv[q][4] = bflo(yq.z) * siluf_(bflo(z.z)); gv[q][5] = bfhi(yq.z) * siluf_(bfhi(z.z)); gv[q][6] = bflo(yq.w) * siluf_(bflo(z.w)); gv[q][7] = bfhi(yq.w) * siluf_(bfhi(z.w));
          float a = 0.f;
#pragma unroll
          for (int e = 0; e < 8; ++e) a += gv[q][e] * gv[q][e];
          ss[q] = wave_sum(a); }
      if ((tid & 63) == 0) {
#pragma unroll
          for (int q = 0; q < 8; ++q) SSQ[(tid >> 6) * 8 + q] = ss[q]; }
      __syncthreads();
      const f32x4 w0 = *(const GAS f32x4*)(F.a->in[I_SSMNW] + c8), w1 = *(const GAS f32x4*)(F.a->in[I_SSMNW] + c8 + 4);
      bf16* MX = (bf16*)(F.out + O_YP) + (size_t)(b * SEQ + t0) * 2048;
#pragma unroll
      for (int q = 0; q < 8; ++q) { const int t = (tid >> 7) + 4 * q; const float rs = rsqrtf((SSQ[((tid >> 7) * 2) * 8 + q] + SSQ[((tid >> 7) * 2 + 1) * 8 + q]) * (1.f / D) + EPS);
          v4u o; o.x = pk2(gv[q][0] * rs * w0.x, gv[q][1] * rs * w0.y); o.y = pk2(gv[q][2] * rs * w0.z, gv[q][3] * rs * w0.w); o.z = pk2(gv[q][4] * rs * w1.x, gv[q][5] * rs * w1.y); o.w = pk2(gv[q][6] * rs * w1.z, gv[q][7] * rs * w1.w);
          *(GAS v4u*)(MX + (size_t)t * 2048 + c8) = o; } }
    __syncthreads();
}
__device__ __forceinline__ void ssd_out_phase(Frame& F) {
    { LAS float* CWL = (LAS float*)(F.lds + SSDO_CWL);
      for (int e = F.tid; e < 5 * XBC; e += NTHR) CWL[e] = e < 4 * XBC ? F.a->in[I_CONVW][e] : F.a->in[I_CONVB][e - 4 * XBC]; }
    __syncthreads();
    for (int it = F.vcu; it < 8 * 64; it += F.G) ssd_out_item(F, it >> 6, it & 63);
}

constexpr size_t B_SB = 0;
static_assert(B_SB + (size_t)8 * 16 * 8 * 16384 * 2 <= B_PROJB, "hgrn state buffer");
__device__ __forceinline__ float hg_lb(const Frame& F, int c) { return __builtin_amdgcn_rcpf(1.f + __expf(F.a->in[I_HGLB][1024 + c] - F.a->in[I_HGLB][c])); }

__device__ __forceinline__ void hg_state_item(Frame& F, int b, int h, int vq, int sj, int sh) {
    const bf16* PB = (const bf16*)(F.ws + WS_BIG + B_PROJB); bf16* SB = (bf16*)(F.ws + WS_BIG + B_SB);
    constexpr int KP = 272;
    LAS unsigned char* KT0 = F.lds;
    LAS unsigned char* VT0 = KT0 + 2 * 128 * KP;
    LAS unsigned char* RAW = VT0 + 2 * 32 * KP;
    LAS float* EL = (LAS float*)(RAW + 128 * KP);
    LAS float* SEG = EL + 256;
    int tid = F.tid; asm volatile("" : "+v"(tid));
    const int lane = tid & 63, wave = __builtin_amdgcn_readfirstlane(tid >> 6), r = lane & 31, hh = lane >> 5;
    const int kcol = tid & 127, seg = tid >> 7;
    const float lb = hg_lb(F, h * 128 + kcol);
    const int vs = tid >> 2, voc = tid & 3;
    const bf16* fsrc = PB + (size_t)(b * SEQ + (tid >> 4)) * NBH + 1024 + h * 128 + 8 * (tid & 15);
    const bf16* vsrc = PB + (size_t)(b * SEQ + vs) * NBH + 2048 + h * 128 + vq * 32 + 8 * voc;
    v4u pf[4], pv;
#pragma unroll
    for (int q = 0; q < 4; ++q) pf[q] = *(const GAS v4u*)(fsrc + (size_t)(32 * q) * NBH);
    pv = *(const GAS v4u*)vsrc;
    LAS float* SM = (LAS float*)(F.lds + HALO_OFF); LAS float* OW = SM + 1024; LAS float* OH = OW + 1024;
    const bf16* PS = PB + (size_t)(MP + sj) * NBH + 512 * sh;
    const float* S0 = F.a->in[I_SHG] + (size_t)sj * 131072 + (size_t)sh * 65536; float* S1 = F.out + O_SHG + (size_t)sj * 131072 + (size_t)sh * 65536;
    const int ln_ = lane_op_();
    f32x4 oacc = {0.f, 0.f, 0.f, 0.f};
    const int kt = wave - 4;
    f32x16 acc;
#pragma unroll
    for (int i = 0; i < 16; ++i) acc[i] = 0.f;
#pragma unroll 1
    for (int cc = 0; cc < 16; ++cc) {
        LAS unsigned char* KT = KT0 + (cc & 1) * 128 * KP; LAS unsigned char* VT = VT0 + (cc & 1) * 32 * KP;
        const int hl = cc >> 2, si0 = cc * 1024 + tid, si1 = si0 + 512;
        const f32x4 sv0 = *(const GAS f32x4*)(S0 + (size_t)si0 * 4), sv1 = *(const GAS f32x4*)(S0 + (size_t)si1 * 4);
        if ((cc & 3) == 0 && tid < 128) { LAS float* sm = SM + (hl & 1) * 512; const int c = hl * 128 + tid; const float lbs = hg_lb(F, 512 * sh + c), sg = sigmoidf_(bf2f(PS[1024 + c]));
            sm[tid] = lbs + (1.f - lbs) * sg; sm[128 + tid] = (1.f - lbs) * (1.f - sg); sm[256 + tid] = siluf_(bf2f(PS[c])); sm[384 + tid] = bf2f(PS[2048 + c]); }
#pragma unroll
        for (int q = 0; q < 4; ++q) *(LAS v4u*)(RAW + ((tid >> 4) + 32 * q) * KP + 16 * (tid & 15)) = pf[q];
        { const unsigned ww[4] = {pv.x, pv.y, pv.z, pv.w};
#pragma unroll
          for (int e = 0; e < 4; ++e) { *(LAS unsigned short*)(VT + (8 * voc + 2 * e) * KP + 2 * vs) = (unsigned short)(ww[e] & 0xffffu); *(LAS unsigned short*)(VT + (8 * voc + 2 * e + 1) * KP + 2 * vs) = (unsigned short)(ww[e] >> 16); } }
        if (cc + 1 < 16) {
#pragma unroll
            for (int q = 0; q < 4; ++q) pf[q] = *(const GAS v4u*)(fsrc + (size_t)(128 * (cc + 1) + 32 * q) * NBH);
            pv = *(const GAS v4u*)(vsrc + (size_t)(128 * (cc + 1)) * NBH); }
        if (wave >= 4) {
            bf16* sb = SB + ((((size_t)b * 16 + cc) * 8 + h) * 128 + vq * 32) * 128 + kt * 32 + r;
#pragma unroll
            for (int i = 0; i < 16; ++i) sb[(size_t)((i & 3) + 8 * (i >> 2) + 4 * hh) * 128] = (bf16)f2bf(acc[i]); }
        asm volatile("s_waitcnt lgkmcnt(0)" ::: "memory"); __builtin_amdgcn_s_barrier(); asm volatile("" ::: "memory");
        float kp[32];
        { float run = 1.f;
#pragma unroll
          for (int j = 31; j >= 0; --j) { const float sg = sigmoidf_(bf2f(*(const LAS unsigned short*)(RAW + (32 * seg + j) * KP + 2 * kcol))); kp[j] = (1.f - lb) * (1.f - sg) * run; run *= lb + (1.f - lb) * sg; }
          SEG[seg * 128 + kcol] = run; }
        asm volatile("s_waitcnt lgkmcnt(0)" ::: "memory"); __builtin_amdgcn_s_barrier(); asm volatile("" ::: "memory");
        { const float t0 = SEG[kcol], t1 = SEG[128 + kcol], t2 = SEG[256 + kcol], t3 = SEG[384 + kcol];
          const float R = seg == 3 ? 1.f : (seg == 2 ? t3 : (seg == 1 ? t2 * t3 : t1 * t2 * t3));
          if (seg == 0) EL[(cc & 1) * 128 + kcol] = (t0 * t1) * (t2 * t3);
#pragma unroll
          for (int j8 = 0; j8 < 4; ++j8) { v4u p;
              p.x = pk2(kp[8 * j8] * R, kp[8 * j8 + 1] * R); p.y = pk2(kp[8 * j8 + 2] * R, kp[8 * j8 + 3] * R); p.z = pk2(kp[8 * j8 + 4] * R, kp[8 * j8 + 5] * R); p.w = pk2(kp[8 * j8 + 6] * R, kp[8 * j8 + 7] * R);
              *(LAS v4u*)(KT + kcol * KP + 2 * (32 * seg + 8 * j8)) = p; } }
        asm volatile("s_waitcnt lgkmcnt(0)" ::: "memory"); __builtin_amdgcn_s_barrier(); asm volatile("" ::: "memory");
        if (wave >= 4) {
            const float el = EL[(cc & 1) * 128 + kt * 32 + r];
#pragma unroll
            for (int i = 0; i < 16; ++i) acc[i] *= el;
#pragma unroll
            for (int ks = 0; ks < 8; ++ks) { const bf16x8 a = *(const LAS bf16x8*)(VT + r * KP + 32 * ks + 16 * hh), bb = *(const LAS bf16x8*)(KT + (kt * 32 + r) * KP + 32 * ks + 16 * hh);
                acc = __builtin_amdgcn_mfma_f32_32x32x16_bf16(a, bb, acc, 0, 0, 0); }
        }
        { const LAS float* sm = SM + (hl & 1) * 512; const int v4 = (tid & 31) * 4; const f32x4 vv = *(const LAS f32x4*)(sm + 384 + v4);
          const int k0 = (si0 >> 5) & 127, k1 = (si1 >> 5) & 127;
          const f32x4 n0 = sv0 * sm[k0] + vv * sm[128 + k0], n1 = sv1 * sm[k1] + vv * sm[128 + k1];
          *(GAS f32x4*)(S1 + (size_t)si0 * 4) = n0; *(GAS f32x4*)(S1 + (size_t)si1 * 4) = n1;
          oacc += n0 * sm[256 + k0] + n1 * sm[256 + k1];
          if ((cc & 3) == 3) {
              f32x4 t; t[0] = oacc[0] + shx_(oacc[0], 32, ln_); t[1] = oacc[1] + shx_(oacc[1], 32, ln_); t[2] = oacc[2] + shx_(oacc[2], 32, ln_); t[3] = oacc[3] + shx_(oacc[3], 32, ln_);
              if (lane < 32) *(LAS f32x4*)(OW + wave * 128 + v4) = t;
              oacc = (f32x4){0.f, 0.f, 0.f, 0.f}; } }
        if ((cc & 3) == 0 && cc > 0 && tid < 128) { float o = 0.f;
#pragma unroll
            for (int w = 0; w < 8; ++w) o += OW[w * 128 + tid];
            OH[(hl - 1) * 128 + tid] = o; }
    }
    __syncthreads();
    if (tid < 128) { float o = 0.f;
#pragma unroll
        for (int w = 0; w < 8; ++w) o += OW[w * 128 + tid];
        OH[3 * 128 + tid] = o; }
    __syncthreads();
    { const int c = tid; const float o = OH[c]; const float ss = wave_sum(o * o); if (lane == 0) SM[wave] = ss;
      __syncthreads();
      const float rs = rsqrtf((SM[(tid >> 7) * 2] + SM[(tid >> 7) * 2 + 1]) * (1.f / 128.f) + EPS);
      ((bf16*)(F.ws + WS_MIXS) + (size_t)sj * 2048 + 1024 + 512 * sh)[c] = (bf16)f2bf(o * rs * F.a->in[I_HGNW][c & 127] * siluf_(bf2f(PS[3072 + c]))); }
    if (wave >= 4) { float* ps = F.out + O_PHG + ((size_t)(b * 8 + h) * 128 + kt * 32 + r) * 128 + vq * 32;
#pragma unroll
        for (int i = 0; i < 16; ++i) ps[(i & 3) + 8 * (i >> 2) + 4 * hh] = acc[i]; }
    __syncthreads();
}

__device__ __forceinline__ void hg_out_phase(Frame& F) {
    const bf16* PB = (const bf16*)(F.ws + WS_BIG + B_PROJB); const bf16* SB = (const bf16*)(F.ws + WS_BIG + B_SB);
    constexpr int KP = 272, SP = 80, OP = 528;
    LAS unsigned char* QH = F.lds;
    LAS unsigned char* Q1 = QH + 32 * KP;
    LAS unsigned char* KA = Q1 + 16 * KP;
    LAS unsigned char* KB = KA + 16 * KP;
    LAS unsigned char* KHT = KB + 32 * KP;
    LAS unsigned char* VT = KHT + 128 * SP;
    LAS float* CSEG = (LAS float*)(VT + 128 * SP);
    LAS float* EL = CSEG + 512;
    LAS float* SSQ = EL + 128;
    LAS unsigned char* OF = (LAS unsigned char*)(SSQ + 256);
    LAS unsigned char* RQ = OF + 32 * OP;
    LAS unsigned char* RF = RQ + 32 * KP;
    int tid = F.tid; asm volatile("" : "+v"(tid));
    const int lane = tid & 63, wave = __builtin_amdgcn_readfirstlane(tid >> 6), fr = lane & 15, q4 = lane >> 4;
    const int kcol = tid & 127, seg = tid >> 7;
    const int NITEM = 8 * 16 * 8;
    const int nit = F.vcu < NITEM ? (NITEM - 1 - F.vcu) / F.G + 1 : 0, NIT = 4 * nit;
    v4u pq, pf, pv, pg;
#define HG_ROW0(n) ((((F.vcu + ((n) >> 2) * F.G) >> 7) * SEQ) + 128 * (((F.vcu + ((n) >> 2) * F.G) >> 3) & 15) + 32 * ((n) & 3))
#define HG_HEAD(n) ((F.vcu + ((n) >> 2) * F.G) & 7)
#define HG_PREFETCH(n) do { const int T0_ = HG_ROW0(n), h_ = HG_HEAD(n); const bf16* rp_ = PB + (size_t)(T0_ + (tid >> 4)) * NBH + h_ * 128 + 8 * (tid & 15); \
        pq = *(const GAS v4u*)rp_; pf = *(const GAS v4u*)(rp_ + 1024); pv = *(const GAS v4u*)(rp_ + 2048); pg = *(const GAS v4u*)(rp_ + 3072); } while (0)
    if (NIT > 0) HG_PREFETCH(0);
    f32x4 S[8]; v2u psb[8];
    float lb = 0.f;
#pragma unroll 1
    for (int n = 0; n < NIT; ++n) {
        const int item = F.vcu + (n >> 2) * F.G, b = item >> 7, cc = (item >> 3) & 15, h = item & 7, fc = n & 3;
        const int T0 = b * SEQ + 128 * cc + 32 * fc;
        const v4u vv = pv, gv = pg;
        *(LAS v4u*)(RQ + (tid >> 4) * KP + 16 * (tid & 15)) = pq; *(LAS v4u*)(RF + (tid >> 4) * KP + 16 * (tid & 15)) = pf;
        if (n + 1 < NIT) HG_PREFETCH(n + 1);
        if (fc == 0) {
            lb = hg_lb(F, h * 128 + kcol);
            if (n == 0) { const bf16* sb = SB + ((((size_t)b * 16 + cc) * 8 + h) * 128 + 16 * wave + fr) * 128 + 4 * q4;
#pragma unroll
                for (int kt = 0; kt < 8; ++kt) psb[kt] = *(const GAS v2u*)(sb + 16 * kt); }
#pragma unroll
            for (int kt = 0; kt < 8; ++kt) { const v2u u = psb[kt]; S[kt][0] = bflo(u.x); S[kt][1] = bfhi(u.x); S[kt][2] = bflo(u.y); S[kt][3] = bfhi(u.y); } }
        if (fc == 3 && n + 1 < NIT) { const int it2 = F.vcu + ((n + 1) >> 2) * F.G; const bf16* sb = SB + ((((size_t)(it2 >> 7) * 16 + ((it2 >> 3) & 15)) * 8 + (it2 & 7)) * 128 + 16 * wave + fr) * 128 + 4 * q4;
#pragma unroll
            for (int kt = 0; kt < 8; ++kt) psb[kt] = *(const GAS v2u*)(sb + 16 * kt); }
        asm volatile("s_waitcnt lgkmcnt(0)" ::: "memory"); __builtin_amdgcn_s_barrier(); asm volatile("" ::: "memory");
        float cl[8], kk[8], qs[8];
        { float a = 0.f;
#pragma unroll
          for (int j = 0; j < 8; ++j) { const float sg = sigmoidf_(bf2f(*(const LAS unsigned short*)(RF + (8 * seg + j) * KP + 2 * kcol)));
              a += __logf(lb + (1.f - lb) * sg); cl[j] = a; kk[j] = (1.f - lb) * (1.f - sg); qs[j] = siluf_(bf2f(*(const LAS unsigned short*)(RQ + (8 * seg + j) * KP + 2 * kcol))); }
          CSEG[seg * 128 + kcol] = a; }
        { const int s = tid >> 4, oc = tid & 15; const unsigned ww[4] = {vv.x, vv.y, vv.z, vv.w};
#pragma unroll
          for (int e = 0; e < 4; ++e) { *(LAS unsigned short*)(VT + (8 * oc + 2 * e) * SP + 2 * s) = (unsigned short)(ww[e] & 0xffffu); *(LAS unsigned short*)(VT + (8 * oc + 2 * e + 1) * SP + 2 * s) = (unsigned short)(ww[e] >> 16); } }
        asm volatile("s_waitcnt lgkmcnt(0)" ::: "memory"); __builtin_amdgcn_s_barrier(); asm volatile("" ::: "memory");
        { const float t0 = CSEG[kcol], t1 = CSEG[128 + kcol], t2 = CSEG[256 + kcol], t3 = CSEG[384 + kcol];
          const float off = seg == 0 ? 0.f : (seg == 1 ? t0 : (seg == 2 ? t0 + t1 : t0 + t1 + t2)), c15 = t0 + t1, last = (t0 + t1) + (t2 + t3);
          if (seg == 0) EL[kcol] = __expf(last);
#pragma unroll
          for (int j = 0; j < 8; ++j) { const int t = 8 * seg + j; const float cum = off + cl[j];
              *(LAS unsigned short*)(QH + t * KP + 2 * kcol) = (unsigned short)f2bf(qs[j] * __expf(cum));
              if (seg >= 2) *(LAS unsigned short*)(Q1 + (t - 16) * KP + 2 * kcol) = (unsigned short)f2bf(qs[j] * __expf(cum - c15));
              else *(LAS unsigned short*)(KA + t * KP + 2 * kcol) = (unsigned short)f2bf(kk[j] * __expf(fminf(-cum, 80.f)));
              *(LAS unsigned short*)(KB + t * KP + 2 * kcol) = (unsigned short)f2bf(kk[j] * __expf(fminf(c15 - cum, 80.f)));
              *(LAS unsigned short*)(KHT + kcol * SP + 2 * t) = (unsigned short)f2bf(kk[j] * __expf(last - cum)); } }
        asm volatile("s_waitcnt lgkmcnt(0)" ::: "memory"); __builtin_amdgcn_s_barrier(); asm volatile("" ::: "memory");
        f32x4 at00 = {0.f, 0.f, 0.f, 0.f}, at01 = at00, at11 = at00;
#pragma unroll
        for (int ks = 0; ks < 4; ++ks) { const int kb = 64 * ks + 16 * q4;
            const bf16x8 ka = *(const LAS bf16x8*)(KA + fr * KP + kb), kb0 = *(const LAS bf16x8*)(KB + fr * KP + kb), kb1 = *(const LAS bf16x8*)(KB + (16 + fr) * KP + kb);
            const bf16x8 qh = *(const LAS bf16x8*)(QH + fr * KP + kb), q1 = *(const LAS bf16x8*)(Q1 + fr * KP + kb);
            at00 = __builtin_amdgcn_mfma_f32_16x16x32_bf16(ka, qh, at00, 0, 0, 0);
            at01 = __builtin_amdgcn_mfma_f32_16x16x32_bf16(kb0, q1, at01, 0, 0, 0);
            at11 = __builtin_amdgcn_mfma_f32_16x16x32_bf16(kb1, q1, at11, 0, 0, 0); }
#pragma unroll
        for (int e = 0; e < 4; ++e) { const bool keep = (4 * q4 + e) <= fr; at00[e] = keep ? at00[e] : 0.f; at11[e] = keep ? at11[e] : 0.f; }
        v4u pa0, pa1;
        pa0.x = pk2(at00[0], at00[1]); pa0.y = pk2(at00[2], at00[3]); pa0.z = 0u; pa0.w = 0u;
        pa1.x = pk2(at01[0], at01[1]); pa1.y = pk2(at01[2], at01[3]); pa1.z = pk2(at11[0], at11[1]); pa1.w = pk2(at11[2], at11[3]);
        f32x4 o0 = {0.f, 0.f, 0.f, 0.f}, o1 = o0;
        { const LAS unsigned char* vrow = VT + (16 * wave + fr) * SP; const v2u lo = *(const LAS v2u*)(vrow + 8 * q4), hi = *(const LAS v2u*)(vrow + 32 + 8 * q4);
          v4u bv; bv.x = lo.x; bv.y = lo.y; bv.z = hi.x; bv.w = hi.y;
          o0 = __builtin_amdgcn_mfma_f32_16x16x32_bf16(__builtin_bit_cast(bf16x8, pa0), __builtin_bit_cast(bf16x8, bv), o0, 0, 0, 0);
          o1 = __builtin_amdgcn_mfma_f32_16x16x32_bf16(__builtin_bit_cast(bf16x8, pa1), __builtin_bit_cast(bf16x8, bv), o1, 0, 0, 0); }
#pragma unroll
        for (int ks = 0; ks < 4; ++ks) { v4u bs; bs.x = pk2(S[2 * ks][0], S[2 * ks][1]); bs.y = pk2(S[2 * ks][2], S[2 * ks][3]); bs.z = pk2(S[2 * ks + 1][0], S[2 * ks + 1][1]); bs.w = pk2(S[2 * ks + 1][2], S[2 * ks + 1][3]);
            const int kb = 64 * ks + 8 * q4;
            const v2u a0l = *(const LAS v2u*)(QH + fr * KP + kb), a0h = *(const LAS v2u*)(QH + fr * KP + kb + 32), a1l = *(const LAS v2u*)(QH + (16 + fr) * KP + kb), a1h = *(const LAS v2u*)(QH + (16 + fr) * KP + kb + 32);
            v4u a0; a0.x = a0l.x; a0.y = a0l.y; a0.z = a0h.x; a0.w = a0h.y; v4u a1; a1.x = a1l.x; a1.y = a1l.y; a1.z = a1h.x; a1.w = a1h.y;
            o0 = __builtin_amdgcn_mfma_f32_16x16x32_bf16(__builtin_bit_cast(bf16x8, a0), __builtin_bit_cast(bf16x8, bs), o0, 0, 0, 0);
            o1 = __builtin_amdgcn_mfma_f32_16x16x32_bf16(__builtin_bit_cast(bf16x8, a1), __builtin_bit_cast(bf16x8, bs), o1, 0, 0, 0); }
#pragma unroll
        for (int e = 0; e < 4; ++e) { const int t0r = 4 * q4 + e; *(LAS float*)(OF + t0r * OP + 4 * (16 * wave + fr)) = o0[e]; *(LAS float*)(OF + (16 + t0r) * OP + 4 * (16 * wave + fr)) = o1[e];
            const float s0 = row16_sum(o0[e] * o0[e]), s1 = row16_sum(o1[e] * o1[e]);
            if (fr == 0) { SSQ[wave * 32 + t0r] = s0; SSQ[wave * 32 + 16 + t0r] = s1; } }
        { const bf16x8 bv = *(const LAS bf16x8*)(VT + (16 * wave + fr) * SP + 16 * q4);
#pragma unroll
          for (int kt = 0; kt < 8; ++kt) { const f32x4 el = *(const LAS f32x4*)(EL + 16 * kt + 4 * q4); const bf16x8 ak = *(const LAS bf16x8*)(KHT + (16 * kt + fr) * SP + 16 * q4);
              S[kt] = __builtin_amdgcn_mfma_f32_16x16x32_bf16(ak, bv, S[kt] * el, 0, 0, 0); } }
        asm volatile("s_waitcnt lgkmcnt(0)" ::: "memory"); __builtin_amdgcn_s_barrier(); asm volatile("" ::: "memory");
        { const int t = tid >> 4, v8 = (tid & 15) * 8; float tot = 0.f;
#pragma unroll
          for (int w = 0; w < 8; ++w) tot += SSQ[w * 32 + t];
          const float rs = rsqrtf(tot * (1.f / 128.f) + EPS);
          const f32x4 oa = *(const LAS f32x4*)(OF + t * OP + 4 * v8), ob = *(const LAS f32x4*)(OF + t * OP + 4 * v8 + 16);
          const f32x4 wa = *(const GAS f32x4*)(F.a->in[I_HGNW] + v8), wb = *(const GAS f32x4*)(F.a->in[I_HGNW] + v8 + 4);
          v4u o; o.x = pk2(oa.x * rs * wa.x * siluf_(bflo(gv.x)), oa.y * rs * wa.y * siluf_(bfhi(gv.x))); o.y = pk2(oa.z * rs * wa.z * siluf_(bflo(gv.y)), oa.w * rs * wa.w * siluf_(bfhi(gv.y)));
          o.z = pk2(ob.x * rs * wb.x * siluf_(bflo(gv.z)), ob.y * rs * wb.y * siluf_(bfhi(gv.z))); o.w = pk2(ob.z * rs * wb.z * siluf_(bflo(gv.w)), ob.w * rs * wb.w * siluf_(bfhi(gv.w)));
          *(GAS v4u*)((bf16*)(F.out + O_YP) + (size_t)(T0 + t) * 2048 + 1024 + h * 128 + v8) = o; }
    }
#undef HG_ROW0
#undef HG_HEAD
#undef HG_PREFETCH
    __syncthreads();
}

__device__ __forceinline__ void hg_sample_item(Frame& F, int j, int half) {
    const bf16* PB = (const bf16*)(F.ws + WS_BIG + B_PROJB) + (size_t)(MP + j) * NBH + 512 * half; bf16* MX = (bf16*)(F.ws + WS_MIXS) + (size_t)j * 2048 + 1024 + 512 * half;
    LAS float* fS = (LAS float*)F.lds;
    LAS float* kS = fS + 512; LAS float* qS = kS + 512; LAS float* vS = qS + 512; LAS float* oP = vS + 512;
    int tid = F.tid; asm volatile("" : "+v"(tid));
    { const int c = tid; const float lb = hg_lb(F, 512 * half + c), sg = sigmoidf_(bf2f(PB[1024 + c]));
      fS[c] = lb + (1.f - lb) * sg; kS[c] = (1.f - lb) * (1.f - sg); qS[c] = siluf_(bf2f(PB[c])); vS[c] = bf2f(PB[2048 + c]); }
    __syncthreads();
    const int v4 = (tid & 31) * 4, krow = tid >> 5;
    const float* S0 = F.a->in[I_SHG] + (size_t)j * 131072 + (size_t)half * 65536; float* S1 = F.out + O_SHG + (size_t)j * 131072 + (size_t)half * 65536;
#pragma unroll 1
    for (int hl = 0; hl < 4; ++hl) { const f32x4 vv = *(const LAS f32x4*)(vS + hl * 128 + v4); f32x4 a = {0.f, 0.f, 0.f, 0.f};
        f32x4 sv[8];
#pragma unroll
        for (int kb = 0; kb < 8; ++kb) sv[kb] = *(const GAS f32x4*)(S0 + ((size_t)hl * 128 + krow + 16 * kb) * 128 + v4);
#pragma unroll
        for (int kb = 0; kb < 8; ++kb) { const int k = krow + 16 * kb; const f32x4 sn = sv[kb] * fS[hl * 128 + k] + vv * kS[hl * 128 + k];
            *(GAS f32x4*)(S1 + ((size_t)hl * 128 + k) * 128 + v4) = sn; a += sn * qS[hl * 128 + k]; }
        *(LAS f32x4*)(oP + krow * 512 + hl * 128 + v4) = a; }
    __syncthreads();
    { const int c = tid; float o = 0.f;
#pragma unroll
      for (int q = 0; q < 16; ++q) o += oP[q * 512 + c];
      float ss = wave_sum(o * o); if ((tid & 63) == 0) fS[tid >> 6] = ss;
      __syncthreads();
      const float tot = fS[(tid >> 7) * 2] + fS[(tid >> 7) * 2 + 1];
      const float rs = rsqrtf(tot * (1.f / 128.f) + EPS);
      MX[c] = (bf16)f2bf(o * rs * F.a->in[I_HGNW][c & 127] * siluf_(bf2f(PB[3072 + c]))); }
    __syncthreads();
}
__device__ __forceinline__ void hg_state_phase(Frame& F) {
    for (int it = F.vcu; it < 256; it += F.G) hg_state_item(F, it >> 5, (it >> 2) & 7, it & 3, it >> 1, it & 1);
}

__device__ __forceinline__ void s5_lambda(const Frame& F, int g, int n, float& abr, float& abi, float& cfr, float& cfi) {
    const float lr = F.a->in[I_LAMRE][g * 64 + n], li = F.a->in[I_LAMIM][g * 64 + n], step = expf(F.a->in[I_LOGSTEP][g]);
    const float mag = expf(lr * step); float sn, cs; sincosf(li * step, &sn, &cs);
    abr = mag * cs; abi = mag * sn;
    const float den = lr * lr + li * li, nr = abr - 1.0f;
    cfr = (nr * lr + abi * li) / den; cfi = (abi * lr - nr * li) / den;
}
__device__ __forceinline__ void s5_tables_item(Frame& F, int g) {
    LAS float* POW = (LAS float*)F.lds;
    LAS float* CC = POW + 17 * 128;
    LAS float* BB = CC + 16 * 128;
    LAS float* KS = BB + 64 * 32;
    const int tid = F.tid;
    bf16* KQ = (bf16*)(F.ws + WS_BIG + B_S5T + S5T_KQ) + (size_t)g * 256 * 384; bf16* PM = (bf16*)(F.ws + WS_BIG + B_S5T + S5T_PM) + (size_t)g * 128 * 256;
    if (tid < 64) { const int n = tid; float abr, abi, cfr, cfi; s5_lambda(F, g, n, abr, abi, cfr, cfi);
        float pr = 1.f, pi = 0.f;
        for (int t = 0; t <= 16; ++t) { POW[(t * 64 + n) * 2] = pr; POW[(t * 64 + n) * 2 + 1] = pi; const float nr = pr * abr - pi * abi, ni = pr * abi + pi * abr; pr = nr; pi = ni; }
        const float* br = F.a->in[I_BRE] + (size_t)(g * 64 + n) * 16; const float* bi = F.a->in[I_BIM] + (size_t)(g * 64 + n) * 16;
        for (int c = 0; c < 16; ++c) { BB[(n * 16 + c) * 2] = cfr * br[c] - cfi * bi[c]; BB[(n * 16 + c) * 2 + 1] = cfr * bi[c] + cfi * br[c]; } }
    for (int e = tid; e < 1024; e += NTHR) { CC[e * 2] = F.a->in[I_CRE][(size_t)g * 1024 + e]; CC[e * 2 + 1] = F.a->in[I_CIM][(size_t)g * 1024 + e]; }
    __syncthreads();
    { const int cc = tid & 255, cp = cc >> 4, c = cc & 15, th = tid >> 8; float a[8];
#pragma unroll
      for (int i = 0; i < 8; ++i) a[i] = 0.f;
      for (int n = 0; n < 64; ++n) { const float cr = CC[(cp * 64 + n) * 2], ci = CC[(cp * 64 + n) * 2 + 1], br = BB[(n * 16 + c) * 2], bi = BB[(n * 16 + c) * 2 + 1];
          const float xr = cr * br - ci * bi, xi = cr * bi + ci * br;
#pragma unroll
          for (int i = 0; i < 8; ++i) { const int t = th + 2 * i; a[i] += xr * POW[(t * 64 + n) * 2] - xi * POW[(t * 64 + n) * 2 + 1]; } }
#pragma unroll
      for (int i = 0; i < 8; ++i) KS[(th + 2 * i) * 256 + cc] = a[i]; }
    __syncthreads();
    for (int e2 = tid; e2 < 256 * 192; e2 += NTHR) { const int row = e2 / 192, col0 = (e2 % 192) * 2, t = row >> 4, cp = row & 15; float v[2];
#pragma unroll
        for (int q = 0; q < 2; ++q) { const int col = col0 + q;
            if (col < 256) { const int s = col >> 4, c = col & 15; v[q] = s <= t ? KS[(t - s) * 256 + cp * 16 + c] : 0.f; }
            else { const int np = col - 256, n = np & 63; const float pr = POW[((t + 1) * 64 + n) * 2], pi = POW[((t + 1) * 64 + n) * 2 + 1], cr = CC[(cp * 64 + n) * 2], ci = CC[(cp * 64 + n) * 2 + 1];
                v[q] = np < 64 ? cr * pr - ci * pi : -(cr * pi + ci * pr); } }
        *(GAS unsigned*)(KQ + (size_t)row * 384 + col0) = pk2(v[0], v[1]); }
    for (int e2 = tid; e2 < 128 * 128; e2 += NTHR) { const int np = e2 >> 7, col0 = (e2 & 127) * 2, n = np & 63; float v[2];
#pragma unroll
        for (int q = 0; q < 2; ++q) { const int col = col0 + q, s = col >> 4, c = col & 15; const float pr = POW[((15 - s) * 64 + n) * 2], pi = POW[((15 - s) * 64 + n) * 2 + 1], br = BB[(n * 16 + c) * 2], bi = BB[(n * 16 + c) * 2 + 1];
            v[q] = np < 64 ? pr * br - pi * bi : pr * bi + pi * br; }
        *(GAS unsigned*)(PM + (size_t)np * 256 + col0) = pk2(v[0], v[1]); }
    __syncthreads();
}
__device__ __forceinline__ void s5_fused_item(Frame& F, int b, int g) {
    const bf16* HN = (const bf16*)(F.ws + WS_XN); const bf16* PM = (const bf16*)(F.ws + WS_BIG + B_S5T + S5T_PM) + (size_t)g * 128 * 256; const bf16* KQ = (const bf16*)(F.ws + WS_BIG + B_S5T + S5T_KQ) + (size_t)g * 256 * 384;
    bf16* GY = (bf16*)(F.ws + WS_BIG + B_GY);
    constexpr int UP_ = 528, PP = 132, XPP = 272, KQP = 784;
    LAS unsigned char* UL = F.lds;
    LAS unsigned char* XL = UL;
    LAS unsigned char* BL = UL + 128 * XPP;
    LAS float* PL = (LAS float*)BL;
    LAS float* SE = (LAS float*)(BL + 128 * UP_);
    static_assert(64 * UP_ <= 128 * XPP && 128 * PP * 4 <= 128 * UP_ && 64 * KQP <= 128 * UP_ && 128 * XPP + 128 * UP_ + 4096 <= RING_BYTES, "s5 LDS map");
    int tid = F.tid; asm volatile("" : "+v"(tid));
    const int lane = tid & 63, wave = __builtin_amdgcn_readfirstlane(tid >> 6), r = lane & 31, hh = lane >> 5, mt = wave >> 1, ch = wave & 1;
    for (int e = tid; e < 128 * 32; e += NTHR) { const int row = e >> 5, c16 = e & 31; *(LAS v4u*)(BL + row * UP_ + 16 * c16) = *(const GAS v4u*)(PM + (size_t)row * 256 + 8 * c16); }
    bf16x8 au[16];
#pragma unroll
    for (int half = 0; half < 2; ++half) {
        for (int e = tid; e < 64 * 32; e += NTHR) { const int tok = e >> 1, pc = e & 1, m = tok >> 4, s2 = tok & 15;
            *(LAS v4u*)(UL + m * UP_ + 32 * s2 + 16 * pc) = *(const GAS v4u*)(HN + (size_t)(b * SEQ + 1024 * half + tok) * D + 16 * g + 8 * pc); }
        __syncthreads();
        if ((mt >> 1) == half) {
#pragma unroll
            for (int s2 = 0; s2 < 16; ++s2) au[s2] = *(const LAS bf16x8*)(UL + (32 * (mt & 1) + r) * UP_ + 32 * s2 + 16 * hh); }
        __syncthreads();
    }
    { f32x16 acc[2];
#pragma unroll
      for (int nt = 0; nt < 2; ++nt)
#pragma unroll
          for (int i = 0; i < 16; ++i) acc[nt][i] = 0.f;
#pragma unroll
      for (int s2 = 0; s2 < 16; ++s2)
#pragma unroll
          for (int nt = 0; nt < 2; ++nt) { const bf16x8 bb = *(const LAS bf16x8*)(BL + (64 * ch + 32 * nt + r) * UP_ + 32 * s2 + 16 * hh); acc[nt] = __builtin_amdgcn_mfma_f32_32x32x16_bf16(au[s2], bb, acc[nt], 0, 0, 0); }
      __syncthreads();
#pragma unroll
      for (int nt = 0; nt < 2; ++nt)
#pragma unroll
          for (int i = 0; i < 16; ++i) PL[(32 * mt + (i & 3) + 8 * (i >> 2) + 4 * hh) * PP + 64 * ch + 32 * nt + r] = acc[nt][i]; }
    __syncthreads();
    { const int n = lane, seg = wave; float abr, abi, cfr, cfi; s5_lambda(F, g, n, abr, abi, cfr, cfi);
#pragma unroll
      for (int q = 0; q < 4; ++q) { const float nr = abr * abr - abi * abi, ni = 2.f * abr * abi; abr = nr; abi = ni; }
      float yr[16], yi[16];
      { float xr = 0.f, xi = 0.f;
#pragma unroll
        for (int i = 0; i < 16; ++i) { const float pr = PL[(16 * seg + i) * PP + n], pi = PL[(16 * seg + i) * PP + 64 + n]; const float nr = abr * xr - abi * xi + pr, ni = abr * xi + abi * xr + pi; xr = nr; xi = ni; yr[i] = xr; yi[i] = xi; }
        SE[seg * 128 + n] = xr; SE[seg * 128 + 64 + n] = xi; }
      float a16r = abr, a16i = abi;
#pragma unroll
      for (int q = 0; q < 4; ++q) { const float nr = a16r * a16r - a16i * a16i, ni = 2.f * a16r * a16i; a16r = nr; a16i = ni; }
      __syncthreads();
      float cr = 0.f, ci = 0.f;
      for (int s2 = 0; s2 < seg; ++s2) { const float er = SE[s2 * 128 + n], ei = SE[s2 * 128 + 64 + n]; const float nr = a16r * cr - a16i * ci + er, ni = a16r * ci + a16i * cr + ei; cr = nr; ci = ni; }
      float pwr = 1.f, pwi = 0.f;
#pragma unroll
      for (int i = 0; i < 16; ++i) { const float xr = (i == 0 ? 0.f : yr[i == 0 ? 0 : i - 1]) + pwr * cr - pwi * ci, xi = (i == 0 ? 0.f : yi[i == 0 ? 0 : i - 1]) + pwr * ci + pwi * cr;
          *(LAS unsigned short*)(XL + (16 * seg + i) * XPP + 2 * n) = (unsigned short)f2bf(xr); *(LAS unsigned short*)(XL + (16 * seg + i) * XPP + 2 * (64 + n)) = (unsigned short)f2bf(xi);
          const float nr = pwr * abr - pwi * abi, ni = pwr * abi + pwi * abr; pwr = nr; pwi = ni; }
      if (seg == 7) { const float xr = yr[15] + pwr * cr - pwi * ci, xi = yi[15] + pwr * ci + pwi * cr;
          F.out[O_PS5R + (size_t)(b * 64 + g) * 64 + n] = xr; F.out[O_PS5I + (size_t)(b * 64 + g) * 64 + n] = xi; } }
    __syncthreads();
    bf16x8 ax[8];
#pragma unroll
    for (int s2 = 0; s2 < 8; ++s2) ax[s2] = *(const LAS bf16x8*)(XL + (32 * mt + r) * XPP + 32 * s2 + 16 * hh);
    v4u kq[6];
#pragma unroll
    for (int q = 0; q < 6; ++q) { const int e = tid + NTHR * q, row = e / 48, c16 = e % 48; kq[q] = *(const GAS v4u*)(KQ + (size_t)row * 384 + 8 * c16); }
#pragma unroll 1
    for (int p = 0; p < 4; ++p) {
#pragma unroll
        for (int q = 0; q < 6; ++q) { const int e = tid + NTHR * q, row = e / 48, c16 = e % 48; *(LAS v4u*)(BL + row * KQP + 16 * c16) = kq[q]; }
        if (p < 3) {
#pragma unroll
            for (int q = 0; q < 6; ++q) { const int e = tid + NTHR * q, row = e / 48, c16 = e % 48; kq[q] = *(const GAS v4u*)(KQ + (size_t)(64 * (p + 1) + row) * 384 + 8 * c16); } }
        v4u uq[2];
#pragma unroll
        for (int q = 0; q < 2; ++q) { const int e = tid + NTHR * q, m = e >> 3, tl = (e >> 1) & 3, hf = e & 1; uq[q] = *(const GAS v4u*)(HN + (size_t)(b * SEQ + 16 * m + 4 * p + tl) * D + 16 * g + 8 * hf); }
        __syncthreads();
        f32x16 acc;
#pragma unroll
        for (int i = 0; i < 16; ++i) acc[i] = 0.f;
        const LAS unsigned char* brow = BL + (32 * ch + r) * KQP + 16 * hh;
#pragma unroll
        for (int s2 = 0; s2 < 16; ++s2) acc = __builtin_amdgcn_mfma_f32_32x32x16_bf16(au[s2], *(const LAS bf16x8*)(brow + 32 * s2), acc, 0, 0, 0);
#pragma unroll
        for (int s2 = 0; s2 < 8; ++s2) acc = __builtin_amdgcn_mfma_f32_32x32x16_bf16(ax[s2], *(const LAS bf16x8*)(brow + 512 + 32 * s2), acc, 0, 0, 0);
        { LAS float* OL = (LAS float*)XL;
#pragma unroll
          for (int i = 0; i < 16; ++i) OL[(32 * mt + (i & 3) + 8 * (i >> 2) + 4 * hh) * 68 + 32 * ch + r] = acc[i]; }
        __syncthreads();
#pragma unroll
        for (int q = 0; q < 2; ++q) { const int e = tid + NTHR * q, m = e >> 3, tl = (e >> 1) & 3, hf = e & 1; const LAS float* ol = (const LAS float*)XL + m * 68 + 16 * tl + 8 * hf;
            const f32x4 o0 = *(const LAS f32x4*)ol, o1 = *(const LAS f32x4*)(ol + 4);
            const size_t o = (size_t)(b * SEQ + 16 * m + 4 * p + tl) * D + 16 * g + 8 * hf;
            const v4u uu = uq[q]; const f32x4 d0 = *(const GAS f32x4*)(F.a->in[I_S5D] + 16 * g + 8 * hf), d1 = *(const GAS f32x4*)(F.a->in[I_S5D] + 16 * g + 8 * hf + 4);
            v4u w; w.x = pk2(gelu_tanh(o0.x + d0.x * bflo(uu.x)), gelu_tanh(o0.y + d0.y * bfhi(uu.x))); w.y = pk2(gelu_tanh(o0.z + d0.z * bflo(uu.y)), gelu_tanh(o0.w + d0.w * bfhi(uu.y)));
            w.z = pk2(gelu_tanh(o1.x + d1.x * bflo(uu.z)), gelu_tanh(o1.y + d1.y * bfhi(uu.z))); w.w = pk2(gelu_tanh(o1.z + d1.z * bflo(uu.w)), gelu_tanh(o1.w + d1.w * bfhi(uu.w)));
            *(GAS v4u*)(GY + o) = w; }
        __syncthreads();
    }
}
__device__ __forceinline__ void s5_fused_phase(Frame& F) {
    for (int it = F.vcu; it < 8 * 64; it += F.G) s5_fused_item(F, it >> 6, it & 63);
}
__device__ __forceinline__ void s5_sample(Frame& F) {
    const bf16* HN = (const bf16*)(F.ws + WS_XN) + (size_t)MP * D; bf16* GY = (bf16*)(F.ws + WS_BIG + B_GY) + (size_t)MP * D;
    const int n = F.lane;
    const int ntk = (MS * 64 + GW_N(F) - 1) / GW_N(F);
#pragma unroll 4
    for (int tq = 0; tq < ntk; ++tq) { const int task = GW_ID(F) + tq * GW_N(F); if (task >= MS * 64) break; const int j = task >> 6, g = task & 63;
        float abr, abi, cfr, cfi; s5_lambda(F, g, n, abr, abi, cfr, cfi);
        const v4u u0 = *(const GAS v4u*)(HN + (size_t)j * D + 16 * g), u1 = *(const GAS v4u*)(HN + (size_t)j * D + 16 * g + 8);
        float u[16]; u[0] = bflo(u0.x); u[1] = bfhi(u0.x); u[2] = bflo(u0.y); u[3] = bfhi(u0.y); u[4] = bflo(u0.z); u[5] = bfhi(u0.z); u[6] = bflo(u0.w); u[7] = bfhi(u0.w);
        u[8] = bflo(u1.x); u[9] = bfhi(u1.x); u[10] = bflo(u1.y); u[11] = bfhi(u1.y); u[12] = bflo(u1.z); u[13] = bfhi(u1.z); u[14] = bflo(u1.w); u[15] = bfhi(u1.w);
        const float* br = F.a->in[I_BRE] + (size_t)(g * 64 + n) * 16; const float* bi = F.a->in[I_BIM] + (size_t)(g * 64 + n) * 16;
        float bur = 0.f, bui = 0.f;
#pragma unroll
        for (int c = 0; c < 16; ++c) { const float b0 = br[c], b1 = bi[c]; bur += (cfr * b0 - cfi * b1) * u[c]; bui += (cfr * b1 + cfi * b0) * u[c]; }
        const size_t si = ((size_t)j * 64 + g) * 64 + n; const float sr = F.a->in[I_SS5R][si], sim = F.a->in[I_SS5I][si];
        const float xr = abr * sr - abi * sim + bur, xi = abr * sim + abi * sr + bui;
        F.out[O_SS5R + si] = xr; F.out[O_SS5I + si] = xi;
        float ymine = 0.f;
#pragma unroll
        for (int cp = 0; cp < 16; ++cp) { const float part = F.a->in[I_CRE][((size_t)g * 16 + cp) * 64 + n] * xr - F.a->in[I_CIM][((size_t)g * 16 + cp) * 64 + n] * xi; const float tot = wave_sum(part); if (n == cp) ymine = tot; }
        if (n < 16) { float uu = 0.f;
#pragma unroll
            for (int c = 0; c < 16; ++c) uu = (n == c) ? u[c] : uu;
            GY[(size_t)j * D + 16 * g + n] = (bf16)f2bf(gelu_tanh(ymine + F.a->in[I_S5D][16 * g + n] * uu)); }
    }
}

constexpr int CW_BAR = 4096;

struct SkAny { int mode; void* O; int ld;
    __device__ __forceinline__ void operator()(int row, int col, const float (&v)[1]) const { if (mode == 0) ((bf16*)O)[(size_t)row * ld + col] = (bf16)f2bf(v[0]); else ((float*)O)[(size_t)row * ld + col] = v[0]; } };

__global__ void __launch_bounds__(NTHR, 2) fwd_kernel(Args args) {
    extern __shared__ __attribute__((aligned(16))) unsigned char lds[];
    Frame F;
    F.lds = (LAS unsigned char*)lds;
    F.tid = threadIdx.x;
    F.out = args.out; F.ws = args.ws;
    volatile LAS unsigned* MISC = (volatile LAS unsigned*)(F.lds + MISC_OFF);
    for (int u = F.tid; u < (LDS_BYTES - LDSCTL_OFF) / 4; u += NTHR) ((LAS unsigned*)(F.lds + LDSCTL_OFF))[u] = 0u;
    __syncthreads();
    const int lo = args.ph_lo, hi = args.ph_hi;
    if (hi - lo > 1) (void)xcd_barrier_post((unsigned*)(args.ws + WS_CTL) + CW_BAR + args.li * XCD_BAR_WORDS, MISC + 8);
#pragma unroll 1
    for (int ph = lo; ph < hi; ++ph) {
        { int t_ = threadIdx.x; asm volatile("" : "+v"(t_)); F.tid = t_; F.lane = t_ & 63; F.wave = __builtin_amdgcn_readfirstlane(t_ >> 6); }
        { int g_ = gridDim.x, b_ = blockIdx.x; asm volatile("" : "+s"(g_), "+s"(b_)); F.G = g_; F.vcu = (g_ % 8 == 0) ? (b_ % 8) * (g_ / 8) + b_ / 8 : b_; }
        { const CAS Args* ap_ = (const CAS Args*)__builtin_amdgcn_kernarg_segment_ptr(); asm volatile("" : "+s"(ap_)); F.a = ap_; }
        { float* o_ = args.out; unsigned char* w_ = args.ws; asm volatile("" : "+s"(o_), "+s"(w_)); F.out = o_; F.ws = w_; }
        unsigned char* BIG = F.ws + WS_BIG; bf16* XN = (bf16*)(F.ws + WS_XN); bf16* WIN = (bf16*)(F.ws + WS_WIN);
        const bf16* gA = nullptr; const bf16* gAs = nullptr; const bf16* gB = nullptr; int gN = 0, gK = 0, gmode = 0, gld = 0; void* gO = nullptr; void* gOs = nullptr;
        int l = 0, fixl = -1;
        switch (ph) {
            case 0: p0_prologue(F); break;
            case 1: gA = XN; gAs = XN + (size_t)MP * D; gB = WIN; gN = NA; gK = D; gmode = 0; gld = NA; gO = BIG + B_PROJA; gOs = (bf16*)gO + (size_t)MP * NA; break;
            case 2: ssd_state_phase(F); break;
            case 3: ssd_out_phase(F); break;
            case 4: gA = XN; gAs = XN + (size_t)MP * D; gB = WIN + (size_t)NA * D; gN = NBH; gK = D; gmode = 0; gld = NBH; gO = BIG + B_PROJB; gOs = (bf16*)gO + (size_t)MP * NBH; break;
            case 5: hg_state_phase(F); break;
            case 6: hg_out_phase(F); break;
            case 7: gA = (const bf16*)(F.out + O_YP); gAs = (const bf16*)(F.ws + WS_MIXS); gB = (const bf16*)(F.ws + WS_WOUT); gN = D; gK = 2048; gmode = 0; gld = D; gO = BIG + B_M1; gOs = (bf16*)gO + (size_t)MP * D; break;
            case 8: resid_norm_rows(F, (const bf16*)(BIG + B_M1), F.a->in[I_NMPOST], F.a->in[I_NFPRE], 0); break;
            case 15: l = 1; [[fallthrough]];
            case 9: gA = XN; gAs = XN + (size_t)MP * D; gB = (const bf16*)(F.ws + WS_WUP) + (size_t)l * FF2 * D; gN = FF2; gK = D; gmode = 3; gld = FF2; gO = BIG + B_ACT; gOs = BIG + B_ACT; break;
            case 16: l = 1; [[fallthrough]];
            case 10: gA = (const bf16*)(BIG + B_ACT); gAs = gA + (size_t)MP * FF; gB = (const bf16*)(F.ws + WS_WDN) + (size_t)l * D * FF; gN = D; gK = FF; gmode = 0; gld = D; gO = BIG + B_M1; gOs = (bf16*)gO + (size_t)MP * D; fixl = l; break;
            case 11: resid_norm_rows(F, (const bf16*)(BIG + B_M1), F.a->in[I_NFPOST], F.a->in[I_NMPRE] + D, 1);
                     for (int g = F.vcu; g < 64; g += F.G) s5_tables_item(F, g);
                     break;
            case 12: s5_fused_phase(F); s5_sample(F); break;
            case 13: gA = (const bf16*)(BIG + B_GY); gAs = gA + (size_t)MP * D; gB = (const bf16*)(F.ws + WS_WGLU); gN = 2048; gK = D; gmode = 2; gld = D; gO = BIG + B_M1G; gOs = (bf16*)gO + (size_t)MP * D; break;
            case 14: resid_norm_rows(F, (const bf16*)(BIG + B_M1G), F.a->in[I_NMPOST] + D, F.a->in[I_NFPRE] + D, 1); break;
            case 17: resid_norm_rows(F, (const bf16*)(BIG + B_M1), F.a->in[I_NFPOST] + D, nullptr, 2); break;
            default: break;
        }
        if (gA) {
            pg8::Gemm g{gA, gB, MP, gN, gK}; pg8::StaticOrder S; S.init(MP, gN, F.G, (int)blockIdx.x);
            if (fixl >= 0) { pg8::Unit u0; for (int i = 0; S.next(i, u0); ++i) ffn_fix_rows(F, fixl, u0.pm);
                asm volatile("s_waitcnt vmcnt(0)" ::: "memory"); __syncthreads(); }
            pg8::EpiConvGate cg{(pg8::bf16_t*)(BIG + B_ACT), F.a->in[I_FCW] + (size_t)l * 3 * FF2, F.a->in[I_FCB] + (size_t)l * FF2, (float*)(BIG + B_HEAD), (float*)(BIG + B_TAIL), (PG8_LAS float*)(F.lds + HALO_OFF), F.out + O_PFC + (size_t)l * 8 * 2 * FF2};
            pg8::gemm_phase<pg8::EpiAny, pg8::StaticOrder, true, true>(F.lds, g, S, pg8::EpiAny{gmode, gmode == 0 || gmode == 3, gO, gld, cg}, F.tid);
            __syncthreads();
            const int nrem = ((MP / 256) * (gN / 256)) % F.G, tb = nrem ? (int)blockIdx.x - nrem : (int)blockIdx.x, tstr = nrem ? F.G - nrem : F.G;
            if (gmode == 2) skinny_gemm<2, true>(F, gAs, gK, gB, gK, D / 32, SkGlu{(bf16*)gOs, gld}, tb, tstr);
            else if (gmode == 3) skinny_gemm<2, true>(F, gAs, gK, gB, gK, FF / 32, SkConvGate{(bf16*)(BIG + B_ACT) + (size_t)MP * FF, F.a->in[I_FCW] + (size_t)l * 3 * FF2, F.a->in[I_FCB] + (size_t)l * FF2, F.a->in[I_SFC] + (size_t)l * MS * 2 * FF2, F.out + O_SFC + (size_t)l * MS * 2 * FF2}, tb, tstr);
            else skinny_gemm<1, false>(F, gAs, gK, gB, gK, gN / 32, SkAny{gmode, gOs, gld}, tb, tstr);
        }
        if (ph + 1 < hi) { XcdBarrier b2; b2.bar = (unsigned*)(F.ws + WS_CTL) + CW_BAR + F.a->li * XCD_BAR_WORDS; b2.x = xb_xcc_id(); b2.st = (volatile LAS unsigned*)(F.lds + MISC_OFF) + 8; xcd_barrier(b2); }
    }
}

extern "C" void kernel_launch(void* const* d_in, const int* in_sizes, int n_in, void* d_out, int out_size, void* d_ws, size_t ws_size, hipStream_t stream) {
    static int grid = 0;
    if (grid == 0) {
        if (n_in != N_IN || out_size != (int)O_END || ws_size < WS_END) { fprintf(stderr, "kernel_launch: unexpected shapes (n_in %d, out %d, ws %zu)\n", n_in, out_size, ws_size); grid = -1; return; }
        int dev = 0, cus = 0, per_cu = 0;
        if (hipGetDevice(&dev) != hipSuccess || hipDeviceGetAttribute(&cus, hipDeviceAttributeMultiprocessorCount, dev) != hipSuccess) { grid = -1; return; }
        if (hipFuncSetAttribute((const void*)fwd_kernel, hipFuncAttributeMaxDynamicSharedMemorySize, LDS_BYTES) != hipSuccess) { fprintf(stderr, "kernel_launch: hipFuncSetAttribute failed\n"); grid = -1; return; }
        if (hipOccupancyMaxActiveBlocksPerMultiprocessor(&per_cu, (const void*)fwd_kernel, NTHR, LDS_BYTES) != hipSuccess || per_cu < 1) fprintf(stderr, "kernel_launch: occupancy query says %d\n", per_cu);
        (void)hipGetLastError();
        if (per_cu < 1) { fprintf(stderr, "kernel_launch: the kernel does not fit a CU\n"); grid = -1; return; }
        grid = cus;
    }
    if (grid < 0) return;
    (void)hipMemsetAsync((char*)d_ws + WS_CTL, 0, CTL_BYTES, stream);
    Args a{};
    for (int i = 0; i < 35; ++i) a.in[i] = (const float*)d_in[i];
    a.out = (float*)d_out; a.ws = (unsigned char*)d_ws;
#if PROBE_PH >= 0
    a.ph_lo = 0; a.ph_hi = PROBE_PH + 1; a.li = 0; hipLaunchKernelGGL(fwd_kernel, dim3(grid), dim3(NTHR), LDS_BYTES, stream, a);
    for (int rep = 0; rep < PROBE_REPS; ++rep) { a.ph_lo = PROBE_PH; a.ph_hi = PROBE_PH + 1; a.li = 1; hipLaunchKernelGGL(fwd_kernel, dim3(grid), dim3(NTHR), LDS_BYTES, stream, a); }
    if (PROBE_PH + 1 < NPH) { a.ph_lo = PROBE_PH + 1; a.ph_hi = NPH; a.li = 2; hipLaunchKernelGGL(fwd_kernel, dim3(grid), dim3(NTHR), LDS_BYTES, stream, a); }
#elif MK_ONE_LAUNCH
    a.ph_lo = 0; a.ph_hi = NPH; a.li = 0;
    { void* kargs[] = {&a};
      if (hipLaunchCooperativeKernel((const void*)fwd_kernel, dim3(grid), dim3(NTHR), kargs, LDS_BYTES, stream) != hipSuccess) { (void)hipGetLastError(); fprintf(stderr, "kernel_launch: cooperative launch refused\n"); } }
#else
    for (int p = 0; p < NPH; ++p) { a.ph_lo = p; a.ph_hi = p + 1; a.li = 0; hipLaunchKernelGGL(fwd_kernel, dim3(grid), dim3(NTHR), LDS_BYTES, stream, a); }
#endif
}
```

```cpp
#include <hip/hip_runtime.h>
#include <cstdio>
#include <cstdint>

#ifndef PROBE_PH
#define PROBE_PH -1
#endif
#ifndef PROBE_REPS
#define PROBE_REPS 1
#endif
#ifndef MK_ONE_LAUNCH
#define MK_ONE_LAUNCH 1
#endif

__device__ __forceinline__ float dpp_add_(float v, const int ctrl_sel) {
    const int b = __builtin_bit_cast(int, v); int r;
    if (ctrl_sel == 0) r = __builtin_amdgcn_update_dpp(0, b, 0xB1, 0xf, 0xf, true); else if (ctrl_sel == 1) r = __builtin_amdgcn_update_dpp(0, b, 0x4E, 0xf, 0xf, true);
    else if (ctrl_sel == 2) r = __builtin_amdgcn_update_dpp(0, b, 0x141, 0xf, 0xf, true); else r = __builtin_amdgcn_update_dpp(0, b, 0x140, 0xf, 0xf, true);
    return v + __builtin_bit_cast(float, r); }
__device__ __forceinline__ float row16_sum(float v) { v = dpp_add_(v, 0); v = dpp_add_(v, 1); v = dpp_add_(v, 2); v = dpp_add_(v, 3); return v; }
__device__ __forceinline__ float wave_sum(float v) {
    v = row16_sum(v);
    v += __builtin_bit_cast(float, __builtin_amdgcn_update_dpp(0, __builtin_bit_cast(int, v), 0x142, 0xa, 0xf, false));
    v += __builtin_bit_cast(float, __builtin_amdgcn_update_dpp(0, __builtin_bit_cast(int, v), 0x143, 0xc, 0xf, false));
    return __builtin_bit_cast(float, __builtin_amdgcn_readlane(__builtin_bit_cast(int, v), 63)); }
__device__ __forceinline__ int lane_op_() { int l = __builtin_amdgcn_mbcnt_hi(-1, __builtin_amdgcn_mbcnt_lo(-1, 0)); asm volatile("" : "+v"(l)); return l; }
__device__ __forceinline__ float shx_(float v, int o, int l) { return __builtin_bit_cast(float, __builtin_amdgcn_ds_bpermute((l ^ o) << 2, __builtin_bit_cast(int, v))); }
__device__ __forceinline__ float shup_(float v, int off, int width, int l) { const int src = ((l & (width - 1)) >= off) ? l - off : l; return __builtin_bit_cast(float, __builtin_amdgcn_ds_bpermute(src << 2, __builtin_bit_cast(int, v))); }
__device__ __forceinline__ float shidx_(float v, int src, int width, int l) { return __builtin_bit_cast(float, __builtin_amdgcn_ds_bpermute(((l & ~(width - 1)) + src) << 2, __builtin_bit_cast(int, v))); }
namespace pg8 {
#define PG8_LAS __attribute__((address_space(3)))
typedef unsigned short bf16_t;
typedef short bf16x8 __attribute__((ext_vector_type(8)));
typedef float f32x4 __attribute__((ext_vector_type(4)));
typedef unsigned u32x4 __attribute__((ext_vector_type(4)));
typedef float f32x2 __attribute__((ext_vector_type(2)));
constexpr int BM = 256, BK = 64, HALF = 128, HTB = HALF * BK * 2  , STAGE_BYTES = 8 * HTB, NXCD = 8, WGM = 8;

__host__ __device__ __forceinline__ int lds_byte(int r, int c) { const int st = (r >> 4) * 2 + (c >> 5), rr = r & 15, cc = c & 31, ob = rr * 64 + cc * 2; return st * 1024 + (ob ^ (((ob >> 9) & 1) << 5)); }
__host__ __device__ __forceinline__ void stage_rc(int b, int& R, int& C) { const int st = b / 1024, sb = b % 1024, swz = sb ^ (((sb >> 9) & 1) << 5); R = (st >> 1) * 16 + swz / 64; C = (st & 1) * 32 + (swz % 64) / 2; }
__host__ __device__ __forceinline__ int perm32(int rho) { const int n = rho >> 4, i = rho & 15; return 8 * (i >> 2) + 4 * n + (i & 3); }

struct Unit { int pm, pn; };
struct Gemm { const bf16_t* A; const bf16_t* Bt; int M, N, K; };

struct StaticOrder {
    int nM, nN, nwg, G, c;
    __host__ __device__ void init(int M, int N, int G_, int c_) { nM = M / BM; nN = N / BM; nwg = nM * nN; G = G_; c = c_; }
    __host__ __device__ bool next(int i, Unit& u) const {
        const long L = (long)i * G + c; if (L >= nwg) return false;
        int wgid = (int)L; { const int q = nwg / NXCD, r = nwg % NXCD, xcd = wgid % NXCD, off = wgid / NXCD; wgid = (xcd < r ? xcd * (q + 1) : r * (q + 1) + (xcd - r) * q) + off; }
        const int nig = WGM * nN, gid = wgid / nig, fm = gid * WGM, gsz = (nM - fm) < WGM ? (nM - fm) : WGM;
        u.pm = fm + ((wgid % nig) % gsz); u.pn = (wgid % nig) / gsz; return true;
    }
    __device__ __forceinline__ void a_ready(const Unit&) const {}
    __device__ __forceinline__ void done(const Unit&) const {}
};

__device__ __forceinline__ unsigned cvt_pk_bf16(float lo, float hi) { unsigned r; asm volatile("v_cvt_pk_bf16_f32 %0, %1, %2" : "=v"(r) : "v"(lo), "v"(hi)); return r; }

struct EpiF32 {
    static constexpr bool PERM = false, AFTER_DRAIN = false;
    float* C; int ldc;
    __device__ __forceinline__ void operator()(const f32x4 (&acc)[2][2][4][2], const Unit& u, int wr, int wc, int fr, int fq) const {
        const int row0 = u.pm * BM + wr * 64 + fr, col0 = u.pn * BM + wc * 32 + 4 * fq;
#pragma unroll
        for (int ai = 0; ai < 2; ++ai)
#pragma unroll
            for (int m = 0; m < 4; ++m) { float* rowp = C + (size_t)(row0 + ai * HALF + m * 16) * ldc + col0;
#pragma unroll
                for (int bj = 0; bj < 2; ++bj)
#pragma unroll
                    for (int n = 0; n < 2; ++n) *(f32x4*)(rowp + bj * HALF + n * 16) = acc[ai][bj][m][n]; }
    }
};
struct EpiBf16 {
    static constexpr bool PERM = true, AFTER_DRAIN = false;
    bf16_t* O; int ldc;
    __device__ __forceinline__ void operator()(const f32x4 (&acc)[2][2][4][2], const Unit& u, int wr, int wc, int fr, int fq) const {
        const int row0 = u.pm * BM + wr * 64 + fr, col0 = u.pn * BM + wc * 32 + 8 * fq;
#pragma unroll
        for (int ai = 0; ai < 2; ++ai)
#pragma unroll
            for (int m = 0; m < 4; ++m) { bf16_t* rowp = O + (size_t)(row0 + ai * HALF + m * 16) * ldc + col0;
#pragma unroll
                for (int bj = 0; bj < 2; ++bj) { const f32x4 v0 = acc[ai][bj][m][0], v1 = acc[ai][bj][m][1];
                    u32x4 w; w.x = cvt_pk_bf16(v0[0], v0[1]); w.y = cvt_pk_bf16(v0[2], v0[3]); w.z = cvt_pk_bf16(v1[0], v1[1]); w.w = cvt_pk_bf16(v1[2], v1[3]);
                    *(u32x4*)(rowp + bj * HALF) = w; } }
    }
};
struct EpiGlu {
    static constexpr bool PERM = false, AFTER_DRAIN = false;
    bf16_t* C; int ldc;
    __device__ __forceinline__ void operator()(const f32x4 (&acc)[2][2][4][2], const Unit& u, int wr, int wc, int fr, int fq) const {
        const int row0 = u.pm * BM + wr * 64 + fr, col0 = u.pn * HALF + wc * 32 + 4 * fq;
        typedef unsigned u32x2g __attribute__((ext_vector_type(2)));
#pragma unroll
        for (int ai = 0; ai < 2; ++ai)
#pragma unroll
            for (int m = 0; m < 4; ++m) { bf16_t* rowp = C + (size_t)(row0 + ai * HALF + m * 16) * ldc + col0;
#pragma unroll
                for (int n = 0; n < 2; ++n) { const f32x4 v = acc[ai][0][m][n], g = acc[ai][1][m][n]; float o[4];
#pragma unroll
                    for (int j = 0; j < 4; ++j) o[j] = v[j] * __builtin_amdgcn_rcpf(1.0f + __expf(-g[j]));
                    u32x2g w; w.x = cvt_pk_bf16(o[0], o[1]); w.y = cvt_pk_bf16(o[2], o[3]); *(u32x2g*)(rowp + n * 16) = w; } }
    }
};


__device__ __forceinline__ float dpp_shr1(float old, float src) { return __builtin_bit_cast(float, __builtin_amdgcn_update_dpp(__builtin_bit_cast(int, old), __builtin_bit_cast(int, src), 0x111, 0xf, 0xf, false)); }
__device__ __forceinline__ float dpp_shr2(float old, float src) { return __builtin_bit_cast(float, __builtin_amdgcn_update_dpp(__builtin_bit_cast(int, old), __builtin_bit_cast(int, src), 0x112, 0xf, 0xf, false)); }
__device__ __forceinline__ float dpp_ror1(float src) { return __builtin_bit_cast(float, __builtin_amdgcn_update_dpp(0, __builtin_bit_cast(int, src), 0x121, 0xf, 0xf, false)); }
__device__ __forceinline__ float dpp_ror2(float src) { return __builtin_bit_cast(float, __builtin_amdgcn_update_dpp(0, __builtin_bit_cast(int, src), 0x122, 0xf, 0xf, false)); }
struct EpiConvGate {
    bf16_t* ACT; const float* cw; const float* cb; float* HEAD; float* TAIL; PG8_LAS float* HALO; float* PFC;
    __device__ __forceinline__ void operator()(const f32x4 (&acc)[2][2][4][2], const Unit& u, int wr, int wc, int fr, int fq) const {
        constexpr int FF_ = 2816, FF2_ = 5632;
        asm volatile("" : "+v"(fr), "+v"(fq));
        const int colt = wc * 32 + 8 * fq;
        if (fr >= 14) {
#pragma unroll
            for (int ai = 0; ai < 2; ++ai)
#pragma unroll
                for (int bj = 0; bj < 2; ++bj)
#pragma unroll
                    for (int n = 0; n < 2; ++n) { *(PG8_LAS f32x4*)(HALO + ((ai * 2 + wr) * 2 + (fr - 14)) * 256 + bj * 128 + colt + 4 * n) = acc[ai][bj][3][n];
                        if (ai == 1 && wr == 1) { *(f32x4*)(TAIL + ((size_t)u.pm * 2 + (fr - 14)) * FF2_ + bj * FF_ + u.pn * 128 + colt + 4 * n) = acc[1][bj][3][n];
                            if ((u.pm & 7) == 7) *(f32x4*)(PFC + ((size_t)(u.pm >> 3) * 2 + (fr - 14)) * FF2_ + bj * FF_ + u.pn * 128 + colt + 4 * n) = acc[1][bj][3][n]; } } }
        if (fr < 2 && wr == 0) {
#pragma unroll
            for (int bj = 0; bj < 2; ++bj)
#pragma unroll
                for (int n = 0; n < 2; ++n) *(f32x4*)(HEAD + ((size_t)u.pm * 2 + fr) * FF2_ + bj * FF_ + u.pn * 128 + colt + 4 * n) = acc[0][bj][0][n]; }
        { PG8_LAS float* WL = HALO + 2048;
          const int tid_ = (wr * 4 + wc) * 64 + fq * 16 + fr, e = 2 * tid_, arr = e >> 8, c = e & 255;
          const float* src = (arr < 3 ? cw + arr * FF2_ : cb) + (c < 128 ? u.pn * 128 + c : FF_ + u.pn * 128 + (c - 128));
          *(PG8_LAS f32x2*)(WL + e) = *(const __attribute__((address_space(1))) f32x2*)src; }
        asm volatile("s_waitcnt vmcnt(0) lgkmcnt(0)" ::: "memory"); __builtin_amdgcn_s_barrier(); asm volatile("" ::: "memory");
        const PG8_LAS float* WL = HALO + 2048;
        typedef unsigned u32x2 __attribute__((ext_vector_type(2)));
#pragma unroll
        for (int ai = 0; ai < 2; ++ai) {
            const int pred = wr == 1 ? (ai * 2 + 0) : (0 * 2 + 1);
            const bool nohist = (ai == 0 && wr == 0);
            const int row0 = u.pm * BM + ai * HALF + wr * 64 + fr;
#pragma unroll
            for (int n = 0; n < 2; ++n) {
                unsigned pk[4][2];
#pragma unroll
                for (int jp = 0; jp < 2; ++jp) {
                    float gsil[4][2];
#pragma unroll
                    for (int bj = 1; bj >= 0; --bj) { const int wc_ = bj * 128 + colt + 4 * n + 2 * jp;
                        const f32x2 w0 = *(const PG8_LAS f32x2*)(WL + wc_), w1 = *(const PG8_LAS f32x2*)(WL + 256 + wc_), w2 = *(const PG8_LAS f32x2*)(WL + 512 + wc_), bb = *(const PG8_LAS f32x2*)(WL + 768 + wc_);
                        const f32x2 h0 = *(const PG8_LAS f32x2*)(HALO + (pred * 2 + 0) * 256 + bj * 128 + colt + 4 * n + 2 * jp), h1 = *(const PG8_LAS f32x2*)(HALO + (pred * 2 + 1) * 256 + bj * 128 + colt + 4 * n + 2 * jp);
#pragma unroll
                        for (int m = 0; m < 4; ++m) { float r[2];
#pragma unroll
                            for (int jj = 0; jj < 2; ++jj) { const int j = 2 * jp + jj; const float cur = acc[ai][bj][m][n][j];
                                const float x1 = m == 0 ? h1[jj] : dpp_ror1(acc[ai][bj][m == 0 ? 0 : m - 1][n][j]);
                                const float x2 = m == 0 ? (fr == 0 ? h0[jj] : h1[jj]) : dpp_ror2(acc[ai][bj][m == 0 ? 0 : m - 1][n][j]);
                                const float p1 = dpp_shr1(x1, cur), p2 = dpp_shr2(x2, cur);
                                r[jj] = bb[jj] + w0[jj] * p2 + w1[jj] * p1 + w2[jj] * cur; }
                            if (bj == 1) { gsil[m][0] = r[0] * __builtin_amdgcn_rcpf(1.0f + __expf(-r[0])); gsil[m][1] = r[1] * __builtin_amdgcn_rcpf(1.0f + __expf(-r[1])); }
                            else pk[m][jp] = cvt_pk_bf16(r[0] * gsil[m][0], r[1] * gsil[m][1]); }
                    }
                }
#pragma unroll
                for (int m = 0; m < 4; ++m) { if (nohist && m == 0 && fr < 2) continue;
                    u32x2 w; w.x = pk[m][0]; w.y = pk[m][1]; *(u32x2*)(ACT + (size_t)(row0 + m * 16) * FF_ + u.pn * 128 + colt + 4 * n) = w; }
                asm volatile("" ::: "memory");
            }
        }
    }
};
struct EpiAny {
    static constexpr bool AFTER_DRAIN = false;
    int mode; bool perm; void* O; int ldc; EpiConvGate cg;
    __device__ __forceinline__ void operator()(const f32x4 (&acc)[2][2][4][2], const Unit& u, int wr, int wc, int fr, int fq) const {
        if (mode == 0) { EpiBf16 e{(bf16_t*)O, ldc}; e(acc, u, wr, wc, fr, fq); }
        else if (mode == 1) { EpiF32 e{(float*)O, ldc}; e(acc, u, wr, wc, fr, fq); }
        else if (mode == 2) { EpiGlu e{(bf16_t*)O, ldc}; e(acc, u, wr, wc, fr, fq); }
        else cg(acc, u, wr, wc, fr, fq);
    }
};
template <class Epi, class Sched, bool ALIGN_EPI = false, bool SP2 = false>
__device__ __forceinline__ void gemm_phase(PG8_LAS unsigned char* lds, const Gemm g, const Sched& S, const Epi& E, const int tid) {
    const int wid = __builtin_amdgcn_readfirstlane(tid >> 6), lane = tid & 63, wr = wid >> 2, wc = wid & 3, fr = lane & 15, fq = lane >> 4;
    const int K = g.K, nt = K / BK;
    unsigned voffA[2], voffB[2];
#pragma unroll
    for (int i = 0; i < 2; ++i) { int R, C; stage_rc(tid * 16 + i * 8192, R, C); const int Rb = E.perm ? ((R & ~31) + perm32(R & 31)) : R;
        voffA[i] = (unsigned)(R * K + C) * 2u; voffB[i] = (unsigned)(Rb * K + C) * 2u; }
    const size_t kstep = (size_t)(BK * 2);
    const size_t hstep = (size_t)HALF * K * 2;
    const size_t tstep = 2 * hstep;
    const unsigned ldsw = (unsigned)wid * 1024u;
    const int aoff = lds_byte(wr * 64 + fr, fq * 8), boff = lds_byte(wc * 32 + fr, fq * 8);
#define PG8_SA(b, h) (((b) * 2 + (h)) * HTB)
#define PG8_SB(b, h) ((4 + (b) * 2 + (h)) * HTB)
#define PG8_STAGE(bufoff, gbase, voff) do { _Pragma("unroll") for (int _i = 0; _i < 2; ++_i) \
        __builtin_amdgcn_global_load_lds((const unsigned*)((const char*)(gbase) + (voff)[_i]), (PG8_LAS unsigned*)(lds + (bufoff) + ldsw + _i * 8192), 16, 0, 0); } while (0)
#define PG8_LDA(dst, b, h) do { _Pragma("unroll") for (int m = 0; m < 4; ++m) _Pragma("unroll") for (int k = 0; k < 2; ++k) dst[m][k] = *(const PG8_LAS bf16x8*)(lds + PG8_SA(b, h) + aoff + m * 2048 + k * 1024); } while (0)
#define PG8_LDB(dst, b, h) do { _Pragma("unroll") for (int n = 0; n < 2; ++n) _Pragma("unroll") for (int k = 0; k < 2; ++k) dst[n][k] = *(const PG8_LAS bf16x8*)(lds + PG8_SB(b, h) + boff + n * 2048 + k * 1024); } while (0)
#define PG8_MMA(ai, bj, At, Bt) do { __builtin_amdgcn_s_setprio(1); _Pragma("unroll") for (int m = 0; m < 4; ++m) _Pragma("unroll") for (int n = 0; n < 2; ++n) _Pragma("unroll") for (int k = 0; k < 2; ++k) \
        acc[ai][bj][m][n] = __builtin_amdgcn_mfma_f32_16x16x32_bf16(Bt[n][k], At[m][k], acc[ai][bj][m][n], 0, 0, 0); __builtin_amdgcn_s_setprio(0); } while (0)
#define PG8_WAIT_V(n) asm volatile("s_waitcnt vmcnt(" #n ")" ::: "memory")
#define PG8_WAIT_L(n) asm volatile("s_waitcnt lgkmcnt(" #n ")" ::: "memory")
#define PG8_BAR __builtin_amdgcn_s_barrier()
#define PG8_SCHED __builtin_amdgcn_sched_barrier(0)
    Unit cur, nxt; int ui = 0;
    if (!S.next(0, cur)) return;
    f32x4 acc[2][2][4][2];
#pragma unroll
    for (int a = 0; a < 2; ++a)
#pragma unroll
        for (int b = 0; b < 2; ++b)
#pragma unroll
            for (int m = 0; m < 4; ++m)
#pragma unroll
                for (int n = 0; n < 2; ++n) acc[a][b][m][n] = (f32x4){0.f, 0.f, 0.f, 0.f};
    bf16x8 At[4][2], B0[2][2], B1[2][2];
    const char* cA = (const char*)g.A + (size_t)cur.pm * tstep; const char* cB = (const char*)g.Bt + (size_t)cur.pn * tstep;
    S.a_ready(cur);
    if constexpr (SP2) {
        PG8_STAGE(PG8_SB(0, 0), cB, voffB); PG8_STAGE(PG8_SB(0, 1), cB + hstep, voffB); PG8_STAGE(PG8_SA(0, 0), cA, voffA); PG8_STAGE(PG8_SA(0, 1), cA + hstep, voffA);
        if (wr == 1) PG8_BAR;
        PG8_WAIT_V(2); PG8_BAR;
        PG8_STAGE(PG8_SB(1, 0), cB + kstep, voffB); PG8_STAGE(PG8_SA(1, 0), cA + kstep, voffA); PG8_STAGE(PG8_SB(1, 1), cB + hstep + kstep, voffB);
        PG8_WAIT_V(6); PG8_BAR;
    } else {
        PG8_STAGE(PG8_SB(0, 0), cB, voffB); PG8_STAGE(PG8_SA(0, 0), cA, voffA); PG8_STAGE(PG8_SB(0, 1), cB + hstep, voffB); PG8_STAGE(PG8_SA(0, 1), cA + hstep, voffA);
        if (wr == 1) PG8_BAR;
        PG8_WAIT_V(4); PG8_BAR;
        PG8_STAGE(PG8_SB(1, 0), cB + kstep, voffB); PG8_STAGE(PG8_SA(1, 0), cA + kstep, voffA); PG8_STAGE(PG8_SB(1, 1), cB + hstep + kstep, voffB);
        PG8_WAIT_V(6); PG8_BAR;
    }
    for (;;) {
        const bool has_next = S.next(ui + 1, nxt);
        const char* nA = has_next ? (const char*)g.A + (size_t)nxt.pm * tstep : cA; const char* nB = has_next ? (const char*)g.Bt + (size_t)nxt.pn * tstep : cB;
        for (int t = 0; t < nt; t += 2) {
            const bool last = (t == nt - 2);
            const char* a1 = cA + (size_t)(t + 1) * kstep;
            const char* a2 = last ? nA : cA + (size_t)(t + 2) * kstep; const char* b2 = last ? nB : cB + (size_t)(t + 2) * kstep;
            const char* a3 = a2 + kstep; const char* b3 = b2 + kstep;
            if (last && has_next) S.a_ready(nxt);
            if constexpr (SP2) {
            PG8_LDB(B0, 0, 0); PG8_LDB(B1, 0, 1); PG8_SCHED; PG8_LDA(At, 0, 0); PG8_STAGE(PG8_SA(1, 1), a1 + hstep, voffA);
            PG8_WAIT_V(8); PG8_WAIT_L(0); PG8_BAR; PG8_MMA(0, 0, At, B0); PG8_MMA(0, 1, At, B1); PG8_BAR; PG8_SCHED;
            PG8_LDA(At, 0, 1); PG8_STAGE(PG8_SB(0, 0), b2, voffB); PG8_STAGE(PG8_SB(0, 1), b2 + hstep, voffB); PG8_STAGE(PG8_SA(0, 0), a2, voffA);
            PG8_WAIT_V(8); PG8_WAIT_L(0); PG8_BAR; PG8_MMA(1, 0, At, B0); PG8_MMA(1, 1, At, B1); PG8_BAR; PG8_SCHED;
            PG8_LDB(B0, 1, 0); PG8_LDB(B1, 1, 1); PG8_SCHED; PG8_LDA(At, 1, 0); PG8_STAGE(PG8_SA(0, 1), a2 + hstep, voffA);
            PG8_WAIT_V(8); PG8_WAIT_L(0); PG8_BAR; PG8_MMA(0, 0, At, B0); PG8_MMA(0, 1, At, B1); PG8_BAR; PG8_SCHED;
            PG8_LDA(At, 1, 1); PG8_STAGE(PG8_SB(1, 0), b3, voffB); PG8_STAGE(PG8_SB(1, 1), b3 + hstep, voffB); PG8_STAGE(PG8_SA(1, 0), a3, voffA);
            PG8_WAIT_V(8); PG8_WAIT_L(0); PG8_BAR; PG8_MMA(1, 0, At, B0); PG8_MMA(1, 1, At, B1); PG8_BAR; PG8_SCHED;
            } else {
            PG8_LDB(B0, 0, 0); PG8_SCHED; PG8_LDA(At, 0, 0); PG8_STAGE(PG8_SA(1, 1), a1 + hstep, voffA);
            PG8_WAIT_L(8); PG8_BAR; PG8_WAIT_L(0); PG8_MMA(0, 0, At, B0); PG8_BAR; PG8_SCHED;
            PG8_LDB(B1, 0, 1); PG8_STAGE(PG8_SB(0, 0), b2, voffB);
            PG8_BAR; PG8_WAIT_L(0); PG8_MMA(0, 1, At, B1); PG8_BAR;
            PG8_LDA(At, 0, 1); PG8_STAGE(PG8_SA(0, 0), a2, voffA);
            PG8_BAR; PG8_WAIT_L(0); PG8_MMA(1, 0, At, B0); PG8_BAR; PG8_SCHED;
            PG8_STAGE(PG8_SB(0, 1), b2 + hstep, voffB);
            PG8_WAIT_V(6); PG8_BAR; PG8_MMA(1, 1, At, B1); PG8_BAR;
            PG8_LDB(B0, 1, 0); PG8_SCHED; PG8_LDA(At, 1, 0); PG8_STAGE(PG8_SA(0, 1), a2 + hstep, voffA);
            PG8_WAIT_L(8); PG8_BAR; PG8_WAIT_L(0); PG8_MMA(0, 0, At, B0); PG8_BAR; PG8_SCHED;
            PG8_LDB(B1, 1, 1); PG8_STAGE(PG8_SB(1, 0), b3, voffB);
            PG8_BAR; PG8_WAIT_L(0); PG8_MMA(0, 1, At, B1); PG8_BAR;
            PG8_LDA(At, 1, 1); PG8_STAGE(PG8_SA(1, 0), a3, voffA);
            PG8_BAR; PG8_WAIT_L(0); PG8_MMA(1, 0, At, B0); PG8_BAR; PG8_SCHED;
            PG8_STAGE(PG8_SB(1, 1), b3 + hstep, voffB);
            PG8_WAIT_V(6); PG8_BAR; PG8_MMA(1, 1, At, B1); PG8_BAR;
            }
        }
        if constexpr (ALIGN_EPI) { if (wr == 0) PG8_BAR; }
        if constexpr (!Epi::AFTER_DRAIN) { E(acc, cur, wr, wc, fr, fq); S.done(cur); }
        if (!has_next) break;
#pragma unroll
        for (int a = 0; a < 2; ++a)
#pragma unroll
            for (int b = 0; b < 2; ++b)
#pragma unroll
                for (int m = 0; m < 4; ++m)
#pragma unroll
                    for (int n = 0; n < 2; ++n) acc[a][b][m][n] = (f32x4){0.f, 0.f, 0.f, 0.f};
        cur = nxt; cA = nA; cB = nB; ++ui;
        if constexpr (ALIGN_EPI) { if (wr == 1) PG8_BAR; }
    }
    PG8_WAIT_V(0);
    if constexpr (!ALIGN_EPI) { if (wr == 0) PG8_BAR; }
    PG8_BAR;
    if constexpr (Epi::AFTER_DRAIN) { E.fused(acc, cur, wr, wc, fr, fq, lds, wid, lane); S.done(cur); }
#undef PG8_SA
#undef PG8_SB
#undef PG8_STAGE
#undef PG8_LDA
#undef PG8_LDB
#undef PG8_MMA
#undef PG8_WAIT_V
#undef PG8_WAIT_L
#undef PG8_BAR
#undef PG8_SCHED
}
}

constexpr int NWAVES = 8, NTHR = 512;
constexpr int D = 1024, NB = 8, SEQ = 2048, MP = NB * SEQ, MS = 128, MT = MP + MS;
constexpr int NA = 2560, NBH = 4096;
constexpr int WIN_ROWS = NA + NBH;
constexpr int XBC = 1280, ABIN = 6416;
constexpr int FF = 2816, FF2 = 5632, NFT = 22;
constexpr float EPS = 1e-6f;
constexpr int NPH = 18;

constexpr size_t O_YP = 0, O_YS = O_YP + (size_t)MP * D, O_PSSM = O_YS + (size_t)MS * D, O_PSCONV = O_PSSM + 8 * 16 * 64 * 64, O_PHG = O_PSCONV + 8 * 3 * XBC,
                 O_PS5R = O_PHG + 8 * 8 * 128 * 128, O_PS5I = O_PS5R + 8 * 64 * 64, O_PFC = O_PS5I + 8 * 64 * 64, O_SSSM = O_PFC + 2 * 8 * 2 * FF2,
                 O_SSCONV = O_SSSM + (size_t)MS * 16 * 64 * 64, O_SHG = O_SSCONV + (size_t)MS * 3 * XBC, O_SS5R = O_SHG + (size_t)MS * 8 * 128 * 128,
                 O_SS5I = O_SS5R + (size_t)MS * 64 * 64, O_SFC = O_SS5I + (size_t)MS * 64 * 64, O_END = O_SFC + (size_t)2 * MS * 2 * FF2;
static_assert(O_END == 48347136, "d_out size");

constexpr size_t al256(size_t x) { return (x + 255) & ~(size_t)255; }
constexpr size_t WS_CTL = 0, CTL_BYTES = 1u << 20;
constexpr size_t WS_WIN = CTL_BYTES;
constexpr size_t WS_WOUT = WS_WIN + (size_t)WIN_ROWS * D * 2;
constexpr size_t WS_WGLU = WS_WOUT + (size_t)D * 2048 * 2;
constexpr size_t WS_WUP = WS_WGLU + (size_t)2048 * D * 2;
constexpr size_t WS_WDN = WS_WUP + (size_t)2 * FF2 * D * 2;
constexpr size_t WS_XN = WS_WDN + (size_t)2 * D * FF * 2;
constexpr size_t WS_MIXS = WS_XN + (size_t)MT * D * 2;
constexpr size_t WS_BIG = al256(WS_MIXS + (size_t)MS * 2048 * 2);
constexpr size_t WS_END = (size_t)256 << 20;
constexpr size_t BIG_BYTES = WS_END - WS_BIG;
constexpr size_t B_PROJA = 0;
constexpr size_t B_Y2 = al256(B_PROJA + (size_t)MT * NA * 2);
constexpr size_t B_ORAW = 0;
constexpr size_t B_PROJB = al256(B_ORAW + (size_t)MT * D * 2);
constexpr size_t B_M1 = 0;
constexpr size_t B_UP = 0;
constexpr size_t B_ACT = al256((size_t)MT * 2048 * 2);
constexpr size_t B_GY = 0;
constexpr size_t B_PC = al256(B_GY + (size_t)MT * D * 2);
constexpr size_t B_XP = al256(B_PC + (size_t)1024 * 8192 * 4);
constexpr size_t B_M1G = (size_t)100 << 20;
constexpr size_t B_S5T = (size_t)120 << 20;
constexpr size_t S5T_KQ = 0, S5T_PM = S5T_KQ + (size_t)64 * 256 * 384 * 2, S5T_AB = S5T_PM + (size_t)64 * 128 * 256 * 2, S5T_BB = S5T_AB + (size_t)64 * 64 * 2 * 4, S5T_END = S5T_BB + (size_t)64 * 64 * 32 * 4;
static_assert(B_Y2 + (size_t)MT * D * 4 <= BIG_BYTES, "ssd stage");
static_assert(B_PROJB + (size_t)MT * NBH * 2 <= BIG_BYTES, "hgrn stage");
static_assert(B_ACT + (size_t)MT * FF * 2 <= BIG_BYTES, "ffn stage");
static_assert(B_XP + (size_t)1024 * 8192 * 2 <= B_S5T && B_M1G + (size_t)MT * D * 4 <= BIG_BYTES && B_S5T + S5T_END <= BIG_BYTES && B_S5T >= B_M1 + (size_t)MT * D * 4, "s5 stage");

#define GAS __attribute__((address_space(1)))
#define LAS __attribute__((address_space(3)))
typedef unsigned short bf16;
typedef unsigned v4u __attribute__((ext_vector_type(4)));
typedef unsigned v2u __attribute__((ext_vector_type(2)));
typedef float f32x4 __attribute__((ext_vector_type(4)));
typedef float f32x16 __attribute__((ext_vector_type(16)));
typedef short bf16x8 __attribute__((ext_vector_type(8)));
typedef GAS unsigned gu32;
#define RLX_AGENT __ATOMIC_RELAXED, __HIP_MEMORY_SCOPE_AGENT
#define LDS_WAIT() asm volatile("s_waitcnt lgkmcnt(0)" ::: "memory")
#define VM_WAIT() asm volatile("s_waitcnt vmcnt(0)" ::: "memory")
__device__ __forceinline__ unsigned f2bf(float f) { unsigned u = __builtin_bit_cast(unsigned, f); return (u + 0x7fffu + ((u >> 16) & 1u)) >> 16; }
__device__ __forceinline__ unsigned pk2(float lo, float hi) { return f2bf(lo) | (f2bf(hi) << 16); }
__device__ __forceinline__ float bf2f(unsigned short b) { return __builtin_bit_cast(float, (unsigned)b << 16); }
__device__ __forceinline__ float bflo(unsigned w) { return __builtin_bit_cast(float, w << 16); }
__device__ __forceinline__ float bfhi(unsigned w) { return __builtin_bit_cast(float, w & 0xffff0000u); }
__device__ __forceinline__ float sigmoidf_(float x) { return __builtin_amdgcn_rcpf(1.0f + __expf(-x)); }
__device__ __forceinline__ float siluf_(float x) { return x * __builtin_amdgcn_rcpf(1.0f + __expf(-x)); }
__device__ __forceinline__ float softplusf_(float x) { return x > 20.f ? x : log1pf(__expf(x)); }
__device__ __forceinline__ float gelu_tanh(float x) { const float u = 0.7978845608028654f * (x + 0.044715f * x * x * x); const float e = __expf(2.f * u); const float th = 1.f - 2.f / (e + 1.f); return 0.5f * x * (1.f + th); }

#define XB_TMO      128
#define XB_XCNT(j)  (256  + 64 * (j))
#define XB_XSUB(j)  (1280 + 64 * (j))
#define XB_XGEN(j)  (2304 + 64 * (j))
#define XB_TOP      3328
#define XB_TOPGEN   3392
#define XCD_BAR_WORDS 3456
#define XB_SPIN_CAP (1u << 18)
__device__ __forceinline__ unsigned xb_ld(unsigned* p)              { return __hip_atomic_load(p, __ATOMIC_RELAXED, __HIP_MEMORY_SCOPE_AGENT); }
__device__ __forceinline__ unsigned xb_add(unsigned* p, unsigned v) { return __hip_atomic_fetch_add(p, v, __ATOMIC_RELAXED, __HIP_MEMORY_SCOPE_AGENT); }
__device__ __forceinline__ unsigned xb_xcc_id() { return (unsigned)__builtin_amdgcn_s_getreg((3 << 11) | 20) & 0xFu; }
#define XB_SPIN(cond, bar) do { unsigned _sp = 0; while (cond) { __builtin_amdgcn_s_sleep(1); \
    if ((++_sp & 255u) == 0u) { if (xb_ld(&(bar)[XB_TMO])) break; if (_sp > XB_SPIN_CAP) { atomicAdd(&(bar)[XB_TMO], 1u); break; } } } } while (0)
struct XcdBarrier { unsigned* bar; unsigned x; volatile LAS unsigned* st; };
__device__ __forceinline__ XcdBarrier xcd_barrier_post(unsigned* bar, volatile LAS unsigned* st) {
    XcdBarrier b; b.bar = bar; b.x = xb_xcc_id(); b.st = st;
    if (threadIdx.x == 0) (void)xb_add(&bar[XB_XCNT(b.x)], 1u);
    return b;
}
__device__ __forceinline__ void xcd_barrier_complete(unsigned* bar, unsigned x, unsigned& nloc, unsigned& nx) {
    const unsigned G = gridDim.x * gridDim.y * gridDim.z;
    unsigned sum, cnt, mine, sp = 0u;
    for (;;) {
        sum = 0u; cnt = 0u; mine = 0u;
#pragma unroll
        for (unsigned j = 0; j < 16; ++j) { const unsigned c = xb_ld(&bar[XB_XCNT(j)]); sum += c; cnt += (c > 0u) ? 1u : 0u; mine = (j == x) ? c : mine; }
        if (sum == G) break;
        __builtin_amdgcn_s_sleep(1);
        if ((++sp & 255u) == 0u) { if (xb_ld(&bar[XB_TMO])) break; if (sp > XB_SPIN_CAP) { atomicAdd(&bar[XB_TMO], 1u); break; } }
    }
    nloc = mine > 0u ? mine : 1u; nx = cnt > 0u ? cnt : 1u;
}
__device__ __forceinline__ void xcd_barrier(const XcdBarrier& b) {
    asm volatile("s_waitcnt vmcnt(0)" ::: "memory");
    __syncthreads();
    if (threadIdx.x == 0) {
        unsigned* bar = b.bar;
        __builtin_amdgcn_s_waitcnt(0);
        unsigned nloc = b.st[0], nx = b.st[1];
        if (nloc == 0u) { xcd_barrier_complete(bar, b.x, nloc, nx); b.st[0] = nloc; b.st[1] = nx; }
        const unsigned old = xb_add(&bar[XB_XSUB(b.x)], 1u);
        const unsigned gen = old / nloc;
        if (old + 1u == (gen + 1u) * nloc) {
            __builtin_amdgcn_fence(__ATOMIC_RELEASE, "agent");
            asm volatile("s_waitcnt vmcnt(0)" ::: "memory");
            const unsigned og = xb_add(&bar[XB_TOP], 1u);
            const unsigned tg = og / nx;
            if (og + 1u == (tg + 1u) * nx) xb_add(&bar[XB_TOPGEN], 1u);
            else XB_SPIN(xb_ld(&bar[XB_TOPGEN]) == tg, bar);
            __builtin_amdgcn_fence(__ATOMIC_ACQUIRE, "agent");
            xb_add(&bar[XB_XGEN(b.x)], 1u);
            asm volatile("s_waitcnt vmcnt(0)" ::: "memory");
        } else {
            XB_SPIN(xb_ld(&bar[XB_XGEN(b.x)]) == gen, bar);
            __builtin_amdgcn_fence(__ATOMIC_ACQUIRE, "agent");
            asm volatile("s_waitcnt vmcnt(0)" ::: "memory");
        }
    }
    __syncthreads();
}

constexpr int RING_BYTES = 131072;
constexpr int LDSCTL_OFF = RING_BYTES, MISC_OFF = LDSCTL_OFF + 320, HALO_OFF = RING_BYTES + 1024;
constexpr int LDS_BYTES = 147456;

struct Args { const float* in[35]; float* out; unsigned char* ws; int ph_lo, ph_hi, li, pad; };
static_assert(sizeof(Args) == 35 * 8 + 8 + 8 + 16, "Args has no padding");
#define CAS __attribute__((address_space(4)))
struct Frame {
    LAS unsigned char* lds;
    int tid, lane, wave, vcu, G;
    const CAS Args* a;
    float* out;
    unsigned char* ws;
};

enum { I_XP = 0, I_XS, I_SSSM, I_SSCONV, I_SHG, I_SS5R, I_SS5I, I_SFC, I_NMPRE, I_NMPOST, I_NFPRE, I_NFPOST, I_WIN, I_CONVW, I_CONVB, I_DTB, I_ALOG, I_SSMD, I_SSMNW,
       I_HGLB, I_HGNW, I_WOUT, I_LAMRE, I_LAMIM, I_LOGSTEP, I_BRE, I_BIM, I_CRE, I_CIM, I_S5D, I_WGLU, I_WUP, I_FCW, I_FCB, I_WDN, N_IN };

#define GW_ID(F) ((F).vcu * NWAVES + (F).wave)
#define GW_N(F) ((F).G * NWAVES)

__device__ __forceinline__ void p0_transpose_item(const float* W, int ldw, int K, int scol0, bf16* WT, int drow0, int kb, LAS float* scr, int lane) {
    const int k0 = 64 * kb;
    f32x4 v[8];
#pragma unroll
    for (int i = 0; i < 8; ++i) v[i] = *(const GAS f32x4*)(W + (size_t)(k0 + (lane >> 3) + 8 * i) * ldw + scol0 + 4 * (lane & 7));
#pragma unroll
    for (int i = 0; i < 8; ++i) { LAS float* d = scr + ((lane >> 3) + 8 * i) * 33 + 4 * (lane & 7); d[0] = v[i].x; d[1] = v[i].y; d[2] = v[i].z; d[3] = v[i].w; }
    LDS_WAIT(); asm volatile("" ::: "memory");
    const int c = lane & 7;
#pragma unroll
    for (int j = 0; j < 4; ++j) { const int n = (lane >> 3) + 8 * j; const LAS float* s = scr + (8 * c) * 33 + n;
        v4u o; o.x = pk2(s[0 * 33], s[1 * 33]); o.y = pk2(s[2 * 33], s[3 * 33]); o.z = pk2(s[4 * 33], s[5 * 33]); o.w = pk2(s[6 * 33], s[7 * 33]);
        *(GAS v4u*)(WT + (size_t)(drow0 + n) * K + k0 + 8 * c) = o; }
    LDS_WAIT(); asm volatile("" ::: "memory");
}
__device__ __forceinline__ void rms_row_to_bf16(const float* xrow, const float* w, bf16* orow, int lane) {
    const GAS f32x4* xr = (const GAS f32x4*)xrow + lane; const GAS f32x4* wr = (const GAS f32x4*)w + lane;
    f32x4 v[4]; float s = 0.f;
#pragma unroll
    for (int j = 0; j < 4; ++j) { v[j] = xr[64 * j]; s += (v[j].x * v[j].x + v[j].y * v[j].y) + (v[j].z * v[j].z + v[j].w * v[j].w); }
    const float rs = rsqrtf(wave_sum(s) * (1.f / D) + EPS);
    GAS v2u* o8 = (GAS v2u*)orow + lane;
#pragma unroll
    for (int j = 0; j < 4; ++j) { const f32x4 ww = wr[64 * j]; v2u o; o.x = pk2(v[j].x * rs * ww.x, v[j].y * rs * ww.y); o.y = pk2(v[j].z * rs * ww.z, v[j].w * rs * ww.w); o8[64 * j] = o; }
}
__device__ __forceinline__ const float* x_in_row(const Frame& F, int r) { return r < MP ? F.a->in[I_XP] + (size_t)r * D : F.a->in[I_XS] + (size_t)(r - MP) * D; }
__device__ __forceinline__ float* x_res_row(const Frame& F, int r) { return r < MP ? F.out + O_YP + (size_t)r * D : F.out + O_YS + (size_t)(r - MP) * D; }

__device__ __forceinline__ void wconv_items(Frame& F, int it_lo, int it_hi, int gw, int NGW) {
    LAS float* scr = (LAS float*)(F.lds + F.wave * 16384);
    bf16* WIN = (bf16*)(F.ws + WS_WIN); bf16* WOUT = (bf16*)(F.ws + WS_WOUT); bf16* WGLU = (bf16*)(F.ws + WS_WGLU); bf16* WUP = (bf16*)(F.ws + WS_WUP); bf16* WDN = (bf16*)(F.ws + WS_WDN);
    constexpr int I_IN = 16 * 200, I_OUT = 32 * 32, I_GLU = 16 * 64, I_UP = 16 * 176, I_DN = 44 * 32;
    constexpr int NITEMS = I_IN + I_OUT + I_GLU + 2 * I_UP + 2 * I_DN;
    (void)NITEMS;
    for (int it = it_lo + gw; it < it_hi; it += NGW) {
        int r = it;
        if (r < I_IN) { const int kb = r / 200, nb = r % 200;
            const int sc = nb < 72 ? 32 * nb : 2320 + 32 * (nb - 72);
            const int dr = nb < 72 ? 32 * nb : NA + 32 * (nb - 72);
            p0_transpose_item(F.a->in[I_WIN], ABIN, D, sc, WIN, dr, kb, scr, F.lane); continue; }
        r -= I_IN;
        if (r < I_OUT) { p0_transpose_item(F.a->in[I_WOUT], D, 2048, 32 * (r % 32), WOUT, 32 * (r % 32), r / 32, scr, F.lane); continue; }
        r -= I_OUT;
        if (r < I_GLU) { const int kb = r / 64, nb = r % 64, d = 32 * nb, j = d >> 8, bj = (d >> 7) & 1, c = d & 127;
            p0_transpose_item(F.a->in[I_WGLU], 2048, D, 1024 * bj + 128 * j + c, WGLU, d, kb, scr, F.lane); continue; }
        r -= I_GLU;
        if (r < 2 * I_UP) { const int l = r / I_UP; r -= l * I_UP; const int kb = r / 176, nb = r % 176, d = 32 * nb, j = d >> 8, bj = (d >> 7) & 1, c = d & 127;
            p0_transpose_item(F.a->in[I_WUP] + (size_t)l * D * FF2, FF2, D, FF * bj + 128 * j + c, WUP + (size_t)l * FF2 * D, d, kb, scr, F.lane); continue; }
        r -= 2 * I_UP;
        { const int l = r / I_DN; r -= l * I_DN; p0_transpose_item(F.a->in[I_WDN] + (size_t)l * FF * D, D, FF, 32 * (r % 32), WDN + (size_t)l * D * FF, 32 * (r % 32), r / 32, scr, F.lane); }
    }
}
constexpr int WC_EARLY = 16 * 200 + 32 * 32, WC_ALL = 16 * 200 + 32 * 32 + 16 * 64 + 2 * 16 * 176 + 2 * 44 * 32;
__device__ __forceinline__ void p0_prologue(Frame& F) {
    const int gw = GW_ID(F), NGW = GW_N(F);
    bf16* WIN = (bf16*)(F.ws + WS_WIN);
    wconv_items(F, 0, F.G > 128 ? WC_EARLY : WC_ALL, gw, NGW);
    { const int gt = (F.vcu * NTHR + F.tid), NT = F.G * NTHR;
      for (int i = gt; i < 16 * D; i += NT) { const int n = i >> 10, k = i & 1023; WIN[(size_t)(2304 + n) * D + k] = (bf16)f2bf(F.a->in[I_WIN][(size_t)k * ABIN + 2304 + n]); }
      unsigned z_ = 0u; asm volatile("" : "+v"(z_));
      for (int i = gt; i < 240 * D / 8; i += NT) ((GAS v4u*)(WIN + (size_t)2320 * D))[i] = (v4u){z_, z_, z_, z_}; }
    bf16* XN = (bf16*)(F.ws + WS_XN);
    { const int lane = F.lane; f32x4 nx[4];
      if (gw < MT) {
#pragma unroll
          for (int j = 0; j < 4; ++j) nx[j] = ((const GAS f32x4*)x_in_row(F, gw) + lane)[64 * j]; }
      for (int m = gw; m < MT; m += NGW) { f32x4 v[4]; float s = 0.f;
#pragma unroll
          for (int j = 0; j < 4; ++j) { v[j] = nx[j]; s += (v[j].x * v[j].x + v[j].y * v[j].y) + (v[j].z * v[j].z + v[j].w * v[j].w); }
          if (m + NGW < MT) {
#pragma unroll
              for (int j = 0; j < 4; ++j) nx[j] = ((const GAS f32x4*)x_in_row(F, m + NGW) + lane)[64 * j]; }
          const float rs = rsqrtf(wave_sum(s) * (1.f / D) + EPS); GAS v2u* o8 = (GAS v2u*)(XN + (size_t)m * D) + lane;
#pragma unroll
          for (int j = 0; j < 4; ++j) { const f32x4 ww = ((const GAS f32x4*)F.a->in[I_NMPRE] + lane)[64 * j]; v2u o; o.x = pk2(v[j].x * rs * ww.x, v[j].y * rs * ww.y); o.y = pk2(v[j].z * rs * ww.z, v[j].w * rs * ww.w); o8[64 * j] = o; } } }
}

template <int NT, bool GLU, class Epi>
__device__ __forceinline__ void skinny_gemm(Frame& F, const bf16* A, int lda, const bf16* Bt, int K, int ncb, const Epi& epi, int tb, int tstride) {
    LAS float* red = (LAS float*)F.lds;
    const int lane = F.lane, r = lane & 31, h = lane >> 5, w = F.wave;
    const int kper = K >> 3, kbeg = w * kper;
    const int ntask = 4 * ncb;
    if (tb < 0) return;
    for (int task = tb; task < ntask; task += tstride) {
        const int rt = task & 3, ct = task >> 2;
        const int brow = GLU ? (256 * (ct >> 2) + 32 * (ct & 3)) : 32 * ct;
        const bf16* ap = A + (size_t)(rt * 32 + r) * lda + kbeg + 8 * h;
        const bf16* bp = Bt + (size_t)(brow + r) * K + kbeg + 8 * h;
        f32x16 acc[NT];
#pragma unroll
        for (int nt = 0; nt < NT; ++nt)
#pragma unroll
            for (int i = 0; i < 16; ++i) acc[nt][i] = 0.f;
#pragma unroll 8
        for (int k = 0; k < kper; k += 16) {
            const bf16x8 a = *(const bf16x8*)(ap + k);
#pragma unroll
            for (int nt = 0; nt < NT; ++nt) { const bf16x8 b = *(const bf16x8*)(bp + (size_t)nt * 128 * K + k); acc[nt] = __builtin_amdgcn_mfma_f32_32x32x16_bf16(a, b, acc[nt], 0, 0, 0); }
        }
#pragma unroll
        for (int nt = 0; nt < NT; ++nt)
#pragma unroll
            for (int i = 0; i < 16; ++i) red[((w * NT + nt) * 16 + i) * 64 + lane] = acc[nt][i];
        __syncthreads();
#pragma unroll
        for (int e0 = 0; e0 < 2; ++e0) { const int e = F.tid + 512 * e0, i = e >> 6, l = e & 63; float v[NT];
#pragma unroll
            for (int nt = 0; nt < NT; ++nt) { float s = 0.f;
#pragma unroll
                for (int ww = 0; ww < 8; ++ww) s += red[((ww * NT + nt) * 16 + i) * 64 + l];
                v[nt] = s; }
            epi(rt * 32 + (i & 3) + 8 * (i >> 2) + 4 * (l >> 5), ct * 32 + (l & 31), v); }
        __syncthreads();
    }
}
struct SkBf16 { bf16* O; int ld; __device__ __forceinline__ void operator()(int row, int col, const float (&v)[1]) const { O[(size_t)row * ld + col] = (bf16)f2bf(v[0]); } };
struct SkF32 { float* O; int ld; __device__ __forceinline__ void operator()(int row, int col, const float (&v)[1]) const { O[(size_t)row * ld + col] = v[0]; } };
struct SkGlu { bf16* O; int ld; __device__ __forceinline__ void operator()(int row, int col, const float (&v)[2]) const { O[(size_t)row * ld + col] = (bf16)f2bf(v[0] * sigmoidf_(v[1])); } };

constexpr size_t B_XR = al256((size_t)MT * D * 2);
__device__ __forceinline__ void resid_norm_rows(Frame& F, const bf16* msrc, const float* w_post, const float* w_pre, int mode) {
    const int gw = GW_ID(F), NGW = GW_N(F), lane = F.lane;
    bf16* XN = (bf16*)(F.ws + WS_XN); bf16* XR = (bf16*)(F.ws + WS_BIG + B_XR);
    v2u pm[4]; f32x4 pxf[4]; v2u pxb[4];
#define RN_LOAD(r_) do { const GAS v2u* mr_ = (const GAS v2u*)(msrc + (size_t)(r_) * D) + lane; \
        _Pragma("unroll") for (int j = 0; j < 4; ++j) { pm[j] = mr_[64 * j]; if (mode == 0) pxf[j] = ((const GAS f32x4*)x_in_row(F, (r_)) + lane)[64 * j]; else pxb[j] = ((const GAS v2u*)(XR + (size_t)(r_) * D) + lane)[64 * j]; } } while (0)
    if (gw < MT) RN_LOAD(gw);
    for (int r = gw; r < MT; r += NGW) {
        f32x4 m[4], x[4]; float s = 0.f;
#pragma unroll
        for (int j = 0; j < 4; ++j) { const v2u mw = pm[j]; m[j] = (f32x4){bflo(mw.x), bfhi(mw.x), bflo(mw.y), bfhi(mw.y)};
            if (mode == 0) x[j] = pxf[j]; else { const v2u xw = pxb[j]; x[j] = (f32x4){bflo(xw.x), bfhi(xw.x), bflo(xw.y), bfhi(xw.y)}; }
            s += (m[j].x * m[j].x + m[j].y * m[j].y) + (m[j].z * m[j].z + m[j].w * m[j].w); }
        if (r + NGW < MT) RN_LOAD(r + NGW);
        const float rs = rsqrtf(wave_sum(s) * (1.f / D) + EPS); float s2 = 0.f;
#pragma unroll
        for (int j = 0; j < 4; ++j) { const f32x4 wp = ((const GAS f32x4*)w_post + lane)[64 * j]; x[j] = x[j] + m[j] * rs * wp;
            if (mode == 2) ((GAS f32x4*)x_res_row(F, r) + lane)[64 * j] = x[j];
            else { v2u o; o.x = pk2(x[j].x, x[j].y); o.y = pk2(x[j].z, x[j].w); ((GAS v2u*)(XR + (size_t)r * D) + lane)[64 * j] = o; }
            s2 += (x[j].x * x[j].x + x[j].y * x[j].y) + (x[j].z * x[j].z + x[j].w * x[j].w); }
        if (mode != 2) { const float rs2 = rsqrtf(wave_sum(s2) * (1.f / D) + EPS); GAS v2u* o8 = (GAS v2u*)(XN + (size_t)r * D) + lane;
#pragma unroll
            for (int j = 0; j < 4; ++j) { const f32x4 ww = ((const GAS f32x4*)w_pre + lane)[64 * j]; v2u o; o.x = pk2(x[j].x * rs2 * ww.x, x[j].y * rs2 * ww.y); o.y = pk2(x[j].z * rs2 * ww.z, x[j].w * rs2 * ww.w); o8[64 * j] = o; } }
    }
#undef RN_LOAD
}
__device__ __forceinline__ bf16* mixed_row(const Frame& F, int r) { return r < MP ? (bf16*)(F.out + O_YP) + (size_t)r * 2048 : (bf16*)(F.ws + WS_MIXS) + (size_t)(r - MP) * 2048; }
constexpr size_t B_HEAD = al256(B_ACT + (size_t)MT * FF * 2), B_TAIL = B_HEAD + (size_t)64 * 2 * FF2 * 4;
static_assert(B_TAIL + (size_t)64 * 2 * FF2 * 4 <= BIG_BYTES, "ffn side buffers");
__device__ __forceinline__ void ffn_fix_rows(Frame& F, int l, int pm) {
    const float* HEAD = (const float*)(F.ws + WS_BIG + B_HEAD); const float* TAIL = (const float*)(F.ws + WS_BIG + B_TAIL); bf16* ACT = (bf16*)(F.ws + WS_BIG + B_ACT);
    const float* cw = F.a->in[I_FCW] + (size_t)l * 3 * FF2; const float* cb = F.a->in[I_FCB] + (size_t)l * FF2;
    for (int c = F.tid; c < FF; c += NTHR) { float r0[2], r1[2];
#pragma unroll
        for (int x = 0; x < 2; ++x) { const int ch = x * FF + c; const float h0 = HEAD[((size_t)pm * 2) * FF2 + ch], h1 = HEAD[((size_t)pm * 2 + 1) * FF2 + ch];
            const float t0 = (pm & 7) ? TAIL[((size_t)(pm - 1) * 2) * FF2 + ch] : 0.f, t1 = (pm & 7) ? TAIL[((size_t)(pm - 1) * 2 + 1) * FF2 + ch] : 0.f;
            const float w0 = cw[ch], w1 = cw[FF2 + ch], w2 = cw[2 * FF2 + ch], bb = cb[ch];
            r0[x] = bb + w0 * t0 + w1 * t1 + w2 * h0; r1[x] = bb + w0 * t1 + w1 * h0 + w2 * h1; }
        ACT[(size_t)(256 * pm) * FF + c] = (bf16)f2bf(r0[0] * siluf_(r0[1])); ACT[(size_t)(256 * pm + 1) * FF + c] = (bf16)f2bf(r1[0] * siluf_(r1[1])); }
}
struct SkConvGate { bf16* ACTs; const float* cw; const float* cb; const float* st; float* sfc;
    __device__ __forceinline__ void operator()(int row, int col, const float (&v)[2]) const {
        const float* s0 = st + ((size_t)row * 2) * FF2; const float* s1 = s0 + FF2; float* p = sfc + (size_t)row * 2 * FF2; const int chv = col, chg = FF + col;
        const float v0 = s0[chv], v1 = s1[chv], g0 = s0[chg], g1 = s1[chg];
        const float vc = cb[chv] + cw[chv] * v0 + cw[FF2 + chv] * v1 + cw[2 * FF2 + chv] * v[0];
        const float gc = cb[chg] + cw[chg] * g0 + cw[FF2 + chg] * g1 + cw[2 * FF2 + chg] * v[1];
        ACTs[(size_t)row * FF + col] = (bf16)f2bf(vc * siluf_(gc)); p[chv] = v1; p[chg] = g1; p[FF2 + chv] = v[0]; p[FF2 + chg] = v[1]; } };

constexpr size_t B_HB = al256(B_PROJA + (size_t)MT * NA * 2);
static_assert(B_HB + (size_t)8 * 64 * 16 * 4096 * 2 <= BIG_BYTES, "ssd state buffer");
typedef float f32x2_t __attribute__((ext_vector_type(2)));

__device__ __forceinline__ void ssd_conv4(const Frame& F, const bf16* PA, int b, int t, int ch0, float (&out)[8][4]) {
    const float* cw = F.a->in[I_CONVW] + ch0; const float* cbias = F.a->in[I_CONVB] + ch0;
    float raw[7][8];
#pragma unroll
    for (int rr = 0; rr < 7; ++rr) { const int tt = t - 3 + rr;
        if (tt >= 0) { const v4u q = *(const GAS v4u*)(PA + (size_t)(b * SEQ + tt) * NA + 1024 + ch0);
            raw[rr][0] = bflo(q.x); raw[rr][1] = bfhi(q.x); raw[rr][2] = bflo(q.y); raw[rr][3] = bfhi(q.y); raw[rr][4] = bflo(q.z); raw[rr][5] = bfhi(q.z); raw[rr][6] = bflo(q.w); raw[rr][7] = bfhi(q.w); }
        else {
#pragma unroll
            for (int e = 0; e < 8; ++e) raw[rr][e] = 0.f; } }
    float w[4][8], bs[8];
#pragma unroll
    for (int k = 0; k < 4; ++k) { const f32x4 a = *(const GAS f32x4*)(cw + k * XBC), c = *(const GAS f32x4*)(cw + k * XBC + 4);
        w[k][0] = a.x; w[k][1] = a.y; w[k][2] = a.z; w[k][3] = a.w; w[k][4] = c.x; w[k][5] = c.y; w[k][6] = c.z; w[k][7] = c.w; }
    { const f32x4 a = *(const GAS f32x4*)cbias, c = *(const GAS f32x4*)(cbias + 4); bs[0] = a.x; bs[1] = a.y; bs[2] = a.z; bs[3] = a.w; bs[4] = c.x; bs[5] = c.y; bs[6] = c.z; bs[7] = c.w; }
#pragma unroll
    for (int e = 0; e < 8; ++e)
#pragma unroll
        for (int j = 0; j < 4; ++j) { float v = bs[e];
#pragma unroll
            for (int k = 0; k < 4; ++k) v += w[k][e] * raw[j + k][e];
            out[e][j] = siluf_(v); }
}

__device__ __forceinline__ void ssd_state_item(Frame& F, int b, int h) {
    const bf16* PA = (const bf16*)(F.ws + WS_BIG + B_PROJA); bf16* HB = (bf16*)(F.ws + WS_BIG + B_HB);
    constexpr int TP = 80, TBUF = 128 * TP;
    LAS unsigned char* T0 = F.lds; LAS float* WG = (LAS float*)(F.lds + 2 * TBUF); LAS float* DEC = WG + SEQ;
    int tid = F.tid; asm volatile("" : "+v"(tid));
    const int lane = tid & 63, wave = __builtin_amdgcn_readfirstlane(tid >> 6), g = h >> 3, r = lane & 31, hh = lane >> 5;
    { const float A = -__expf(F.a->in[I_ALOG][h]), dtb = F.a->in[I_DTB][h];
      float dt[4], cum[4]; float run = 0.f;
#pragma unroll
      for (int j = 0; j < 4; ++j) { dt[j] = softplusf_(bf2f(PA[(size_t)(b * SEQ + 4 * tid + j) * NA + 2304 + h]) + dtb); run += dt[j] * A; cum[j] = run; }
      float incl = run;
      const int ln_ = lane_op_();
#pragma unroll
      for (int off = 1; off < 8; off <<= 1) { const float v = shup_(incl, off, 8, ln_); if ((tid & 7) >= off) incl += v; }
      const float excl = incl - run, last = shidx_(incl, 7, 8, ln_);
#pragma unroll
      for (int j = 0; j < 4; ++j) WG[4 * tid + j] = dt[j] * __expf(last - (excl + cum[j]));
      if ((tid & 7) == 0) DEC[tid >> 3] = __expf(last); }
    __syncthreads();
    if (wave < 4) {
        const int o = tid >> 4, tp = tid & 15, ch0 = o < 8 ? h * 64 + 8 * o : 1024 + g * 64 + 8 * (o - 8);
        float w[4][8], bs[8];
        { const float* cw = F.a->in[I_CONVW] + ch0; const float* cbias = F.a->in[I_CONVB] + ch0;
#pragma unroll
          for (int k = 0; k < 4; ++k) { const f32x4 a = *(const GAS f32x4*)(cw + k * XBC), c4 = *(const GAS f32x4*)(cw + k * XBC + 4);
              w[k][0] = a.x; w[k][1] = a.y; w[k][2] = a.z; w[k][3] = a.w; w[k][4] = c4.x; w[k][5] = c4.y; w[k][6] = c4.z; w[k][7] = c4.w; }
          const f32x4 a = *(const GAS f32x4*)cbias, c4 = *(const GAS f32x4*)(cbias + 4); bs[0] = a.x; bs[1] = a.y; bs[2] = a.z; bs[3] = a.w; bs[4] = c4.x; bs[5] = c4.y; bs[6] = c4.z; bs[7] = c4.w; }
        const bf16* xrow = PA + (size_t)(b * SEQ + 2 * tp) * NA + 1024 + ch0;
        v4u pre[5];
#pragma unroll
        for (int k = 0; k < 5; ++k) { const int rr = 2 * tp - 3 + k < 0 ? 0 : 2 * tp - 3 + k; pre[k] = *(const GAS v4u*)(xrow + (ptrdiff_t)(rr - 2 * tp) * NA); }
        for (int c = 0; c < 64; ++c) {
            LAS unsigned char* T = T0 + (c & 1) * TBUF;
            v4u cur[5];
#pragma unroll
            for (int k = 0; k < 5; ++k) cur[k] = pre[k];
            if (c + 1 < 64) { const bf16* xn = xrow + (size_t)(32 * (c + 1)) * NA;
#pragma unroll
                for (int k = 0; k < 5; ++k) pre[k] = *(const GAS v4u*)(xn + (ptrdiff_t)(k - 3) * NA); }
            const f32x2_t wq = *(const LAS f32x2_t*)(WG + 32 * c + 2 * tp);
            const float w0 = o < 8 ? wq.x : 1.0f, w1 = o < 8 ? wq.y : 1.0f;
            float x8[5][8];
#pragma unroll
            for (int k = 0; k < 5; ++k) { const v4u qv = cur[k]; const float mk = (c == 0 && 2 * tp - 3 + k < 0) ? 0.f : 1.f;
                x8[k][0] = bflo(qv.x) * mk; x8[k][1] = bfhi(qv.x) * mk; x8[k][2] = bflo(qv.y) * mk; x8[k][3] = bfhi(qv.y) * mk; x8[k][4] = bflo(qv.z) * mk; x8[k][5] = bfhi(qv.z) * mk; x8[k][6] = bflo(qv.w) * mk; x8[k][7] = bfhi(qv.w) * mk; }
#pragma unroll
            for (int e = 0; e < 8; ++e) { float v0 = bs[e], v1 = bs[e];
#pragma unroll
                for (int k = 0; k < 4; ++k) { v0 += w[k][e] * x8[k][e]; v1 += w[k][e] * x8[k + 1][e]; }
                *(LAS unsigned*)(T + (8 * o + e) * TP + 4 * tp) = pk2(siluf_(v0) * w0, siluf_(v1) * w1); }
            asm volatile("s_waitcnt lgkmcnt(0)" ::: "memory"); __builtin_amdgcn_s_barrier(); asm volatile("" ::: "memory");
        }
    } else {
        f32x16 acc;
#pragma unroll
        for (int i = 0; i < 16; ++i) acc[i] = 0.f;
        const int q = wave - 4, pt = q >> 1, nt = q & 1;
        for (int c = 0; c < 64; ++c) {
            LAS unsigned char* T = T0 + (c & 1) * TBUF;
            bf16* hb = HB + ((((size_t)b * 64 + c) * 16 + h) * 64 + pt * 32) * 64 + nt * 32 + r;
#pragma unroll
            for (int i = 0; i < 16; ++i) hb[(size_t)((i & 3) + 8 * (i >> 2) + 4 * hh) * 64] = (bf16)f2bf(acc[i]);
            const float dec = DEC[c];
#pragma unroll
            for (int i = 0; i < 16; ++i) acc[i] *= dec;
            asm volatile("s_waitcnt lgkmcnt(0)" ::: "memory"); __builtin_amdgcn_s_barrier(); asm volatile("" ::: "memory");
#pragma unroll
            for (int ks = 0; ks < 2; ++ks) { const bf16x8 a = *(const LAS bf16x8*)(T + (pt * 32 + r) * TP + 32 * ks + 16 * hh), bb = *(const LAS bf16x8*)(T + (64 + nt * 32 + r) * TP + 32 * ks + 16 * hh);
                acc = __builtin_amdgcn_mfma_f32_32x32x16_bf16(a, bb, acc, 0, 0, 0); }
        }
        float* ps = F.out + O_PSSM + ((size_t)(b * 16 + h) * 64 + pt * 32) * 64 + nt * 32 + r;
#pragma unroll
        for (int i = 0; i < 16; ++i) ps[(size_t)((i & 3) + 8 * (i >> 2) + 4 * hh) * 64] = acc[i];
    }
    { float* pc = F.out + O_PSCONV + (size_t)b * 3 * XBC;
      for (int e = tid; e < 3 * 192; e += NTHR) { const int k = e / 192, cc = e % 192; if (cc >= 64 && (h & 7) != 0) continue;
          const int ch = cc < 64 ? h * 64 + cc : (cc < 128 ? 1024 + g * 64 + (cc - 64) : 1152 + g * 64 + (cc - 128));
          pc[k * XBC + ch] = bf2f(PA[(size_t)(b * SEQ + SEQ - 3 + k) * NA + 1024 + ch]); } }
    __syncthreads();
}

__device__ __forceinline__ void ssd_sample_item(Frame& F, int j) {
    const bf16* PA = (const bf16*)(F.ws + WS_BIG + B_PROJA) + (size_t)(MP + j) * NA; bf16* MX = (bf16*)(F.ws + WS_MIXS) + (size_t)j * 2048;
    LAS float* act = (LAS float*)F.lds;
    LAS float* dts = act + XBC;
    LAS float* y2 = dts + 32;
    LAS float* red = y2 + 1024;
    const int tid = F.tid;
    const float* cw = F.a->in[I_CONVW]; const float* cbias = F.a->in[I_CONVB]; const float* st = F.a->in[I_SSCONV] + (size_t)j * 3 * XBC; float* so = F.out + O_SSCONV + (size_t)j * 3 * XBC;
    for (int ch = tid; ch < XBC; ch += NTHR) { const float nw = bf2f(PA[1024 + ch]); const float s0 = st[ch], s1 = st[XBC + ch], s2 = st[2 * XBC + ch];
        act[ch] = siluf_(cbias[ch] + cw[ch] * s0 + cw[XBC + ch] * s1 + cw[2 * XBC + ch] * s2 + cw[3 * XBC + ch] * nw);
        so[ch] = s1; so[XBC + ch] = s2; so[2 * XBC + ch] = nw; }
    if (tid < 16) { const float d = softplusf_(bf2f(PA[2304 + tid]) + F.a->in[I_DTB][tid]); dts[tid] = d; dts[16 + tid] = __expf(-__expf(F.a->in[I_ALOG][tid]) * d); }
    __syncthreads();
    const float* S0 = F.a->in[I_SSSM] + (size_t)j * 65536; float* S1 = F.out + O_SSSM + (size_t)j * 65536;
    float ssq = 0.f;
#pragma unroll 1
    for (int it8 = 0; it8 < 4; ++it8) { f32x4 sv[8];
#pragma unroll
      for (int u = 0; u < 8; ++u) sv[u] = *(const GAS f32x4*)(S0 + (size_t)((it8 * 8 + u) * NTHR + tid) * 4);
#pragma unroll
      for (int u = 0; u < 8; ++u) { const int it = it8 * 8 + u; const int v = it * NTHR + tid, n4 = v & 15, p = (v >> 4) & 63, h = v >> 10, g = h >> 3;
        const f32x4 s = sv[u];
        const f32x4 bb = *(const LAS f32x4*)(act + 1024 + g * 64 + 4 * n4), cc = *(const LAS f32x4*)(act + 1152 + g * 64 + 4 * n4);
        const float x = act[h * 64 + p], dtx = dts[h] * x, dec = dts[16 + h];
        f32x4 nn; float a = 0.f;
#pragma unroll
        for (int i = 0; i < 4; ++i) { nn[i] = dec * s[i] + dtx * bb[i]; a += nn[i] * cc[i]; }
        *(GAS f32x4*)(S1 + (size_t)v * 4) = nn;
        a = row16_sum(a);
        if (n4 == 0) { const float yy = (a + F.a->in[I_SSMD][h] * x) * siluf_(bf2f(PA[h * 64 + p])); y2[h * 64 + p] = yy; ssq += yy * yy; } } }
    ssq = wave_sum(ssq); if (F.lane == 0) red[F.wave] = ssq;
    __syncthreads();
    float tot = 0.f;
#pragma unroll
    for (int w = 0; w < 8; ++w) tot += red[w];
    const float rs = rsqrtf(tot * (1.f / D) + EPS);
    for (int c = tid; c < 1024; c += NTHR) MX[c] = (bf16)f2bf(y2[c] * rs * F.a->in[I_SSMNW][c]);
    __syncthreads();
}
__device__ __forceinline__ void ssd_state_phase(Frame& F) {
    for (int it = F.vcu; it < 128 + MS; it += F.G) { if (it < 128) ssd_state_item(F, it >> 4, it & 15); else ssd_sample_item(F, it - 128); }
    if (F.G > 128 && F.vcu >= 128) { __syncthreads(); wconv_items(F, WC_EARLY, WC_ALL, (F.vcu - 128) * NWAVES + F.wave, (F.G - 128) * NWAVES); }
}

__device__ __forceinline__ void ssd_rows7(const bf16* PA, int b, int t, int ch0, v4u (&rw)[7]) {
#pragma unroll
    for (int rr = 0; rr < 7; ++rr) { const int tt = t - 3 + rr < 0 ? 0 : t - 3 + rr; rw[rr] = *(const GAS v4u*)(PA + (size_t)(b * SEQ + tt) * NA + 1024 + ch0); }
}
__device__ __forceinline__ void ssd_conv4_lds(const v4u (&rw)[7], const LAS float* CWL, int t, int ch0, float (&out)[8][4]) {
    float raw[7][8];
#pragma unroll
    for (int rr = 0; rr < 7; ++rr) { const v4u q = rw[rr]; const float mk = (t - 3 + rr >= 0) ? 1.f : 0.f;
        raw[rr][0] = bflo(q.x) * mk; raw[rr][1] = bfhi(q.x) * mk; raw[rr][2] = bflo(q.y) * mk; raw[rr][3] = bfhi(q.y) * mk; raw[rr][4] = bflo(q.z) * mk; raw[rr][5] = bfhi(q.z) * mk; raw[rr][6] = bflo(q.w) * mk; raw[rr][7] = bfhi(q.w) * mk; }
    float w[4][8], bs[8];
#pragma unroll
    for (int k = 0; k < 5; ++k) { const f32x4 a = *(const LAS f32x4*)(CWL + k * XBC + ch0), c = *(const LAS f32x4*)(CWL + k * XBC + ch0 + 4);
        if (k < 4) { w[k < 4 ? k : 0][0] = a.x; w[k < 4 ? k : 0][1] = a.y; w[k < 4 ? k : 0][2] = a.z; w[k < 4 ? k : 0][3] = a.w; w[k < 4 ? k : 0][4] = c.x; w[k < 4 ? k : 0][5] = c.y; w[k < 4 ? k : 0][6] = c.z; w[k < 4 ? k : 0][7] = c.w; }
        else { bs[0] = a.x; bs[1] = a.y; bs[2] = a.z; bs[3] = a.w; bs[4] = c.x; bs[5] = c.y; bs[6] = c.z; bs[7] = c.w; } }
#pragma unroll
    for (int e = 0; e < 8; ++e)
#pragma unroll
        for (int j = 0; j < 4; ++j) { float v = bs[e];
#pragma unroll
            for (int k = 0; k < 4; ++k) v += w[k][e] * raw[j + k][e];
            out[e][j] = siluf_(v); }
}
constexpr int SSDO_CWL = 16 * 64 * 80 + 2 * (2 * 32 * 144) + (512 + 512 + 256) * 4;
static_assert(SSDO_CWL + 5 * XBC * 4 <= RING_BYTES, "ssd_out LDS map");
__device__ __forceinline__ void ssd_out_item(Frame& F, int b, int c) {
    const bf16* PA = (const bf16*)(F.ws + WS_BIG + B_PROJA); const bf16* HB = (const bf16*)(F.ws + WS_BIG + B_HB);
    constexpr int XP_ = 80, BP_ = 144;
    LAS unsigned char* XT = F.lds;
    LAS unsigned char* BS = XT + 16 * 64 * XP_;
    LAS unsigned char* CS = BS + 2 * 32 * BP_;
    LAS float* DT = (LAS float*)(CS + 2 * 32 * BP_);
    LAS float* CUM = DT + 512;
    LAS float* SSQ = CUM + 512;
    const LAS float* CWL = (const LAS float*)(F.lds + SSDO_CWL);
    int tid = F.tid; asm volatile("" : "+v"(tid));
    const int t0 = 32 * c;
    v4u zq[8];
#pragma unroll
    for (int q = 0; q < 8; ++q) zq[q] = *(const GAS v4u*)(PA + (size_t)(b * SEQ + t0 + (tid >> 7) + 4 * q) * NA + 8 * (tid & 127));
    v4u rwn[7]; ssd_rows7(PA, b, t0 + 4 * (tid & 7), 8 * (tid >> 3), rwn);
#pragma unroll 1
    for (int task = tid; task < 160 * 8; task += NTHR) { const int o = task >> 3, run = task & 7;
        v4u rwc[7];
#pragma unroll
        for (int rr = 0; rr < 7; ++rr) rwc[rr] = rwn[rr];
        if (task + NTHR < 160 * 8) ssd_rows7(PA, b, t0 + 4 * ((task + NTHR) & 7), 8 * ((task + NTHR) >> 3), rwn);
        float act[8][4]; ssd_conv4_lds(rwc, CWL, t0 + 4 * run, 8 * o, act);
        if (o < 128) { const int h = o >> 3, p0 = (o & 7) * 8;
#pragma unroll
            for (int e = 0; e < 8; ++e) { v2u pk; pk.x = pk2(act[e][0], act[e][1]); pk.y = pk2(act[e][2], act[e][3]); *(LAS v2u*)(XT + (h * 64 + p0 + e) * XP_ + 8 * run) = pk; } }
        else { const int oo = o - 128, isC = oo >> 4, g = (oo >> 3) & 1, n0 = (oo & 7) * 8; LAS unsigned char* dst = (isC ? CS : BS) + g * 32 * BP_;
#pragma unroll
            for (int jx = 0; jx < 4; ++jx) { v4u pk; pk.x = pk2(act[0][jx], act[1][jx]); pk.y = pk2(act[2][jx], act[3][jx]); pk.z = pk2(act[4][jx], act[5][jx]); pk.w = pk2(act[6][jx], act[7][jx]);
                *(LAS v4u*)(dst + (4 * run + jx) * BP_ + 2 * n0) = pk; } }
    }
    { const int h = tid >> 5, t = tid & 31;
      const float dt = softplusf_(bf2f(PA[(size_t)(b * SEQ + t0 + t) * NA + 2304 + h]) + F.a->in[I_DTB][h]);
      float cum = -__expf(F.a->in[I_ALOG][h]) * dt;
      const int ln_ = lane_op_();
#pragma unroll
      for (int off = 1; off < 32; off <<= 1) { const float v = shup_(cum, off, 32, ln_); if (t >= off) cum += v; }
      DT[tid] = dt; CUM[tid] = cum; }
    __syncthreads();
    asm volatile("" : "+v"(tid));
    const int lane = tid & 63, wave = __builtin_amdgcn_readfirstlane(tid >> 6), r = lane & 31, hh = lane >> 5;
    const int g = wave >> 2;
    f32x16 gt;
#pragma unroll
    for (int i = 0; i < 16; ++i) gt[i] = 0.f;
#pragma unroll
    for (int ks = 0; ks < 4; ++ks) { const bf16x8 a = *(const LAS bf16x8*)(BS + (g * 32 + r) * BP_ + 32 * ks + 16 * hh), bb = *(const LAS bf16x8*)(CS + (g * 32 + r) * BP_ + 32 * ks + 16 * hh);
        gt = __builtin_amdgcn_mfma_f32_32x32x16_bf16(a, bb, gt, 0, 0, 0); }
#pragma unroll 1
    for (int hi = 0; hi < 2; ++hi) { const int h = 2 * wave + hi;
        bf16x8 hbf[2][4];
        { const bf16* hb0 = HB + ((((size_t)b * 64 + c) * 16 + h) * 64 + r) * 64 + 8 * hh;
#pragma unroll
          for (int pt = 0; pt < 2; ++pt)
#pragma unroll
              for (int ks = 0; ks < 4; ++ks) hbf[pt][ks] = *(const GAS bf16x8*)(hb0 + (size_t)pt * 32 * 64 + 16 * ks); }
        const float cum_t = CUM[h * 32 + r];
        bf16x8 am[2];
#pragma unroll
        for (int ks = 0; ks < 2; ++ks) { unsigned mf[4];
#pragma unroll
            for (int i2 = 0; i2 < 4; ++i2) { float m2[2];
#pragma unroll
                for (int q = 0; q < 2; ++q) { const int i = 8 * ks + 2 * i2 + q, s = (i & 3) + 8 * (i >> 2) + 4 * hh;
                    const float e_ = gt[i] * __expf(fminf(cum_t - CUM[h * 32 + s], 0.f)) * DT[h * 32 + s]; m2[q] = s <= r ? e_ : 0.f; }
                mf[i2] = pk2(m2[0], m2[1]); }
            v4u t4; t4.x = mf[0]; t4.y = mf[1]; t4.z = mf[2]; t4.w = mf[3]; am[ks] = __builtin_bit_cast(bf16x8, t4); }
        const float dsk = F.a->in[I_SSMD][h];
        f32x16 yv[2];
#pragma unroll
        for (int pt = 0; pt < 2; ++pt) {
            f32x16 yi;
#pragma unroll
            for (int i = 0; i < 16; ++i) { yv[pt][i] = 0.f; yi[i] = 0.f; }
            const LAS unsigned char* xrow = XT + (h * 64 + pt * 32 + r) * XP_;
#pragma unroll
            for (int ks = 0; ks < 2; ++ks) { const v2u lo = *(const LAS v2u*)(xrow + 2 * (16 * ks + 4 * hh)), hi2 = *(const LAS v2u*)(xrow + 2 * (16 * ks + 8 + 4 * hh));
                v4u t4; t4.x = lo.x; t4.y = lo.y; t4.z = hi2.x; t4.w = hi2.y;
                yv[pt] = __builtin_amdgcn_mfma_f32_32x32x16_bf16(am[ks], __builtin_bit_cast(bf16x8, t4), yv[pt], 0, 0, 0); }
#pragma unroll
            for (int ks = 0; ks < 4; ++ks) { const bf16x8 a = *(const LAS bf16x8*)(CS + (g * 32 + r) * BP_ + 32 * ks + 16 * hh), bb = hbf[pt][ks];
                yi = __builtin_amdgcn_mfma_f32_32x32x16_bf16(a, bb, yi, 0, 0, 0); }
#pragma unroll
            for (int i4 = 0; i4 < 4; ++i4) { const int tb = 8 * i4 + 4 * hh; const v2u xv = *(const LAS v2u*)(xrow + 2 * tb);
                const float xs[4] = {bflo(xv.x), bfhi(xv.x), bflo(xv.y), bfhi(xv.y)};
#pragma unroll
                for (int q = 0; q < 4; ++q) { const int i = 4 * i4 + q, t = tb + q; yv[pt][i] = yv[pt][i] + __expf(CUM[h * 32 + t]) * yi[i] + dsk * xs[q]; } }
        }
        LAS unsigned char* yb = XT + h * 64 * XP_;
#pragma unroll
        for (int pt = 0; pt < 2; ++pt)
#pragma unroll
            for (int i = 0; i < 16; ++i) { const int t = (i & 3) + 8 * (i >> 2) + 4 * hh; *(LAS unsigned short*)(yb + t * 128 + 2 * (pt * 32 + r)) = (unsigned short)f2bf(yv[pt][i]); }
    }
    __syncthreads();
    { const int c8 = (tid & 127) * 8, h = c8 >> 6, pp = c8 & 63; float gv[8][8], ss[8];
#pragma unroll
      for (int q = 0; q < 8; ++q) { const int t = (tid >> 7) + 4 * q; const v4u yq = *(const LAS v4u*)(XT + h * 64 * XP_ + t * 128 + 2 * pp); const v4u z = zq[q];
          gv[q][0] = bflo(yq.x) * siluf_(bflo(z.x)); gv[q][1] = bfhi(yq.x) * siluf_(bfhi(z.x)); gv[q][2] = bflo(yq.y) * siluf_(bflo(z.y)); gv[q][3] = bfhi(yq.y) * siluf_(bfhi(z.y));
          gv[q][4] = bflo(yq.z) * siluf_(bflo(z.z)); gv[q][5] = bfhi(yq.z) * siluf_(bfhi(z.z)); gv[q][6] = bflo(yq.w) * siluf_(bflo(z.w)); gv[q][7] = bfhi(yq.w) * siluf_(bfhi(z.w));
          float a = 0.f;
#pragma unroll
          for (int e = 0; e < 8; ++e) a += gv[q][e] * gv[q][e];
          ss[q] = wave_sum(a); }
      if ((tid & 63) == 0) {
#pragma unroll
          for (int q = 0; q < 8; ++q) SSQ[(tid >> 6) * 8 + q] = ss[q]; }
      __syncthreads();
      const f32x4 w0 = *(const GAS f32x4*)(F.a->in[I_SSMNW] + c8), w1 = *(const GAS f32x4*)(F.a->in[I_SSMNW] + c8 + 4);
      bf16* MX = (bf16*)(F.out + O_YP) + (size_t)(b * SEQ + t0) * 2048;
#pragma unroll
      for (int q = 0; q < 8; ++q) { const int t = (tid >> 7) + 4 * q; const float rs = rsqrtf((SSQ[((tid >> 7) * 2) * 8 + q] + SSQ[((tid >> 7) * 2 + 1) * 8 + q]) * (1.f / D) + EPS);
          v4u o; o.x = pk2(gv[q][0] * rs * w0.x, gv[q][1] * rs * w0.y); o.y = pk2(gv[q][2] * rs * w0.z, gv[q][3] * rs * w0.w); o.z = pk2(gv[q][4] * rs * w1.x, gv[q][5] * rs * w1.y); o.w = pk2(gv[q][6] * rs * w1.z, gv[q][7] * rs * w1.w);
          *(GAS v4u*)(MX + (size_t)t * 2048 + c8) = o; } }
    __syncthreads();
}
__device__ __forceinline__ void ssd_out_phase(Frame& F) {
    { LAS float* CWL = (LAS float*)(F.lds + SSDO_CWL);
      for (int e = F.tid; e < 5 * XBC; e += NTHR) CWL[e] = e < 4 * XBC ? F.a->in[I_CONVW][e] : F.a->in[I_CONVB][e - 4 * XBC]; }
    __syncthreads();
    for (int it = F.vcu; it < 8 * 64; it += F.G) ssd_out_item(F, it >> 6, it & 63);
}

constexpr size_t B_SB = 0;
static_assert(B_SB + (size_t)8 * 16 * 8 * 16384 * 2 <= B_PROJB, "hgrn state buffer");
__device__ __forceinline__ float hg_lb(const Frame& F, int c) { return __builtin_amdgcn_rcpf(1.f + __expf(F.a->in[I_HGLB][1024 + c] - F.a->in[I_HGLB][c])); }

__device__ __forceinline__ void hg_state_item(Frame& F, int b, int h, int vq, int sj, int sh) {
    const bf16* PB = (const bf16*)(F.ws + WS_BIG + B_PROJB); bf16* SB = (bf16*)(F.ws + WS_BIG + B_SB);
    constexpr int KP = 272;
    LAS unsigned char* KT0 = F.lds;
    LAS unsigned char* VT0 = KT0 + 2 * 128 * KP;
    LAS unsigned char* RAW = VT0 + 2 * 32 * KP;
    LAS float* EL = (LAS float*)(RAW + 128 * KP);
    LAS float* SEG = EL + 256;
    int tid = F.tid; asm volatile("" : "+v"(tid));
    const int lane = tid & 63, wave = __builtin_amdgcn_readfirstlane(tid >> 6), r = lane & 31, hh = lane >> 5;
    const int kcol = tid & 127, seg = tid >> 7;
    const float lb = hg_lb(F, h * 128 + kcol);
    const int vs = tid >> 2, voc = tid & 3;
    const bf16* fsrc = PB + (size_t)(b * SEQ + (tid >> 4)) * NBH + 1024 + h * 128 + 8 * (tid & 15);
    const bf16* vsrc = PB + (size_t)(b * SEQ + vs) * NBH + 2048 + h * 128 + vq * 32 + 8 * voc;
    v4u pf[4], pv;
#pragma unroll
    for (int q = 0; q < 4; ++q) pf[q] = *(const GAS v4u*)(fsrc + (size_t)(32 * q) * NBH);
    pv = *(const GAS v4u*)vsrc;
    LAS float* SM = (LAS float*)(F.lds + HALO_OFF); LAS float* OW = SM + 1024; LAS float* OH = OW + 1024;
    const bf16* PS = PB + (size_t)(MP + sj) * NBH + 512 * sh;
    const float* S0 = F.a->in[I_SHG] + (size_t)sj * 131072 + (size_t)sh * 65536; float* S1 = F.out + O_SHG + (size_t)sj * 131072 + (size_t)sh * 65536;
    const int ln_ = lane_op_();
    f32x4 oacc = {0.f, 0.f, 0.f, 0.f};
    const int kt = wave - 4;
    f32x16 acc;
#pragma unroll
    for (int i = 0; i < 16; ++i) acc[i] = 0.f;
#pragma unroll 1
    for (int cc = 0; cc < 16; ++cc) {
        LAS unsigned char* KT = KT0 + (cc & 1) * 128 * KP; LAS unsigned char* VT = VT0 + (cc & 1) * 32 * KP;
        const int hl = cc >> 2, si0 = cc * 1024 + tid, si1 = si0 + 512;
        const f32x4 sv0 = *(const GAS f32x4*)(S0 + (size_t)si0 * 4), sv1 = *(const GAS f32x4*)(S0 + (size_t)si1 * 4);
        if ((cc & 3) == 0 && tid < 128) { LAS float* sm = SM + (hl & 1) * 512; const int c = hl * 128 + tid; const float lbs = hg_lb(F, 512 * sh + c), sg = sigmoidf_(bf2f(PS[1024 + c]));
            sm[tid] = lbs + (1.f - lbs) * sg; sm[128 + tid] = (1.f - lbs) * (1.f - sg); sm[256 + tid] = siluf_(bf2f(PS[c])); sm[384 + tid] = bf2f(PS[2048 + c]); }
#pragma unroll
        for (int q = 0; q < 4; ++q) *(LAS v4u*)(RAW + ((tid >> 4) + 32 * q) * KP + 16 * (tid & 15)) = pf[q];
        { const unsigned ww[4] = {pv.x, pv.y, pv.z, pv.w};
#pragma unroll
          for (int e = 0; e < 4; ++e) { *(LAS unsigned short*)(VT + (8 * voc + 2 * e) * KP + 2 * vs) = (unsigned short)(ww[e] & 0xffffu); *(LAS unsigned short*)(VT + (8 * voc + 2 * e + 1) * KP + 2 * vs) = (unsigned short)(ww[e] >> 16); } }
        if (cc + 1 < 16) {
#pragma unroll
            for (int q = 0; q < 4; ++q) pf[q] = *(const GAS v4u*)(fsrc + (size_t)(128 * (cc + 1) + 32 * q) * NBH);
            pv = *(const GAS v4u*)(vsrc + (size_t)(128 * (cc + 1)) * NBH); }
        if (wave >= 4) {
            bf16* sb = SB + ((((size_t)b * 16 + cc) * 8 + h) * 128 + vq * 32) * 128 + kt * 32 + r;
#pragma unroll
            for (int i = 0; i < 16; ++i) sb[(size_t)((i & 3) + 8 * (i >> 2) + 4 * hh) * 128] = (bf16)f2bf(acc[i]); }
        asm volatile("s_waitcnt lgkmcnt(0)" ::: "memory"); __builtin_amdgcn_s_barrier(); asm volatile("" ::: "memory");
        float kp[32];
        { float run = 1.f;
#pragma unroll
          for (int j = 31; j >= 0; --j) { const float sg = sigmoidf_(bf2f(*(const LAS unsigned short*)(RAW + (32 * seg + j) * KP + 2 * kcol))); kp[j] = (1.f - lb) * (1.f - sg) * run; run *= lb + (1.f - lb) * sg; }
          SEG[seg * 128 + kcol] = run; }
        asm volatile("s_waitcnt lgkmcnt(0)" ::: "memory"); __builtin_amdgcn_s_barrier(); asm volatile("" ::: "memory");
        { const float t0 = SEG[kcol], t1 = SEG[128 + kcol], t2 = SEG[256 + kcol], t3 = SEG[384 + kcol];
          const float R = seg == 3 ? 1.f : (seg == 2 ? t3 : (seg == 1 ? t2 * t3 : t1 * t2 * t3));
          if (seg == 0) EL[(cc & 1) * 128 + kcol] = (t0 * t1) * (t2 * t3);
#pragma unroll
          for (int j8 = 0; j8 < 4; ++j8) { v4u p;
              p.x = pk2(kp[8 * j8] * R, kp[8 * j8 + 1] * R); p.y = pk2(kp[8 * j8 + 2] * R, kp[8 * j8 + 3] * R); p.z = pk2(kp[8 * j8 + 4] * R, kp[8 * j8 + 5] * R); p.w = pk2(kp[8 * j8 + 6] * R, kp[8 * j8 + 7] * R);
              *(LAS v4u*)(KT + kcol * KP + 2 * (32 * seg + 8 * j8)) = p; } }
        asm volatile("s_waitcnt lgkmcnt(0)" ::: "memory"); __builtin_amdgcn_s_barrier(); asm volatile("" ::: "memory");
        if (wave >= 4) {
            const float el = EL[(cc & 1) * 128 + kt * 32 + r];
#pragma unroll
            for (int i = 0; i < 16; ++i) acc[i] *= el;
#pragma unroll
            for (int ks = 0; ks < 8; ++ks) { const bf16x8 a = *(const LAS bf16x8*)(VT + r * KP + 32 * ks + 16 * hh), bb = *(const LAS bf16x8*)(KT + (kt * 32 + r) * KP + 32 * ks + 16 * hh);
                acc = __builtin_amdgcn_mfma_f32_32x32x16_bf16(a, bb, acc, 0, 0, 0); }
        }
        { const LAS float* sm = SM + (hl & 1) * 512; const int v4 = (tid & 31) * 4; const f32x4 vv = *(const LAS f32x4*)(sm + 384 + v4);
          const int k0 = (si0 >> 5) & 127, k1 = (si1 >> 5) & 127;
          const f32x4 n0 = sv0 * sm[k0] + vv * sm[128 + k0], n1 = sv1 * sm[k1] + vv * sm[128 + k1];
          *(GAS f32x4*)(S1 + (size_t)si0 * 4) = n0; *(GAS f32x4*)(S1 + (size_t)si1 * 4) = n1;
          oacc += n0 * sm[256 + k0] + n1 * sm[256 + k1];
          if ((cc & 3) == 3) {
              f32x4 t; t[0] = oacc[0] + shx_(oacc[0], 32, ln_); t[1] = oacc[1] + shx_(oacc[1], 32, ln_); t[2] = oacc[2] + shx_(oacc[2], 32, ln_); t[3] = oacc[3] + shx_(oacc[3], 32, ln_);
              if (lane < 32) *(LAS f32x4*)(OW + wave * 128 + v4) = t;
              oacc = (f32x4){0.f, 0.f, 0.f, 0.f}; } }
        if ((cc & 3) == 0 && cc > 0 && tid < 128) { float o = 0.f;
#pragma unroll
            for (int w = 0; w < 8; ++w) o += OW[w * 128 + tid];
            OH[(hl - 1) * 128 + tid] = o; }
    }
    __syncthreads();
    if (tid < 128) { float o = 0.f;
#pragma unroll
        for (int w = 0; w < 8; ++w) o += OW[w * 128 + tid];
        OH[3 * 128 + tid] = o; }
    __syncthreads();
    { const int c = tid; const float o = OH[c]; const float ss = wave_sum(o * o); if (lane == 0) SM[wave] = ss;
      __syncthreads();
      const float rs = rsqrtf((SM[(tid >> 7) * 2] + SM[(tid >> 7) * 2 + 1]) * (1.f / 128.f) + EPS);
      ((bf16*)(F.ws + WS_MIXS) + (size_t)sj * 2048 + 1024 + 512 * sh)[c] = (bf16)f2bf(o * rs * F.a->in[I_HGNW][c & 127] * siluf_(bf2f(PS[3072 + c]))); }
    if (wave >= 4) { float* ps = F.out + O_PHG + ((size_t)(b * 8 + h) * 128 + kt * 32 + r) * 128 + vq * 32;
#pragma unroll
        for (int i = 0; i < 16; ++i) ps[(i & 3) + 8 * (i >> 2) + 4 * hh] = acc[i]; }
    __syncthreads();
}

__device__ __forceinline__ void hg_out_phase(Frame& F) {
    const bf16* PB = (const bf16*)(F.ws + WS_BIG + B_PROJB); const bf16* SB = (const bf16*)(F.ws + WS_BIG + B_SB);
    constexpr int KP = 272, SP = 80, OP = 528;
    LAS unsigned char* QH = F.lds;
    LAS unsigned char* Q1 = QH + 32 * KP;
    LAS unsigned char* KA = Q1 + 16 * KP;
    LAS unsigned char* KB = KA + 16 * KP;
    LAS unsigned char* KHT = KB + 32 * KP;
    LAS unsigned char* VT = KHT + 128 * SP;
    LAS float* CSEG = (LAS float*)(VT + 128 * SP);
    LAS float* EL = CSEG + 512;
    LAS float* SSQ = EL + 128;
    LAS unsigned char* OF = (LAS unsigned char*)(SSQ + 256);
    LAS unsigned char* RQ = OF + 32 * OP;
    LAS unsigned char* RF = RQ + 32 * KP;
    int tid = F.tid; asm volatile("" : "+v"(tid));
    const int lane = tid & 63, wave = __builtin_amdgcn_readfirstlane(tid >> 6), fr = lane & 15, q4 = lane >> 4;
    const int kcol = tid & 127, seg = tid >> 7;
    const int NITEM = 8 * 16 * 8;
    const int nit = F.vcu < NITEM ? (NITEM - 1 - F.vcu) / F.G + 1 : 0, NIT = 4 * nit;
    v4u pq, pf, pv, pg;
#define HG_ROW0(n) ((((F.vcu + ((n) >> 2) * F.G) >> 7) * SEQ) + 128 * (((F.vcu + ((n) >> 2) * F.G) >> 3) & 15) + 32 * ((n) & 3))
#define HG_HEAD(n) ((F.vcu + ((n) >> 2) * F.G) & 7)
#define HG_PREFETCH(n) do { const int T0_ = HG_ROW0(n), h_ = HG_HEAD(n); const bf16* rp_ = PB + (size_t)(T0_ + (tid >> 4)) * NBH + h_ * 128 + 8 * (tid & 15); \
        pq = *(const GAS v4u*)rp_; pf = *(const GAS v4u*)(rp_ + 1024); pv = *(const GAS v4u*)(rp_ + 2048); pg = *(const GAS v4u*)(rp_ + 3072); } while (0)
    if (NIT > 0) HG_PREFETCH(0);
    f32x4 S[8]; v2u psb[8];
    float lb = 0.f;
#pragma unroll 1
    for (int n = 0; n < NIT; ++n) {
        const int item = F.vcu + (n >> 2) * F.G, b = item >> 7, cc = (item >> 3) & 15, h = item & 7, fc = n & 3;
        const int T0 = b * SEQ + 128 * cc + 32 * fc;
        const v4u vv = pv, gv = pg;
        *(LAS v4u*)(RQ + (tid >> 4) * KP + 16 * (tid & 15)) = pq; *(LAS v4u*)(RF + (tid >> 4) * KP + 16 * (tid & 15)) = pf;
        if (n + 1 < NIT) HG_PREFETCH(n + 1);
        if (fc == 0) {
            lb = hg_lb(F, h * 128 + kcol);
            if (n == 0) { const bf16* sb = SB + ((((size_t)b * 16 + cc) * 8 + h) * 128 + 16 * wave + fr) * 128 + 4 * q4;
#pragma unroll
                for (int kt = 0; kt < 8; ++kt) psb[kt] = *(const GAS v2u*)(sb + 16 * kt); }
#pragma unroll
            for (int kt = 0; kt < 8; ++kt) { const v2u u = psb[kt]; S[kt][0] = bflo(u.x); S[kt][1] = bfhi(u.x); S[kt][2] = bflo(u.y); S[kt][3] = bfhi(u.y); } }
        if (fc == 3 && n + 1 < NIT) { const int it2 = F.vcu + ((n + 1) >> 2) * F.G; const bf16* sb = SB + ((((size_t)(it2 >> 7) * 16 + ((it2 >> 3) & 15)) * 8 + (it2 & 7)) * 128 + 16 * wave + fr) * 128 + 4 * q4;
#pragma unroll
            for (int kt = 0; kt < 8; ++kt) psb[kt] = *(const GAS v2u*)(sb + 16 * kt); }
        asm volatile("s_waitcnt lgkmcnt(0)" ::: "memory"); __builtin_amdgcn_s_barrier(); asm volatile("" ::: "memory");
        float cl[8], kk[8], qs[8];
        { float a = 0.f;
#pragma unroll
          for (int j = 0; j < 8; ++j) { const float sg = sigmoidf_(bf2f(*(const LAS unsigned short*)(RF + (8 * seg + j) * KP + 2 * kcol)));
              a += __logf(lb + (1.f - lb) * sg); cl[j] = a; kk[j] = (1.f - lb) * (1.f - sg); qs[j] = siluf_(bf2f(*(const LAS unsigned short*)(RQ + (8 * seg + j) * KP + 2 * kcol))); }
          CSEG[seg * 128 + kcol] = a; }
        { const int s = tid >> 4, oc = tid & 15; const unsigned ww[4] = {vv.x, vv.y, vv.z, vv.w};
#pragma unroll
          for (int e = 0; e < 4; ++e) { *(LAS unsigned short*)(VT + (8 * oc + 2 * e) * SP + 2 * s) = (unsigned short)(ww[e] & 0xffffu); *(LAS unsigned short*)(VT + (8 * oc + 2 * e + 1) * SP + 2 * s) = (unsigned short)(ww[e] >> 16); } }
        asm volatile("s_waitcnt lgkmcnt(0)" ::: "memory"); __builtin_amdgcn_s_barrier(); asm volatile("" ::: "memory");
        { const float t0 = CSEG[kcol], t1 = CSEG[128 + kcol], t2 = CSEG[256 + kcol], t3 = CSEG[384 + kcol];
          const float off = seg == 0 ? 0.f : (seg == 1 ? t0 : (seg == 2 ? t0 + t1 : t0 + t1 + t2)), c15 = t0 + t1, last = (t0 + t1) + (t2 + t3);
          if (seg == 0) EL[kcol] = __expf(last);
#pragma unroll
          for (int j = 0; j < 8; ++j) { const int t = 8 * seg + j; const float cum = off + cl[j];
              *(LAS unsigned short*)(QH + t * KP + 2 * kcol) = (unsigned short)f2bf(qs[j] * __expf(cum));
              if (seg >= 2) *(LAS unsigned short*)(Q1 + (t - 16) * KP + 2 * kcol) = (unsigned short)f2bf(qs[j] * __expf(cum - c15));
              else *(LAS unsigned short*)(KA + t * KP + 2 * kcol) = (unsigned short)f2bf(kk[j] * __expf(fminf(-cum, 80.f)));
              *(LAS unsigned short*)(KB + t * KP + 2 * kcol) = (unsigned short)f2bf(kk[j] * __expf(fminf(c15 - cum, 80.f)));
              *(LAS unsigned short*)(KHT + kcol * SP + 2 * t) = (unsigned short)f2bf(kk[j] * __expf(last - cum)); } }
        asm volatile("s_waitcnt lgkmcnt(0)" ::: "memory"); __builtin_amdgcn_s_barrier(); asm volatile("" ::: "memory");
        f32x4 at00 = {0.f, 0.f, 0.f, 0.f}, at01 = at00, at11 = at00;
#pragma unroll
        for (int ks = 0; ks < 4; ++ks) { const int kb = 64 * ks + 16 * q4;
            const bf16x8 ka = *(const LAS bf16x8*)(KA + fr * KP + kb), kb0 = *(const LAS bf16x8*)(KB + fr * KP + kb), kb1 = *(const LAS bf16x8*)(KB + (16 + fr) * KP + kb);
            const bf16x8 qh = *(const LAS bf16x8*)(QH + fr * KP + kb), q1 = *(const LAS bf16x8*)(Q1 + fr * KP + kb);
            at00 = __builtin_amdgcn_mfma_f32_16x16x32_bf16(ka, qh, at00, 0, 0, 0);
            at01 = __builtin_amdgcn_mfma_f32_16x16x32_bf16(kb0, q1, at01, 0, 0, 0);
            at11 = __builtin_amdgcn_mfma_f32_16x16x32_bf16(kb1, q1, at11, 0, 0, 0); }
#pragma unroll
        for (int e = 0; e < 4; ++e) { const bool keep = (4 * q4 + e) <= fr; at00[e] = keep ? at00[e] : 0.f; at11[e] = keep ? at11[e] : 0.f; }
        v4u pa0, pa1;
        pa0.x = pk2(at00[0], at00[1]); pa0.y = pk2(at00[2], at00[3]); pa0.z = 0u; pa0.w = 0u;
        pa1.x = pk2(at01[0], at01[1]); pa1.y = pk2(at01[2], at01[3]); pa1.z = pk2(at11[0], at11[1]); pa1.w = pk2(at11[2], at11[3]);
        f32x4 o0 = {0.f, 0.f, 0.f, 0.f}, o1 = o0;
        { const LAS unsigned char* vrow = VT + (16 * wave + fr) * SP; const v2u lo = *(const LAS v2u*)(vrow + 8 * q4), hi = *(const LAS v2u*)(vrow + 32 + 8 * q4);
          v4u bv; bv.x = lo.x; bv.y = lo.y; bv.z = hi.x; bv.w = hi.y;
          o0 = __builtin_amdgcn_mfma_f32_16x16x32_bf16(__builtin_bit_cast(bf16x8, pa0), __builtin_bit_cast(bf16x8, bv), o0, 0, 0, 0);
          o1 = __builtin_amdgcn_mfma_f32_16x16x32_bf16(__builtin_bit_cast(bf16x8, pa1), __builtin_bit_cast(bf16x8, bv), o1, 0, 0, 0); }
#pragma unroll
        for (int ks = 0; ks < 4; ++ks) { v4u bs; bs.x = pk2(S[2 * ks][0], S[2 * ks][1]); bs.y = pk2(S[2 * ks][2], S[2 * ks][3]); bs.z = pk2(S[2 * ks + 1][0], S[2 * ks + 1][1]); bs.w = pk2(S[2 * ks + 1][2], S[2 * ks + 1][3]);
            const int kb = 64 * ks + 8 * q4;
            const v2u a0l = *(const LAS v2u*)(QH + fr * KP + kb), a0h = *(const LAS v2u*)(QH + fr * KP + kb + 32), a1l = *(const LAS v2u*)(QH + (16 + fr) * KP + kb), a1h = *(const LAS v2u*)(QH + (16 + fr) * KP + kb + 32);
            v4u a0; a0.x = a0l.x; a0.y = a0l.y; a0.z = a0h.x; a0.w = a0h.y; v4u a1; a1.x = a1l.x; a1.y = a1l.y; a1.z = a1h.x; a1.w = a1h.y;
            o0 = __builtin_amdgcn_mfma_f32_16x16x32_bf16(__builtin_bit_cast(bf16x8, a0), __builtin_bit_cast(bf16x8, bs), o0, 0, 0, 0);
            o1 = __builtin_amdgcn_mfma_f32_16x16x32_bf16(__builtin_bit_cast(bf16x8, a1), __builtin_bit_cast(bf16x8, bs), o1, 0, 0, 0); }
#pragma unroll
        for (int e = 0; e < 4; ++e) { const int t0r = 4 * q4 + e; *(LAS float*)(OF + t0r * OP + 4 * (16 * wave + fr)) = o0[e]; *(LAS float*)(OF + (16 + t0r) * OP + 4 * (16 * wave + fr)) = o1[e];
            const float s0 = row16_sum(o0[e] * o0[e]), s1 = row16_sum(o1[e] * o1[e]);
            if (fr == 0) { SSQ[wave * 32 + t0r] = s0; SSQ[wave * 32 + 16 + t0r] = s1; } }
        { const bf16x8 bv = *(const LAS bf16x8*)(VT + (16 * wave + fr) * SP + 16 * q4);
#pragma unroll
          for (int kt = 0; kt < 8; ++kt) { const f32x4 el = *(const LAS f32x4*)(EL + 16 * kt + 4 * q4); const bf16x8 ak = *(const LAS bf16x8*)(KHT + (16 * kt + fr) * SP + 16 * q4);
              S[kt] = __builtin_amdgcn_mfma_f32_16x16x32_bf16(ak, bv, S[kt] * el, 0, 0, 0); } }
        asm volatile("s_waitcnt lgkmcnt(0)" ::: "memory"); __builtin_amdgcn_s_barrier(); asm volatile("" ::: "memory");
        { const int t = tid >> 4, v8 = (tid & 15) * 8; float tot = 0.f;
#pragma unroll
          for (int w = 0; w < 8; ++w) tot += SSQ[w * 32 + t];
          const float rs = rsqrtf(tot * (1.f / 128.f) + EPS);
          const f32x4 oa = *(const LAS f32x4*)(OF + t * OP + 4 * v8), ob = *(const LAS f32x4*)(OF + t * OP + 4 * v8 + 16);
          const f32x4 wa = *(const GAS f32x4*)(F.a->in[I_HGNW] + v8), wb = *(const GAS f32x4*)(F.a->in[I_HGNW] + v8 + 4);
          v4u o; o.x = pk2(oa.x * rs * wa.x * siluf_(bflo(gv.x)), oa.y * rs * wa.y * siluf_(bfhi(gv.x))); o.y = pk2(oa.z * rs * wa.z * siluf_(bflo(gv.y)), oa.w * rs * wa.w * siluf_(bfhi(gv.y)));
          o.z = pk2(ob.x * rs * wb.x * siluf_(bflo(gv.z)), ob.y * rs * wb.y * siluf_(bfhi(gv.z))); o.w = pk2(ob.z * rs * wb.z * siluf_(bflo(gv.w)), ob.w * rs * wb.w * siluf_(bfhi(gv.w)));
          *(GAS v4u*)((bf16*)(F.out + O_YP) + (size_t)(T0 + t) * 2048 + 1024 + h * 128 + v8) = o; }
    }
#undef HG_ROW0
#undef HG_HEAD
#undef HG_PREFETCH
    __syncthreads();
}

__device__ __forceinline__ void hg_sample_item(Frame& F, int j, int half) {
    const bf16* PB = (const bf16*)(F.ws + WS_BIG + B_PROJB) + (size_t)(MP + j) * NBH + 512 * half; bf16* MX = (bf16*)(F.ws + WS_MIXS) + (size_t)j * 2048 + 1024 + 512 * half;
    LAS float* fS = (LAS float*)F.lds;
    LAS float* kS = fS + 512; LAS float* qS = kS + 512; LAS float* vS = qS + 512; LAS float* oP = vS + 512;
    int tid = F.tid; asm volatile("" : "+v"(tid));
    { const int c = tid; const float lb = hg_lb(F, 512 * half + c), sg = sigmoidf_(bf2f(PB[1024 + c]));
      fS[c] = lb + (1.f - lb) * sg; kS[c] = (1.f - lb) * (1.f - sg); qS[c] = siluf_(bf2f(PB[c])); vS[c] = bf2f(PB[2048 + c]); }
    __syncthreads();
    const int v4 = (tid & 31) * 4, krow = tid >> 5;
    const float* S0 = F.a->in[I_SHG] + (size_t)j * 131072 + (size_t)half * 65536; float* S1 = F.out + O_SHG + (size_t)j * 131072 + (size_t)half * 65536;
#pragma unroll 1
    for (int hl = 0; hl < 4; ++hl) { const f32x4 vv = *(const LAS f32x4*)(vS + hl * 128 + v4); f32x4 a = {0.f, 0.f, 0.f, 0.f};
        f32x4 sv[8];
#pragma unroll
        for (int kb = 0; kb < 8; ++kb) sv[kb] = *(const GAS f32x4*)(S0 + ((size_t)hl * 128 + krow + 16 * kb) * 128 + v4);
#pragma unroll
        for (int kb = 0; kb < 8; ++kb) { const int k = krow + 16 * kb; const f32x4 sn = sv[kb] * fS[hl * 128 + k] + vv * kS[hl * 128 + k];
            *(GAS f32x4*)(S1 + ((size_t)hl * 128 + k) * 128 + v4) = sn; a += sn * qS[hl * 128 + k]; }
        *(LAS f32x4*)(oP + krow * 512 + hl * 128 + v4) = a; }
    __syncthreads();
    { const int c = tid; float o = 0.f;
#pragma unroll
      for (int q = 0; q < 16; ++q) o += oP[q * 512 + c];
      float ss = wave_sum(o * o); if ((tid & 63) == 0) fS[tid >> 6] = ss;
      __syncthreads();
      const float tot = fS[(tid >> 7) * 2] + fS[(tid >> 7) * 2 + 1];
      const float rs = rsqrtf(tot * (1.f / 128.f) + EPS);
      MX[c] = (bf16)f2bf(o * rs * F.a->in[I_HGNW][c & 127] * siluf_(bf2f(PB[3072 + c]))); }
    __syncthreads();
}
__device__ __forceinline__ void hg_state_phase(Frame& F) {
    for (int it = F.vcu; it < 256; it += F.G) hg_state_item(F, it >> 5, (it >> 2) & 7, it & 3, it >> 1, it & 1);
}

__device__ __forceinline__ void s5_lambda(const Frame& F, int g, int n, float& abr, float& abi, float& cfr, float& cfi) {
    const float lr = F.a->in[I_LAMRE][g * 64 + n], li = F.a->in[I_LAMIM][g * 64 + n], step = expf(F.a->in[I_LOGSTEP][g]);
    const float mag = expf(lr * step); float sn, cs; sincosf(li * step, &sn, &cs);
    abr = mag * cs; abi = mag * sn;
    const float den = lr * lr + li * li, nr = abr - 1.0f;
    cfr = (nr * lr + abi * li) / den; cfi = (abi * lr - nr * li) / den;
}
__device__ __forceinline__ void s5_tables_item(Frame& F, int g) {
    LAS float* POW = (LAS float*)F.lds;
    LAS float* CC = POW + 17 * 128;
    LAS float* BB = CC + 16 * 128;
    LAS float* KS = BB + 64 * 32;
    const int tid = F.tid;
    bf16* KQ = (bf16*)((unsigned char*)(F.out + O_YP) + S5T_KQ) + (size_t)g * 256 * 384; bf16* PM = (bf16*)((unsigned char*)(F.out + O_YP) + S5T_PM) + (size_t)g * 128 * 256;
    if (tid < 64) { const int n = tid; float abr, abi, cfr, cfi; s5_lambda(F, g, n, abr, abi, cfr, cfi);
        float pr = 1.f, pi = 0.f;
        for (int t = 0; t <= 16; ++t) { POW[(t * 64 + n) * 2] = pr; POW[(t * 64 + n) * 2 + 1] = pi; const float nr = pr * abr - pi * abi, ni = pr * abi + pi * abr; pr = nr; pi = ni; }
        const float* br = F.a->in[I_BRE] + (size_t)(g * 64 + n) * 16; const float* bi = F.a->in[I_BIM] + (size_t)(g * 64 + n) * 16;
        float* gab = (float*)((unsigned char*)(F.out + O_YP) + S5T_AB) + (size_t)(g * 64 + n) * 2; float* gbb = (float*)((unsigned char*)(F.out + O_YP) + S5T_BB) + (size_t)(g * 64 + n) * 32;
        gab[0] = abr; gab[1] = abi;
        for (int c = 0; c < 16; ++c) { const float vr = cfr * br[c] - cfi * bi[c], vi = cfr * bi[c] + cfi * br[c]; BB[(n * 16 + c) * 2] = vr; BB[(n * 16 + c) * 2 + 1] = vi; gbb[2 * c] = vr; gbb[2 * c + 1] = vi; } }
    for (int e = tid; e < 1024; e += NTHR) { CC[e * 2] = F.a->in[I_CRE][(size_t)g * 1024 + e]; CC[e * 2 + 1] = F.a->in[I_CIM][(size_t)g * 1024 + e]; }
    __syncthreads();
    { const int cc = tid & 255, cp = cc >> 4, c = cc & 15, th = tid >> 8; float a[8];
#pragma unroll
      for (int i = 0; i < 8; ++i) a[i] = 0.f;
      for (int n = 0; n < 64; ++n) { const float cr = CC[(cp * 64 + n) * 2], ci = CC[(cp * 64 + n) * 2 + 1], br = BB[(n * 16 + c) * 2], bi = BB[(n * 16 + c) * 2 + 1];
          const float xr = cr * br - ci * bi, xi = cr * bi + ci * br;
#pragma unroll
          for (int i = 0; i < 8; ++i) { const int t = th + 2 * i; a[i] += xr * POW[(t * 64 + n) * 2] - xi * POW[(t * 64 + n) * 2 + 1]; } }
#pragma unroll
      for (int i = 0; i < 8; ++i) KS[(th + 2 * i) * 256 + cc] = a[i]; }
    __syncthreads();
    for (int e2 = tid; e2 < 256 * 192; e2 += NTHR) { const int row = e2 / 192, col0 = (e2 % 192) * 2, t = row >> 4, cp = row & 15; float v[2];
#pragma unroll
        for (int q = 0; q < 2; ++q) { const int col = col0 + q;
            if (col < 256) { const int s = col >> 4, c = col & 15; v[q] = s <= t ? KS[(t - s) * 256 + cp * 16 + c] : 0.f; }
            else { const int np = col - 256, n = np & 63; const float pr = POW[((t + 1) * 64 + n) * 2], pi = POW[((t + 1) * 64 + n) * 2 + 1], cr = CC[(cp * 64 + n) * 2], ci = CC[(cp * 64 + n) * 2 + 1];
                v[q] = np < 64 ? cr * pr - ci * pi : -(cr * pi + ci * pr); } }
        *(GAS unsigned*)(KQ + (size_t)row * 384 + col0) = pk2(v[0], v[1]); }
    for (int e2 = tid; e2 < 128 * 128; e2 += NTHR) { const int np = e2 >> 7, col0 = (e2 & 127) * 2, n = np & 63; float v[2];
#pragma unroll
        for (int q = 0; q < 2; ++q) { const int col = col0 + q, s = col >> 4, c = col & 15; const float pr = POW[((15 - s) * 64 + n) * 2], pi = POW[((15 - s) * 64 + n) * 2 + 1], br = BB[(n * 16 + c) * 2], bi = BB[(n * 16 + c) * 2 + 1];
            v[q] = np < 64 ? pr * br - pi * bi : pr * bi + pi * br; }
        *(GAS unsigned*)(PM + (size_t)np * 256 + col0) = pk2(v[0], v[1]); }
    __syncthreads();
}
__device__ __forceinline__ void s5_fused_item(Frame& F, int b, int g) {
    const bf16* HN = (const bf16*)(F.ws + WS_XN); const bf16* PM = (const bf16*)((unsigned char*)(F.out + O_YP) + S5T_PM) + (size_t)g * 128 * 256; const bf16* KQ = (const bf16*)((unsigned char*)(F.out + O_YP) + S5T_KQ) + (size_t)g * 256 * 384;
    bf16* GY = (bf16*)(F.ws + WS_BIG + B_GY);
    constexpr int UP_ = 528, PP = 132, XPP = 272, KQP = 784;
    LAS unsigned char* UL = F.lds;
    LAS unsigned char* XL = UL;
    LAS unsigned char* BL = UL + 128 * XPP;
    LAS float* PL = (LAS float*)BL;
    LAS float* SE = (LAS float*)(BL + 128 * UP_);
    static_assert(64 * UP_ <= 128 * XPP && 128 * PP * 4 <= 128 * UP_ && 64 * KQP <= 128 * UP_ && 128 * XPP + 128 * UP_ + 4096 <= RING_BYTES, "s5 LDS map");
    int tid = F.tid; asm volatile("" : "+v"(tid));
    const int lane = tid & 63, wave = __builtin_amdgcn_readfirstlane(tid >> 6), r = lane & 31, hh = lane >> 5, mt = wave >> 1, ch = wave & 1;
    for (int e = tid; e < 128 * 32; e += NTHR) { const int row = e >> 5, c16 = e & 31; *(LAS v4u*)(BL + row * UP_ + 16 * c16) = *(const GAS v4u*)(PM + (size_t)row * 256 + 8 * c16); }
    bf16x8 au[16];
#pragma unroll
    for (int half = 0; half < 2; ++half) {
        for (int e = tid; e < 64 * 32; e += NTHR) { const int tok = e >> 1, pc = e & 1, m = tok >> 4, s2 = tok & 15;
            *(LAS v4u*)(UL + m * UP_ + 32 * s2 + 16 * pc) = *(const GAS v4u*)(HN + (size_t)(b * SEQ + 1024 * half + tok) * D + 16 * g + 8 * pc); }
        __syncthreads();
        if ((mt >> 1) == half) {
#pragma unroll
            for (int s2 = 0; s2 < 16; ++s2) au[s2] = *(const LAS bf16x8*)(UL + (32 * (mt & 1) + r) * UP_ + 32 * s2 + 16 * hh); }
        __syncthreads();
    }
    { f32x16 acc[2];
#pragma unroll
      for (int nt = 0; nt < 2; ++nt)
#pragma unroll
          for (int i = 0; i < 16; ++i) acc[nt][i] = 0.f;
#pragma unroll
      for (int s2 = 0; s2 < 16; ++s2)
#pragma unroll
          for (int nt = 0; nt < 2; ++nt) { const bf16x8 bb = *(const LAS bf16x8*)(BL + (64 * ch + 32 * nt + r) * UP_ + 32 * s2 + 16 * hh); acc[nt] = __builtin_amdgcn_mfma_f32_32x32x16_bf16(au[s2], bb, acc[nt], 0, 0, 0); }
      __syncthreads();
#pragma unroll
      for (int nt = 0; nt < 2; ++nt)
#pragma unroll
          for (int i = 0; i < 16; ++i) PL[(32 * mt + (i & 3) + 8 * (i >> 2) + 4 * hh) * PP + 64 * ch + 32 * nt + r] = acc[nt][i]; }
    __syncthreads();
    { const int n = lane, seg = wave; float abr, abi, cfr, cfi; s5_lambda(F, g, n, abr, abi, cfr, cfi);
#pragma unroll
      for (int q = 0; q < 4; ++q) { const float nr = abr * abr - abi * abi, ni = 2.f * abr * abi; abr = nr; abi = ni; }
      float yr[16], yi[16];
      { float xr = 0.f, xi = 0.f;
#pragma unroll
        for (int i = 0; i < 16; ++i) { const float pr = PL[(16 * seg + i) * PP + n], pi = PL[(16 * seg + i) * PP + 64 + n]; const float nr = abr * xr - abi * xi + pr, ni = abr * xi + abi * xr + pi; xr = nr; xi = ni; yr[i] = xr; yi[i] = xi; }
        SE[seg * 128 + n] = xr; SE[seg * 128 + 64 + n] = xi; }
      float a16r = abr, a16i = abi;
#pragma unroll
      for (int q = 0; q < 4; ++q) { const float nr = a16r * a16r - a16i * a16i, ni = 2.f * a16r * a16i; a16r = nr; a16i = ni; }
      __syncthreads();
      float cr = 0.f, ci = 0.f;
      for (int s2 = 0; s2 < seg; ++s2) { const float er = SE[s2 * 128 + n], ei = SE[s2 * 128 + 64 + n]; const float nr = a16r * cr - a16i * ci + er, ni = a16r * ci + a16i * cr + ei; cr = nr; ci = ni; }
      float pwr = 1.f, pwi = 0.f;
#pragma unroll
      for (int i = 0; i < 16; ++i) { const float xr = (i == 0 ? 0.f : yr[i == 0 ? 0 : i - 1]) + pwr * cr - pwi * ci, xi = (i == 0 ? 0.f : yi[i == 0 ? 0 : i - 1]) + pwr * ci + pwi * cr;
          *(LAS unsigned short*)(XL + (16 * seg + i) * XPP + 2 * n) = (unsigned short)f2bf(xr); *(LAS unsigned short*)(XL + (16 * seg + i) * XPP + 2 * (64 + n)) = (unsigned short)f2bf(xi);
          const float nr = pwr * abr - pwi * abi, ni = pwr * abi + pwi * abr; pwr = nr; pwi = ni; }
      if (seg == 7) { const float xr = yr[15] + pwr * cr - pwi * ci, xi = yi[15] + pwr * ci + pwi * cr;
          F.out[O_PS5R + (size_t)(b * 64 + g) * 64 + n] = xr; F.out[O_PS5I + (size_t)(b * 64 + g) * 64 + n] = xi; } }
    __syncthreads();
    bf16x8 ax[8];
#pragma unroll
    for (int s2 = 0; s2 < 8; ++s2) ax[s2] = *(const LAS bf16x8*)(XL + (32 * mt + r) * XPP + 32 * s2 + 16 * hh);
    v4u kq[6];
#pragma unroll
    for (int q = 0; q < 6; ++q) { const int e = tid + NTHR * q, row = e / 48, c16 = e % 48; kq[q] = *(const GAS v4u*)(KQ + (size_t)row * 384 + 8 * c16); }
#pragma unroll 1
    for (int p = 0; p < 4; ++p) {
#pragma unroll
        for (int q = 0; q < 6; ++q) { const int e = tid + NTHR * q, row = e / 48, c16 = e % 48; *(LAS v4u*)(BL + row * KQP + 16 * c16) = kq[q]; }
        if (p < 3) {
#pragma unroll
            for (int q = 0; q < 6; ++q) { const int e = tid + NTHR * q, row = e / 48, c16 = e % 48; kq[q] = *(const GAS v4u*)(KQ + (size_t)(64 * (p + 1) + row) * 384 + 8 * c16); } }
        v4u uq[2];
#pragma unroll
        for (int q = 0; q < 2; ++q) { const int e = tid + NTHR * q, m = e >> 3, tl = (e >> 1) & 3, hf = e & 1; uq[q] = *(const GAS v4u*)(HN + (size_t)(b * SEQ + 16 * m + 4 * p + tl) * D + 16 * g + 8 * hf); }
        __syncthreads();
        f32x16 acc;
#pragma unroll
        for (int i = 0; i < 16; ++i) acc[i] = 0.f;
        const LAS unsigned char* brow = BL + (32 * ch + r) * KQP + 16 * hh;
#pragma unroll
        for (int s2 = 0; s2 < 16; ++s2) acc = __builtin_amdgcn_mfma_f32_32x32x16_bf16(au[s2], *(const LAS bf16x8*)(brow + 32 * s2), acc, 0, 0, 0);
#pragma unroll
        for (int s2 = 0; s2 < 8; ++s2) acc = __builtin_amdgcn_mfma_f32_32x32x16_bf16(ax[s2], *(const LAS bf16x8*)(brow + 512 + 32 * s2), acc, 0, 0, 0);
        { LAS float* OL = (LAS float*)XL;
#pragma unroll
          for (int i = 0; i < 16; ++i) OL[(32 * mt + (i & 3) + 8 * (i >> 2) + 4 * hh) * 68 + 32 * ch + r] = acc[i]; }
        __syncthreads();
#pragma unroll
        for (int q = 0; q < 2; ++q) { const int e = tid + NTHR * q, m = e >> 3, tl = (e >> 1) & 3, hf = e & 1; const LAS float* ol = (const LAS float*)XL + m * 68 + 16 * tl + 8 * hf;
            const f32x4 o0 = *(const LAS f32x4*)ol, o1 = *(const LAS f32x4*)(ol + 4);
            const size_t o = (size_t)(b * SEQ + 16 * m + 4 * p + tl) * D + 16 * g + 8 * hf;
            const v4u uu = uq[q]; const f32x4 d0 = *(const GAS f32x4*)(F.a->in[I_S5D] + 16 * g + 8 * hf), d1 = *(const GAS f32x4*)(F.a->in[I_S5D] + 16 * g + 8 * hf + 4);
            v4u w; w.x = pk2(gelu_tanh(o0.x + d0.x * bflo(uu.x)), gelu_tanh(o0.y + d0.y * bfhi(uu.x))); w.y = pk2(gelu_tanh(o0.z + d0.z * bflo(uu.y)), gelu_tanh(o0.w + d0.w * bfhi(uu.y)));
            w.z = pk2(gelu_tanh(o1.x + d1.x * bflo(uu.z)), gelu_tanh(o1.y + d1.y * bfhi(uu.z))); w.w = pk2(gelu_tanh(o1.z + d1.z * bflo(uu.w)), gelu_tanh(o1.w + d1.w * bfhi(uu.w)));
            *(GAS v4u*)(GY + o) = w; }
        __syncthreads();
    }
}
__device__ __forceinline__ void s5_fused_phase(Frame& F) {
    for (int it = F.vcu; it < 8 * 64; it += F.G) s5_fused_item(F, it >> 6, it & 63);
}
__device__ __forceinline__ void s5_sample(Frame& F) {
    const bf16* HN = (const bf16*)(F.ws + WS_XN) + (size_t)MP * D; bf16* GY = (bf16*)(F.ws + WS_BIG + B_GY) + (size_t)MP * D;
    const float* TAB = (const float*)((unsigned char*)(F.out + O_YP) + S5T_AB); const float* TBB = (const float*)((unsigned char*)(F.out + O_YP) + S5T_BB);
    const int n = F.lane;
    for (int task = GW_ID(F); task < MS * 64; task += GW_N(F)) { const int j = task >> 6, g = task & 63;
        const f32x2_t ab = *(const GAS f32x2_t*)(TAB + (size_t)(g * 64 + n) * 2);
        f32x4 bb[8];
#pragma unroll
        for (int q = 0; q < 8; ++q) bb[q] = *(const GAS f32x4*)(TBB + (size_t)(g * 64 + n) * 32 + 4 * q);
        const v4u u0 = *(const GAS v4u*)(HN + (size_t)j * D + 16 * g), u1 = *(const GAS v4u*)(HN + (size_t)j * D + 16 * g + 8);
        const size_t si = ((size_t)j * 64 + g) * 64 + n; const float sr = F.a->in[I_SS5R][si], sim = F.a->in[I_SS5I][si];
        float cr[16], ci[16];
#pragma unroll
        for (int cp = 0; cp < 16; ++cp) { cr[cp] = F.a->in[I_CRE][((size_t)g * 16 + cp) * 64 + n]; ci[cp] = F.a->in[I_CIM][((size_t)g * 16 + cp) * 64 + n]; }
        const float dsk = F.a->in[I_S5D][16 * g + (n & 15)];
        float u[16]; u[0] = bflo(u0.x); u[1] = bfhi(u0.x); u[2] = bflo(u0.y); u[3] = bfhi(u0.y); u[4] = bflo(u0.z); u[5] = bfhi(u0.z); u[6] = bflo(u0.w); u[7] = bfhi(u0.w);
        u[8] = bflo(u1.x); u[9] = bfhi(u1.x); u[10] = bflo(u1.y); u[11] = bfhi(u1.y); u[12] = bflo(u1.z); u[13] = bfhi(u1.z); u[14] = bflo(u1.w); u[15] = bfhi(u1.w);
        float bur = 0.f, bui = 0.f;
#pragma unroll
        for (int q = 0; q < 8; ++q) { bur += bb[q].x * u[2 * q] + bb[q].z * u[2 * q + 1]; bui += bb[q].y * u[2 * q] + bb[q].w * u[2 * q + 1]; }
        const float xr = ab.x * sr - ab.y * sim + bur, xi = ab.x * sim + ab.y * sr + bui;
        F.out[O_SS5R + si] = xr; F.out[O_SS5I + si] = xi;
        float ymine = 0.f, uu = 0.f;
#pragma unroll
        for (int cp = 0; cp < 16; ++cp) { const float tot = wave_sum(cr[cp] * xr - ci[cp] * xi); ymine = (n == cp) ? tot : ymine; uu = (n == cp) ? u[cp] : uu; }
        if (n < 16) GY[(size_t)j * D + 16 * g + n] = (bf16)f2bf(gelu_tanh(ymine + dsk * uu));
    }
}

constexpr int CW_BAR = 4096;

struct SkAny { int mode; void* O; int ld;
    __device__ __forceinline__ void operator()(int row, int col, const float (&v)[1]) const { if (mode == 0) ((bf16*)O)[(size_t)row * ld + col] = (bf16)f2bf(v[0]); else ((float*)O)[(size_t)row * ld + col] = v[0]; } };

__global__ void __launch_bounds__(NTHR, 2) fwd_kernel(Args args) {
    extern __shared__ __attribute__((aligned(16))) unsigned char lds[];
    Frame F;
    F.lds = (LAS unsigned char*)lds;
    F.tid = threadIdx.x;
    F.out = args.out; F.ws = args.ws;
    volatile LAS unsigned* MISC = (volatile LAS unsigned*)(F.lds + MISC_OFF);
    for (int u = F.tid; u < (LDS_BYTES - LDSCTL_OFF) / 4; u += NTHR) ((LAS unsigned*)(F.lds + LDSCTL_OFF))[u] = 0u;
    __syncthreads();
    const int lo = args.ph_lo, hi = args.ph_hi;
    if (hi - lo > 1) (void)xcd_barrier_post((unsigned*)(args.ws + WS_CTL) + CW_BAR + args.li * XCD_BAR_WORDS, MISC + 8);
#pragma unroll 1
    for (int ph = lo; ph < hi; ++ph) {
        { int t_ = threadIdx.x; asm volatile("" : "+v"(t_)); F.tid = t_; F.lane = t_ & 63; F.wave = __builtin_amdgcn_readfirstlane(t_ >> 6); }
        { int g_ = gridDim.x, b_ = blockIdx.x; asm volatile("" : "+s"(g_), "+s"(b_)); F.G = g_; F.vcu = (g_ % 8 == 0) ? (b_ % 8) * (g_ / 8) + b_ / 8 : b_; }
        { const CAS Args* ap_ = (const CAS Args*)__builtin_amdgcn_kernarg_segment_ptr(); asm volatile("" : "+s"(ap_)); F.a = ap_; }
        { float* o_ = args.out; unsigned char* w_ = args.ws; asm volatile("" : "+s"(o_), "+s"(w_)); F.out = o_; F.ws = w_; }
        unsigned char* BIG = F.ws + WS_BIG; bf16* XN = (bf16*)(F.ws + WS_XN); bf16* WIN = (bf16*)(F.ws + WS_WIN);
        const bf16* gA = nullptr; const bf16* gAs = nullptr; const bf16* gB = nullptr; int gN = 0, gK = 0, gmode = 0, gld = 0; void* gO = nullptr; void* gOs = nullptr;
        int l = 0, fixl = -1;
        switch (ph) {
            case 0: p0_prologue(F); break;
            case 1: gA = XN; gAs = XN + (size_t)MP * D; gB = WIN; gN = NA; gK = D; gmode = 0; gld = NA; gO = BIG + B_PROJA; gOs = (bf16*)gO + (size_t)MP * NA; break;
            case 2: ssd_state_phase(F); break;
            case 3: ssd_out_phase(F); break;
            case 4: gA = XN; gAs = XN + (size_t)MP * D; gB = WIN + (size_t)NA * D; gN = NBH; gK = D; gmode = 0; gld = NBH; gO = BIG + B_PROJB; gOs = (bf16*)gO + (size_t)MP * NBH; break;
            case 5: hg_state_phase(F); break;
            case 6: hg_out_phase(F); break;
            case 7: gA = (const bf16*)(F.out + O_YP); gAs = (const bf16*)(F.ws + WS_MIXS); gB = (const bf16*)(F.ws + WS_WOUT); gN = D; gK = 2048; gmode = 0; gld = D; gO = BIG + B_M1; gOs = (bf16*)gO + (size_t)MP * D; break;
            case 8: resid_norm_rows(F, (const bf16*)(BIG + B_M1), F.a->in[I_NMPOST], F.a->in[I_NFPRE], 0); break;
            case 15: l = 1; [[fallthrough]];
            case 9: gA = XN; gAs = XN + (size_t)MP * D; gB = (const bf16*)(F.ws + WS_WUP) + (size_t)l * FF2 * D; gN = FF2; gK = D; gmode = 3; gld = FF2; gO = BIG + B_ACT; gOs = BIG + B_ACT; break;
            case 16: l = 1; [[fallthrough]];
            case 10: gA = (const bf16*)(BIG + B_ACT); gAs = gA + (size_t)MP * FF; gB = (const bf16*)(F.ws + WS_WDN) + (size_t)l * D * FF; gN = D; gK = FF; gmode = 0; gld = D; gO = BIG + B_M1; gOs = (bf16*)gO + (size_t)MP * D; fixl = l; break;
            case 11: resid_norm_rows(F, (const bf16*)(BIG + B_M1), F.a->in[I_NFPOST], F.a->in[I_NMPRE] + D, 1); break;
            case 12: s5_fused_phase(F); s5_sample(F); break;
            case 13: gA = (const bf16*)(BIG + B_GY); gAs = gA + (size_t)MP * D; gB = (const bf16*)(F.ws + WS_WGLU); gN = 2048; gK = D; gmode = 2; gld = D; gO = BIG + B_M1G; gOs = (bf16*)gO + (size_t)MP * D; break;
            case 14: resid_norm_rows(F, (const bf16*)(BIG + B_M1G), F.a->in[I_NMPOST] + D, F.a->in[I_NFPRE] + D, 1); break;
            case 17: resid_norm_rows(F, (const bf16*)(BIG + B_M1), F.a->in[I_NFPOST] + D, nullptr, 2); break;
            default: break;
        }
        if (gA) {
            pg8::Gemm g{gA, gB, MP, gN, gK}; pg8::StaticOrder S; S.init(MP, gN, F.G, (int)blockIdx.x);
            if (fixl >= 0) { pg8::Unit u0; for (int i = 0; S.next(i, u0); ++i) ffn_fix_rows(F, fixl, u0.pm);
                asm volatile("s_waitcnt vmcnt(0)" ::: "memory"); __syncthreads(); }
            pg8::EpiConvGate cg{(pg8::bf16_t*)(BIG + B_ACT), F.a->in[I_FCW] + (size_t)l * 3 * FF2, F.a->in[I_FCB] + (size_t)l * FF2, (float*)(BIG + B_HEAD), (float*)(BIG + B_TAIL), (PG8_LAS float*)(F.lds + HALO_OFF), F.out + O_PFC + (size_t)l * 8 * 2 * FF2};
            pg8::gemm_phase<pg8::EpiAny, pg8::StaticOrder, true, true>(F.lds, g, S, pg8::EpiAny{gmode, gmode == 0 || gmode == 3, gO, gld, cg}, F.tid);
            __syncthreads();
            const int nrem = ((MP / 256) * (gN / 256)) % F.G, tb = nrem ? (int)blockIdx.x - nrem : (int)blockIdx.x, tstr = nrem ? F.G - nrem : F.G;
            if (gmode == 2) skinny_gemm<2, true>(F, gAs, gK, gB, gK, D / 32, SkGlu{(bf16*)gOs, gld}, tb, tstr);
            else if (gmode == 3) { if (l == 0 && tb >= 0) { __syncthreads(); for (int g2 = tb; g2 < 64; g2 += tstr) s5_tables_item(F, g2); }
              skinny_gemm<2, true>(F, gAs, gK, gB, gK, FF / 32, SkConvGate{(bf16*)(BIG + B_ACT) + (size_t)MP * FF, F.a->in[I_FCW] + (size_t)l * 3 * FF2, F.a->in[I_FCB] + (size_t)l * FF2, F.a->in[I_SFC] + (size_t)l * MS * 2 * FF2, F.out + O_SFC + (size_t)l * MS * 2 * FF2}, tb, tstr); }
            else skinny_gemm<1, false>(F, gAs, gK, gB, gK, gN / 32, SkAny{gmode, gOs, gld}, tb, tstr);
        }
        if (ph + 1 < hi) { XcdBarrier b2; b2.bar = (unsigned*)(F.ws + WS_CTL) + CW_BAR + F.a->li * XCD_BAR_WORDS; b2.x = xb_xcc_id(); b2.st = (volatile LAS unsigned*)(F.lds + MISC_OFF) + 8; xcd_barrier(b2); }
    }
}

extern "C" void kernel_launch(void* const* d_in, const int* in_sizes, int n_in, void* d_out, int out_size, void* d_ws, size_t ws_size, hipStream_t stream) {
    static int grid = 0;
    if (grid == 0) {
        if (n_in != N_IN || out_size != (int)O_END || ws_size < WS_END) { fprintf(stderr, "kernel_launch: unexpected shapes (n_in %d, out %d, ws %zu)\n", n_in, out_size, ws_size); grid = -1; return; }
        int dev = 0, cus = 0, per_cu = 0;
        if (hipGetDevice(&dev) != hipSuccess || hipDeviceGetAttribute(&cus, hipDeviceAttributeMultiprocessorCount, dev) != hipSuccess) { grid = -1; return; }
        if (hipFuncSetAttribute((const void*)fwd_kernel, hipFuncAttributeMaxDynamicSharedMemorySize, LDS_BYTES) != hipSuccess) { fprintf(stderr, "kernel_launch: hipFuncSetAttribute failed\n"); grid = -1; return; }
        if (hipOccupancyMaxActiveBlocksPerMultiprocessor(&per_cu, (const void*)fwd_kernel, NTHR, LDS_BYTES) != hipSuccess || per_cu < 1) fprintf(stderr, "kernel_launch: occupancy query says %d\n", per_cu);
        (void)hipGetLastError();
        if (per_cu < 1) { fprintf(stderr, "kernel_launch: the kernel does not fit a CU\n"); grid = -1; return; }
        grid = cus;
    }
    if (grid < 0) return;
    (void)hipMemsetAsync((char*)d_ws + WS_CTL, 0, CTL_BYTES, stream);
    Args a{};
    for (int i = 0; i < 35; ++i) a.in[i] = (const float*)d_in[i];
    a.out = (float*)d_out; a.ws = (unsigned char*)d_ws;
#if PROBE_PH >= 0
    a.ph_lo = 0; a.ph_hi = PROBE_PH + 1; a.li = 0; hipLaunchKernelGGL(fwd_kernel, dim3(grid), dim3(NTHR), LDS_BYTES, stream, a);
    for (int rep = 0; rep < PROBE_REPS; ++rep) { a.ph_lo = PROBE_PH; a.ph_hi = PROBE_PH + 1; a.li = 1; hipLaunchKernelGGL(fwd_kernel, dim3(grid), dim3(NTHR), LDS_BYTES, stream, a); }
    if (PROBE_PH + 1 < NPH) { a.ph_lo = PROBE_PH + 1; a.ph_hi = NPH; a.li = 2; hipLaunchKernelGGL(fwd_kernel, dim3(grid), dim3(NTHR), LDS_BYTES, stream, a); }
#elif MK_ONE_LAUNCH
    a.ph_lo = 0; a.ph_hi = NPH; a.li = 0;
    { void* kargs[] = {&a};
      if (hipLaunchCooperativeKernel((const void*)fwd_kernel, dim3(grid), dim3(NTHR), kargs, LDS_BYTES, stream) != hipSuccess) { (void)hipGetLastError(); fprintf(stderr, "kernel_launch: cooperative launch refused\n"); } }
#else
    for (int p = 0; p < NPH; ++p) { a.ph_lo = p; a.ph_hi = p + 1; a.li = 0; hipLaunchKernelGGL(fwd_kernel, dim3(grid), dim3(NTHR), LDS_BYTES, stream, a); }
#endif
}
```

```cpp
#include <hip/hip_runtime.h>
#include <cstdio>
#include <cstdint>

#ifndef PROBE_PH
#define PROBE_PH -1
#endif
#ifndef PROBE_REPS
#define PROBE_REPS 1
#endif
#ifndef MK_ONE_LAUNCH
#define MK_ONE_LAUNCH 1
#endif

__device__ __forceinline__ float dpp_add_(float v, const int ctrl_sel) {
    const int b = __builtin_bit_cast(int, v); int r;
    if (ctrl_sel == 0) r = __builtin_amdgcn_update_dpp(0, b, 0xB1, 0xf, 0xf, true); else if (ctrl_sel == 1) r = __builtin_amdgcn_update_dpp(0, b, 0x4E, 0xf, 0xf, true);
    else if (ctrl_sel == 2) r = __builtin_amdgcn_update_dpp(0, b, 0x141, 0xf, 0xf, true); else r = __builtin_amdgcn_update_dpp(0, b, 0x140, 0xf, 0xf, true);
    return v + __builtin_bit_cast(float, r); }
__device__ __forceinline__ float row16_sum(float v) { v = dpp_add_(v, 0); v = dpp_add_(v, 1); v = dpp_add_(v, 2); v = dpp_add_(v, 3); return v; }
__device__ __forceinline__ float wave_sum(float v) {
    v = row16_sum(v);
    v += __builtin_bit_cast(float, __builtin_amdgcn_update_dpp(0, __builtin_bit_cast(int, v), 0x142, 0xa, 0xf, false));
    v += __builtin_bit_cast(float, __builtin_amdgcn_update_dpp(0, __builtin_bit_cast(int, v), 0x143, 0xc, 0xf, false));
    return __builtin_bit_cast(float, __builtin_amdgcn_readlane(__builtin_bit_cast(int, v), 63)); }
__device__ __forceinline__ int lane_op_() { int l = __builtin_amdgcn_mbcnt_hi(-1, __builtin_amdgcn_mbcnt_lo(-1, 0)); asm volatile("" : "+v"(l)); return l; }
__device__ __forceinline__ float shx_(float v, int o, int l) { return __builtin_bit_cast(float, __builtin_amdgcn_ds_bpermute((l ^ o) << 2, __builtin_bit_cast(int, v))); }
__device__ __forceinline__ float shup_(float v, int off, int width, int l) { const int src = ((l & (width - 1)) >= off) ? l - off : l; return __builtin_bit_cast(float, __builtin_amdgcn_ds_bpermute(src << 2, __builtin_bit_cast(int, v))); }
__device__ __forceinline__ float shidx_(float v, int src, int width, int l) { return __builtin_bit_cast(float, __builtin_amdgcn_ds_bpermute(((l & ~(width - 1)) + src) << 2, __builtin_bit_cast(int, v))); }
namespace pg8 {
#define PG8_LAS __attribute__((address_space(3)))
typedef unsigned short bf16_t;
typedef short bf16x8 __attribute__((ext_vector_type(8)));
typedef float f32x4 __attribute__((ext_vector_type(4)));
typedef unsigned u32x4 __attribute__((ext_vector_type(4)));
typedef float f32x2 __attribute__((ext_vector_type(2)));
constexpr int BM = 256, BK = 64, HALF = 128, HTB = HALF * BK * 2  , STAGE_BYTES = 8 * HTB, NXCD = 8, WGM = 8;

__host__ __device__ __forceinline__ int lds_byte(int r, int c) { const int st = (r >> 4) * 2 + (c >> 5), rr = r & 15, cc = c & 31, ob = rr * 64 + cc * 2; return st * 1024 + (ob ^ (((ob >> 9) & 1) << 5)); }
__host__ __device__ __forceinline__ void stage_rc(int b, int& R, int& C) { const int st = b / 1024, sb = b % 1024, swz = sb ^ (((sb >> 9) & 1) << 5); R = (st >> 1) * 16 + swz / 64; C = (st & 1) * 32 + (swz % 64) / 2; }
__host__ __device__ __forceinline__ int perm32(int rho) { const int n = rho >> 4, i = rho & 15; return 8 * (i >> 2) + 4 * n + (i & 3); }

struct Unit { int pm, pn; };
struct Gemm { const bf16_t* A; const bf16_t* Bt; int M, N, K; };

struct StaticOrder {
    int nM, nN, nwg, G, c;
    __host__ __device__ void init(int M, int N, int G_, int c_) { nM = M / BM; nN = N / BM; nwg = nM * nN; G = G_; c = c_; }
    __host__ __device__ bool next(int i, Unit& u) const {
        const long L = (long)i * G + c; if (L >= nwg) return false;
        int wgid = (int)L; { const int q = nwg / NXCD, r = nwg % NXCD, xcd = wgid % NXCD, off = wgid / NXCD; wgid = (xcd < r ? xcd * (q + 1) : r * (q + 1) + (xcd - r) * q) + off; }
        const int nig = WGM * nN, gid = wgid / nig, fm = gid * WGM, gsz = (nM - fm) < WGM ? (nM - fm) : WGM;
        u.pm = fm + ((wgid % nig) % gsz); u.pn = (wgid % nig) / gsz; return true;
    }
    __device__ __forceinline__ void a_ready(const Unit&) const {}
    __device__ __forceinline__ void done(const Unit&) const {}
};

__device__ __forceinline__ unsigned cvt_pk_bf16(float lo, float hi) { unsigned r; asm volatile("v_cvt_pk_bf16_f32 %0, %1, %2" : "=v"(r) : "v"(lo), "v"(hi)); return r; }

struct EpiF32 {
    static constexpr bool PERM = false, AFTER_DRAIN = false;
    float* C; int ldc;
    __device__ __forceinline__ void operator()(const f32x4 (&acc)[2][2][4][2], const Unit& u, int wr, int wc, int fr, int fq) const {
        const int row0 = u.pm * BM + wr * 64 + fr, col0 = u.pn * BM + wc * 32 + 4 * fq;
#pragma unroll
        for (int ai = 0; ai < 2; ++ai)
#pragma unroll
            for (int m = 0; m < 4; ++m) { float* rowp = C + (size_t)(row0 + ai * HALF + m * 16) * ldc + col0;
#pragma unroll
                for (int bj = 0; bj < 2; ++bj)
#pragma unroll
                    for (int n = 0; n < 2; ++n) *(f32x4*)(rowp + bj * HALF + n * 16) = acc[ai][bj][m][n]; }
    }
};
struct EpiBf16 {
    static constexpr bool PERM = true, AFTER_DRAIN = false;
    bf16_t* O; int ldc;
    __device__ __forceinline__ void operator()(const f32x4 (&acc)[2][2][4][2], const Unit& u, int wr, int wc, int fr, int fq) const {
        const int row0 = u.pm * BM + wr * 64 + fr, col0 = u.pn * BM + wc * 32 + 8 * fq;
#pragma unroll
        for (int ai = 0; ai < 2; ++ai)
#pragma unroll
            for (int m = 0; m < 4; ++m) { bf16_t* rowp = O + (size_t)(row0 + ai * HALF + m * 16) * ldc + col0;
#pragma unroll
                for (int bj = 0; bj < 2; ++bj) { const f32x4 v0 = acc[ai][bj][m][0], v1 = acc[ai][bj][m][1];
                    u32x4 w; w.x = cvt_pk_bf16(v0[0], v0[1]); w.y = cvt_pk_bf16(v0[2], v0[3]); w.z = cvt_pk_bf16(v1[0], v1[1]); w.w = cvt_pk_bf16(v1[2], v1[3]);
                    *(u32x4*)(rowp + bj * HALF) = w; } }
    }
};
struct EpiGlu {
    static constexpr bool PERM = false, AFTER_DRAIN = false;
    bf16_t* C; int ldc;
    __device__ __forceinline__ void operator()(const f32x4 (&acc)[2][2][4][2], const Unit& u, int wr, int wc, int fr, int fq) const {
        const int row0 = u.pm * BM + wr * 64 + fr, col0 = u.pn * HALF + wc * 32 + 4 * fq;
        typedef unsigned u32x2g __attribute__((ext_vector_type(2)));
#pragma unroll
        for (int ai = 0; ai < 2; ++ai)
#pragma unroll
            for (int m = 0; m < 4; ++m) { bf16_t* rowp = C + (size_t)(row0 + ai * HALF + m * 16) * ldc + col0;
#pragma unroll
                for (int n = 0; n < 2; ++n) { const f32x4 v = acc[ai][0][m][n], g = acc[ai][1][m][n]; float o[4];
#pragma unroll
                    for (int j = 0; j < 4; ++j) o[j] = v[j] * __builtin_amdgcn_rcpf(1.0f + __expf(-g[j]));
                    u32x2g w; w.x = cvt_pk_bf16(o[0], o[1]); w.y = cvt_pk_bf16(o[2], o[3]); *(u32x2g*)(rowp + n * 16) = w; } }
    }
};


__device__ __forceinline__ float dpp_shr1(float old, float src) { return __builtin_bit_cast(float, __builtin_amdgcn_update_dpp(__builtin_bit_cast(int, old), __builtin_bit_cast(int, src), 0x111, 0xf, 0xf, false)); }
__device__ __forceinline__ float dpp_shr2(float old, float src) { return __builtin_bit_cast(float, __builtin_amdgcn_update_dpp(__builtin_bit_cast(int, old), __builtin_bit_cast(int, src), 0x112, 0xf, 0xf, false)); }
__device__ __forceinline__ float dpp_ror1(float src) { return __builtin_bit_cast(float, __builtin_amdgcn_update_dpp(0, __builtin_bit_cast(int, src), 0x121, 0xf, 0xf, false)); }
__device__ __forceinline__ float dpp_ror2(float src) { return __builtin_bit_cast(float, __builtin_amdgcn_update_dpp(0, __builtin_bit_cast(int, src), 0x122, 0xf, 0xf, false)); }
struct EpiConvGate {
    bf16_t* ACT; const float* cw; const float* cb; float* HEAD; float* TAIL; PG8_LAS float* HALO; float* PFC;
    __device__ __forceinline__ void operator()(const f32x4 (&acc)[2][2][4][2], const Unit& u, int wr, int wc, int fr, int fq) const {
        constexpr int FF_ = 2816, FF2_ = 5632;
        asm volatile("" : "+v"(fr), "+v"(fq));
        const int colt = wc * 32 + 8 * fq;
        if (fr >= 14) {
#pragma unroll
            for (int ai = 0; ai < 2; ++ai)
#pragma unroll
                for (int bj = 0; bj < 2; ++bj)
#pragma unroll
                    for (int n = 0; n < 2; ++n) { *(PG8_LAS f32x4*)(HALO + ((ai * 2 + wr) * 2 + (fr - 14)) * 256 + bj * 128 + colt + 4 * n) = acc[ai][bj][3][n];
                        if (ai == 1 && wr == 1) { *(f32x4*)(TAIL + ((size_t)u.pm * 2 + (fr - 14)) * FF2_ + bj * FF_ + u.pn * 128 + colt + 4 * n) = acc[1][bj][3][n];
                            if ((u.pm & 7) == 7) *(f32x4*)(PFC + ((size_t)(u.pm >> 3) * 2 + (fr - 14)) * FF2_ + bj * FF_ + u.pn * 128 + colt + 4 * n) = acc[1][bj][3][n]; } } }
        if (fr < 2 && wr == 0) {
#pragma unroll
            for (int bj = 0; bj < 2; ++bj)
#pragma unroll
                for (int n = 0; n < 2; ++n) *(f32x4*)(HEAD + ((size_t)u.pm * 2 + fr) * FF2_ + bj * FF_ + u.pn * 128 + colt + 4 * n) = acc[0][bj][0][n]; }
        { PG8_LAS float* WL = HALO + 2048;
          const int tid_ = (wr * 4 + wc) * 64 + fq * 16 + fr, e = 2 * tid_, arr = e >> 8, c = e & 255;
          const float* src = (arr < 3 ? cw + arr * FF2_ : cb) + (c < 128 ? u.pn * 128 + c : FF_ + u.pn * 128 + (c - 128));
          *(PG8_LAS f32x2*)(WL + e) = *(const __attribute__((address_space(1))) f32x2*)src; }
        asm volatile("s_waitcnt vmcnt(0) lgkmcnt(0)" ::: "memory"); __builtin_amdgcn_s_barrier(); asm volatile("" ::: "memory");
        const PG8_LAS float* WL = HALO + 2048;
        typedef unsigned u32x2 __attribute__((ext_vector_type(2)));
#pragma unroll
        for (int ai = 0; ai < 2; ++ai) {
            const int pred = wr == 1 ? (ai * 2 + 0) : (0 * 2 + 1);
            const bool nohist = (ai == 0 && wr == 0);
            const int row0 = u.pm * BM + ai * HALF + wr * 64 + fr;
#pragma unroll
            for (int n = 0; n < 2; ++n) {
                unsigned pk[4][2];
#pragma unroll
                for (int jp = 0; jp < 2; ++jp) {
                    float gsil[4][2];
#pragma unroll
                    for (int bj = 1; bj >= 0; --bj) { const int wc_ = bj * 128 + colt + 4 * n + 2 * jp;
                        const f32x2 w0 = *(const PG8_LAS f32x2*)(WL + wc_), w1 = *(const PG8_LAS f32x2*)(WL + 256 + wc_), w2 = *(const PG8_LAS f32x2*)(WL + 512 + wc_), bb = *(const PG8_LAS f32x2*)(WL + 768 + wc_);
                        const f32x2 h0 = *(const PG8_LAS f32x2*)(HALO + (pred * 2 + 0) * 256 + bj * 128 + colt + 4 * n + 2 * jp), h1 = *(const PG8_LAS f32x2*)(HALO + (pred * 2 + 1) * 256 + bj * 128 + colt + 4 * n + 2 * jp);
#pragma unroll
                        for (int m = 0; m < 4; ++m) { float r[2];
#pragma unroll
                            for (int jj = 0; jj < 2; ++jj) { const int j = 2 * jp + jj; const float cur = acc[ai][bj][m][n][j];
                                const float x1 = m == 0 ? h1[jj] : dpp_ror1(acc[ai][bj][m == 0 ? 0 : m - 1][n][j]);
                                const float x2 = m == 0 ? (fr == 0 ? h0[jj] : h1[jj]) : dpp_ror2(acc[ai][bj][m == 0 ? 0 : m - 1][n][j]);
                                const float p1 = dpp_shr1(x1, cur), p2 = dpp_shr2(x2, cur);
                                r[jj] = bb[jj] + w0[jj] * p2 + w1[jj] * p1 + w2[jj] * cur; }
                            if (bj == 1) { gsil[m][0] = r[0] * __builtin_amdgcn_rcpf(1.0f + __expf(-r[0])); gsil[m][1] = r[1] * __builtin_amdgcn_rcpf(1.0f + __expf(-r[1])); }
                            else pk[m][jp] = cvt_pk_bf16(r[0] * gsil[m][0], r[1] * gsil[m][1]); }
                    }
                }
#pragma unroll
                for (int m = 0; m < 4; ++m) { if (nohist && m == 0 && fr < 2) continue;
                    u32x2 w; w.x = pk[m][0]; w.y = pk[m][1]; *(u32x2*)(ACT + (size_t)(row0 + m * 16) * FF_ + u.pn * 128 + colt + 4 * n) = w; }
                asm volatile("" ::: "memory");
            }
        }
    }
};
struct EpiAny {
    static constexpr bool AFTER_DRAIN = false;
    int mode; bool perm; void* O; int ldc; EpiConvGate cg;
    __device__ __forceinline__ void operator()(const f32x4 (&acc)[2][2][4][2], const Unit& u, int wr, int wc, int fr, int fq) const {
        if (mode == 0) { EpiBf16 e{(bf16_t*)O, ldc}; e(acc, u, wr, wc, fr, fq); }
        else if (mode == 1) { EpiF32 e{(float*)O, ldc}; e(acc, u, wr, wc, fr, fq); }
        else if (mode == 2) { EpiGlu e{(bf16_t*)O, ldc}; e(acc, u, wr, wc, fr, fq); }
        else cg(acc, u, wr, wc, fr, fq);
    }
};
template <class Epi, class Sched, bool ALIGN_EPI = false, bool SP2 = false>
__device__ __forceinline__ void gemm_phase(PG8_LAS unsigned char* lds, const Gemm g, const Sched& S, const Epi& E, const int tid) {
    const int wid = __builtin_amdgcn_readfirstlane(tid >> 6), lane = tid & 63, wr = wid >> 2, wc = wid & 3, fr = lane & 15, fq = lane >> 4;
    const int K = g.K, nt = K / BK;
    unsigned voffA[2], voffB[2];
#pragma unroll
    for (int i = 0; i < 2; ++i) { int R, C; stage_rc(tid * 16 + i * 8192, R, C); const int Rb = E.perm ? ((R & ~31) + perm32(R & 31)) : R;
        voffA[i] = (unsigned)(R * K + C) * 2u; voffB[i] = (unsigned)(Rb * K + C) * 2u; }
    const size_t kstep = (size_t)(BK * 2);
    const size_t hstep = (size_t)HALF * K * 2;
    const size_t tstep = 2 * hstep;
    const unsigned ldsw = (unsigned)wid * 1024u;
    const int aoff = lds_byte(wr * 64 + fr, fq * 8), boff = lds_byte(wc * 32 + fr, fq * 8);
#define PG8_SA(b, h) (((b) * 2 + (h)) * HTB)
#define PG8_SB(b, h) ((4 + (b) * 2 + (h)) * HTB)
#define PG8_STAGE(bufoff, gbase, voff) do { _Pragma("unroll") for (int _i = 0; _i < 2; ++_i) \
        __builtin_amdgcn_global_load_lds((const unsigned*)((const char*)(gbase) + (voff)[_i]), (PG8_LAS unsigned*)(lds + (bufoff) + ldsw + _i * 8192), 16, 0, 0); } while (0)
#define PG8_LDA(dst, b, h) do { _Pragma("unroll") for (int m = 0; m < 4; ++m) _Pragma("unroll") for (int k = 0; k < 2; ++k) dst[m][k] = *(const PG8_LAS bf16x8*)(lds + PG8_SA(b, h) + aoff + m * 2048 + k * 1024); } while (0)
#define PG8_LDB(dst, b, h) do { _Pragma("unroll") for (int n = 0; n < 2; ++n) _Pragma("unroll") for (int k = 0; k < 2; ++k) dst[n][k] = *(const PG8_LAS bf16x8*)(lds + PG8_SB(b, h) + boff + n * 2048 + k * 1024); } while (0)
#define PG8_MMA(ai, bj, At, Bt) do { __builtin_amdgcn_s_setprio(1); _Pragma("unroll") for (int m = 0; m < 4; ++m) _Pragma("unroll") for (int n = 0; n < 2; ++n) _Pragma("unroll") for (int k = 0; k < 2; ++k) \
        acc[ai][bj][m][n] = __builtin_amdgcn_mfma_f32_16x16x32_bf16(Bt[n][k], At[m][k], acc[ai][bj][m][n], 0, 0, 0); __builtin_amdgcn_s_setprio(0); } while (0)
#define PG8_WAIT_V(n) asm volatile("s_waitcnt vmcnt(" #n ")" ::: "memory")
#define PG8_WAIT_L(n) asm volatile("s_waitcnt lgkmcnt(" #n ")" ::: "memory")
#define PG8_BAR __builtin_amdgcn_s_barrier()
#define PG8_SCHED __builtin_amdgcn_sched_barrier(0)
    Unit cur, nxt; int ui = 0;
    if (!S.next(0, cur)) return;
    f32x4 acc[2][2][4][2];
#pragma unroll
    for (int a = 0; a < 2; ++a)
#pragma unroll
        for (int b = 0; b < 2; ++b)
#pragma unroll
            for (int m = 0; m < 4; ++m)
#pragma unroll
                for (int n = 0; n < 2; ++n) acc[a][b][m][n] = (f32x4){0.f, 0.f, 0.f, 0.f};
    bf16x8 At[4][2], B0[2][2], B1[2][2];
    const char* cA = (const char*)g.A + (size_t)cur.pm * tstep; const char* cB = (const char*)g.Bt + (size_t)cur.pn * tstep;
    S.a_ready(cur);
    if constexpr (SP2) {
        PG8_STAGE(PG8_SB(0, 0), cB, voffB); PG8_STAGE(PG8_SB(0, 1), cB + hstep, voffB); PG8_STAGE(PG8_SA(0, 0), cA, voffA); PG8_STAGE(PG8_SA(0, 1), cA + hstep, voffA);
        if (wr == 1) PG8_BAR;
        PG8_WAIT_V(2); PG8_BAR;
        PG8_STAGE(PG8_SB(1, 0), cB + kstep, voffB); PG8_STAGE(PG8_SA(1, 0), cA + kstep, voffA); PG8_STAGE(PG8_SB(1, 1), cB + hstep + kstep, voffB);
        PG8_WAIT_V(6); PG8_BAR;
    } else {
        PG8_STAGE(PG8_SB(0, 0), cB, voffB); PG8_STAGE(PG8_SA(0, 0), cA, voffA); PG8_STAGE(PG8_SB(0, 1), cB + hstep, voffB); PG8_STAGE(PG8_SA(0, 1), cA + hstep, voffA);
        if (wr == 1) PG8_BAR;
        PG8_WAIT_V(4); PG8_BAR;
        PG8_STAGE(PG8_SB(1, 0), cB + kstep, voffB); PG8_STAGE(PG8_SA(1, 0), cA + kstep, voffA); PG8_STAGE(PG8_SB(1, 1), cB + hstep + kstep, voffB);
        PG8_WAIT_V(6); PG8_BAR;
    }
    for (;;) {
        const bool has_next = S.next(ui + 1, nxt);
        const char* nA = has_next ? (const char*)g.A + (size_t)nxt.pm * tstep : cA; const char* nB = has_next ? (const char*)g.Bt + (size_t)nxt.pn * tstep : cB;
        for (int t = 0; t < nt; t += 2) {
            const bool last = (t == nt - 2);
            const char* a1 = cA + (size_t)(t + 1) * kstep;
            const char* a2 = last ? nA : cA + (size_t)(t + 2) * kstep; const char* b2 = last ? nB : cB + (size_t)(t + 2) * kstep;
            const char* a3 = a2 + kstep; const char* b3 = b2 + kstep;
            if (last && has_next) S.a_ready(nxt);
            if constexpr (SP2) {
            PG8_LDB(B0, 0, 0); PG8_LDB(B1, 0, 1); PG8_SCHED; PG8_LDA(At, 0, 0); PG8_STAGE(PG8_SA(1, 1), a1 + hstep, voffA);
            PG8_WAIT_V(8); PG8_WAIT_L(0); PG8_BAR; PG8_MMA(0, 0, At, B0); PG8_MMA(0, 1, At, B1); PG8_BAR; PG8_SCHED;
            PG8_LDA(At, 0, 1); PG8_STAGE(PG8_SB(0, 0), b2, voffB); PG8_STAGE(PG8_SB(0, 1), b2 + hstep, voffB); PG8_STAGE(PG8_SA(0, 0), a2, voffA);
            PG8_WAIT_V(8); PG8_WAIT_L(0); PG8_BAR; PG8_MMA(1, 0, At, B0); PG8_MMA(1, 1, At, B1); PG8_BAR; PG8_SCHED;
            PG8_LDB(B0, 1, 0); PG8_LDB(B1, 1, 1); PG8_SCHED; PG8_LDA(At, 1, 0); PG8_STAGE(PG8_SA(0, 1), a2 + hstep, voffA);
            PG8_WAIT_V(8); PG8_WAIT_L(0); PG8_BAR; PG8_MMA(0, 0, At, B0); PG8_MMA(0, 1, At, B1); PG8_BAR; PG8_SCHED;
            PG8_LDA(At, 1, 1); PG8_STAGE(PG8_SB(1, 0), b3, voffB); PG8_STAGE(PG8_SB(1, 1), b3 + hstep, voffB); PG8_STAGE(PG8_SA(1, 0), a3, voffA);
            PG8_WAIT_V(8); PG8_WAIT_L(0); PG8_BAR; PG8_MMA(1, 0, At, B0); PG8_MMA(1, 1, At, B1); PG8_BAR; PG8_SCHED;
            } else {
            PG8_LDB(B0, 0, 0); PG8_SCHED; PG8_LDA(At, 0, 0); PG8_STAGE(PG8_SA(1, 1), a1 + hstep, voffA);
            PG8_WAIT_L(8); PG8_BAR; PG8_WAIT_L(0); PG8_MMA(0, 0, At, B0); PG8_BAR; PG8_SCHED;
            PG8_LDB(B1, 0, 1); PG8_STAGE(PG8_SB(0, 0), b2, voffB);
            PG8_BAR; PG8_WAIT_L(0); PG8_MMA(0, 1, At, B1); PG8_BAR;
            PG8_LDA(At, 0, 1); PG8_STAGE(PG8_SA(0, 0), a2, voffA);
            PG8_BAR; PG8_WAIT_L(0); PG8_MMA(1, 0, At, B0); PG8_BAR; PG8_SCHED;
            PG8_STAGE(PG8_SB(0, 1), b2 + hstep, voffB);
            PG8_WAIT_V(6); PG8_BAR; PG8_MMA(1, 1, At, B1); PG8_BAR;
            PG8_LDB(B0, 1, 0); PG8_SCHED; PG8_LDA(At, 1, 0); PG8_STAGE(PG8_SA(0, 1), a2 + hstep, voffA);
            PG8_WAIT_L(8); PG8_BAR; PG8_WAIT_L(0); PG8_MMA(0, 0, At, B0); PG8_BAR; PG8_SCHED;
            PG8_LDB(B1, 1, 1); PG8_STAGE(PG8_SB(1, 0), b3, voffB);
            PG8_BAR; PG8_WAIT_L(0); PG8_MMA(0, 1, At, B1); PG8_BAR;
            PG8_LDA(At, 1, 1); PG8_STAGE(PG8_SA(1, 0), a3, voffA);
            PG8_BAR; PG8_WAIT_L(0); PG8_MMA(1, 0, At, B0); PG8_BAR; PG8_SCHED;
            PG8_STAGE(PG8_SB(1, 1), b3 + hstep, voffB);
            PG8_WAIT_V(6); PG8_BAR; PG8_MMA(1, 1, At, B1); PG8_BAR;
            }
        }
        if constexpr (ALIGN_EPI) { if (wr == 0) PG8_BAR; }
        if constexpr (!Epi::AFTER_DRAIN) { E(acc, cur, wr, wc, fr, fq); S.done(cur); }
        if (!has_next) break;
#pragma unroll
        for (int a = 0; a < 2; ++a)
#pragma unroll
            for (int b = 0; b < 2; ++b)
#pragma unroll
                for (int m = 0; m < 4; ++m)
#pragma unroll
                    for (int n = 0; n < 2; ++n) acc[a][b][m][n] = (f32x4){0.f, 0.f, 0.f, 0.f};
        cur = nxt; cA = nA; cB = nB; ++ui;
        if constexpr (ALIGN_EPI) { if (wr == 1) PG8_BAR; }
    }
    PG8_WAIT_V(0);
    if constexpr (!ALIGN_EPI) { if (wr == 0) PG8_BAR; }
    PG8_BAR;
    if constexpr (Epi::AFTER_DRAIN) { E.fused(acc, cur, wr, wc, fr, fq, lds, wid, lane); S.done(cur); }
#undef PG8_SA
#undef PG8_SB
#undef PG8_STAGE
#undef PG8_LDA
#undef PG8_LDB
#undef PG8_MMA
#undef PG8_WAIT_V
#undef PG8_WAIT_L
#undef PG8_BAR
#undef PG8_SCHED
}
}

constexpr int NWAVES = 8, NTHR = 512;
constexpr int D = 1024, NB = 8, SEQ = 2048, MP = NB * SEQ, MS = 128, MT = MP + MS;
constexpr int NA = 2560, NBH = 4096;
constexpr int WIN_ROWS = NA + NBH;
constexpr int XBC = 1280, ABIN = 6416;
constexpr int FF = 2816, FF2 = 5632, NFT = 22;
constexpr float EPS = 1e-6f;
constexpr int NPH = 18;

constexpr size_t O_YP = 0, O_YS = O_YP + (size_t)MP * D, O_PSSM = O_YS + (size_t)MS * D, O_PSCONV = O_PSSM + 8 * 16 * 64 * 64, O_PHG = O_PSCONV + 8 * 3 * XBC,
                 O_PS5R = O_PHG + 8 * 8 * 128 * 128, O_PS5I = O_PS5R + 8 * 64 * 64, O_PFC = O_PS5I + 8 * 64 * 64, O_SSSM = O_PFC + 2 * 8 * 2 * FF2,
                 O_SSCONV = O_SSSM + (size_t)MS * 16 * 64 * 64, O_SHG = O_SSCONV + (size_t)MS * 3 * XBC, O_SS5R = O_SHG + (size_t)MS * 8 * 128 * 128,
                 O_SS5I = O_SS5R + (size_t)MS * 64 * 64, O_SFC = O_SS5I + (size_t)MS * 64 * 64, O_END = O_SFC + (size_t)2 * MS * 2 * FF2;
static_assert(O_END == 48347136, "d_out size");

constexpr size_t al256(size_t x) { return (x + 255) & ~(size_t)255; }
constexpr size_t WS_CTL = 0, CTL_BYTES = 1u << 20;
constexpr size_t WS_WIN = CTL_BYTES;
constexpr size_t WS_WOUT = WS_WIN + (size_t)WIN_ROWS * D * 2;
constexpr size_t WS_WGLU = WS_WOUT + (size_t)D * 2048 * 2;
constexpr size_t WS_WUP = WS_WGLU + (size_t)2048 * D * 2;
constexpr size_t WS_WDN = WS_WUP + (size_t)2 * FF2 * D * 2;
constexpr size_t WS_XN = WS_WDN + (size_t)2 * D * FF * 2;
constexpr size_t WS_MIXS = WS_XN + (size_t)MT * D * 2;
constexpr size_t WS_BIG = al256(WS_MIXS + (size_t)MS * 2048 * 2);
constexpr size_t WS_END = (size_t)256 << 20;
constexpr size_t BIG_BYTES = WS_END - WS_BIG;
constexpr size_t B_PROJA = 0;
constexpr size_t B_Y2 = al256(B_PROJA + (size_t)MT * NA * 2);
constexpr size_t B_ORAW = 0;
constexpr size_t B_PROJB = al256(B_ORAW + (size_t)MT * D * 2);
constexpr size_t B_M1 = 0;
constexpr size_t B_UP = 0;
constexpr size_t B_ACT = al256((size_t)MT * 2048 * 2);
constexpr size_t B_GY = 0;
constexpr size_t B_PC = al256(B_GY + (size_t)MT * D * 2);
constexpr size_t B_XP = al256(B_PC + (size_t)1024 * 8192 * 4);
constexpr size_t B_M1G = (size_t)100 << 20;
constexpr size_t B_S5T = (size_t)120 << 20;
constexpr size_t S5T_KQ = 0, S5T_PM = S5T_KQ + (size_t)64 * 256 * 384 * 2, S5T_AB = S5T_PM + (size_t)64 * 128 * 256 * 2, S5T_BB = S5T_AB + (size_t)64 * 64 * 2 * 4, S5T_END = S5T_BB + (size_t)64 * 64 * 32 * 4;
static_assert(B_Y2 + (size_t)MT * D * 4 <= BIG_BYTES, "ssd stage");
static_assert(B_PROJB + (size_t)MT * NBH * 2 <= BIG_BYTES, "hgrn stage");
static_assert(B_ACT + (size_t)MT * FF * 2 <= BIG_BYTES, "ffn stage");
static_assert(B_XP + (size_t)1024 * 8192 * 2 <= B_S5T && B_M1G + (size_t)MT * D * 4 <= BIG_BYTES && B_S5T + S5T_END <= BIG_BYTES && B_S5T >= B_M1 + (size_t)MT * D * 4, "s5 stage");

#define GAS __attribute__((address_space(1)))
#define LAS __attribute__((address_space(3)))
typedef unsigned short bf16;
typedef unsigned v4u __attribute__((ext_vector_type(4)));
typedef unsigned v2u __attribute__((ext_vector_type(2)));
typedef float f32x4 __attribute__((ext_vector_type(4)));
typedef float f32x16 __attribute__((ext_vector_type(16)));
typedef short bf16x8 __attribute__((ext_vector_type(8)));
typedef GAS unsigned gu32;
#define RLX_AGENT __ATOMIC_RELAXED, __HIP_MEMORY_SCOPE_AGENT
#define LDS_WAIT() asm volatile("s_waitcnt lgkmcnt(0)" ::: "memory")
#define VM_WAIT() asm volatile("s_waitcnt vmcnt(0)" ::: "memory")
__device__ __forceinline__ unsigned f2bf(float f) { unsigned u = __builtin_bit_cast(unsigned, f); return (u + 0x7fffu + ((u >> 16) & 1u)) >> 16; }
__device__ __forceinline__ unsigned pk2(float lo, float hi) { return f2bf(lo) | (f2bf(hi) << 16); }
__device__ __forceinline__ float bf2f(unsigned short b) { return __builtin_bit_cast(float, (unsigned)b << 16); }
__device__ __forceinline__ float bflo(unsigned w) { return __builtin_bit_cast(float, w << 16); }
__device__ __forceinline__ float bfhi(unsigned w) { return __builtin_bit_cast(float, w & 0xffff0000u); }
__device__ __forceinline__ float sigmoidf_(float x) { return __builtin_amdgcn_rcpf(1.0f + __expf(-x)); }
__device__ __forceinline__ float siluf_(float x) { return x * __builtin_amdgcn_rcpf(1.0f + __expf(-x)); }
__device__ __forceinline__ float softplusf_(float x) { return x > 20.f ? x : log1pf(__expf(x)); }
__device__ __forceinline__ float gelu_tanh(float x) { const float u = 0.7978845608028654f * (x + 0.044715f * x * x * x); const float e = __expf(2.f * u); const float th = 1.f - 2.f / (e + 1.f); return 0.5f * x * (1.f + th); }

#define XB_TMO      128
#define XB_XCNT(j)  (256  + 64 * (j))
#define XB_XSUB(j)  (1280 + 64 * (j))
#define XB_XGEN(j)  (2304 + 64 * (j))
#define XB_TOP      3328
#define XB_TOPGEN   3392
#define XCD_BAR_WORDS 3456
#define XB_SPIN_CAP (1u << 18)
__device__ __forceinline__ unsigned xb_ld(unsigned* p)              { return __hip_atomic_load(p, __ATOMIC_RELAXED, __HIP_MEMORY_SCOPE_AGENT); }
__device__ __forceinline__ unsigned xb_add(unsigned* p, unsigned v) { return __hip_atomic_fetch_add(p, v, __ATOMIC_RELAXED, __HIP_MEMORY_SCOPE_AGENT); }
__device__ __forceinline__ unsigned xb_xcc_id() { return (unsigned)__builtin_amdgcn_s_getreg((3 << 11) | 20) & 0xFu; }
#define XB_SPIN(cond, bar) do { unsigned _sp = 0; while (cond) { __builtin_amdgcn_s_sleep(1); \
    if ((++_sp & 255u) == 0u) { if (xb_ld(&(bar)[XB_TMO])) break; if (_sp > XB_SPIN_CAP) { atomicAdd(&(bar)[XB_TMO], 1u); break; } } } } while (0)
struct XcdBarrier { unsigned* bar; unsigned x; volatile LAS unsigned* st; };
__device__ __forceinline__ XcdBarrier xcd_barrier_post(unsigned* bar, volatile LAS unsigned* st) {
    XcdBarrier b; b.bar = bar; b.x = xb_xcc_id(); b.st = st;
    if (threadIdx.x == 0) (void)xb_add(&bar[XB_XCNT(b.x)], 1u);
    return b;
}
__device__ __forceinline__ void xcd_barrier_complete(unsigned* bar, unsigned x, unsigned& nloc, unsigned& nx) {
    const unsigned G = gridDim.x * gridDim.y * gridDim.z;
    unsigned sum, cnt, mine, sp = 0u;
    for (;;) {
        sum = 0u; cnt = 0u; mine = 0u;
#pragma unroll
        for (unsigned j = 0; j < 16; ++j) { const unsigned c = xb_ld(&bar[XB_XCNT(j)]); sum += c; cnt += (c > 0u) ? 1u : 0u; mine = (j == x) ? c : mine; }
        if (sum == G) break;
        __builtin_amdgcn_s_sleep(1);
        if ((++sp & 255u) == 0u) { if (xb_ld(&bar[XB_TMO])) break; if (sp > XB_SPIN_CAP) { atomicAdd(&bar[XB_TMO], 1u); break; } }
    }
    nloc = mine > 0u ? mine : 1u; nx = cnt > 0u ? cnt : 1u;
}
__device__ __forceinline__ void xcd_barrier(const XcdBarrier& b) {
    asm volatile("s_waitcnt vmcnt(0)" ::: "memory");
    __syncthreads();
    if (threadIdx.x == 0) {
        unsigned* bar = b.bar;
        __builtin_amdgcn_s_waitcnt(0);
        unsigned nloc = b.st[0], nx = b.st[1];
        if (nloc == 0u) { xcd_barrier_complete(bar, b.x, nloc, nx); b.st[0] = nloc; b.st[1] = nx; }
        const unsigned old = xb_add(&bar[XB_XSUB(b.x)], 1u);
        const unsigned gen = old / nloc;
        if (old + 1u == (gen + 1u) * nloc) {
            __builtin_amdgcn_fence(__ATOMIC_RELEASE, "agent");
            asm volatile("s_waitcnt vmcnt(0)" ::: "memory");
            const unsigned og = xb_add(&bar[XB_TOP], 1u);
            const unsigned tg = og / nx;
            if (og + 1u == (tg + 1u) * nx) xb_add(&bar[XB_TOPGEN], 1u);
            else XB_SPIN(xb_ld(&bar[XB_TOPGEN]) == tg, bar);
            __builtin_amdgcn_fence(__ATOMIC_ACQUIRE, "agent");
            xb_add(&bar[XB_XGEN(b.x)], 1u);
            asm volatile("s_waitcnt vmcnt(0)" ::: "memory");
        } else {
            XB_SPIN(xb_ld(&bar[XB_XGEN(b.x)]) == gen, bar);
            __builtin_amdgcn_fence(__ATOMIC_ACQUIRE, "agent");
            asm volatile("s_waitcnt vmcnt(0)" ::: "memory");
        }
    }
    __syncthreads();
}

constexpr int RING_BYTES = 131072;
constexpr int LDSCTL_OFF = RING_BYTES, MISC_OFF = LDSCTL_OFF + 320, HALO_OFF = RING_BYTES + 1024;
constexpr int LDS_BYTES = 147456;

struct Args { const float* in[35]; float* out; unsigned char* ws; int ph_lo, ph_hi, li, pad; };
static_assert(sizeof(Args) == 35 * 8 + 8 + 8 + 16, "Args has no padding");
#define CAS __attribute__((address_space(4)))
struct Frame {
    LAS unsigned char* lds;
    int tid, lane, wave, vcu, G;
    const CAS Args* a;
    float* out;
    unsigned char* ws;
};

enum { I_XP = 0, I_XS, I_SSSM, I_SSCONV, I_SHG, I_SS5R, I_SS5I, I_SFC, I_NMPRE, I_NMPOST, I_NFPRE, I_NFPOST, I_WIN, I_CONVW, I_CONVB, I_DTB, I_ALOG, I_SSMD, I_SSMNW,
       I_HGLB, I_HGNW, I_WOUT, I_LAMRE, I_LAMIM, I_LOGSTEP, I_BRE, I_BIM, I_CRE, I_CIM, I_S5D, I_WGLU, I_WUP, I_FCW, I_FCB, I_WDN, N_IN };

#define GW_ID(F) ((F).vcu * NWAVES + (F).wave)
#define GW_N(F) ((F).G * NWAVES)

__device__ __forceinline__ void p0_transpose_item(const float* W, int ldw, int K, int scol0, bf16* WT, int drow0, int kb, LAS float* scr, int lane) {
    const int k0 = 64 * kb;
    f32x4 v[8];
#pragma unroll
    for (int i = 0; i < 8; ++i) v[i] = *(const GAS f32x4*)(W + (size_t)(k0 + (lane >> 3) + 8 * i) * ldw + scol0 + 4 * (lane & 7));
#pragma unroll
    for (int i = 0; i < 8; ++i) { LAS float* d = scr + ((lane >> 3) + 8 * i) * 33 + 4 * (lane & 7); d[0] = v[i].x; d[1] = v[i].y; d[2] = v[i].z; d[3] = v[i].w; }
    LDS_WAIT(); asm volatile("" ::: "memory");
    const int c = lane & 7;
#pragma unroll
    for (int j = 0; j < 4; ++j) { const int n = (lane >> 3) + 8 * j; const LAS float* s = scr + (8 * c) * 33 + n;
        v4u o; o.x = pk2(s[0 * 33], s[1 * 33]); o.y = pk2(s[2 * 33], s[3 * 33]); o.z = pk2(s[4 * 33], s[5 * 33]); o.w = pk2(s[6 * 33], s[7 * 33]);
        *(GAS v4u*)(WT + (size_t)(drow0 + n) * K + k0 + 8 * c) = o; }
    LDS_WAIT(); asm volatile("" ::: "memory");
}
__device__ __forceinline__ void rms_row_to_bf16(const float* xrow, const float* w, bf16* orow, int lane) {
    const GAS f32x4* xr = (const GAS f32x4*)xrow + lane; const GAS f32x4* wr = (const GAS f32x4*)w + lane;
    f32x4 v[4]; float s = 0.f;
#pragma unroll
    for (int j = 0; j < 4; ++j) { v[j] = xr[64 * j]; s += (v[j].x * v[j].x + v[j].y * v[j].y) + (v[j].z * v[j].z + v[j].w * v[j].w); }
    const float rs = rsqrtf(wave_sum(s) * (1.f / D) + EPS);
    GAS v2u* o8 = (GAS v2u*)orow + lane;
#pragma unroll
    for (int j = 0; j < 4; ++j) { const f32x4 ww = wr[64 * j]; v2u o; o.x = pk2(v[j].x * rs * ww.x, v[j].y * rs * ww.y); o.y = pk2(v[j].z * rs * ww.z, v[j].w * rs * ww.w); o8[64 * j] = o; }
}
__device__ __forceinline__ const float* x_in_row(const Frame& F, int r) { return r < MP ? F.a->in[I_XP] + (size_t)r * D : F.a->in[I_XS] + (size_t)(r - MP) * D; }
__device__ __forceinline__ float* x_res_row(const Frame& F, int r) { return r < MP ? F.out + O_YP + (size_t)r * D : F.out + O_YS + (size_t)(r - MP) * D; }

__device__ __forceinline__ void wconv_items(Frame& F, int it_lo, int it_hi, int gw, int NGW) {
    LAS float* scr = (LAS float*)(F.lds + F.wave * 16384);
    bf16* WIN = (bf16*)(F.ws + WS_WIN); bf16* WOUT = (bf16*)(F.ws + WS_WOUT); bf16* WGLU = (bf16*)(F.ws + WS_WGLU); bf16* WUP = (bf16*)(F.ws + WS_WUP); bf16* WDN = (bf16*)(F.ws + WS_WDN);
    constexpr int I_IN = 16 * 200, I_OUT = 32 * 32, I_GLU = 16 * 64, I_UP = 16 * 176, I_DN = 44 * 32;
    constexpr int NITEMS = I_IN + I_OUT + I_GLU + 2 * I_UP + 2 * I_DN;
    (void)NITEMS;
    for (int it = it_lo + gw; it < it_hi; it += NGW) {
        int r = it;
        if (r < I_IN) { const int kb = r / 200, nb = r % 200;
            const int sc = nb < 72 ? 32 * nb : 2320 + 32 * (nb - 72);
            const int dr = nb < 72 ? 32 * nb : NA + 32 * (nb - 72);
            p0_transpose_item(F.a->in[I_WIN], ABIN, D, sc, WIN, dr, kb, scr, F.lane); continue; }
        r -= I_IN;
        if (r < I_OUT) { p0_transpose_item(F.a->in[I_WOUT], D, 2048, 32 * (r % 32), WOUT, 32 * (r % 32), r / 32, scr, F.lane); continue; }
        r -= I_OUT;
        if (r < I_GLU) { const int kb = r / 64, nb = r % 64, d = 32 * nb, j = d >> 8, bj = (d >> 7) & 1, c = d & 127;
            p0_transpose_item(F.a->in[I_WGLU], 2048, D, 1024 * bj + 128 * j + c, WGLU, d, kb, scr, F.lane); continue; }
        r -= I_GLU;
        if (r < 2 * I_UP) { const int l = r / I_UP; r -= l * I_UP; const int kb = r / 176, nb = r % 176, d = 32 * nb, j = d >> 8, bj = (d >> 7) & 1, c = d & 127;
            p0_transpose_item(F.a->in[I_WUP] + (size_t)l * D * FF2, FF2, D, FF * bj + 128 * j + c, WUP + (size_t)l * FF2 * D, d, kb, scr, F.lane); continue; }
        r -= 2 * I_UP;
        { const int l = r / I_DN; r -= l * I_DN; p0_transpose_item(F.a->in[I_WDN] + (size_t)l * FF * D, D, FF, 32 * (r % 32), WDN + (size_t)l * D * FF, 32 * (r % 32), r / 32, scr, F.lane); }
    }
}
constexpr int WC_EARLY = 16 * 200 + 32 * 32, WC_ALL = 16 * 200 + 32 * 32 + 16 * 64 + 2 * 16 * 176 + 2 * 44 * 32;
__device__ __forceinline__ void p0_prologue(Frame& F) {
    const int gw = GW_ID(F), NGW = GW_N(F);
    bf16* WIN = (bf16*)(F.ws + WS_WIN);
    wconv_items(F, 0, F.G > 128 ? WC_EARLY : WC_ALL, gw, NGW);
    { const int gt = (F.vcu * NTHR + F.tid), NT = F.G * NTHR;
      for (int i = gt; i < 16 * D; i += NT) { const int n = i >> 10, k = i & 1023; WIN[(size_t)(2304 + n) * D + k] = (bf16)f2bf(F.a->in[I_WIN][(size_t)k * ABIN + 2304 + n]); }
      unsigned z_ = 0u; asm volatile("" : "+v"(z_));
      for (int i = gt; i < 240 * D / 8; i += NT) ((GAS v4u*)(WIN + (size_t)2320 * D))[i] = (v4u){z_, z_, z_, z_}; }
    bf16* XN = (bf16*)(F.ws + WS_XN);
    { const int lane = F.lane; f32x4 nx[4];
      if (gw < MT) {
#pragma unroll
          for (int j = 0; j < 4; ++j) nx[j] = ((const GAS f32x4*)x_in_row(F, gw) + lane)[64 * j]; }
      for (int m = gw; m < MT; m += NGW) { f32x4 v[4]; float s = 0.f;
#pragma unroll
          for (int j = 0; j < 4; ++j) { v[j] = nx[j]; s += (v[j].x * v[j].x + v[j].y * v[j].y) + (v[j].z * v[j].z + v[j].w * v[j].w); }
          if (m + NGW < MT) {
#pragma unroll
              for (int j = 0; j < 4; ++j) nx[j] = ((const GAS f32x4*)x_in_row(F, m + NGW) + lane)[64 * j]; }
          const float rs = rsqrtf(wave_sum(s) * (1.f / D) + EPS); GAS v2u* o8 = (GAS v2u*)(XN + (size_t)m * D) + lane;
#pragma unroll
          for (int j = 0; j < 4; ++j) { const f32x4 ww = ((const GAS f32x4*)F.a->in[I_NMPRE] + lane)[64 * j]; v2u o; o.x = pk2(v[j].x * rs * ww.x, v[j].y * rs * ww.y); o.y = pk2(v[j].z * rs * ww.z, v[j].w * rs * ww.w); o8[64 * j] = o; } } }
}

template <int NT, bool GLU, class Epi>
__device__ __forceinline__ void skinny_gemm(Frame& F, const bf16* A, int lda, const bf16* Bt, int K, int ncb, const Epi& epi, int tb, int tstride) {
    LAS float* red = (LAS float*)F.lds;
    const int lane = F.lane, r = lane & 31, h = lane >> 5, w = F.wave;
    const int kper = K >> 3, kbeg = w * kper;
    const int ntask = 4 * ncb;
    if (tb < 0) return;
    for (int task = tb; task < ntask; task += tstride) {
        const int rt = task & 3, ct = task >> 2;
        const int brow = GLU ? (256 * (ct >> 2) + 32 * (ct & 3)) : 32 * ct;
        const bf16* ap = A + (size_t)(rt * 32 + r) * lda + kbeg + 8 * h;
        const bf16* bp = Bt + (size_t)(brow + r) * K + kbeg + 8 * h;
        f32x16 acc[NT];
#pragma unroll
        for (int nt = 0; nt < NT; ++nt)
#pragma unroll
            for (int i = 0; i < 16; ++i) acc[nt][i] = 0.f;
#pragma unroll 8
        for (int k = 0; k < kper; k += 16) {
            const bf16x8 a = *(const bf16x8*)(ap + k);
#pragma unroll
            for (int nt = 0; nt < NT; ++nt) { const bf16x8 b = *(const bf16x8*)(bp + (size_t)nt * 128 * K + k); acc[nt] = __builtin_amdgcn_mfma_f32_32x32x16_bf16(a, b, acc[nt], 0, 0, 0); }
        }
#pragma unroll
        for (int nt = 0; nt < NT; ++nt)
#pragma unroll
            for (int i = 0; i < 16; ++i) red[((w * NT + nt) * 16 + i) * 64 + lane] = acc[nt][i];
        __syncthreads();
#pragma unroll
        for (int e0 = 0; e0 < 2; ++e0) { const int e = F.tid + 512 * e0, i = e >> 6, l = e & 63; float v[NT];
#pragma unroll
            for (int nt = 0; nt < NT; ++nt) { float s = 0.f;
#pragma unroll
                for (int ww = 0; ww < 8; ++ww) s += red[((ww * NT + nt) * 16 + i) * 64 + l];
                v[nt] = s; }
            epi(rt * 32 + (i & 3) + 8 * (i >> 2) + 4 * (l >> 5), ct * 32 + (l & 31), v); }
        __syncthreads();
    }
}
struct SkBf16 { bf16* O; int ld; __device__ __forceinline__ void operator()(int row, int col, const float (&v)[1]) const { O[(size_t)row * ld + col] = (bf16)f2bf(v[0]); } };
struct SkF32 { float* O; int ld; __device__ __forceinline__ void operator()(int row, int col, const float (&v)[1]) const { O[(size_t)row * ld + col] = v[0]; } };
struct SkGlu { bf16* O; int ld; __device__ __forceinline__ void operator()(int row, int col, const float (&v)[2]) const { O[(size_t)row * ld + col] = (bf16)f2bf(v[0] * sigmoidf_(v[1])); } };

constexpr size_t B_XR = al256((size_t)MT * D * 2);
__device__ __forceinline__ void resid_norm_rows(Frame& F, const bf16* msrc, const float* w_post, const float* w_pre, int mode) {
    const int gw = GW_ID(F), NGW = GW_N(F), lane = F.lane;
    bf16* XN = (bf16*)(F.ws + WS_XN); bf16* XR = (bf16*)(F.ws + WS_BIG + B_XR);
    v2u pm[4]; f32x4 pxf[4]; v2u pxb[4];
#define RN_LOAD(r_) do { const GAS v2u* mr_ = (const GAS v2u*)(msrc + (size_t)(r_) * D) + lane; \
        _Pragma("unroll") for (int j = 0; j < 4; ++j) { pm[j] = mr_[64 * j]; if (mode == 0) pxf[j] = ((const GAS f32x4*)x_in_row(F, (r_)) + lane)[64 * j]; else pxb[j] = ((const GAS v2u*)(XR + (size_t)(r_) * D) + lane)[64 * j]; } } while (0)
    if (gw < MT) RN_LOAD(gw);
    for (int r = gw; r < MT; r += NGW) {
        f32x4 m[4], x[4]; float s = 0.f;
#pragma unroll
        for (int j = 0; j < 4; ++j) { const v2u mw = pm[j]; m[j] = (f32x4){bflo(mw.x), bfhi(mw.x), bflo(mw.y), bfhi(mw.y)};
            if (mode == 0) x[j] = pxf[j]; else { const v2u xw = pxb[j]; x[j] = (f32x4){bflo(xw.x), bfhi(xw.x), bflo(xw.y), bfhi(xw.y)}; }
            s += (m[j].x * m[j].x + m[j].y * m[j].y) + (m[j].z * m[j].z + m[j].w * m[j].w); }
        if (r + NGW < MT) RN_LOAD(r + NGW);
        const float rs = rsqrtf(wave_sum(s) * (1.f / D) + EPS); float s2 = 0.f;
#pragma unroll
        for (int j = 0; j < 4; ++j) { const f32x4 wp = ((const GAS f32x4*)w_post + lane)[64 * j]; x[j] = x[j] + m[j] * rs * wp;
            if (mode == 2) ((GAS f32x4*)x_res_row(F, r) + lane)[64 * j] = x[j];
            else { v2u o; o.x = pk2(x[j].x, x[j].y); o.y = pk2(x[j].z, x[j].w); ((GAS v2u*)(XR + (size_t)r * D) + lane)[64 * j] = o; }
            s2 += (x[j].x * x[j].x + x[j].y * x[j].y) + (x[j].z * x[j].z + x[j].w * x[j].w); }
        if (mode != 2) { const float rs2 = rsqrtf(wave_sum(s2) * (1.f / D) + EPS); GAS v2u* o8 = (GAS v2u*)(XN + (size_t)r * D) + lane;
#pragma unroll
            for (int j = 0; j < 4; ++j) { const f32x4 ww = ((const GAS f32x4*)w_pre + lane)[64 * j]; v2u o; o.x = pk2(x[j].x * rs2 * ww.x, x[j].y * rs2 * ww.y); o.y = pk2(x[j].z * rs2 * ww.z, x[j].w * rs2 * ww.w); o8[64 * j] = o; } }
    }
#undef RN_LOAD
}
__device__ __forceinline__ bf16* mixed_row(const Frame& F, int r) { return r < MP ? (bf16*)(F.out + O_YP) + (size_t)r * 2048 : (bf16*)(F.ws + WS_MIXS) + (size_t)(r - MP) * 2048; }
constexpr size_t B_HEAD = al256(B_ACT + (size_t)MT * FF * 2), B_TAIL = B_HEAD + (size_t)64 * 2 * FF2 * 4;
static_assert(B_TAIL + (size_t)64 * 2 * FF2 * 4 <= BIG_BYTES, "ffn side buffers");
__device__ __forceinline__ void ffn_fix_rows(Frame& F, int l, int pm) {
    const float* HEAD = (const float*)(F.ws + WS_BIG + B_HEAD); const float* TAIL = (const float*)(F.ws + WS_BIG + B_TAIL); bf16* ACT = (bf16*)(F.ws + WS_BIG + B_ACT);
    const float* cw = F.a->in[I_FCW] + (size_t)l * 3 * FF2; const float* cb = F.a->in[I_FCB] + (size_t)l * FF2;
    for (int c = F.tid; c < FF; c += NTHR) { float r0[2], r1[2];
#pragma unroll
        for (int x = 0; x < 2; ++x) { const int ch = x * FF + c; const float h0 = HEAD[((size_t)pm * 2) * FF2 + ch], h1 = HEAD[((size_t)pm * 2 + 1) * FF2 + ch];
            const float t0 = (pm & 7) ? TAIL[((size_t)(pm - 1) * 2) * FF2 + ch] : 0.f, t1 = (pm & 7) ? TAIL[((size_t)(pm - 1) * 2 + 1) * FF2 + ch] : 0.f;
            const float w0 = cw[ch], w1 = cw[FF2 + ch], w2 = cw[2 * FF2 + ch], bb = cb[ch];
            r0[x] = bb + w0 * t0 + w1 * t1 + w2 * h0; r1[x] = bb + w0 * t1 + w1 * h0 + w2 * h1; }
        ACT[(size_t)(256 * pm) * FF + c] = (bf16)f2bf(r0[0] * siluf_(r0[1])); ACT[(size_t)(256 * pm + 1) * FF + c] = (bf16)f2bf(r1[0] * siluf_(r1[1])); }
}
struct SkConvGate { bf16* ACTs; const float* cw; const float* cb; const float* st; float* sfc;
    __device__ __forceinline__ void operator()(int row, int col, const float (&v)[2]) const {
        const float* s0 = st + ((size_t)row * 2) * FF2; const float* s1 = s0 + FF2; float* p = sfc + (size_t)row * 2 * FF2; const int chv = col, chg = FF + col;
        const float v0 = s0[chv], v1 = s1[chv], g0 = s0[chg], g1 = s1[chg];
        const float vc = cb[chv] + cw[chv] * v0 + cw[FF2 + chv] * v1 + cw[2 * FF2 + chv] * v[0];
        const float gc = cb[chg] + cw[chg] * g0 + cw[FF2 + chg] * g1 + cw[2 * FF2 + chg] * v[1];
        ACTs[(size_t)row * FF + col] = (bf16)f2bf(vc * siluf_(gc)); p[chv] = v1; p[chg] = g1; p[FF2 + chv] = v[0]; p[FF2 + chg] = v[1]; } };

constexpr size_t B_HB = al256(B_PROJA + (size_t)MT * NA * 2);
static_assert(B_HB + (size_t)8 * 64 * 16 * 4096 * 2 <= BIG_BYTES, "ssd state buffer");
typedef float f32x2_t __attribute__((ext_vector_type(2)));

__device__ __forceinline__ void ssd_conv4(const Frame& F, const bf16* PA, int b, int t, int ch0, float (&out)[8][4]) {
    const float* cw = F.a->in[I_CONVW] + ch0; const float* cbias = F.a->in[I_CONVB] + ch0;
    float raw[7][8];
#pragma unroll
    for (int rr = 0; rr < 7; ++rr) { const int tt = t - 3 + rr;
        if (tt >= 0) { const v4u q = *(const GAS v4u*)(PA + (size_t)(b * SEQ + tt) * NA + 1024 + ch0);
            raw[rr][0] = bflo(q.x); raw[rr][1] = bfhi(q.x); raw[rr][2] = bflo(q.y); raw[rr][3] = bfhi(q.y); raw[rr][4] = bflo(q.z); raw[rr][5] = bfhi(q.z); raw[rr][6] = bflo(q.w); raw[rr][7] = bfhi(q.w); }
        else {
#pragma unroll
            for (int e = 0; e < 8; ++e) raw[rr][e] = 0.f; } }
    float w[4][8], bs[8];
#pragma unroll
    for (int k = 0; k < 4; ++k) { const f32x4 a = *(const GAS f32x4*)(cw + k * XBC), c = *(const GAS f32x4*)(cw + k * XBC + 4);
        w[k][0] = a.x; w[k][1] = a.y; w[k][2] = a.z; w[k][3] = a.w; w[k][4] = c.x; w[k][5] = c.y; w[k][6] = c.z; w[k][7] = c.w; }
    { const f32x4 a = *(const GAS f32x4*)cbias, c = *(const GAS f32x4*)(cbias + 4); bs[0] = a.x; bs[1] = a.y; bs[2] = a.z; bs[3] = a.w; bs[4] = c.x; bs[5] = c.y; bs[6] = c.z; bs[7] = c.w; }
#pragma unroll
    for (int e = 0; e < 8; ++e)
#pragma unroll
        for (int j = 0; j < 4; ++j) { float v = bs[e];
#pragma unroll
            for (int k = 0; k < 4; ++k) v += w[k][e] * raw[j + k][e];
            out[e][j] = siluf_(v); }
}

__device__ __forceinline__ void ssd_state_item(Frame& F, int b, int h) {
    const bf16* PA = (const bf16*)(F.ws + WS_BIG + B_PROJA); bf16* HB = (bf16*)(F.ws + WS_BIG + B_HB);
    constexpr int TP = 80, TBUF = 128 * TP;
    LAS unsigned char* T0 = F.lds; LAS float* WG = (LAS float*)(F.lds + 2 * TBUF); LAS float* DEC = WG + SEQ;
    int tid = F.tid; asm volatile("" : "+v"(tid));
    const int lane = tid & 63, wave = __builtin_amdgcn_readfirstlane(tid >> 6), g = h >> 3, r = lane & 31, hh = lane >> 5;
    { const float A = -__expf(F.a->in[I_ALOG][h]), dtb = F.a->in[I_DTB][h];
      float dt[4], cum[4]; float run = 0.f;
#pragma unroll
      for (int j = 0; j < 4; ++j) { dt[j] = softplusf_(bf2f(PA[(size_t)(b * SEQ + 4 * tid + j) * NA + 2304 + h]) + dtb); run += dt[j] * A; cum[j] = run; }
      float incl = run;
      const int ln_ = lane_op_();
#pragma unroll
      for (int off = 1; off < 8; off <<= 1) { const float v = shup_(incl, off, 8, ln_); if ((tid & 7) >= off) incl += v; }
      const float excl = incl - run, last = shidx_(incl, 7, 8, ln_);
#pragma unroll
      for (int j = 0; j < 4; ++j) WG[4 * tid + j] = dt[j] * __expf(last - (excl + cum[j]));
      if ((tid & 7) == 0) DEC[tid >> 3] = __expf(last); }
    __syncthreads();
    if (wave < 4) {
        const int o = tid >> 4, tp = tid & 15, ch0 = o < 8 ? h * 64 + 8 * o : 1024 + g * 64 + 8 * (o - 8);
        float w[4][8], bs[8];
        { const float* cw = F.a->in[I_CONVW] + ch0; const float* cbias = F.a->in[I_CONVB] + ch0;
#pragma unroll
          for (int k = 0; k < 4; ++k) { const f32x4 a = *(const GAS f32x4*)(cw + k * XBC), c4 = *(const GAS f32x4*)(cw + k * XBC + 4);
              w[k][0] = a.x; w[k][1] = a.y; w[k][2] = a.z; w[k][3] = a.w; w[k][4] = c4.x; w[k][5] = c4.y; w[k][6] = c4.z; w[k][7] = c4.w; }
          const f32x4 a = *(const GAS f32x4*)cbias, c4 = *(const GAS f32x4*)(cbias + 4); bs[0] = a.x; bs[1] = a.y; bs[2] = a.z; bs[3] = a.w; bs[4] = c4.x; bs[5] = c4.y; bs[6] = c4.z; bs[7] = c4.w; }
        const bf16* xrow = PA + (size_t)(b * SEQ + 2 * tp) * NA + 1024 + ch0;
        v4u pre[5];
#pragma unroll
        for (int k = 0; k < 5; ++k) { const int rr = 2 * tp - 3 + k < 0 ? 0 : 2 * tp - 3 + k; pre[k] = *(const GAS v4u*)(xrow + (ptrdiff_t)(rr - 2 * tp) * NA); }
        for (int c = 0; c < 64; ++c) {
            LAS unsigned char* T = T0 + (c & 1) * TBUF;
            v4u cur[5];
#pragma unroll
            for (int k = 0; k < 5; ++k) cur[k] = pre[k];
            if (c + 1 < 64) { const bf16* xn = xrow + (size_t)(32 * (c + 1)) * NA;
#pragma unroll
                for (int k = 0; k < 5; ++k) pre[k] = *(const GAS v4u*)(xn + (ptrdiff_t)(k - 3) * NA); }
            const f32x2_t wq = *(const LAS f32x2_t*)(WG + 32 * c + 2 * tp);
            const float w0 = o < 8 ? wq.x : 1.0f, w1 = o < 8 ? wq.y : 1.0f;
            float x8[5][8];
#pragma unroll
            for (int k = 0; k < 5; ++k) { const v4u qv = cur[k]; const float mk = (c == 0 && 2 * tp - 3 + k < 0) ? 0.f : 1.f;
                x8[k][0] = bflo(qv.x) * mk; x8[k][1] = bfhi(qv.x) * mk; x8[k][2] = bflo(qv.y) * mk; x8[k][3] = bfhi(qv.y) * mk; x8[k][4] = bflo(qv.z) * mk; x8[k][5] = bfhi(qv.z) * mk; x8[k][6] = bflo(qv.w) * mk; x8[k][7] = bfhi(qv.w) * mk; }
#pragma unroll
            for (int e = 0; e < 8; ++e) { float v0 = bs[e], v1 = bs[e];
#pragma unroll
                for (int k = 0; k < 4; ++k) { v0 += w[k][e] * x8[k][e]; v1 += w[k][e] * x8[k + 1][e]; }
                *(LAS unsigned*)(T + (8 * o + e) * TP + 4 * tp) = pk2(siluf_(v0) * w0, siluf_(v1) * w1); }
            asm volatile("s_waitcnt lgkmcnt(0)" ::: "memory"); __builtin_amdgcn_s_barrier(); asm volatile("" ::: "memory");
        }
    } else {
        f32x16 acc;
#pragma unroll
        for (int i = 0; i < 16; ++i) acc[i] = 0.f;
        const int q = wave - 4, pt = q >> 1, nt = q & 1;
        for (int c = 0; c < 64; ++c) {
            LAS unsigned char* T = T0 + (c & 1) * TBUF;
            bf16* hb = HB + ((((size_t)b * 64 + c) * 16 + h) * 64 + pt * 32) * 64 + nt * 32 + r;
#pragma unroll
            for (int i = 0; i < 16; ++i) hb[(size_t)((i & 3) + 8 * (i >> 2) + 4 * hh) * 64] = (bf16)f2bf(acc[i]);
            const float dec = DEC[c];
#pragma unroll
            for (int i = 0; i < 16; ++i) acc[i] *= dec;
            asm volatile("s_waitcnt lgkmcnt(0)" ::: "memory"); __builtin_amdgcn_s_barrier(); asm volatile("" ::: "memory");
#pragma unroll
            for (int ks = 0; ks < 2; ++ks) { const bf16x8 a = *(const LAS bf16x8*)(T + (pt * 32 + r) * TP + 32 * ks + 16 * hh), bb = *(const LAS bf16x8*)(T + (64 + nt * 32 + r) * TP + 32 * ks + 16 * hh);
                acc = __builtin_amdgcn_mfma_f32_32x32x16_bf16(a, bb, acc, 0, 0, 0); }
        }
        float* ps = F.out + O_PSSM + ((size_t)(b * 16 + h) * 64 + pt * 32) * 64 + nt * 32 + r;
#pragma unroll
        for (int i = 0; i < 16; ++i) ps[(size_t)((i & 3) + 8 * (i >> 2) + 4 * hh) * 64] = acc[i];
    }
    { float* pc = F.out + O_PSCONV + (size_t)b * 3 * XBC;
      for (int e = tid; e < 3 * 192; e += NTHR) { const int k = e / 192, cc = e % 192; if (cc >= 64 && (h & 7) != 0) continue;
          const int ch = cc < 64 ? h * 64 + cc : (cc < 128 ? 1024 + g * 64 + (cc - 64) : 1152 + g * 64 + (cc - 128));
          pc[k * XBC + ch] = bf2f(PA[(size_t)(b * SEQ + SEQ - 3 + k) * NA + 1024 + ch]); } }
    __syncthreads();
}

__device__ __forceinline__ void ssd_sample_item(Frame& F, int j) {
    const bf16* PA = (const bf16*)(F.ws + WS_BIG + B_PROJA) + (size_t)(MP + j) * NA; bf16* MX = (bf16*)(F.ws + WS_MIXS) + (size_t)j * 2048;
    LAS float* act = (LAS float*)F.lds;
    LAS float* dts = act + XBC;
    LAS float* y2 = dts + 32;
    LAS float* red = y2 + 1024;
    const int tid = F.tid;
    const float* cw = F.a->in[I_CONVW]; const float* cbias = F.a->in[I_CONVB]; const float* st = F.a->in[I_SSCONV] + (size_t)j * 3 * XBC; float* so = F.out + O_SSCONV + (size_t)j * 3 * XBC;
    for (int ch = tid; ch < XBC; ch += NTHR) { const float nw = bf2f(PA[1024 + ch]); const float s0 = st[ch], s1 = st[XBC + ch], s2 = st[2 * XBC + ch];
        act[ch] = siluf_(cbias[ch] + cw[ch] * s0 + cw[XBC + ch] * s1 + cw[2 * XBC + ch] * s2 + cw[3 * XBC + ch] * nw);
        so[ch] = s1; so[XBC + ch] = s2; so[2 * XBC + ch] = nw; }
    if (tid < 16) { const float d = softplusf_(bf2f(PA[2304 + tid]) + F.a->in[I_DTB][tid]); dts[tid] = d; dts[16 + tid] = __expf(-__expf(F.a->in[I_ALOG][tid]) * d); }
    __syncthreads();
    const float* S0 = F.a->in[I_SSSM] + (size_t)j * 65536; float* S1 = F.out + O_SSSM + (size_t)j * 65536;
    float ssq = 0.f;
#pragma unroll 1
    for (int it8 = 0; it8 < 4; ++it8) { f32x4 sv[8];
#pragma unroll
      for (int u = 0; u < 8; ++u) sv[u] = *(const GAS f32x4*)(S0 + (size_t)((it8 * 8 + u) * NTHR + tid) * 4);
#pragma unroll
      for (int u = 0; u < 8; ++u) { const int it = it8 * 8 + u; const int v = it * NTHR + tid, n4 = v & 15, p = (v >> 4) & 63, h = v >> 10, g = h >> 3;
        const f32x4 s = sv[u];
        const f32x4 bb = *(const LAS f32x4*)(act + 1024 + g * 64 + 4 * n4), cc = *(const LAS f32x4*)(act + 1152 + g * 64 + 4 * n4);
        const float x = act[h * 64 + p], dtx = dts[h] * x, dec = dts[16 + h];
        f32x4 nn; float a = 0.f;
#pragma unroll
        for (int i = 0; i < 4; ++i) { nn[i] = dec * s[i] + dtx * bb[i]; a += nn[i] * cc[i]; }
        *(GAS f32x4*)(S1 + (size_t)v * 4) = nn;
        a = row16_sum(a);
        if (n4 == 0) { const float yy = (a + F.a->in[I_SSMD][h] * x) * siluf_(bf2f(PA[h * 64 + p])); y2[h * 64 + p] = yy; ssq += yy * yy; } } }
    ssq = wave_sum(ssq); if (F.lane == 0) red[F.wave] = ssq;
    __syncthreads();
    float tot = 0.f;
#pragma unroll
    for (int w = 0; w < 8; ++w) tot += red[w];
    const float rs = rsqrtf(tot * (1.f / D) + EPS);
    for (int c = tid; c < 1024; c += NTHR) MX[c] = (bf16)f2bf(y2[c] * rs * F.a->in[I_SSMNW][c]);
    __syncthreads();
}
__device__ __forceinline__ void ssd_state_phase(Frame& F) {
    for (int it = F.vcu; it < 128 + MS; it += F.G) { if (it < 128) ssd_state_item(F, it >> 4, it & 15); else ssd_sample_item(F, it - 128); }
    if (F.G > 128 && F.vcu >= 128) { __syncthreads(); wconv_items(F, WC_EARLY, WC_ALL, (F.vcu - 128) * NWAVES + F.wave, (F.G - 128) * NWAVES); }
}

__device__ __forceinline__ void ssd_rows7(const bf16* PA, int b, int t, int ch0, v4u (&rw)[7]) {
#pragma unroll
    for (int rr = 0; rr < 7; ++rr) { const int tt = t - 3 + rr < 0 ? 0 : t - 3 + rr; rw[rr] = *(const GAS v4u*)(PA + (size_t)(b * SEQ + tt) * NA + 1024 + ch0); }
}
__device__ __forceinline__ void ssd_conv4_lds(const v4u (&rw)[7], const LAS float* CWL, int t, int ch0, float (&out)[8][4]) {
    float raw[7][8];
#pragma unroll
    for (int rr = 0; rr < 7; ++rr) { const v4u q = rw[rr]; const float mk = (t - 3 + rr >= 0) ? 1.f : 0.f;
        raw[rr][0] = bflo(q.x) * mk; raw[rr][1] = bfhi(q.x) * mk; raw[rr][2] = bflo(q.y) * mk; raw[rr][3] = bfhi(q.y) * mk; raw[rr][4] = bflo(q.z) * mk; raw[rr][5] = bfhi(q.z) * mk; raw[rr][6] = bflo(q.w) * mk; raw[rr][7] = bfhi(q.w) * mk; }
    float w[4][8], bs[8];
#pragma unroll
    for (int k = 0; k < 5; ++k) { const f32x4 a = *(const LAS f32x4*)(CWL + k * XBC + ch0), c = *(const LAS f32x4*)(CWL + k * XBC + ch0 + 4);
        if (k < 4) { w[k < 4 ? k : 0][0] = a.x; w[k < 4 ? k : 0][1] = a.y; w[k < 4 ? k : 0][2] = a.z; w[k < 4 ? k : 0][3] = a.w; w[k < 4 ? k : 0][4] = c.x; w[k < 4 ? k : 0][5] = c.y; w[k < 4 ? k : 0][6] = c.z; w[k < 4 ? k : 0][7] = c.w; }
        else { bs[0] = a.x; bs[1] = a.y; bs[2] = a.z; bs[3] = a.w; bs[4] = c.x; bs[5] = c.y; bs[6] = c.z; bs[7] = c.w; } }
#pragma unroll
    for (int e = 0; e < 8; ++e)
#pragma unroll
        for (int j = 0; j < 4; ++j) { float v = bs[e];
#pragma unroll
            for (int k = 0; k < 4; ++k) v += w[k][e] * raw[j + k][e];
            out[e][j] = siluf_(v); }
}
constexpr int SSDO_CWL = 16 * 64 * 80 + 2 * (2 * 32 * 144) + (512 + 512 + 256) * 4;
static_assert(SSDO_CWL + 5 * XBC * 4 <= RING_BYTES, "ssd_out LDS map");
__device__ __forceinline__ void ssd_out_item(Frame& F, int b, int c) {
    const bf16* PA = (const bf16*)(F.ws + WS_BIG + B_PROJA); const bf16* HB = (const bf16*)(F.ws + WS_BIG + B_HB);
    constexpr int XP_ = 80, BP_ = 144;
    LAS unsigned char* XT = F.lds;
    LAS unsigned char* BS = XT + 16 * 64 * XP_;
    LAS unsigned char* CS = BS + 2 * 32 * BP_;
    LAS float* DT = (LAS float*)(CS + 2 * 32 * BP_);
    LAS float* CUM = DT + 512;
    LAS float* SSQ = CUM + 512;
    const LAS float* CWL = (const LAS float*)(F.lds + SSDO_CWL);
    int tid = F.tid; asm volatile("" : "+v"(tid));
    const int t0 = 32 * c;
    v4u zq[8];
#pragma unroll
    for (int q = 0; q < 8; ++q) zq[q] = *(const GAS v4u*)(PA + (size_t)(b * SEQ + t0 + (tid >> 7) + 4 * q) * NA + 8 * (tid & 127));
    v4u rwn[7]; ssd_rows7(PA, b, t0 + 4 * (tid & 7), 8 * (tid >> 3), rwn);
#pragma unroll 1
    for (int task = tid; task < 160 * 8; task += NTHR) { const int o = task >> 3, run = task & 7;
        v4u rwc[7];
#pragma unroll
        for (int rr = 0; rr < 7; ++rr) rwc[rr] = rwn[rr];
        if (task + NTHR < 160 * 8) ssd_rows7(PA, b, t0 + 4 * ((task + NTHR) & 7), 8 * ((task + NTHR) >> 3), rwn);
        float act[8][4]; ssd_conv4_lds(rwc, CWL, t0 + 4 * run, 8 * o, act);
        if (o < 128) { const int h = o >> 3, p0 = (o & 7) * 8;
#pragma unroll
            for (int e = 0; e < 8; ++e) { v2u pk; pk.x = pk2(act[e][0], act[e][1]); pk.y = pk2(act[e][2], act[e][3]); *(LAS v2u*)(XT + (h * 64 + p0 + e) * XP_ + 8 * run) = pk; } }
        else { const int oo = o - 128, isC = oo >> 4, g = (oo >> 3) & 1, n0 = (oo & 7) * 8; LAS unsigned char* dst = (isC ? CS : BS) + g * 32 * BP_;
#pragma unroll
            for (int jx = 0; jx < 4; ++jx) { v4u pk; pk.x = pk2(act[0][jx], act[1][jx]); pk.y = pk2(act[2][jx], act[3][jx]); pk.z = pk2(act[4][jx], act[5][jx]); pk.w = pk2(act[6][jx], act[7][jx]);
                *(LAS v4u*)(dst + (4 * run + jx) * BP_ + 2 * n0) = pk; } }
    }
    { const int h = tid >> 5, t = tid & 31;
      const float dt = softplusf_(bf2f(PA[(size_t)(b * SEQ + t0 + t) * NA + 2304 + h]) + F.a->in[I_DTB][h]);
      float cum = -__expf(F.a->in[I_ALOG][h]) * dt;
      const int ln_ = lane_op_();
#pragma unroll
      for (int off = 1; off < 32; off <<= 1) { const float v = shup_(cum, off, 32, ln_); if (t >= off) cum += v; }
      DT[tid] = dt; CUM[tid] = cum; }
    __syncthreads();
    asm volatile("" : "+v"(tid));
    const int lane = tid & 63, wave = __builtin_amdgcn_readfirstlane(tid >> 6), r = lane & 31, hh = lane >> 5;
    const int g = wave >> 2;
    f32x16 gt;
#pragma unroll
    for (int i = 0; i < 16; ++i) gt[i] = 0.f;
#pragma unroll
    for (int ks = 0; ks < 4; ++ks) { const bf16x8 a = *(const LAS bf16x8*)(BS + (g * 32 + r) * BP_ + 32 * ks + 16 * hh), bb = *(const LAS bf16x8*)(CS + (g * 32 + r) * BP_ + 32 * ks + 16 * hh);
        gt = __builtin_amdgcn_mfma_f32_32x32x16_bf16(a, bb, gt, 0, 0, 0); }
#pragma unroll 1
    for (int hi = 0; hi < 2; ++hi) { const int h = 2 * wave + hi;
        bf16x8 hbf[2][4];
        { const bf16* hb0 = HB + ((((size_t)b * 64 + c) * 16 + h) * 64 + r) * 64 + 8 * hh;
#pragma unroll
          for (int pt = 0; pt < 2; ++pt)
#pragma unroll
              for (int ks = 0; ks < 4; ++ks) hbf[pt][ks] = *(const GAS bf16x8*)(hb0 + (size_t)pt * 32 * 64 + 16 * ks); }
        const float cum_t = CUM[h * 32 + r];
        bf16x8 am[2];
#pragma unroll
        for (int ks = 0; ks < 2; ++ks) { unsigned mf[4];
#pragma unroll
            for (int i2 = 0; i2 < 4; ++i2) { float m2[2];
#pragma unroll
                for (int q = 0; q < 2; ++q) { const int i = 8 * ks + 2 * i2 + q, s = (i & 3) + 8 * (i >> 2) + 4 * hh;
                    const float e_ = gt[i] * __expf(fminf(cum_t - CUM[h * 32 + s], 0.f)) * DT[h * 32 + s]; m2[q] = s <= r ? e_ : 0.f; }
                mf[i2] = pk2(m2[0], m2[1]); }
            v4u t4; t4.x = mf[0]; t4.y = mf[1]; t4.z = mf[2]; t4.w = mf[3]; am[ks] = __builtin_bit_cast(bf16x8, t4); }
        const float dsk = F.a->in[I_SSMD][h];
        f32x16 yv[2];
#pragma unroll
        for (int pt = 0; pt < 2; ++pt) {
            f32x16 yi;
#pragma unroll
            for (int i = 0; i < 16; ++i) { yv[pt][i] = 0.f; yi[i] = 0.f; }
            const LAS unsigned char* xrow = XT + (h * 64 + pt * 32 + r) * XP_;
#pragma unroll
            for (int ks = 0; ks < 2; ++ks) { const v2u lo = *(const LAS v2u*)(xrow + 2 * (16 * ks + 4 * hh)), hi2 = *(const LAS v2u*)(xrow + 2 * (16 * ks + 8 + 4 * hh));
                v4u t4; t4.x = lo.x; t4.y = lo.y; t4.z = hi2.x; t4.w = hi2.y;
                yv[pt] = __builtin_amdgcn_mfma_f32_32x32x16_bf16(am[ks], __builtin_bit_cast(bf16x8, t4), yv[pt], 0, 0, 0); }
#pragma unroll
            for (int ks = 0; ks < 4; ++ks) { const bf16x8 a = *(const LAS bf16x8*)(CS + (g * 32 + r) * BP_ + 32 * ks + 16 * hh), bb = hbf[pt][ks];
                yi = __builtin_amdgcn_mfma_f32_32x32x16_bf16(a, bb, yi, 0, 0, 0); }
#pragma unroll
            for (int i4 = 0; i4 < 4; ++i4) { const int tb = 8 * i4 + 4 * hh; const v2u xv = *(const LAS v2u*)(xrow + 2 * tb);
                const float xs[4] = {bflo(xv.x), bfhi(xv.x), bflo(xv.y), bfhi(xv.y)};
#pragma unroll
                for (int q = 0; q < 4; ++q) { const int i = 4 * i4 + q, t = tb + q; yv[pt][i] = yv[pt][i] + __expf(CUM[h * 32 + t]) * yi[i] + dsk * xs[q]; } }
        }
        LAS unsigned char* yb = XT + h * 64 * XP_;
#pragma unroll
        for (int pt = 0; pt < 2; ++pt)
#pragma unroll
            for (int i = 0; i < 16; ++i) { const int t = (i & 3) + 8 * (i >> 2) + 4 * hh; *(LAS unsigned short*)(yb + t * 128 + 2 * (pt * 32 + r)) = (unsigned short)f2bf(yv[pt][i]); }
    }
    __syncthreads();
    { const int c8 = (tid & 127) * 8, h = c8 >> 6, pp = c8 & 63; float gv[8][8], ss[8];
#pragma unroll
      for (int q = 0; q < 8; ++q) { const int t = (tid >> 7) + 4 * q; const v4u yq = *(const LAS v4u*)(XT + h * 64 * XP_ + t * 128 + 2 * pp); const v4u z = zq[q];
          gv[q][0] = bflo(yq.x) * siluf_(bflo(z.x)); gv[q][1] = bfhi(yq.x) * siluf_(bfhi(z.x)); gv[q][2] = bflo(yq.y) * siluf_(bflo(z.y)); gv[q][3] = bfhi(yq.y) * siluf_(bfhi(z.y));
          gv[q][4] = bflo(yq.z) * siluf_(bflo(z.z)); gv[q][5] = bfhi(yq.z) * siluf_(bfhi(z.z)); gv[q][6] = bflo(yq.w) * siluf_(bflo(z.w)); gv[q][7] = bfhi(yq.w) * siluf_(bfhi(z.w));
          float a = 0.f;
#pragma unroll
          for (int e = 0; e < 8; ++e) a += gv[q][e] * gv[q][e];
          ss[q] = wave_sum(a); }
      if ((tid & 63) == 0) {
#pragma unroll
          for (int q = 0; q < 8; ++q) SSQ[(tid >> 6) * 8 + q] = ss[q]; }
      __syncthreads();
      const f32x4 w0 = *(const GAS f32x4*)(F.a->in[I_SSMNW] + c8), w1 = *(const GAS f32x4*)(F.a->in[I_SSMNW] + c8 + 4);
      bf16* MX = (bf16*)(F.out + O_YP) + (size_t)(b * SEQ + t0) * 2048;
#pragma unroll
      for (int q = 0; q < 8; ++q) { const int t = (tid >> 7) + 4 * q; const float rs = rsqrtf((SSQ[((tid >> 7) * 2) * 8 + q] + SSQ[((tid >> 7) * 2 + 1) * 8 + q]) * (1.f / D) + EPS);
          v4u o; o.x = pk2(gv[q][0] * rs * w0.x, gv[q][1] * rs * w0.y); o.y = pk2(gv[q][2] * rs * w0.z, gv[q][3] * rs * w0.w); o.z = pk2(gv[q][4] * rs * w1.x, gv[q][5] * rs * w1.y); o.w = pk2(gv[q][6] * rs * w1.z, gv[q][7] * rs * w1.w);
          *(GAS v4u*)(MX + (size_t)t * 2048 + c8) = o; } }
    __syncthreads();
}
__device__ __forceinline__ void ssd_out_phase(Frame& F) {
    { LAS float* CWL = (LAS float*)(F.lds + SSDO_CWL);
      for (int e = F.tid; e < 5 * XBC; e += NTHR) CWL[e] = e < 4 * XBC ? F.a->in[I_CONVW][e] : F.a->in[I_CONVB][e - 4 * XBC]; }
    __syncthreads();
    for (int it = F.vcu; it < 8 * 64; it += F.G) ssd_out_item(F, it >> 6, it & 63);
}

constexpr size_t B_SB = 0;
static_assert(B_SB + (size_t)8 * 16 * 8 * 16384 * 2 <= B_PROJB, "hgrn state buffer");
__device__ __forceinline__ float hg_lb(const Frame& F, int c) { return __builtin_amdgcn_rcpf(1.f + __expf(F.a->in[I_HGLB][1024 + c] - F.a->in[I_HGLB][c])); }

__device__ __forceinline__ void hg_state_item(Frame& F, int b, int h, int vq, int sj, int sh) {
    const bf16* PB = (const bf16*)(F.ws + WS_BIG + B_PROJB); bf16* SB = (bf16*)(F.ws + WS_BIG + B_SB);
    constexpr int KP = 272;
    LAS unsigned char* KT0 = F.lds;
    LAS unsigned char* VT0 = KT0 + 2 * 128 * KP;
    LAS unsigned char* RAW = VT0 + 2 * 32 * KP;
    LAS float* EL = (LAS float*)(RAW + 128 * KP);
    LAS float* SEG = EL + 256;
    int tid = F.tid; asm volatile("" : "+v"(tid));
    const int lane = tid & 63, wave = __builtin_amdgcn_readfirstlane(tid >> 6), r = lane & 31, hh = lane >> 5;
    const int kcol = tid & 127, seg = tid >> 7;
    const float lb = hg_lb(F, h * 128 + kcol);
    const int vs = tid >> 2, voc = tid & 3;
    const bf16* fsrc = PB + (size_t)(b * SEQ + (tid >> 4)) * NBH + 1024 + h * 128 + 8 * (tid & 15);
    const bf16* vsrc = PB + (size_t)(b * SEQ + vs) * NBH + 2048 + h * 128 + vq * 32 + 8 * voc;
    v4u pf[4], pv;
#pragma unroll
    for (int q = 0; q < 4; ++q) pf[q] = *(const GAS v4u*)(fsrc + (size_t)(32 * q) * NBH);
    pv = *(const GAS v4u*)vsrc;
    LAS float* SM = (LAS float*)(F.lds + HALO_OFF); LAS float* OW = SM + 1024; LAS float* OH = OW + 1024;
    const bf16* PS = PB + (size_t)(MP + sj) * NBH + 512 * sh;
    const float* S0 = F.a->in[I_SHG] + (size_t)sj * 131072 + (size_t)sh * 65536; float* S1 = F.out + O_SHG + (size_t)sj * 131072 + (size_t)sh * 65536;
    const int ln_ = lane_op_();
    f32x4 oacc = {0.f, 0.f, 0.f, 0.f};
    const int kt = wave - 4;
    f32x16 acc;
#pragma unroll
    for (int i = 0; i < 16; ++i) acc[i] = 0.f;
#pragma unroll 1
    for (int cc = 0; cc < 16; ++cc) {
        LAS unsigned char* KT = KT0 + (cc & 1) * 128 * KP; LAS unsigned char* VT = VT0 + (cc & 1) * 32 * KP;
        const int hl = cc >> 2, si0 = cc * 1024 + tid, si1 = si0 + 512;
        const f32x4 sv0 = *(const GAS f32x4*)(S0 + (size_t)si0 * 4), sv1 = *(const GAS f32x4*)(S0 + (size_t)si1 * 4);
        if ((cc & 3) == 0 && tid < 128) { LAS float* sm = SM + (hl & 1) * 512; const int c = hl * 128 + tid; const float lbs = hg_lb(F, 512 * sh + c), sg = sigmoidf_(bf2f(PS[1024 + c]));
            sm[tid] = lbs + (1.f - lbs) * sg; sm[128 + tid] = (1.f - lbs) * (1.f - sg); sm[256 + tid] = siluf_(bf2f(PS[c])); sm[384 + tid] = bf2f(PS[2048 + c]); }
#pragma unroll
        for (int q = 0; q < 4; ++q) *(LAS v4u*)(RAW + ((tid >> 4) + 32 * q) * KP + 16 * (tid & 15)) = pf[q];
        { const unsigned ww[4] = {pv.x, pv.y, pv.z, pv.w};
#pragma unroll
          for (int e = 0; e < 4; ++e) { *(LAS unsigned short*)(VT + (8 * voc + 2 * e) * KP + 2 * vs) = (unsigned short)(ww[e] & 0xffffu); *(LAS unsigned short*)(VT + (8 * voc + 2 * e + 1) * KP + 2 * vs) = (unsigned short)(ww[e] >> 16); } }
        if (cc + 1 < 16) {
#pragma unroll
            for (int q = 0; q < 4; ++q) pf[q] = *(const GAS v4u*)(fsrc + (size_t)(128 * (cc + 1) + 32 * q) * NBH);
            pv = *(const GAS v4u*)(vsrc + (size_t)(128 * (cc + 1)) * NBH); }
        if (wave >= 4) {
            bf16* sb = SB + ((((size_t)b * 16 + cc) * 8 + h) * 128 + vq * 32) * 128 + kt * 32 + r;
#pragma unroll
            for (int i = 0; i < 16; ++i) sb[(size_t)((i & 3) + 8 * (i >> 2) + 4 * hh) * 128] = (bf16)f2bf(acc[i]); }
        asm volatile("s_waitcnt lgkmcnt(0)" ::: "memory"); __builtin_amdgcn_s_barrier(); asm volatile("" ::: "memory");
        float kp[32];
        { float run = 1.f;
#pragma unroll
          for (int j = 31; j >= 0; --j) { const float sg = sigmoidf_(bf2f(*(const LAS unsigned short*)(RAW + (32 * seg + j) * KP + 2 * kcol))); kp[j] = (1.f - lb) * (1.f - sg) * run; run *= lb + (1.f - lb) * sg; }
          SEG[seg * 128 + kcol] = run; }
        asm volatile("s_waitcnt lgkmcnt(0)" ::: "memory"); __builtin_amdgcn_s_barrier(); asm volatile("" ::: "memory");
        { const float t0 = SEG[kcol], t1 = SEG[128 + kcol], t2 = SEG[256 + kcol], t3 = SEG[384 + kcol];
          const float R = seg == 3 ? 1.f : (seg == 2 ? t3 : (seg == 1 ? t2 * t3 : t1 * t2 * t3));
          if (seg == 0) EL[(cc & 1) * 128 + kcol] = (t0 * t1) * (t2 * t3);
#pragma unroll
          for (int j8 = 0; j8 < 4; ++j8) { v4u p;
              p.x = pk2(kp[8 * j8] * R, kp[8 * j8 + 1] * R); p.y = pk2(kp[8 * j8 + 2] * R, kp[8 * j8 + 3] * R); p.z = pk2(kp[8 * j8 + 4] * R, kp[8 * j8 + 5] * R); p.w = pk2(kp[8 * j8 + 6] * R, kp[8 * j8 + 7] * R);
              *(LAS v4u*)(KT + kcol * KP + 2 * (32 * seg + 8 * j8)) = p; } }
        asm volatile("s_waitcnt lgkmcnt(0)" ::: "memory"); __builtin_amdgcn_s_barrier(); asm volatile("" ::: "memory");
        if (wave >= 4) {
            const float el = EL[(cc & 1) * 128 + kt * 32 + r];
#pragma unroll
            for (int i = 0; i < 16; ++i) acc[i] *= el;
#pragma unroll
            for (int ks = 0; ks < 8; ++ks) { const bf16x8 a = *(const LAS bf16x8*)(VT + r * KP + 32 * ks + 16 * hh), bb = *(const LAS bf16x8*)(KT + (kt * 32 + r) * KP + 32 * ks + 16 * hh);
                acc = __builtin_amdgcn_mfma_f32_32x32x16_bf16(a, bb, acc, 0, 0, 0); }
        }
        { const LAS float* sm = SM + (hl & 1) * 512; const int v4 = (tid & 31) * 4; const f32x4 vv = *(const LAS f32x4*)(sm + 384 + v4);
          const int k0 = (si0 >> 5) & 127, k1 = (si1 >> 5) & 127;
          const f32x4 n0 = sv0 * sm[k0] + vv * sm[128 + k0], n1 = sv1 * sm[k1] + vv * sm[128 + k1];
          *(GAS f32x4*)(S1 + (size_t)si0 * 4) = n0; *(GAS f32x4*)(S1 + (size_t)si1 * 4) = n1;
          oacc += n0 * sm[256 + k0] + n1 * sm[256 + k1];
          if ((cc & 3) == 3) {
              f32x4 t; t[0] = oacc[0] + shx_(oacc[0], 32, ln_); t[1] = oacc[1] + shx_(oacc[1], 32, ln_); t[2] = oacc[2] + shx_(oacc[2], 32, ln_); t[3] = oacc[3] + shx_(oacc[3], 32, ln_);
              if (lane < 32) *(LAS f32x4*)(OW + wave * 128 + v4) = t;
              oacc = (f32x4){0.f, 0.f, 0.f, 0.f}; } }
        if ((cc & 3) == 0 && cc > 0 && tid < 128) { float o = 0.f;
#pragma unroll
            for (int w = 0; w < 8; ++w) o += OW[w * 128 + tid];
            OH[(hl - 1) * 128 + tid] = o; }
    }
    __syncthreads();
    if (tid < 128) { float o = 0.f;
#pragma unroll
        for (int w = 0; w < 8; ++w) o += OW[w * 128 + tid];
        OH[3 * 128 + tid] = o; }
    __syncthreads();
    { const int c = tid; const float o = OH[c]; const float ss = wave_sum(o * o); if (lane == 0) SM[wave] = ss;
      __syncthreads();
      const float rs = rsqrtf((SM[(tid >> 7) * 2] + SM[(tid >> 7) * 2 + 1]) * (1.f / 128.f) + EPS);
      ((bf16*)(F.ws + WS_MIXS) + (size_t)sj * 2048 + 1024 + 512 * sh)[c] = (bf16)f2bf(o * rs * F.a->in[I_HGNW][c & 127] * siluf_(bf2f(PS[3072 + c]))); }
    if (wave >= 4) { float* ps = F.out + O_PHG + ((size_t)(b * 8 + h) * 128 + kt * 32 + r) * 128 + vq * 32;
#pragma unroll
        for (int i = 0; i < 16; ++i) ps[(i & 3) + 8 * (i >> 2) + 4 * hh] = acc[i]; }
    __syncthreads();
}

__device__ __forceinline__ void hg_out_phase(Frame& F) {
    const bf16* PB = (const bf16*)(F.ws + WS_BIG + B_PROJB); const bf16* SB = (const bf16*)(F.ws + WS_BIG + B_SB);
    constexpr int KP = 272, SP = 80, OP = 528;
    LAS unsigned char* QH = F.lds;
    LAS unsigned char* Q1 = QH + 32 * KP;
    LAS unsigned char* KA = Q1 + 16 * KP;
    LAS unsigned char* KB = KA + 16 * KP;
    LAS unsigned char* KHT = KB + 32 * KP;
    LAS unsigned char* VT = KHT + 128 * SP;
    LAS float* CSEG = (LAS float*)(VT + 128 * SP);
    LAS float* EL = CSEG + 512;
    LAS float* SSQ = EL + 128;
    LAS unsigned char* OF = (LAS unsigned char*)(SSQ + 256);
    LAS unsigned char* RQ = OF + 32 * OP;
    LAS unsigned char* RF = RQ + 32 * KP;
    int tid = F.tid; asm volatile("" : "+v"(tid));
    const int lane = tid & 63, wave = __builtin_amdgcn_readfirstlane(tid >> 6), fr = lane & 15, q4 = lane >> 4;
    const int kcol = tid & 127, seg = tid >> 7;
    const int NITEM = 8 * 16 * 8;
    const int nit = F.vcu < NITEM ? (NITEM - 1 - F.vcu) / F.G + 1 : 0, NIT = 4 * nit;
    v4u pq, pf, pv, pg;
#define HG_ROW0(n) ((((F.vcu + ((n) >> 2) * F.G) >> 7) * SEQ) + 128 * (((F.vcu + ((n) >> 2) * F.G) >> 3) & 15) + 32 * ((n) & 3))
#define HG_HEAD(n) ((F.vcu + ((n) >> 2) * F.G) & 7)
#define HG_PREFETCH(n) do { const int T0_ = HG_ROW0(n), h_ = HG_HEAD(n); const bf16* rp_ = PB + (size_t)(T0_ + (tid >> 4)) * NBH + h_ * 128 + 8 * (tid & 15); \
        pq = *(const GAS v4u*)rp_; pf = *(const GAS v4u*)(rp_ + 1024); pv = *(const GAS v4u*)(rp_ + 2048); pg = *(const GAS v4u*)(rp_ + 3072); } while (0)
    if (NIT > 0) HG_PREFETCH(0);
    f32x4 S[8]; v2u psb[8];
    float lb = 0.f;
#pragma unroll 1
    for (int n = 0; n < NIT; ++n) {
        const int item = F.vcu + (n >> 2) * F.G, b = item >> 7, cc = (item >> 3) & 15, h = item & 7, fc = n & 3;
        const int T0 = b * SEQ + 128 * cc + 32 * fc;
        const v4u vv = pv, gv = pg;
        *(LAS v4u*)(RQ + (tid >> 4) * KP + 16 * (tid & 15)) = pq; *(LAS v4u*)(RF + (tid >> 4) * KP + 16 * (tid & 15)) = pf;
        if (n + 1 < NIT) HG_PREFETCH(n + 1);
        if (fc == 0) {
            lb = hg_lb(F, h * 128 + kcol);
            if (n == 0) { const bf16* sb = SB + ((((size_t)b * 16 + cc) * 8 + h) * 128 + 16 * wave + fr) * 128 + 4 * q4;
#pragma unroll
                for (int kt = 0; kt < 8; ++kt) psb[kt] = *(const GAS v2u*)(sb + 16 * kt); }
#pragma unroll
            for (int kt = 0; kt < 8; ++kt) { const v2u u = psb[kt]; S[kt][0] = bflo(u.x); S[kt][1] = bfhi(u.x); S[kt][2] = bflo(u.y); S[kt][3] = bfhi(u.y); } }
        if (fc == 3 && n + 1 < NIT) { const int it2 = F.vcu + ((n + 1) >> 2) * F.G; const bf16* sb = SB + ((((size_t)(it2 >> 7) * 16 + ((it2 >> 3) & 15)) * 8 + (it2 & 7)) * 128 + 16 * wave + fr) * 128 + 4 * q4;
#pragma unroll
            for (int kt = 0; kt < 8; ++kt) psb[kt] = *(const GAS v2u*)(sb + 16 * kt); }
        asm volatile("s_waitcnt lgkmcnt(0)" ::: "memory"); __builtin_amdgcn_s_barrier(); asm volatile("" ::: "memory");
        float cl[8], kk[8], qs[8];
        { float a = 0.f;
#pragma unroll
          for (int j = 0; j < 8; ++j) { const float sg = sigmoidf_(bf2f(*(const LAS unsigned short*)(RF + (8 * seg + j) * KP + 2 * kcol)));
              a += __logf(lb + (1.f - lb) * sg); cl[j] = a; kk[j] = (1.f - lb) * (1.f - sg); qs[j] = siluf_(bf2f(*(const LAS unsigned short*)(RQ + (8 * seg + j) * KP + 2 * kcol))); }
          CSEG[seg * 128 + kcol] = a; }
        { const int s = tid >> 4, oc = tid & 15; const unsigned ww[4] = {vv.x, vv.y, vv.z, vv.w};
#pragma unroll
          for (int e = 0; e < 4; ++e) { *(LAS unsigned short*)(VT + (8 * oc + 2 * e) * SP + 2 * s) = (unsigned short)(ww[e] & 0xffffu); *(LAS unsigned short*)(VT + (8 * oc + 2 * e + 1) * SP + 2 * s) = (unsigned short)(ww[e] >> 16); } }
        asm volatile("s_waitcnt lgkmcnt(0)" ::: "memory"); __builtin_amdgcn_s_barrier(); asm volatile("" ::: "memory");
        { const float t0 = CSEG[kcol], t1 = CSEG[128 + kcol], t2 = CSEG[256 + kcol], t3 = CSEG[384 + kcol];
          const float off = seg == 0 ? 0.f : (seg == 1 ? t0 : (seg == 2 ? t0 + t1 : t0 + t1 + t2)), c15 = t0 + t1, last = (t0 + t1) + (t2 + t3);
          const float el = __expf(last), ec15 = __expf(c15), el15 = __expf(last - c15);
          if (seg == 0) EL[kcol] = el;
#pragma unroll
          for (int j = 0; j < 8; ++j) { const int t = 8 * seg + j; const float cum = off + cl[j];
              const float e = __expf(seg >= 2 ? cum - c15 : cum), ri = __builtin_amdgcn_rcpf(fmaxf(e, 1.8e-35f)), kr = kk[j] * ri;
              if (seg >= 2) { *(LAS unsigned short*)(Q1 + (t - 16) * KP + 2 * kcol) = (unsigned short)f2bf(qs[j] * e); *(LAS unsigned short*)(QH + t * KP + 2 * kcol) = (unsigned short)f2bf(qs[j] * e * ec15);
                  *(LAS unsigned short*)(KB + t * KP + 2 * kcol) = (unsigned short)f2bf(kr); *(LAS unsigned short*)(KHT + kcol * SP + 2 * t) = (unsigned short)f2bf(kr * el15); }
              else { *(LAS unsigned short*)(QH + t * KP + 2 * kcol) = (unsigned short)f2bf(qs[j] * e); *(LAS unsigned short*)(KA + t * KP + 2 * kcol) = (unsigned short)f2bf(kr);
                  *(LAS unsigned short*)(KB + t * KP + 2 * kcol) = (unsigned short)f2bf(kr * ec15); *(LAS unsigned short*)(KHT + kcol * SP + 2 * t) = (unsigned short)f2bf(kr * el); } } }
        asm volatile("s_waitcnt lgkmcnt(0)" ::: "memory"); __builtin_amdgcn_s_barrier(); asm volatile("" ::: "memory");
        f32x4 at00 = {0.f, 0.f, 0.f, 0.f}, at01 = at00, at11 = at00;
#pragma unroll
        for (int ks = 0; ks < 4; ++ks) { const int kb = 64 * ks + 16 * q4;
            const bf16x8 ka = *(const LAS bf16x8*)(KA + fr * KP + kb), kb0 = *(const LAS bf16x8*)(KB + fr * KP + kb), kb1 = *(const LAS bf16x8*)(KB + (16 + fr) * KP + kb);
            const bf16x8 qh = *(const LAS bf16x8*)(QH + fr * KP + kb), q1 = *(const LAS bf16x8*)(Q1 + fr * KP + kb);
            at00 = __builtin_amdgcn_mfma_f32_16x16x32_bf16(ka, qh, at00, 0, 0, 0);
            at01 = __builtin_amdgcn_mfma_f32_16x16x32_bf16(kb0, q1, at01, 0, 0, 0);
            at11 = __builtin_amdgcn_mfma_f32_16x16x32_bf16(kb1, q1, at11, 0, 0, 0); }
#pragma unroll
        for (int e = 0; e < 4; ++e) { const bool keep = (4 * q4 + e) <= fr; at00[e] = keep ? at00[e] : 0.f; at11[e] = keep ? at11[e] : 0.f; }
        v4u pa0, pa1;
        pa0.x = pk2(at00[0], at00[1]); pa0.y = pk2(at00[2], at00[3]); pa0.z = 0u; pa0.w = 0u;
        pa1.x = pk2(at01[0], at01[1]); pa1.y = pk2(at01[2], at01[3]); pa1.z = pk2(at11[0], at11[1]); pa1.w = pk2(at11[2], at11[3]);
        f32x4 o0 = {0.f, 0.f, 0.f, 0.f}, o1 = o0;
        { const LAS unsigned char* vrow = VT + (16 * wave + fr) * SP; const v2u lo = *(const LAS v2u*)(vrow + 8 * q4), hi = *(const LAS v2u*)(vrow + 32 + 8 * q4);
          v4u bv; bv.x = lo.x; bv.y = lo.y; bv.z = hi.x; bv.w = hi.y;
          o0 = __builtin_amdgcn_mfma_f32_16x16x32_bf16(__builtin_bit_cast(bf16x8, pa0), __builtin_bit_cast(bf16x8, bv), o0, 0, 0, 0);
          o1 = __builtin_amdgcn_mfma_f32_16x16x32_bf16(__builtin_bit_cast(bf16x8, pa1), __builtin_bit_cast(bf16x8, bv), o1, 0, 0, 0); }
#pragma unroll
        for (int ks = 0; ks < 4; ++ks) { v4u bs; bs.x = pk2(S[2 * ks][0], S[2 * ks][1]); bs.y = pk2(S[2 * ks][2], S[2 * ks][3]); bs.z = pk2(S[2 * ks + 1][0], S[2 * ks + 1][1]); bs.w = pk2(S[2 * ks + 1][2], S[2 * ks + 1][3]);
            const int kb = 64 * ks + 8 * q4;
            const v2u a0l = *(const LAS v2u*)(QH + fr * KP + kb), a0h = *(const LAS v2u*)(QH + fr * KP + kb + 32), a1l = *(const LAS v2u*)(QH + (16 + fr) * KP + kb), a1h = *(const LAS v2u*)(QH + (16 + fr) * KP + kb + 32);
            v4u a0; a0.x = a0l.x; a0.y = a0l.y; a0.z = a0h.x; a0.w = a0h.y; v4u a1; a1.x = a1l.x; a1.y = a1l.y; a1.z = a1h.x; a1.w = a1h.y;
            o0 = __builtin_amdgcn_mfma_f32_16x16x32_bf16(__builtin_bit_cast(bf16x8, a0), __builtin_bit_cast(bf16x8, bs), o0, 0, 0, 0);
            o1 = __builtin_amdgcn_mfma_f32_16x16x32_bf16(__builtin_bit_cast(bf16x8, a1), __builtin_bit_cast(bf16x8, bs), o1, 0, 0, 0); }
#pragma unroll
        for (int e = 0; e < 4; ++e) { const int t0r = 4 * q4 + e; *(LAS float*)(OF + t0r * OP + 4 * (16 * wave + fr)) = o0[e]; *(LAS float*)(OF + (16 + t0r) * OP + 4 * (16 * wave + fr)) = o1[e];
            const float s0 = row16_sum(o0[e] * o0[e]), s1 = row16_sum(o1[e] * o1[e]);
            if (fr == 0) { SSQ[wave * 32 + t0r] = s0; SSQ[wave * 32 + 16 + t0r] = s1; } }
        { const bf16x8 bv = *(const LAS bf16x8*)(VT + (16 * wave + fr) * SP + 16 * q4);
#pragma unroll
          for (int kt = 0; kt < 8; ++kt) { const f32x4 el = *(const LAS f32x4*)(EL + 16 * kt + 4 * q4); const bf16x8 ak = *(const LAS bf16x8*)(KHT + (16 * kt + fr) * SP + 16 * q4);
              S[kt] = __builtin_amdgcn_mfma_f32_16x16x32_bf16(ak, bv, S[kt] * el, 0, 0, 0); } }
        asm volatile("s_waitcnt lgkmcnt(0)" ::: "memory"); __builtin_amdgcn_s_barrier(); asm volatile("" ::: "memory");
        { const int t = tid >> 4, v8 = (tid & 15) * 8; float tot = 0.f;
#pragma unroll
          for (int w = 0; w < 8; ++w) tot += SSQ[w * 32 + t];
          const float rs = rsqrtf(tot * (1.f / 128.f) + EPS);
          const f32x4 oa = *(const LAS f32x4*)(OF + t * OP + 4 * v8), ob = *(const LAS f32x4*)(OF + t * OP + 4 * v8 + 16);
          const f32x4 wa = *(const GAS f32x4*)(F.a->in[I_HGNW] + v8), wb = *(const GAS f32x4*)(F.a->in[I_HGNW] + v8 + 4);
          v4u o; o.x = pk2(oa.x * rs * wa.x * siluf_(bflo(gv.x)), oa.y * rs * wa.y * siluf_(bfhi(gv.x))); o.y = pk2(oa.z * rs * wa.z * siluf_(bflo(gv.y)), oa.w * rs * wa.w * siluf_(bfhi(gv.y)));
          o.z = pk2(ob.x * rs * wb.x * siluf_(bflo(gv.z)), ob.y * rs * wb.y * siluf_(bfhi(gv.z))); o.w = pk2(ob.z * rs * wb.z * siluf_(bflo(gv.w)), ob.w * rs * wb.w * siluf_(bfhi(gv.w)));
          *(GAS v4u*)((bf16*)(F.out + O_YP) + (size_t)(T0 + t) * 2048 + 1024 + h * 128 + v8) = o; }
    }
#undef HG_ROW0
#undef HG_HEAD
#undef HG_PREFETCH
    __syncthreads();
}

__device__ __forceinline__ void hg_sample_item(Frame& F, int j, int half) {
    const bf16* PB = (const bf16*)(F.ws + WS_BIG + B_PROJB) + (size_t)(MP + j) * NBH + 512 * half; bf16* MX = (bf16*)(F.ws + WS_MIXS) + (size_t)j * 2048 + 1024 + 512 * half;
    LAS float* fS = (LAS float*)F.lds;
    LAS float* kS = fS + 512; LAS float* qS = kS + 512; LAS float* vS = qS + 512; LAS float* oP = vS + 512;
    int tid = F.tid; asm volatile("" : "+v"(tid));
    { const int c = tid; const float lb = hg_lb(F, 512 * half + c), sg = sigmoidf_(bf2f(PB[1024 + c]));
      fS[c] = lb + (1.f - lb) * sg; kS[c] = (1.f - lb) * (1.f - sg); qS[c] = siluf_(bf2f(PB[c])); vS[c] = bf2f(PB[2048 + c]); }
    __syncthreads();
    const int v4 = (tid & 31) * 4, krow = tid >> 5;
    const float* S0 = F.a->in[I_SHG] + (size_t)j * 131072 + (size_t)half * 65536; float* S1 = F.out + O_SHG + (size_t)j * 131072 + (size_t)half * 65536;
#pragma unroll 1
    for (int hl = 0; hl < 4; ++hl) { const f32x4 vv = *(const LAS f32x4*)(vS + hl * 128 + v4); f32x4 a = {0.f, 0.f, 0.f, 0.f};
        f32x4 sv[8];
#pragma unroll
        for (int kb = 0; kb < 8; ++kb) sv[kb] = *(const GAS f32x4*)(S0 + ((size_t)hl * 128 + krow + 16 * kb) * 128 + v4);
#pragma unroll
        for (int kb = 0; kb < 8; ++kb) { const int k = krow + 16 * kb; const f32x4 sn = sv[kb] * fS[hl * 128 + k] + vv * kS[hl * 128 + k];
            *(GAS f32x4*)(S1 + ((size_t)hl * 128 + k) * 128 + v4) = sn; a += sn * qS[hl * 128 + k]; }
        *(LAS f32x4*)(oP + krow * 512 + hl * 128 + v4) = a; }
    __syncthreads();
    { const int c = tid; float o = 0.f;
#pragma unroll
      for (int q = 0; q < 16; ++q) o += oP[q * 512 + c];
      float ss = wave_sum(o * o); if ((tid & 63) == 0) fS[tid >> 6] = ss;
      __syncthreads();
      const float tot = fS[(tid >> 7) * 2] + fS[(tid >> 7) * 2 + 1];
      const float rs = rsqrtf(tot * (1.f / 128.f) + EPS);
      MX[c] = (bf16)f2bf(o * rs * F.a->in[I_HGNW][c & 127] * siluf_(bf2f(PB[3072 + c]))); }
    __syncthreads();
}
__device__ __forceinline__ void hg_state_phase(Frame& F) {
    for (int it = F.vcu; it < 256; it += F.G) hg_state_item(F, it >> 5, (it >> 2) & 7, it & 3, it >> 1, it & 1);
}

__device__ __forceinline__ void s5_lambda(const Frame& F, int g, int n, float& abr, float& abi, float& cfr, float& cfi) {
    const float lr = F.a->in[I_LAMRE][g * 64 + n], li = F.a->in[I_LAMIM][g * 64 + n], step = expf(F.a->in[I_LOGSTEP][g]);
    const float mag = expf(lr * step); float sn, cs; sincosf(li * step, &sn, &cs);
    abr = mag * cs; abi = mag * sn;
    const float den = lr * lr + li * li, nr = abr - 1.0f;
    cfr = (nr * lr + abi * li) / den; cfi = (abi * lr - nr * li) / den;
}
__device__ __forceinline__ void s5_tables_item(Frame& F, int g) {
    LAS float* POW = (LAS float*)F.lds;
    LAS float* CC = POW + 17 * 128;
    LAS float* BB = CC + 16 * 128;
    LAS float* KS = BB + 64 * 32;
    const int tid = F.tid;
    bf16* KQ = (bf16*)((unsigned char*)(F.out + O_YP) + S5T_KQ) + (size_t)g * 256 * 384; bf16* PM = (bf16*)((unsigned char*)(F.out + O_YP) + S5T_PM) + (size_t)g * 128 * 256;
    if (tid < 64) { const int n = tid; float abr, abi, cfr, cfi; s5_lambda(F, g, n, abr, abi, cfr, cfi);
        float pr = 1.f, pi = 0.f;
        for (int t = 0; t <= 16; ++t) { POW[(t * 64 + n) * 2] = pr; POW[(t * 64 + n) * 2 + 1] = pi; const float nr = pr * abr - pi * abi, ni = pr * abi + pi * abr; pr = nr; pi = ni; }
        const float* br = F.a->in[I_BRE] + (size_t)(g * 64 + n) * 16; const float* bi = F.a->in[I_BIM] + (size_t)(g * 64 + n) * 16;
        float* gab = (float*)((unsigned char*)(F.out + O_YP) + S5T_AB) + (size_t)(g * 64 + n) * 2; float* gbb = (float*)((unsigned char*)(F.out + O_YP) + S5T_BB) + (size_t)(g * 64 + n) * 32;
        gab[0] = abr; gab[1] = abi;
        for (int c = 0; c < 16; ++c) { const float vr = cfr * br[c] - cfi * bi[c], vi = cfr * bi[c] + cfi * br[c]; BB[(n * 16 + c) * 2] = vr; BB[(n * 16 + c) * 2 + 1] = vi; gbb[2 * c] = vr; gbb[2 * c + 1] = vi; } }
    for (int e = tid; e < 1024; e += NTHR) { CC[e * 2] = F.a->in[I_CRE][(size_t)g * 1024 + e]; CC[e * 2 + 1] = F.a->in[I_CIM][(size_t)g * 1024 + e]; }
    __syncthreads();
    { const int cc = tid & 255, cp = cc >> 4, c = cc & 15, th = tid >> 8; float a[8];
#pragma unroll
      for (int i = 0; i < 8; ++i) a[i] = 0.f;
      for (int n = 0; n < 64; ++n) { const float cr = CC[(cp * 64 + n) * 2], ci = CC[(cp * 64 + n) * 2 + 1], br = BB[(n * 16 + c) * 2], bi = BB[(n * 16 + c) * 2 + 1];
          const float xr = cr * br - ci * bi, xi = cr * bi + ci * br;
#pragma unroll
          for (int i = 0; i < 8; ++i) { const int t = th + 2 * i; a[i] += xr * POW[(t * 64 + n) * 2] - xi * POW[(t * 64 + n) * 2 + 1]; } }
#pragma unroll
      for (int i = 0; i < 8; ++i) KS[(th + 2 * i) * 256 + cc] = a[i]; }
    __syncthreads();
    for (int e2 = tid; e2 < 256 * 192; e2 += NTHR) { const int row = e2 / 192, col0 = (e2 % 192) * 2, t = row >> 4, cp = row & 15; float v[2];
#pragma unroll
        for (int q = 0; q < 2; ++q) { const int col = col0 + q;
            if (col < 256) { const int s = col >> 4, c = col & 15; v[q] = s <= t ? KS[(t - s) * 256 + cp * 16 + c] : 0.f; }
            else { const int np = col - 256, n = np & 63; const float pr = POW[((t + 1) * 64 + n) * 2], pi = POW[((t + 1) * 64 + n) * 2 + 1], cr = CC[(cp * 64 + n) * 2], ci = CC[(cp * 64 + n) * 2 + 1];
                v[q] = np < 64 ? cr * pr - ci * pi : -(cr * pi + ci * pr); } }
        *(GAS unsigned*)(KQ + (size_t)row * 384 + col0) = pk2(v[0], v[1]); }
    for (int e2 = tid; e2 < 128 * 128; e2 += NTHR) { const int np = e2 >> 7, col0 = (e2 & 127) * 2, n = np & 63; float v[2];
#pragma unroll
        for (int q = 0; q < 2; ++q) { const int col = col0 + q, s = col >> 4, c = col & 15; const float pr = POW[((15 - s) * 64 + n) * 2], pi = POW[((15 - s) * 64 + n) * 2 + 1], br = BB[(n * 16 + c) * 2], bi = BB[(n * 16 + c) * 2 + 1];
            v[q] = np < 64 ? pr * br - pi * bi : pr * bi + pi * br; }
        *(GAS unsigned*)(PM + (size_t)np * 256 + col0) = pk2(v[0], v[1]); }
    __syncthreads();
}
__device__ __forceinline__ void s5_fused_item(Frame& F, int b, int g) {
    const bf16* HN = (const bf16*)(F.ws + WS_XN); const bf16* PM = (const bf16*)((unsigned char*)(F.out + O_YP) + S5T_PM) + (size_t)g * 128 * 256; const bf16* KQ = (const bf16*)((unsigned char*)(F.out + O_YP) + S5T_KQ) + (size_t)g * 256 * 384;
    bf16* GY = (bf16*)(F.ws + WS_BIG + B_GY);
    constexpr int UP_ = 528, PP = 132, XPP = 272, KQP = 784;
    LAS unsigned char* UL = F.lds;
    LAS unsigned char* XL = UL;
    LAS unsigned char* BL = UL + 128 * XPP;
    LAS float* PL = (LAS float*)BL;
    LAS float* SE = (LAS float*)(BL + 128 * UP_);
    static_assert(64 * UP_ <= 128 * XPP && 128 * PP * 4 <= 128 * UP_ && 64 * KQP <= 128 * UP_ && 128 * XPP + 128 * UP_ + 4096 <= RING_BYTES, "s5 LDS map");
    int tid = F.tid; asm volatile("" : "+v"(tid));
    const int lane = tid & 63, wave = __builtin_amdgcn_readfirstlane(tid >> 6), r = lane & 31, hh = lane >> 5, mt = wave >> 1, ch = wave & 1;
    for (int e = tid; e < 128 * 32; e += NTHR) { const int row = e >> 5, c16 = e & 31; *(LAS v4u*)(BL + row * UP_ + 16 * c16) = *(const GAS v4u*)(PM + (size_t)row * 256 + 8 * c16); }
    bf16x8 au[16];
#pragma unroll
    for (int half = 0; half < 2; ++half) {
        for (int e = tid; e < 64 * 32; e += NTHR) { const int tok = e >> 1, pc = e & 1, m = tok >> 4, s2 = tok & 15;
            *(LAS v4u*)(UL + m * UP_ + 32 * s2 + 16 * pc) = *(const GAS v4u*)(HN + (size_t)(b * SEQ + 1024 * half + tok) * D + 16 * g + 8 * pc); }
        __syncthreads();
        if ((mt >> 1) == half) {
#pragma unroll
            for (int s2 = 0; s2 < 16; ++s2) au[s2] = *(const LAS bf16x8*)(UL + (32 * (mt & 1) + r) * UP_ + 32 * s2 + 16 * hh); }
        __syncthreads();
    }
    { f32x16 acc[2];
#pragma unroll
      for (int nt = 0; nt < 2; ++nt)
#pragma unroll
          for (int i = 0; i < 16; ++i) acc[nt][i] = 0.f;
#pragma unroll
      for (int s2 = 0; s2 < 16; ++s2)
#pragma unroll
          for (int nt = 0; nt < 2; ++nt) { const bf16x8 bb = *(const LAS bf16x8*)(BL + (64 * ch + 32 * nt + r) * UP_ + 32 * s2 + 16 * hh); acc[nt] = __builtin_amdgcn_mfma_f32_32x32x16_bf16(au[s2], bb, acc[nt], 0, 0, 0); }
      __syncthreads();
#pragma unroll
      for (int nt = 0; nt < 2; ++nt)
#pragma unroll
          for (int i = 0; i < 16; ++i) PL[(32 * mt + (i & 3) + 8 * (i >> 2) + 4 * hh) * PP + 64 * ch + 32 * nt + r] = acc[nt][i]; }
    __syncthreads();
    { const int n = lane, seg = wave; float abr, abi, cfr, cfi; s5_lambda(F, g, n, abr, abi, cfr, cfi);
#pragma unroll
      for (int q = 0; q < 4; ++q) { const float nr = abr * abr - abi * abi, ni = 2.f * abr * abi; abr = nr; abi = ni; }
      float yr[16], yi[16];
      { float xr = 0.f, xi = 0.f;
#pragma unroll
        for (int i = 0; i < 16; ++i) { const float pr = PL[(16 * seg + i) * PP + n], pi = PL[(16 * seg + i) * PP + 64 + n]; const float nr = abr * xr - abi * xi + pr, ni = abr * xi + abi * xr + pi; xr = nr; xi = ni; yr[i] = xr; yi[i] = xi; }
        SE[seg * 128 + n] = xr; SE[seg * 128 + 64 + n] = xi; }
      float a16r = abr, a16i = abi;
#pragma unroll
      for (int q = 0; q < 4; ++q) { const float nr = a16r * a16r - a16i * a16i, ni = 2.f * a16r * a16i; a16r = nr; a16i = ni; }
      __syncthreads();
      float cr = 0.f, ci = 0.f;
      for (int s2 = 0; s2 < seg; ++s2) { const float er = SE[s2 * 128 + n], ei = SE[s2 * 128 + 64 + n]; const float nr = a16r * cr - a16i * ci + er, ni = a16r * ci + a16i * cr + ei; cr = nr; ci = ni; }
      float pwr = 1.f, pwi = 0.f;
#pragma unroll
      for (int i = 0; i < 16; ++i) { const float xr = (i == 0 ? 0.f : yr[i == 0 ? 0 : i - 1]) + pwr * cr - pwi * ci, xi = (i == 0 ? 0.f : yi[i == 0 ? 0 : i - 1]) + pwr * ci + pwi * cr;
          *(LAS unsigned short*)(XL + (16 * seg + i) * XPP + 2 * n) = (unsigned short)f2bf(xr); *(LAS unsigned short*)(XL + (16 * seg + i) * XPP + 2 * (64 + n)) = (unsigned short)f2bf(xi);
          const float nr = pwr * abr - pwi * abi, ni = pwr * abi + pwi * abr; pwr = nr; pwi = ni; }
      if (seg == 7) { const float xr = yr[15] + pwr * cr - pwi * ci, xi = yi[15] + pwr * ci + pwi * cr;
          F.out[O_PS5R + (size_t)(b * 64 + g) * 64 + n] = xr; F.out[O_PS5I + (size_t)(b * 64 + g) * 64 + n] = xi; } }
    __syncthreads();
    bf16x8 ax[8];
#pragma unroll
    for (int s2 = 0; s2 < 8; ++s2) ax[s2] = *(const LAS bf16x8*)(XL + (32 * mt + r) * XPP + 32 * s2 + 16 * hh);
    v4u kq[6];
#pragma unroll
    for (int q = 0; q < 6; ++q) { const int e = tid + NTHR * q, row = e / 48, c16 = e % 48; kq[q] = *(const GAS v4u*)(KQ + (size_t)row * 384 + 8 * c16); }
#pragma unroll 1
    for (int p = 0; p < 4; ++p) {
#pragma unroll
        for (int q = 0; q < 6; ++q) { const int e = tid + NTHR * q, row = e / 48, c16 = e % 48; *(LAS v4u*)(BL + row * KQP + 16 * c16) = kq[q]; }
        if (p < 3) {
#pragma unroll
            for (int q = 0; q < 6; ++q) { const int e = tid + NTHR * q, row = e / 48, c16 = e % 48; kq[q] = *(const GAS v4u*)(KQ + (size_t)(64 * (p + 1) + row) * 384 + 8 * c16); } }
        v4u uq[2];
#pragma unroll
        for (int q = 0; q < 2; ++q) { const int e = tid + NTHR * q, m = e >> 3, tl = (e >> 1) & 3, hf = e & 1; uq[q] = *(const GAS v4u*)(HN + (size_t)(b * SEQ + 16 * m + 4 * p + tl) * D + 16 * g + 8 * hf); }
        __syncthreads();
        f32x16 acc;
#pragma unroll
        for (int i = 0; i < 16; ++i) acc[i] = 0.f;
        const LAS unsigned char* brow = BL + (32 * ch + r) * KQP + 16 * hh;
#pragma unroll
        for (int s2 = 0; s2 < 16; ++s2) acc = __builtin_amdgcn_mfma_f32_32x32x16_bf16(au[s2], *(const LAS bf16x8*)(brow + 32 * s2), acc, 0, 0, 0);
#pragma unroll
        for (int s2 = 0; s2 < 8; ++s2) acc = __builtin_amdgcn_mfma_f32_32x32x16_bf16(ax[s2], *(const LAS bf16x8*)(brow + 512 + 32 * s2), acc, 0, 0, 0);
        { LAS float* OL = (LAS float*)XL;
#pragma unroll
          for (int i = 0; i < 16; ++i) OL[(32 * mt + (i & 3) + 8 * (i >> 2) + 4 * hh) * 68 + 32 * ch + r] = acc[i]; }
        __syncthreads();
#pragma unroll
        for (int q = 0; q < 2; ++q) { const int e = tid + NTHR * q, m = e >> 3, tl = (e >> 1) & 3, hf = e & 1; const LAS float* ol = (const LAS float*)XL + m * 68 + 16 * tl + 8 * hf;
            const f32x4 o0 = *(const LAS f32x4*)ol, o1 = *(const LAS f32x4*)(ol + 4);
            const size_t o = (size_t)(b * SEQ + 16 * m + 4 * p + tl) * D + 16 * g + 8 * hf;
            const v4u uu = uq[q]; const f32x4 d0 = *(const GAS f32x4*)(F.a->in[I_S5D] + 16 * g + 8 * hf), d1 = *(const GAS f32x4*)(F.a->in[I_S5D] + 16 * g + 8 * hf + 4);
            v4u w; w.x = pk2(gelu_tanh(o0.x + d0.x * bflo(uu.x)), gelu_tanh(o0.y + d0.y * bfhi(uu.x))); w.y = pk2(gelu_tanh(o0.z + d0.z * bflo(uu.y)), gelu_tanh(o0.w + d0.w * bfhi(uu.y)));
            w.z = pk2(gelu_tanh(o1.x + d1.x * bflo(uu.z)), gelu_tanh(o1.y + d1.y * bfhi(uu.z))); w.w = pk2(gelu_tanh(o1.z + d1.z * bflo(uu.w)), gelu_tanh(o1.w + d1.w * bfhi(uu.w)));
            *(GAS v4u*)(GY + o) = w; }
        __syncthreads();
    }
}
__device__ __forceinline__ void s5_fused_phase(Frame& F) {
    for (int it = F.vcu; it < 8 * 64; it += F.G) s5_fused_item(F, it >> 6, it & 63);
}
__device__ __forceinline__ void s5_sample(Frame& F) {
    const bf16* HN = (const bf16*)(F.ws + WS_XN) + (size_t)MP * D; bf16* GY = (bf16*)(F.ws + WS_BIG + B_GY) + (size_t)MP * D;
    const float* TAB = (const float*)((unsigned char*)(F.out + O_YP) + S5T_AB); const float* TBB = (const float*)((unsigned char*)(F.out + O_YP) + S5T_BB);
    const int n = F.lane;
    for (int task = GW_ID(F); task < MS * 64; task += GW_N(F)) { const int j = task >> 6, g = task & 63;
        const f32x2_t ab = *(const GAS f32x2_t*)(TAB + (size_t)(g * 64 + n) * 2);
        f32x4 bb[8];
#pragma unroll
        for (int q = 0; q < 8; ++q) bb[q] = *(const GAS f32x4*)(TBB + (size_t)(g * 64 + n) * 32 + 4 * q);
        const v4u u0 = *(const GAS v4u*)(HN + (size_t)j * D + 16 * g), u1 = *(const GAS v4u*)(HN + (size_t)j * D + 16 * g + 8);
        const size_t si = ((size_t)j * 64 + g) * 64 + n; const float sr = F.a->in[I_SS5R][si], sim = F.a->in[I_SS5I][si];
        float cr[16], ci[16];
#pragma unroll
        for (int cp = 0; cp < 16; ++cp) { cr[cp] = F.a->in[I_CRE][((size_t)g * 16 + cp) * 64 + n]; ci[cp] = F.a->in[I_CIM][((size_t)g * 16 + cp) * 64 + n]; }
        const float dsk = F.a->in[I_S5D][16 * g + (n & 15)];
        float u[16]; u[0] = bflo(u0.x); u[1] = bfhi(u0.x); u[2] = bflo(u0.y); u[3] = bfhi(u0.y); u[4] = bflo(u0.z); u[5] = bfhi(u0.z); u[6] = bflo(u0.w); u[7] = bfhi(u0.w);
        u[8] = bflo(u1.x); u[9] = bfhi(u1.x); u[10] = bflo(u1.y); u[11] = bfhi(u1.y); u[12] = bflo(u1.z); u[13] = bfhi(u1.z); u[14] = bflo(u1.w); u[15] = bfhi(u1.w);
        float bur = 0.f, bui = 0.f;
#pragma unroll
        for (int q = 0; q < 8; ++q) { bur += bb[q].x * u[2 * q] + bb[q].z * u[2 * q + 1]; bui += bb[q].y * u[2 * q] + bb[q].w * u[2 * q + 1]; }
        const float xr = ab.x * sr - ab.y * sim + bur, xi = ab.x * sim + ab.y * sr + bui;
        F.out[O_SS5R + si] = xr; F.out[O_SS5I + si] = xi;
        float ymine = 0.f, uu = 0.f;
#pragma unroll
        for (int cp = 0; cp < 16; ++cp) { const float tot = wave_sum(cr[cp] * xr - ci[cp] * xi); ymine = (n == cp) ? tot : ymine; uu = (n == cp) ? u[cp] : uu; }
        if (n < 16) GY[(size_t)j * D + 16 * g + n] = (bf16)f2bf(gelu_tanh(ymine + dsk * uu));
    }
}

constexpr int CW_BAR = 4096;

struct SkAny { int mode; void* O; int ld;
    __device__ __forceinline__ void operator()(int row, int col, const float (&v)[1]) const { if (mode == 0) ((bf16*)O)[(size_t)row * ld + col] = (bf16)f2bf(v[0]); else ((float*)O)[(size_t)row * ld + col] = v[0]; } };

__global__ void __launch_bounds__(NTHR, 2) fwd_kernel(Args args) {
    extern __shared__ __attribute__((aligned(16))) unsigned char lds[];
    Frame F;
    F.lds = (LAS unsigned char*)lds;
    F.tid = threadIdx.x;
    F.out = args.out; F.ws = args.ws;
    volatile LAS unsigned* MISC = (volatile LAS unsigned*)(F.lds + MISC_OFF);
    for (int u = F.tid; u < (LDS_BYTES - LDSCTL_OFF) / 4; u += NTHR) ((LAS unsigned*)(F.lds + LDSCTL_OFF))[u] = 0u;
    __syncthreads();
    const int lo = args.ph_lo, hi = args.ph_hi;
    if (hi - lo > 1) (void)xcd_barrier_post((unsigned*)(args.ws + WS_CTL) + CW_BAR + args.li * XCD_BAR_WORDS, MISC + 8);
#pragma unroll 1
    for (int ph = lo; ph < hi; ++ph) {
        { int t_ = threadIdx.x; asm volatile("" : "+v"(t_)); F.tid = t_; F.lane = t_ & 63; F.wave = __builtin_amdgcn_readfirstlane(t_ >> 6); }
        { int g_ = gridDim.x, b_ = blockIdx.x; asm volatile("" : "+s"(g_), "+s"(b_)); F.G = g_; F.vcu = (g_ % 8 == 0) ? (b_ % 8) * (g_ / 8) + b_ / 8 : b_; }
        { const CAS Args* ap_ = (const CAS Args*)__builtin_amdgcn_kernarg_segment_ptr(); asm volatile("" : "+s"(ap_)); F.a = ap_; }
        { float* o_ = args.out; unsigned char* w_ = args.ws; asm volatile("" : "+s"(o_), "+s"(w_)); F.out = o_; F.ws = w_; }
        unsigned char* BIG = F.ws + WS_BIG; bf16* XN = (bf16*)(F.ws + WS_XN); bf16* WIN = (bf16*)(F.ws + WS_WIN);
        const bf16* gA = nullptr; const bf16* gAs = nullptr; const bf16* gB = nullptr; int gN = 0, gK = 0, gmode = 0, gld = 0; void* gO = nullptr; void* gOs = nullptr;
        int l = 0, fixl = -1;
        switch (ph) {
            case 0: p0_prologue(F); break;
            case 1: gA = XN; gAs = XN + (size_t)MP * D; gB = WIN; gN = NA; gK = D; gmode = 0; gld = NA; gO = BIG + B_PROJA; gOs = (bf16*)gO + (size_t)MP * NA; break;
            case 2: ssd_state_phase(F); break;
            case 3: ssd_out_phase(F); break;
            case 4: gA = XN; gAs = XN + (size_t)MP * D; gB = WIN + (size_t)NA * D; gN = NBH; gK = D; gmode = 0; gld = NBH; gO = BIG + B_PROJB; gOs = (bf16*)gO + (size_t)MP * NBH; break;
            case 5: hg_state_phase(F); break;
            case 6: hg_out_phase(F); break;
            case 7: gA = (const bf16*)(F.out + O_YP); gAs = (const bf16*)(F.ws + WS_MIXS); gB = (const bf16*)(F.ws + WS_WOUT); gN = D; gK = 2048; gmode = 0; gld = D; gO = BIG + B_M1; gOs = (bf16*)gO + (size_t)MP * D; break;
            case 8: resid_norm_rows(F, (const bf16*)(BIG + B_M1), F.a->in[I_NMPOST], F.a->in[I_NFPRE], 0); break;
            case 15: l = 1; [[fallthrough]];
            case 9: gA = XN; gAs = XN + (size_t)MP * D; gB = (const bf16*)(F.ws + WS_WUP) + (size_t)l * FF2 * D; gN = FF2; gK = D; gmode = 3; gld = FF2; gO = BIG + B_ACT; gOs = BIG + B_ACT; break;
            case 16: l = 1; [[fallthrough]];
            case 10: gA = (const bf16*)(BIG + B_ACT); gAs = gA + (size_t)MP * FF; gB = (const bf16*)(F.ws + WS_WDN) + (size_t)l * D * FF; gN = D; gK = FF; gmode = 0; gld = D; gO = BIG + B_M1; gOs = (bf16*)gO + (size_t)MP * D; fixl = l; break;
            case 11: resid_norm_rows(F, (const bf16*)(BIG + B_M1), F.a->in[I_NFPOST], F.a->in[I_NMPRE] + D, 1); break;
            case 12: s5_fused_phase(F); s5_sample(F); break;
            case 13: gA = (const bf16*)(BIG + B_GY); gAs = gA + (size_t)MP * D; gB = (const bf16*)(F.ws + WS_WGLU); gN = 2048; gK = D; gmode = 2; gld = D; gO = BIG + B_M1G; gOs = (bf16*)gO + (size_t)MP * D; break;
            case 14: resid_norm_rows(F, (const bf16*)(BIG + B_M1G), F.a->in[I_NMPOST] + D, F.a->in[I_NFPRE] + D, 1); break;
            case 17: resid_norm_rows(F, (const bf16*)(BIG + B_M1), F.a->in[I_NFPOST] + D, nullptr, 2); break;
            default: break;
        }
        if (gA) {
            pg8::Gemm g{gA, gB, MP, gN, gK}; pg8::StaticOrder S; S.init(MP, gN, F.G, (int)blockIdx.x);
            if (fixl >= 0) { pg8::Unit u0; for (int i = 0; S.next(i, u0); ++i) ffn_fix_rows(F, fixl, u0.pm);
                asm volatile("s_waitcnt vmcnt(0)" ::: "memory"); __syncthreads(); }
            pg8::EpiConvGate cg{(pg8::bf16_t*)(BIG + B_ACT), F.a->in[I_FCW] + (size_t)l * 3 * FF2, F.a->in[I_FCB] + (size_t)l * FF2, (float*)(BIG + B_HEAD), (float*)(BIG + B_TAIL), (PG8_LAS float*)(F.lds + HALO_OFF), F.out + O_PFC + (size_t)l * 8 * 2 * FF2};
            pg8::gemm_phase<pg8::EpiAny, pg8::StaticOrder, true, true>(F.lds, g, S, pg8::EpiAny{gmode, gmode == 0 || gmode == 3, gO, gld, cg}, F.tid);
            __syncthreads();
            const int nrem = ((MP / 256) * (gN / 256)) % F.G, tb = nrem ? (int)blockIdx.x - nrem : (int)blockIdx.x, tstr = nrem ? F.G - nrem : F.G;
            if (gmode == 2) skinny_gemm<2, true>(F, gAs, gK, gB, gK, D / 32, SkGlu{(bf16*)gOs, gld}, tb, tstr);
            else if (gmode == 3) { if (l == 0 && tb >= 0) { __syncthreads(); for (int g2 = tb; g2 < 64; g2 += tstr) s5_tables_item(F, g2); }
              skinny_gemm<2, true>(F, gAs, gK, gB, gK, FF / 32, SkConvGate{(bf16*)(BIG + B_ACT) + (size_t)MP * FF, F.a->in[I_FCW] + (size_t)l * 3 * FF2, F.a->in[I_FCB] + (size_t)l * FF2, F.a->in[I_SFC] + (size_t)l * MS * 2 * FF2, F.out + O_SFC + (size_t)l * MS * 2 * FF2}, tb, tstr); }
            else skinny_gemm<1, false>(F, gAs, gK, gB, gK, gN / 32, SkAny{gmode, gOs, gld}, tb, tstr);
        }
        if (ph + 1 < hi) { XcdBarrier b2; b2.bar = (unsigned*)(F.ws + WS_CTL) + CW_BAR + F.a->li * XCD_BAR_WORDS; b2.x = xb_xcc_id(); b2.st = (volatile LAS unsigned*)(F.lds + MISC_OFF) + 8; xcd_barrier(b2); }
    }
}

extern "C" void kernel_launch(void* const* d_in, const int* in_sizes, int n_in, void* d_out, int out_size, void* d_ws, size_t ws_size, hipStream_t stream) {
    static int grid = 0;
    if (grid == 0) {
        if (n_in != N_IN || out_size != (int)O_END || ws_size < WS_END) { fprintf(stderr, "kernel_launch: unexpected shapes (n_in %d, out %d, ws %zu)\n", n_in, out_size, ws_size); grid = -1; return; }
        int dev = 0, cus = 0, per_cu = 0;
        if (hipGetDevice(&dev) != hipSuccess || hipDeviceGetAttribute(&cus, hipDeviceAttributeMultiprocessorCount, dev) != hipSuccess) { grid = -1; return; }
        if (hipFuncSetAttribute((const void*)fwd_kernel, hipFuncAttributeMaxDynamicSharedMemorySize, LDS_BYTES) != hipSuccess) { fprintf(stderr, "kernel_launch: hipFuncSetAttribute failed\n"); grid = -1; return; }
        if (hipOccupancyMaxActiveBlocksPerMultiprocessor(&per_cu, (const void*)fwd_kernel, NTHR, LDS_BYTES) != hipSuccess || per_cu < 1) fprintf(stderr, "kernel_launch: occupancy query says %d\n", per_cu);
        (void)hipGetLastError();
        if (per_cu < 1) { fprintf(stderr, "kernel_launch: the kernel does not fit a CU\n"); grid = -1; return; }
        grid = cus;
    }
    if (grid < 0) return;
    (void)hipMemsetAsync((char*)d_ws + WS_CTL, 0, CTL_BYTES, stream);
    Args a{};
    for (int i = 0; i < 35; ++i) a.in[i] = (const float*)d_in[i];
    a.out = (float*)d_out; a.ws = (unsigned char*)d_ws;
#if PROBE_PH >= 0
    a.ph_lo = 0; a.ph_hi = PROBE_PH + 1; a.li = 0; hipLaunchKernelGGL(fwd_kernel, dim3(grid), dim3(NTHR), LDS_BYTES, stream, a);
    for (int rep = 0; rep < PROBE_REPS; ++rep) { a.ph_lo = PROBE_PH; a.ph_hi = PROBE_PH + 1; a.li = 1; hipLaunchKernelGGL(fwd_kernel, dim3(grid), dim3(NTHR), LDS_BYTES, stream, a); }
    if (PROBE_PH + 1 < NPH) { a.ph_lo = PROBE_PH + 1; a.ph_hi = NPH; a.li = 2; hipLaunchKernelGGL(fwd_kernel, dim3(grid), dim3(NTHR), LDS_BYTES, stream, a); }
#elif MK_ONE_LAUNCH
    a.ph_lo = 0; a.ph_hi = NPH; a.li = 0;
    { void* kargs[] = {&a};
      if (hipLaunchCooperativeKernel((const void*)fwd_kernel, dim3(grid), dim3(NTHR), kargs, LDS_BYTES, stream) != hipSuccess) { (void)hipGetLastError(); fprintf(stderr, "kernel_launch: cooperative launch refused\n"); } }
#else
    for (int p = 0; p < NPH; ++p) { a.ph_lo = p; a.ph_hi = p + 1; a.li = 0; hipLaunchKernelGGL(fwd_kernel, dim3(grid), dim3(NTHR), LDS_BYTES, stream, a); }
#endif
}
```

```cpp
#include <hip/hip_runtime.h>
#include <cstdio>
#include <cstdint>

#ifndef PROBE_T
#define PROBE_T -1
#endif
#ifndef PROBE_E
#define PROBE_E 0
#endif
#ifndef PROBE_EB
#define PROBE_EB 0
#endif
#ifndef PROBE_SEG
#define PROBE_SEG 1
#endif
#if PROBE_E == 1
#define PSEG_B(seg, ldsb) do { if (PROBE_SEG == (seg) && blockIdx.x == PROBE_EB && threadIdx.x == 0) { volatile __attribute__((address_space(3))) unsigned long long* ST_ = (volatile __attribute__((address_space(3))) unsigned long long*)((ldsb) + 131072 + 320 + 64); ST_[4] = __builtin_amdgcn_s_memrealtime(); } } while (0)
#define PSEG_E(seg, ldsb) do { if (PROBE_SEG == (seg) && blockIdx.x == PROBE_EB && threadIdx.x == 0) { volatile __attribute__((address_space(3))) unsigned long long* ST_ = (volatile __attribute__((address_space(3))) unsigned long long*)((ldsb) + 131072 + 320 + 64); if (ST_[3]) ST_[2] += __builtin_amdgcn_s_memrealtime() - ST_[4]; } } while (0)
#else
#define PSEG_B(seg, ldsb) do {} while (0)
#define PSEG_E(seg, ldsb) do {} while (0)
#endif
#ifndef PROBE_PH
#define PROBE_PH -1
#endif
#ifndef PROBE_REPS
#define PROBE_REPS 1
#endif
#ifndef MK_ONE_LAUNCH
#define MK_ONE_LAUNCH 1
#endif

__device__ __forceinline__ float dpp_add_(float v, const int ctrl_sel) {
    const int b = __builtin_bit_cast(int, v); int r;
    if (ctrl_sel == 0) r = __builtin_amdgcn_update_dpp(0, b, 0xB1, 0xf, 0xf, true); else if (ctrl_sel == 1) r = __builtin_amdgcn_update_dpp(0, b, 0x4E, 0xf, 0xf, true);
    else if (ctrl_sel == 2) r = __builtin_amdgcn_update_dpp(0, b, 0x141, 0xf, 0xf, true); else r = __builtin_amdgcn_update_dpp(0, b, 0x140, 0xf, 0xf, true);
    return v + __builtin_bit_cast(float, r); }
__device__ __forceinline__ float row16_sum(float v) { v = dpp_add_(v, 0); v = dpp_add_(v, 1); v = dpp_add_(v, 2); v = dpp_add_(v, 3); return v; }
__device__ __forceinline__ float wave_sum(float v) {
    v = row16_sum(v);
    v += __builtin_bit_cast(float, __builtin_amdgcn_update_dpp(0, __builtin_bit_cast(int, v), 0x142, 0xa, 0xf, false));
    v += __builtin_bit_cast(float, __builtin_amdgcn_update_dpp(0, __builtin_bit_cast(int, v), 0x143, 0xc, 0xf, false));
    return __builtin_bit_cast(float, __builtin_amdgcn_readlane(__builtin_bit_cast(int, v), 63)); }
__device__ __forceinline__ int lane_op_() { int l = __builtin_amdgcn_mbcnt_hi(-1, __builtin_amdgcn_mbcnt_lo(-1, 0)); asm volatile("" : "+v"(l)); return l; }
__device__ __forceinline__ float shx_(float v, int o, int l) { return __builtin_bit_cast(float, __builtin_amdgcn_ds_bpermute((l ^ o) << 2, __builtin_bit_cast(int, v))); }
__device__ __forceinline__ float shup_(float v, int off, int width, int l) { const int src = ((l & (width - 1)) >= off) ? l - off : l; return __builtin_bit_cast(float, __builtin_amdgcn_ds_bpermute(src << 2, __builtin_bit_cast(int, v))); }
__device__ __forceinline__ float shidx_(float v, int src, int width, int l) { return __builtin_bit_cast(float, __builtin_amdgcn_ds_bpermute(((l & ~(width - 1)) + src) << 2, __builtin_bit_cast(int, v))); }
namespace pg8 {
#define PG8_LAS __attribute__((address_space(3)))
typedef unsigned short bf16_t;
typedef short bf16x8 __attribute__((ext_vector_type(8)));
typedef float f32x4 __attribute__((ext_vector_type(4)));
typedef unsigned u32x4 __attribute__((ext_vector_type(4)));
typedef float f32x2 __attribute__((ext_vector_type(2)));
constexpr int BM = 256, BK = 64, HALF = 128, HTB = HALF * BK * 2  , STAGE_BYTES = 8 * HTB, NXCD = 8, WGM = 8;

__host__ __device__ __forceinline__ int lds_byte(int r, int c) { const int st = (r >> 4) * 2 + (c >> 5), rr = r & 15, cc = c & 31, ob = rr * 64 + cc * 2; return st * 1024 + (ob ^ (((ob >> 9) & 1) << 5)); }
__host__ __device__ __forceinline__ void stage_rc(int b, int& R, int& C) { const int st = b / 1024, sb = b % 1024, swz = sb ^ (((sb >> 9) & 1) << 5); R = (st >> 1) * 16 + swz / 64; C = (st & 1) * 32 + (swz % 64) / 2; }
__host__ __device__ __forceinline__ int perm32(int rho) { const int n = rho >> 4, i = rho & 15; return 8 * (i >> 2) + 4 * n + (i & 3); }

struct Unit { int pm, pn; };
struct Gemm { const bf16_t* A; const bf16_t* Bt; int M, N, K; };

struct StaticOrder {
    int nM, nN, nwg, G, c;
    __host__ __device__ void init(int M, int N, int G_, int c_) { nM = M / BM; nN = N / BM; nwg = nM * nN; G = G_; c = c_; }
    __host__ __device__ bool next(int i, Unit& u) const {
        const long L = (long)i * G + c; if (L >= nwg) return false;
        int wgid = (int)L; { const int q = nwg / NXCD, r = nwg % NXCD, xcd = wgid % NXCD, off = wgid / NXCD; wgid = (xcd < r ? xcd * (q + 1) : r * (q + 1) + (xcd - r) * q) + off; }
        const int nig = WGM * nN, gid = wgid / nig, fm = gid * WGM, gsz = (nM - fm) < WGM ? (nM - fm) : WGM;
        u.pm = fm + ((wgid % nig) % gsz); u.pn = (wgid % nig) / gsz; return true;
    }
    __device__ __forceinline__ void a_ready(const Unit&) const {}
    __device__ __forceinline__ void done(const Unit&) const {}
};

__device__ __forceinline__ unsigned cvt_pk_bf16(float lo, float hi) { unsigned r; asm volatile("v_cvt_pk_bf16_f32 %0, %1, %2" : "=v"(r) : "v"(lo), "v"(hi)); return r; }

struct EpiF32 {
    static constexpr bool PERM = false, AFTER_DRAIN = false;
    float* C; int ldc;
    __device__ __forceinline__ void operator()(const f32x4 (&acc)[2][2][4][2], const Unit& u, int wr, int wc, int fr, int fq) const {
        const int row0 = u.pm * BM + wr * 64 + fr, col0 = u.pn * BM + wc * 32 + 4 * fq;
#pragma unroll
        for (int ai = 0; ai < 2; ++ai)
#pragma unroll
            for (int m = 0; m < 4; ++m) { float* rowp = C + (size_t)(row0 + ai * HALF + m * 16) * ldc + col0;
#pragma unroll
                for (int bj = 0; bj < 2; ++bj)
#pragma unroll
                    for (int n = 0; n < 2; ++n) *(f32x4*)(rowp + bj * HALF + n * 16) = acc[ai][bj][m][n]; }
    }
};
struct EpiBf16 {
    static constexpr bool PERM = true, AFTER_DRAIN = false;
    bf16_t* O; int ldc;
    __device__ __forceinline__ void operator()(const f32x4 (&acc)[2][2][4][2], const Unit& u, int wr, int wc, int fr, int fq) const {
        const int row0 = u.pm * BM + wr * 64 + fr, col0 = u.pn * BM + wc * 32 + 8 * fq;
#pragma unroll
        for (int ai = 0; ai < 2; ++ai)
#pragma unroll
            for (int m = 0; m < 4; ++m) { bf16_t* rowp = O + (size_t)(row0 + ai * HALF + m * 16) * ldc + col0;
#pragma unroll
                for (int bj = 0; bj < 2; ++bj) { const f32x4 v0 = acc[ai][bj][m][0], v1 = acc[ai][bj][m][1];
                    u32x4 w; w.x = cvt_pk_bf16(v0[0], v0[1]); w.y = cvt_pk_bf16(v0[2], v0[3]); w.z = cvt_pk_bf16(v1[0], v1[1]); w.w = cvt_pk_bf16(v1[2], v1[3]);
                    *(u32x4*)(rowp + bj * HALF) = w; } }
    }
};
struct EpiGlu {
    static constexpr bool PERM = false, AFTER_DRAIN = false;
    bf16_t* C; int ldc;
    __device__ __forceinline__ void operator()(const f32x4 (&acc)[2][2][4][2], const Unit& u, int wr, int wc, int fr, int fq) const {
        const int row0 = u.pm * BM + wr * 64 + fr, col0 = u.pn * HALF + wc * 32 + 4 * fq;
        typedef unsigned u32x2g __attribute__((ext_vector_type(2)));
#pragma unroll
        for (int ai = 0; ai < 2; ++ai)
#pragma unroll
            for (int m = 0; m < 4; ++m) { bf16_t* rowp = C + (size_t)(row0 + ai * HALF + m * 16) * ldc + col0;
#pragma unroll
                for (int n = 0; n < 2; ++n) { const f32x4 v = acc[ai][0][m][n], g = acc[ai][1][m][n]; float o[4];
#pragma unroll
                    for (int j = 0; j < 4; ++j) o[j] = v[j] * __builtin_amdgcn_rcpf(1.0f + __expf(-g[j]));
                    u32x2g w; w.x = cvt_pk_bf16(o[0], o[1]); w.y = cvt_pk_bf16(o[2], o[3]); *(u32x2g*)(rowp + n * 16) = w; } }
    }
};


__device__ __forceinline__ float dpp_shr1(float old, float src) { return __builtin_bit_cast(float, __builtin_amdgcn_update_dpp(__builtin_bit_cast(int, old), __builtin_bit_cast(int, src), 0x111, 0xf, 0xf, false)); }
__device__ __forceinline__ float dpp_shr2(float old, float src) { return __builtin_bit_cast(float, __builtin_amdgcn_update_dpp(__builtin_bit_cast(int, old), __builtin_bit_cast(int, src), 0x112, 0xf, 0xf, false)); }
__device__ __forceinline__ float dpp_ror1(float src) { return __builtin_bit_cast(float, __builtin_amdgcn_update_dpp(0, __builtin_bit_cast(int, src), 0x121, 0xf, 0xf, false)); }
__device__ __forceinline__ float dpp_ror2(float src) { return __builtin_bit_cast(float, __builtin_amdgcn_update_dpp(0, __builtin_bit_cast(int, src), 0x122, 0xf, 0xf, false)); }
struct EpiConvGate {
    bf16_t* ACT; const float* cw; const float* cb; float* HEAD; float* TAIL; PG8_LAS float* HALO; float* PFC;
    __device__ __forceinline__ void operator()(const f32x4 (&acc)[2][2][4][2], const Unit& u, int wr, int wc, int fr, int fq) const {
        constexpr int FF_ = 2816, FF2_ = 5632;
        asm volatile("" : "+v"(fr), "+v"(fq));
        const int colt = wc * 32 + 8 * fq;
        if (fr >= 14) {
#pragma unroll
            for (int ai = 0; ai < 2; ++ai)
#pragma unroll
                for (int bj = 0; bj < 2; ++bj)
#pragma unroll
                    for (int n = 0; n < 2; ++n) { *(PG8_LAS f32x4*)(HALO + ((ai * 2 + wr) * 2 + (fr - 14)) * 256 + bj * 128 + colt + 4 * n) = acc[ai][bj][3][n];
                        if (ai == 1 && wr == 1) { *(f32x4*)(TAIL + ((size_t)u.pm * 2 + (fr - 14)) * FF2_ + bj * FF_ + u.pn * 128 + colt + 4 * n) = acc[1][bj][3][n];
                            if ((u.pm & 7) == 7) *(f32x4*)(PFC + ((size_t)(u.pm >> 3) * 2 + (fr - 14)) * FF2_ + bj * FF_ + u.pn * 128 + colt + 4 * n) = acc[1][bj][3][n]; } } }
        if (fr < 2 && wr == 0) {
#pragma unroll
            for (int bj = 0; bj < 2; ++bj)
#pragma unroll
                for (int n = 0; n < 2; ++n) *(f32x4*)(HEAD + ((size_t)u.pm * 2 + fr) * FF2_ + bj * FF_ + u.pn * 128 + colt + 4 * n) = acc[0][bj][0][n]; }
        { PG8_LAS float* WL = HALO + 2048;
          const int tid_ = (wr * 4 + wc) * 64 + fq * 16 + fr, e = 2 * tid_, arr = e >> 8, c = e & 255;
          const float* src = (arr < 3 ? cw + arr * FF2_ : cb) + (c < 128 ? u.pn * 128 + c : FF_ + u.pn * 128 + (c - 128));
          *(PG8_LAS f32x2*)(WL + e) = *(const __attribute__((address_space(1))) f32x2*)src; }
        asm volatile("s_waitcnt vmcnt(0) lgkmcnt(0)" ::: "memory"); __builtin_amdgcn_s_barrier(); asm volatile("" ::: "memory");
        const PG8_LAS float* WL = HALO + 2048;
        typedef unsigned u32x2 __attribute__((ext_vector_type(2)));
#pragma unroll
        for (int ai = 0; ai < 2; ++ai) {
            const int pred = wr == 1 ? (ai * 2 + 0) : (0 * 2 + 1);
            const bool nohist = (ai == 0 && wr == 0);
            const int row0 = u.pm * BM + ai * HALF + wr * 64 + fr;
#pragma unroll
            for (int n = 0; n < 2; ++n) {
                unsigned pk[4][2];
#pragma unroll
                for (int jp = 0; jp < 2; ++jp) {
                    float gsil[4][2];
#pragma unroll
                    for (int bj = 1; bj >= 0; --bj) { const int wc_ = bj * 128 + colt + 4 * n + 2 * jp;
                        const f32x2 w0 = *(const PG8_LAS f32x2*)(WL + wc_), w1 = *(const PG8_LAS f32x2*)(WL + 256 + wc_), w2 = *(const PG8_LAS f32x2*)(WL + 512 + wc_), bb = *(const PG8_LAS f32x2*)(WL + 768 + wc_);
                        const f32x2 h0 = *(const PG8_LAS f32x2*)(HALO + (pred * 2 + 0) * 256 + bj * 128 + colt + 4 * n + 2 * jp), h1 = *(const PG8_LAS f32x2*)(HALO + (pred * 2 + 1) * 256 + bj * 128 + colt + 4 * n + 2 * jp);
#pragma unroll
                        for (int m = 0; m < 4; ++m) { float r[2];
#pragma unroll
                            for (int jj = 0; jj < 2; ++jj) { const int j = 2 * jp + jj; const float cur = acc[ai][bj][m][n][j];
                                const float x1 = m == 0 ? h1[jj] : dpp_ror1(acc[ai][bj][m == 0 ? 0 : m - 1][n][j]);
                                const float x2 = m == 0 ? (fr == 0 ? h0[jj] : h1[jj]) : dpp_ror2(acc[ai][bj][m == 0 ? 0 : m - 1][n][j]);
                                const float p1 = dpp_shr1(x1, cur), p2 = dpp_shr2(x2, cur);
                                r[jj] = bb[jj] + w0[jj] * p2 + w1[jj] * p1 + w2[jj] * cur; }
                            if (bj == 1) { gsil[m][0] = r[0] * __builtin_amdgcn_rcpf(1.0f + __expf(-r[0])); gsil[m][1] = r[1] * __builtin_amdgcn_rcpf(1.0f + __expf(-r[1])); }
                            else pk[m][jp] = cvt_pk_bf16(r[0] * gsil[m][0], r[1] * gsil[m][1]); }
                    }
                }
#pragma unroll
                for (int m = 0; m < 4; ++m) { if (nohist && m == 0 && fr < 2) continue;
                    u32x2 w; w.x = pk[m][0]; w.y = pk[m][1]; *(u32x2*)(ACT + (size_t)(row0 + m * 16) * FF_ + u.pn * 128 + colt + 4 * n) = w; }
                asm volatile("" ::: "memory");
            }
        }
    }
};
struct EpiAny {
    static constexpr bool AFTER_DRAIN = false;
    int mode; bool perm; void* O; int ldc; EpiConvGate cg;
    __device__ __forceinline__ void operator()(const f32x4 (&acc)[2][2][4][2], const Unit& u, int wr, int wc, int fr, int fq) const {
        if (mode == 0) { EpiBf16 e{(bf16_t*)O, ldc}; e(acc, u, wr, wc, fr, fq); }
        else if (mode == 1) { EpiF32 e{(float*)O, ldc}; e(acc, u, wr, wc, fr, fq); }
        else if (mode == 2) { EpiGlu e{(bf16_t*)O, ldc}; e(acc, u, wr, wc, fr, fq); }
        else cg(acc, u, wr, wc, fr, fq);
    }
};
template <class Epi, class Sched, bool ALIGN_EPI = false, bool SP2 = false>
__device__ __forceinline__ void gemm_phase(PG8_LAS unsigned char* lds, const Gemm g, const Sched& S, const Epi& E, const int tid) {
    const int wid = __builtin_amdgcn_readfirstlane(tid >> 6), lane = tid & 63, wr = wid >> 2, wc = wid & 3, fr = lane & 15, fq = lane >> 4;
    const int K = g.K, nt = K / BK;
    unsigned voffA[2], voffB[2];
#pragma unroll
    for (int i = 0; i < 2; ++i) { int R, C; stage_rc(tid * 16 + i * 8192, R, C); const int Rb = E.perm ? ((R & ~31) + perm32(R & 31)) : R;
        voffA[i] = (unsigned)(R * K + C) * 2u; voffB[i] = (unsigned)(Rb * K + C) * 2u; }
    const size_t kstep = (size_t)(BK * 2);
    const size_t hstep = (size_t)HALF * K * 2;
    const size_t tstep = 2 * hstep;
    const unsigned ldsw = (unsigned)wid * 1024u;
    const int aoff = lds_byte(wr * 64 + fr, fq * 8), boff = lds_byte(wc * 32 + fr, fq * 8);
#define PG8_SA(b, h) (((b) * 2 + (h)) * HTB)
#define PG8_SB(b, h) ((4 + (b) * 2 + (h)) * HTB)
#define PG8_STAGE(bufoff, gbase, voff) do { _Pragma("unroll") for (int _i = 0; _i < 2; ++_i) \
        __builtin_amdgcn_global_load_lds((const unsigned*)((const char*)(gbase) + (voff)[_i]), (PG8_LAS unsigned*)(lds + (bufoff) + ldsw + _i * 8192), 16, 0, 0); } while (0)
#define PG8_LDA(dst, b, h) do { _Pragma("unroll") for (int m = 0; m < 4; ++m) _Pragma("unroll") for (int k = 0; k < 2; ++k) dst[m][k] = *(const PG8_LAS bf16x8*)(lds + PG8_SA(b, h) + aoff + m * 2048 + k * 1024); } while (0)
#define PG8_LDB(dst, b, h) do { _Pragma("unroll") for (int n = 0; n < 2; ++n) _Pragma("unroll") for (int k = 0; k < 2; ++k) dst[n][k] = *(const PG8_LAS bf16x8*)(lds + PG8_SB(b, h) + boff + n * 2048 + k * 1024); } while (0)
#define PG8_MMA(ai, bj, At, Bt) do { __builtin_amdgcn_s_setprio(1); _Pragma("unroll") for (int m = 0; m < 4; ++m) _Pragma("unroll") for (int n = 0; n < 2; ++n) _Pragma("unroll") for (int k = 0; k < 2; ++k) \
        acc[ai][bj][m][n] = __builtin_amdgcn_mfma_f32_16x16x32_bf16(Bt[n][k], At[m][k], acc[ai][bj][m][n], 0, 0, 0); __builtin_amdgcn_s_setprio(0); } while (0)
#define PG8_WAIT_V(n) asm volatile("s_waitcnt vmcnt(" #n ")" ::: "memory")
#define PG8_WAIT_L(n) asm volatile("s_waitcnt lgkmcnt(" #n ")" ::: "memory")
#define PG8_BAR __builtin_amdgcn_s_barrier()
#define PG8_SCHED __builtin_amdgcn_sched_barrier(0)
    Unit cur, nxt; int ui = 0;
    if (!S.next(0, cur)) return;
    f32x4 acc[2][2][4][2];
#pragma unroll
    for (int a = 0; a < 2; ++a)
#pragma unroll
        for (int b = 0; b < 2; ++b)
#pragma unroll
            for (int m = 0; m < 4; ++m)
#pragma unroll
                for (int n = 0; n < 2; ++n) acc[a][b][m][n] = (f32x4){0.f, 0.f, 0.f, 0.f};
    bf16x8 At[4][2], B0[2][2], B1[2][2];
    const char* cA = (const char*)g.A + (size_t)cur.pm * tstep; const char* cB = (const char*)g.Bt + (size_t)cur.pn * tstep;
    S.a_ready(cur);
    if constexpr (SP2) {
        PG8_STAGE(PG8_SB(0, 0), cB, voffB); PG8_STAGE(PG8_SB(0, 1), cB + hstep, voffB); PG8_STAGE(PG8_SA(0, 0), cA, voffA); PG8_STAGE(PG8_SA(0, 1), cA + hstep, voffA);
        if (wr == 1) PG8_BAR;
        PG8_WAIT_V(2); PG8_BAR;
        PG8_STAGE(PG8_SB(1, 0), cB + kstep, voffB); PG8_STAGE(PG8_SA(1, 0), cA + kstep, voffA); PG8_STAGE(PG8_SB(1, 1), cB + hstep + kstep, voffB);
        PG8_WAIT_V(6); PG8_BAR;
    } else {
        PG8_STAGE(PG8_SB(0, 0), cB, voffB); PG8_STAGE(PG8_SA(0, 0), cA, voffA); PG8_STAGE(PG8_SB(0, 1), cB + hstep, voffB); PG8_STAGE(PG8_SA(0, 1), cA + hstep, voffA);
        if (wr == 1) PG8_BAR;
        PG8_WAIT_V(4); PG8_BAR;
        PG8_STAGE(PG8_SB(1, 0), cB + kstep, voffB); PG8_STAGE(PG8_SA(1, 0), cA + kstep, voffA); PG8_STAGE(PG8_SB(1, 1), cB + hstep + kstep, voffB);
        PG8_WAIT_V(6); PG8_BAR;
    }
    for (;;) {
        const bool has_next = S.next(ui + 1, nxt);
        const char* nA = has_next ? (const char*)g.A + (size_t)nxt.pm * tstep : cA; const char* nB = has_next ? (const char*)g.Bt + (size_t)nxt.pn * tstep : cB;
        for (int t = 0; t < nt; t += 2) {
            const bool last = (t == nt - 2);
            const char* a1 = cA + (size_t)(t + 1) * kstep;
            const char* a2 = last ? nA : cA + (size_t)(t + 2) * kstep; const char* b2 = last ? nB : cB + (size_t)(t + 2) * kstep;
            const char* a3 = a2 + kstep; const char* b3 = b2 + kstep;
            if (last && has_next) S.a_ready(nxt);
            if constexpr (SP2) {
            PG8_LDB(B0, 0, 0); PG8_LDB(B1, 0, 1); PG8_SCHED; PG8_LDA(At, 0, 0); PG8_STAGE(PG8_SA(1, 1), a1 + hstep, voffA);
            PG8_WAIT_V(8); PG8_WAIT_L(0); PG8_BAR; PG8_MMA(0, 0, At, B0); PG8_MMA(0, 1, At, B1); PG8_BAR; PG8_SCHED;
            PG8_LDA(At, 0, 1); PG8_STAGE(PG8_SB(0, 0), b2, voffB); PG8_STAGE(PG8_SB(0, 1), b2 + hstep, voffB); PG8_STAGE(PG8_SA(0, 0), a2, voffA);
            PG8_WAIT_V(8); PG8_WAIT_L(0); PG8_BAR; PG8_MMA(1, 0, At, B0); PG8_MMA(1, 1, At, B1); PG8_BAR; PG8_SCHED;
            PG8_LDB(B0, 1, 0); PG8_LDB(B1, 1, 1); PG8_SCHED; PG8_LDA(At, 1, 0); PG8_STAGE(PG8_SA(0, 1), a2 + hstep, voffA);
            PG8_WAIT_V(8); PG8_WAIT_L(0); PG8_BAR; PG8_MMA(0, 0, At, B0); PG8_MMA(0, 1, At, B1); PG8_BAR; PG8_SCHED;
            PG8_LDA(At, 1, 1); PG8_STAGE(PG8_SB(1, 0), b3, voffB); PG8_STAGE(PG8_SB(1, 1), b3 + hstep, voffB); PG8_STAGE(PG8_SA(1, 0), a3, voffA);
            PG8_WAIT_V(8); PG8_WAIT_L(0); PG8_BAR; PG8_MMA(1, 0, At, B0); PG8_MMA(1, 1, At, B1); PG8_BAR; PG8_SCHED;
            } else {
            PG8_LDB(B0, 0, 0); PG8_SCHED; PG8_LDA(At, 0, 0); PG8_STAGE(PG8_SA(1, 1), a1 + hstep, voffA);
            PG8_WAIT_L(8); PG8_BAR; PG8_WAIT_L(0); PG8_MMA(0, 0, At, B0); PG8_BAR; PG8_SCHED;
            PG8_LDB(B1, 0, 1); PG8_STAGE(PG8_SB(0, 0), b2, voffB);
            PG8_BAR; PG8_WAIT_L(0); PG8_MMA(0, 1, At, B1); PG8_BAR;
            PG8_LDA(At, 0, 1); PG8_STAGE(PG8_SA(0, 0), a2, voffA);
            PG8_BAR; PG8_WAIT_L(0); PG8_MMA(1, 0, At, B0); PG8_BAR; PG8_SCHED;
            PG8_STAGE(PG8_SB(0, 1), b2 + hstep, voffB);
            PG8_WAIT_V(6); PG8_BAR; PG8_MMA(1, 1, At, B1); PG8_BAR;
            PG8_LDB(B0, 1, 0); PG8_SCHED; PG8_LDA(At, 1, 0); PG8_STAGE(PG8_SA(0, 1), a2 + hstep, voffA);
            PG8_WAIT_L(8); PG8_BAR; PG8_WAIT_L(0); PG8_MMA(0, 0, At, B0); PG8_BAR; PG8_SCHED;
            PG8_LDB(B1, 1, 1); PG8_STAGE(PG8_SB(1, 0), b3, voffB);
            PG8_BAR; PG8_WAIT_L(0); PG8_MMA(0, 1, At, B1); PG8_BAR;
            PG8_LDA(At, 1, 1); PG8_STAGE(PG8_SA(1, 0), a3, voffA);
            PG8_BAR; PG8_WAIT_L(0); PG8_MMA(1, 0, At, B0); PG8_BAR; PG8_SCHED;
            PG8_STAGE(PG8_SB(1, 1), b3 + hstep, voffB);
            PG8_WAIT_V(6); PG8_BAR; PG8_MMA(1, 1, At, B1); PG8_BAR;
            }
        }
        if constexpr (ALIGN_EPI) { if (wr == 0) PG8_BAR; }
        PSEG_B(1, lds);
        if constexpr (!Epi::AFTER_DRAIN) { E(acc, cur, wr, wc, fr, fq); S.done(cur); }
        PSEG_E(1, lds);
        if (!has_next) break;
#pragma unroll
        for (int a = 0; a < 2; ++a)
#pragma unroll
            for (int b = 0; b < 2; ++b)
#pragma unroll
                for (int m = 0; m < 4; ++m)
#pragma unroll
                    for (int n = 0; n < 2; ++n) acc[a][b][m][n] = (f32x4){0.f, 0.f, 0.f, 0.f};
        cur = nxt; cA = nA; cB = nB; ++ui;
        if constexpr (ALIGN_EPI) { if (wr == 1) PG8_BAR; }
    }
    PG8_WAIT_V(0);
    if constexpr (!ALIGN_EPI) { if (wr == 0) PG8_BAR; }
    PG8_BAR;
    if constexpr (Epi::AFTER_DRAIN) { E.fused(acc, cur, wr, wc, fr, fq, lds, wid, lane); S.done(cur); }
#undef PG8_SA
#undef PG8_SB
#undef PG8_STAGE
#undef PG8_LDA
#undef PG8_LDB
#undef PG8_MMA
#undef PG8_WAIT_V
#undef PG8_WAIT_L
#undef PG8_BAR
#undef PG8_SCHED
}
}

constexpr int NWAVES = 8, NTHR = 512;
constexpr int D = 1024, NB = 8, SEQ = 2048, MP = NB * SEQ, MS = 128, MT = MP + MS;
constexpr int NA = 2560, NBH = 4096;
constexpr int WIN_ROWS = NA + NBH;
constexpr int XBC = 1280, ABIN = 6416;
constexpr int FF = 2816, FF2 = 5632, NFT = 22;
constexpr float EPS = 1e-6f;
constexpr int NPH = 18;

constexpr size_t O_YP = 0, O_YS = O_YP + (size_t)MP * D, O_PSSM = O_YS + (size_t)MS * D, O_PSCONV = O_PSSM + 8 * 16 * 64 * 64, O_PHG = O_PSCONV + 8 * 3 * XBC,
                 O_PS5R = O_PHG + 8 * 8 * 128 * 128, O_PS5I = O_PS5R + 8 * 64 * 64, O_PFC = O_PS5I + 8 * 64 * 64, O_SSSM = O_PFC + 2 * 8 * 2 * FF2,
                 O_SSCONV = O_SSSM + (size_t)MS * 16 * 64 * 64, O_SHG = O_SSCONV + (size_t)MS * 3 * XBC, O_SS5R = O_SHG + (size_t)MS * 8 * 128 * 128,
                 O_SS5I = O_SS5R + (size_t)MS * 64 * 64, O_SFC = O_SS5I + (size_t)MS * 64 * 64, O_END = O_SFC + (size_t)2 * MS * 2 * FF2;
static_assert(O_END == 48347136, "d_out size");

constexpr size_t al256(size_t x) { return (x + 255) & ~(size_t)255; }
constexpr size_t WS_CTL = 0, CTL_BYTES = 1u << 20;
constexpr size_t WS_WIN = CTL_BYTES;
constexpr size_t WS_WOUT = WS_WIN + (size_t)WIN_ROWS * D * 2;
constexpr size_t WS_WGLU = WS_WOUT + (size_t)D * 2048 * 2;
constexpr size_t WS_WUP = WS_WGLU + (size_t)2048 * D * 2;
constexpr size_t WS_WDN = WS_WUP + (size_t)2 * FF2 * D * 2;
constexpr size_t WS_XN = WS_WDN + (size_t)2 * D * FF * 2;
constexpr size_t WS_MIXS = WS_XN + (size_t)MT * D * 2;
constexpr size_t WS_BIG = al256(WS_MIXS + (size_t)MS * 2048 * 2);
constexpr size_t WS_END = (size_t)256 << 20;
constexpr size_t BIG_BYTES = WS_END - WS_BIG;
constexpr size_t B_PROJA = 0;
constexpr size_t B_Y2 = al256(B_PROJA + (size_t)MT * NA * 2);
constexpr size_t B_ORAW = 0;
constexpr size_t B_PROJB = al256(B_ORAW + (size_t)MT * D * 2);
constexpr size_t B_M1 = 0;
constexpr size_t B_UP = 0;
constexpr size_t B_ACT = al256((size_t)MT * 2048 * 2);
constexpr size_t B_GY = 0;
constexpr size_t B_PC = al256(B_GY + (size_t)MT * D * 2);
constexpr size_t B_XP = al256(B_PC + (size_t)1024 * 8192 * 4);
constexpr size_t B_M1G = (size_t)100 << 20;
constexpr size_t B_S5T = (size_t)120 << 20;
constexpr size_t S5T_KQ = 0, S5T_PM = S5T_KQ + (size_t)64 * 256 * 384 * 2, S5T_AB = S5T_PM + (size_t)64 * 128 * 256 * 2, S5T_BB = S5T_AB + (size_t)64 * 64 * 2 * 4, S5T_END = S5T_BB + (size_t)64 * 64 * 32 * 4;
static_assert(B_Y2 + (size_t)MT * D * 4 <= BIG_BYTES, "ssd stage");
static_assert(B_PROJB + (size_t)MT * NBH * 2 <= BIG_BYTES, "hgrn stage");
static_assert(B_ACT + (size_t)MT * FF * 2 <= BIG_BYTES, "ffn stage");
static_assert(B_XP + (size_t)1024 * 8192 * 2 <= B_S5T && B_M1G + (size_t)MT * D * 4 <= BIG_BYTES && B_S5T + S5T_END <= BIG_BYTES && B_S5T >= B_M1 + (size_t)MT * D * 4, "s5 stage");

#define GAS __attribute__((address_space(1)))
#define LAS __attribute__((address_space(3)))
typedef unsigned short bf16;
typedef unsigned v4u __attribute__((ext_vector_type(4)));
typedef unsigned v2u __attribute__((ext_vector_type(2)));
typedef float f32x4 __attribute__((ext_vector_type(4)));
typedef float f32x16 __attribute__((ext_vector_type(16)));
typedef short bf16x8 __attribute__((ext_vector_type(8)));
typedef GAS unsigned gu32;
#define RLX_AGENT __ATOMIC_RELAXED, __HIP_MEMORY_SCOPE_AGENT
#define LDS_WAIT() asm volatile("s_waitcnt lgkmcnt(0)" ::: "memory")
#define VM_WAIT() asm volatile("s_waitcnt vmcnt(0)" ::: "memory")
__device__ __forceinline__ unsigned f2bf(float f) { unsigned u = __builtin_bit_cast(unsigned, f); return (u + 0x7fffu + ((u >> 16) & 1u)) >> 16; }
__device__ __forceinline__ unsigned pk2(float lo, float hi) { return f2bf(lo) | (f2bf(hi) << 16); }
__device__ __forceinline__ float bf2f(unsigned short b) { return __builtin_bit_cast(float, (unsigned)b << 16); }
__device__ __forceinline__ float bflo(unsigned w) { return __builtin_bit_cast(float, w << 16); }
__device__ __forceinline__ float bfhi(unsigned w) { return __builtin_bit_cast(float, w & 0xffff0000u); }
__device__ __forceinline__ float sigmoidf_(float x) { return __builtin_amdgcn_rcpf(1.0f + __expf(-x)); }
__device__ __forceinline__ float siluf_(float x) { return x * __builtin_amdgcn_rcpf(1.0f + __expf(-x)); }
__device__ __forceinline__ float softplusf_(float x) { return x > 20.f ? x : log1pf(__expf(x)); }
__device__ __forceinline__ float gelu_tanh(float x) { const float u = 0.7978845608028654f * (x + 0.044715f * x * x * x); const float e = __expf(2.f * u); const float th = 1.f - 2.f / (e + 1.f); return 0.5f * x * (1.f + th); }

#define XB_TMO      128
#define XB_XCNT(j)  (256  + 64 * (j))
#define XB_XSUB(j)  (1280 + 64 * (j))
#define XB_XGEN(j)  (2304 + 64 * (j))
#define XB_TOP      3328
#define XB_TOPGEN   3392
#define XCD_BAR_WORDS 3456
#define XB_SPIN_CAP (1u << 18)
__device__ __forceinline__ unsigned xb_ld(unsigned* p)              { return __hip_atomic_load(p, __ATOMIC_RELAXED, __HIP_MEMORY_SCOPE_AGENT); }
__device__ __forceinline__ unsigned xb_add(unsigned* p, unsigned v) { return __hip_atomic_fetch_add(p, v, __ATOMIC_RELAXED, __HIP_MEMORY_SCOPE_AGENT); }
__device__ __forceinline__ unsigned xb_xcc_id() { return (unsigned)__builtin_amdgcn_s_getreg((3 << 11) | 20) & 0xFu; }
#define XB_SPIN(cond, bar) do { unsigned _sp = 0; while (cond) { __builtin_amdgcn_s_sleep(1); \
    if ((++_sp & 255u) == 0u) { if (xb_ld(&(bar)[XB_TMO])) break; if (_sp > XB_SPIN_CAP) { atomicAdd(&(bar)[XB_TMO], 1u); break; } } } } while (0)
struct XcdBarrier { unsigned* bar; unsigned x; volatile LAS unsigned* st; };
__device__ __forceinline__ XcdBarrier xcd_barrier_post(unsigned* bar, volatile LAS unsigned* st) {
    XcdBarrier b; b.bar = bar; b.x = xb_xcc_id(); b.st = st;
    if (threadIdx.x == 0) (void)xb_add(&bar[XB_XCNT(b.x)], 1u);
    return b;
}
__device__ __forceinline__ void xcd_barrier_complete(unsigned* bar, unsigned x, unsigned& nloc, unsigned& nx) {
    const unsigned G = gridDim.x * gridDim.y * gridDim.z;
    unsigned sum, cnt, mine, sp = 0u;
    for (;;) {
        sum = 0u; cnt = 0u; mine = 0u;
#pragma unroll
        for (unsigned j = 0; j < 16; ++j) { const unsigned c = xb_ld(&bar[XB_XCNT(j)]); sum += c; cnt += (c > 0u) ? 1u : 0u; mine = (j == x) ? c : mine; }
        if (sum == G) break;
        __builtin_amdgcn_s_sleep(1);
        if ((++sp & 255u) == 0u) { if (xb_ld(&bar[XB_TMO])) break; if (sp > XB_SPIN_CAP) { atomicAdd(&bar[XB_TMO], 1u); break; } }
    }
    nloc = mine > 0u ? mine : 1u; nx = cnt > 0u ? cnt : 1u;
}
__device__ __forceinline__ void xcd_barrier(const XcdBarrier& b) {
    asm volatile("s_waitcnt vmcnt(0)" ::: "memory");
    __syncthreads();
    if (threadIdx.x == 0) {
        unsigned* bar = b.bar;
        __builtin_amdgcn_s_waitcnt(0);
        unsigned nloc = b.st[0], nx = b.st[1];
        if (nloc == 0u) { xcd_barrier_complete(bar, b.x, nloc, nx); b.st[0] = nloc; b.st[1] = nx; }
        const unsigned old = xb_add(&bar[XB_XSUB(b.x)], 1u);
        const unsigned gen = old / nloc;
        if (old + 1u == (gen + 1u) * nloc) {
            __builtin_amdgcn_fence(__ATOMIC_RELEASE, "agent");
            asm volatile("s_waitcnt vmcnt(0)" ::: "memory");
            const unsigned og = xb_add(&bar[XB_TOP], 1u);
            const unsigned tg = og / nx;
            if (og + 1u == (tg + 1u) * nx) xb_add(&bar[XB_TOPGEN], 1u);
            else XB_SPIN(xb_ld(&bar[XB_TOPGEN]) == tg, bar);
            __builtin_amdgcn_fence(__ATOMIC_ACQUIRE, "agent");
            xb_add(&bar[XB_XGEN(b.x)], 1u);
            asm volatile("s_waitcnt vmcnt(0)" ::: "memory");
        } else {
            XB_SPIN(xb_ld(&bar[XB_XGEN(b.x)]) == gen, bar);
            __builtin_amdgcn_fence(__ATOMIC_ACQUIRE, "agent");
            asm volatile("s_waitcnt vmcnt(0)" ::: "memory");
        }
    }
    __syncthreads();
}

constexpr int RING_BYTES = 131072;
constexpr int LDSCTL_OFF = RING_BYTES, MISC_OFF = LDSCTL_OFF + 320, HALO_OFF = RING_BYTES + 1024;
constexpr int LDS_BYTES = 147456;

struct Args { const float* in[35]; float* out; unsigned char* ws; int ph_lo, ph_hi, li, pad; };
static_assert(sizeof(Args) == 35 * 8 + 8 + 8 + 16, "Args has no padding");
#define CAS __attribute__((address_space(4)))
struct Frame {
    LAS unsigned char* lds;
    int tid, lane, wave, vcu, G;
    const CAS Args* a;
    float* out;
    unsigned char* ws;
};

enum { I_XP = 0, I_XS, I_SSSM, I_SSCONV, I_SHG, I_SS5R, I_SS5I, I_SFC, I_NMPRE, I_NMPOST, I_NFPRE, I_NFPOST, I_WIN, I_CONVW, I_CONVB, I_DTB, I_ALOG, I_SSMD, I_SSMNW,
       I_HGLB, I_HGNW, I_WOUT, I_LAMRE, I_LAMIM, I_LOGSTEP, I_BRE, I_BIM, I_CRE, I_CIM, I_S5D, I_WGLU, I_WUP, I_FCW, I_FCB, I_WDN, N_IN };

#define GW_ID(F) ((F).vcu * NWAVES + (F).wave)
#define GW_N(F) ((F).G * NWAVES)

__device__ __forceinline__ void p0_transpose_item(const float* W, int ldw, int K, int scol0, bf16* WT, int drow0, int kb, LAS float* scr, int lane) {
    const int k0 = 64 * kb;
    f32x4 v[8];
#pragma unroll
    for (int i = 0; i < 8; ++i) v[i] = *(const GAS f32x4*)(W + (size_t)(k0 + (lane >> 3) + 8 * i) * ldw + scol0 + 4 * (lane & 7));
#pragma unroll
    for (int i = 0; i < 8; ++i) { LAS float* d = scr + ((lane >> 3) + 8 * i) * 33 + 4 * (lane & 7); d[0] = v[i].x; d[1] = v[i].y; d[2] = v[i].z; d[3] = v[i].w; }
    LDS_WAIT(); asm volatile("" ::: "memory");
    const int c = lane & 7;
#pragma unroll
    for (int j = 0; j < 4; ++j) { const int n = (lane >> 3) + 8 * j; const LAS float* s = scr + (8 * c) * 33 + n;
        v4u o; o.x = pk2(s[0 * 33], s[1 * 33]); o.y = pk2(s[2 * 33], s[3 * 33]); o.z = pk2(s[4 * 33], s[5 * 33]); o.w = pk2(s[6 * 33], s[7 * 33]);
        *(GAS v4u*)(WT + (size_t)(drow0 + n) * K + k0 + 8 * c) = o; }
    LDS_WAIT(); asm volatile("" ::: "memory");
}
__device__ __forceinline__ void rms_row_to_bf16(const float* xrow, const float* w, bf16* orow, int lane) {
    const GAS f32x4* xr = (const GAS f32x4*)xrow + lane; const GAS f32x4* wr = (const GAS f32x4*)w + lane;
    f32x4 v[4]; float s = 0.f;
#pragma unroll
    for (int j = 0; j < 4; ++j) { v[j] = xr[64 * j]; s += (v[j].x * v[j].x + v[j].y * v[j].y) + (v[j].z * v[j].z + v[j].w * v[j].w); }
    const float rs = rsqrtf(wave_sum(s) * (1.f / D) + EPS);
    GAS v2u* o8 = (GAS v2u*)orow + lane;
#pragma unroll
    for (int j = 0; j < 4; ++j) { const f32x4 ww = wr[64 * j]; v2u o; o.x = pk2(v[j].x * rs * ww.x, v[j].y * rs * ww.y); o.y = pk2(v[j].z * rs * ww.z, v[j].w * rs * ww.w); o8[64 * j] = o; }
}
__device__ __forceinline__ const float* x_in_row(const Frame& F, int r) { return r < MP ? F.a->in[I_XP] + (size_t)r * D : F.a->in[I_XS] + (size_t)(r - MP) * D; }
__device__ __forceinline__ float* x_res_row(const Frame& F, int r) { return r < MP ? F.out + O_YP + (size_t)r * D : F.out + O_YS + (size_t)(r - MP) * D; }

__device__ __forceinline__ void wconv_items(Frame& F, int it_lo, int it_hi, int gw, int NGW) {
    LAS float* scr = (LAS float*)(F.lds + F.wave * 16384);
    bf16* WIN = (bf16*)(F.ws + WS_WIN); bf16* WOUT = (bf16*)(F.ws + WS_WOUT); bf16* WGLU = (bf16*)(F.ws + WS_WGLU); bf16* WUP = (bf16*)(F.ws + WS_WUP); bf16* WDN = (bf16*)(F.ws + WS_WDN);
    constexpr int I_IN = 16 * 200, I_OUT = 32 * 32, I_GLU = 16 * 64, I_UP = 16 * 176, I_DN = 44 * 32;
    constexpr int NITEMS = I_IN + I_OUT + I_GLU + 2 * I_UP + 2 * I_DN;
    (void)NITEMS;
    for (int it = it_lo + gw; it < it_hi; it += NGW) {
        int r = it;
        if (r < I_IN) { const int kb = r / 200, nb = r % 200;
            const int sc = nb < 72 ? 32 * nb : 2320 + 32 * (nb - 72);
            const int dr = nb < 72 ? 32 * nb : NA + 32 * (nb - 72);
            p0_transpose_item(F.a->in[I_WIN], ABIN, D, sc, WIN, dr, kb, scr, F.lane); continue; }
        r -= I_IN;
        if (r < I_OUT) { p0_transpose_item(F.a->in[I_WOUT], D, 2048, 32 * (r % 32), WOUT, 32 * (r % 32), r / 32, scr, F.lane); continue; }
        r -= I_OUT;
        if (r < I_GLU) { const int kb = r / 64, nb = r % 64, d = 32 * nb, j = d >> 8, bj = (d >> 7) & 1, c = d & 127;
            p0_transpose_item(F.a->in[I_WGLU], 2048, D, 1024 * bj + 128 * j + c, WGLU, d, kb, scr, F.lane); continue; }
        r -= I_GLU;
        if (r < 2 * I_UP) { const int l = r / I_UP; r -= l * I_UP; const int kb = r / 176, nb = r % 176, d = 32 * nb, j = d >> 8, bj = (d >> 7) & 1, c = d & 127;
            p0_transpose_item(F.a->in[I_WUP] + (size_t)l * D * FF2, FF2, D, FF * bj + 128 * j + c, WUP + (size_t)l * FF2 * D, d, kb, scr, F.lane); continue; }
        r -= 2 * I_UP;
        { const int l = r / I_DN; r -= l * I_DN; p0_transpose_item(F.a->in[I_WDN] + (size_t)l * FF * D, D, FF, 32 * (r % 32), WDN + (size_t)l * D * FF, 32 * (r % 32), r / 32, scr, F.lane); }
    }
}
constexpr int WC_EARLY = 16 * 200 + 32 * 32, WC_ALL = 16 * 200 + 32 * 32 + 16 * 64 + 2 * 16 * 176 + 2 * 44 * 32;
__device__ __forceinline__ void p0_prologue(Frame& F) {
    const int gw = GW_ID(F), NGW = GW_N(F);
    bf16* WIN = (bf16*)(F.ws + WS_WIN);
    wconv_items(F, 0, F.G > 128 ? WC_EARLY : WC_ALL, gw, NGW);
    { const int gt = (F.vcu * NTHR + F.tid), NT = F.G * NTHR;
      for (int i = gt; i < 16 * D; i += NT) { const int n = i >> 10, k = i & 1023; WIN[(size_t)(2304 + n) * D + k] = (bf16)f2bf(F.a->in[I_WIN][(size_t)k * ABIN + 2304 + n]); }
      unsigned z_ = 0u; asm volatile("" : "+v"(z_));
      for (int i = gt; i < 240 * D / 8; i += NT) ((GAS v4u*)(WIN + (size_t)2320 * D))[i] = (v4u){z_, z_, z_, z_}; }
    bf16* XN = (bf16*)(F.ws + WS_XN);
    { const int lane = F.lane; f32x4 nx[4];
      if (gw < MT) {
#pragma unroll
          for (int j = 0; j < 4; ++j) nx[j] = ((const GAS f32x4*)x_in_row(F, gw) + lane)[64 * j]; }
      for (int m = gw; m < MT; m += NGW) { f32x4 v[4]; float s = 0.f;
#pragma unroll
          for (int j = 0; j < 4; ++j) { v[j] = nx[j]; s += (v[j].x * v[j].x + v[j].y * v[j].y) + (v[j].z * v[j].z + v[j].w * v[j].w); }
          if (m + NGW < MT) {
#pragma unroll
              for (int j = 0; j < 4; ++j) nx[j] = ((const GAS f32x4*)x_in_row(F, m + NGW) + lane)[64 * j]; }
          const float rs = rsqrtf(wave_sum(s) * (1.f / D) + EPS); GAS v2u* o8 = (GAS v2u*)(XN + (size_t)m * D) + lane;
#pragma unroll
          for (int j = 0; j < 4; ++j) { const f32x4 ww = ((const GAS f32x4*)F.a->in[I_NMPRE] + lane)[64 * j]; v2u o; o.x = pk2(v[j].x * rs * ww.x, v[j].y * rs * ww.y); o.y = pk2(v[j].z * rs * ww.z, v[j].w * rs * ww.w); o8[64 * j] = o; } } }
}

template <int NT, bool GLU, class Epi>
__device__ __forceinline__ void skinny_gemm(Frame& F, const bf16* A, int lda, const bf16* Bt, int K, int ncb, const Epi& epi, int tb, int tstride) {
    LAS float* red = (LAS float*)F.lds;
    const int lane = F.lane, r = lane & 31, h = lane >> 5, w = F.wave;
    const int kper = K >> 3, kbeg = w * kper;
    const int ntask = 4 * ncb;
    if (tb < 0) return;
    for (int task = tb; task < ntask; task += tstride) {
        const int rt = task & 3, ct = task >> 2;
        const int brow = GLU ? (256 * (ct >> 2) + 32 * (ct & 3)) : 32 * ct;
        const bf16* ap = A + (size_t)(rt * 32 + r) * lda + kbeg + 8 * h;
        const bf16* bp = Bt + (size_t)(brow + r) * K + kbeg + 8 * h;
        f32x16 acc[NT];
#pragma unroll
        for (int nt = 0; nt < NT; ++nt)
#pragma unroll
            for (int i = 0; i < 16; ++i) acc[nt][i] = 0.f;
#pragma unroll 8
        for (int k = 0; k < kper; k += 16) {
            const bf16x8 a = *(const bf16x8*)(ap + k);
#pragma unroll
            for (int nt = 0; nt < NT; ++nt) { const bf16x8 b = *(const bf16x8*)(bp + (size_t)nt * 128 * K + k); acc[nt] = __builtin_amdgcn_mfma_f32_32x32x16_bf16(a, b, acc[nt], 0, 0, 0); }
        }
#pragma unroll
        for (int nt = 0; nt < NT; ++nt)
#pragma unroll
            for (int i = 0; i < 16; ++i) red[((w * NT + nt) * 16 + i) * 64 + lane] = acc[nt][i];
        __syncthreads();
#pragma unroll
        for (int e0 = 0; e0 < 2; ++e0) { const int e = F.tid + 512 * e0, i = e >> 6, l = e & 63; float v[NT];
#pragma unroll
            for (int nt = 0; nt < NT; ++nt) { float s = 0.f;
#pragma unroll
                for (int ww = 0; ww < 8; ++ww) s += red[((ww * NT + nt) * 16 + i) * 64 + l];
                v[nt] = s; }
            epi(rt * 32 + (i & 3) + 8 * (i >> 2) + 4 * (l >> 5), ct * 32 + (l & 31), v); }
        __syncthreads();
    }
}
struct SkBf16 { bf16* O; int ld; __device__ __forceinline__ void operator()(int row, int col, const float (&v)[1]) const { O[(size_t)row * ld + col] = (bf16)f2bf(v[0]); } };
struct SkF32 { float* O; int ld; __device__ __forceinline__ void operator()(int row, int col, const float (&v)[1]) const { O[(size_t)row * ld + col] = v[0]; } };
struct SkGlu { bf16* O; int ld; __device__ __forceinline__ void operator()(int row, int col, const float (&v)[2]) const { O[(size_t)row * ld + col] = (bf16)f2bf(v[0] * sigmoidf_(v[1])); } };

constexpr size_t B_XR = al256((size_t)MT * D * 2);
__device__ __forceinline__ void resid_norm_rows(Frame& F, const bf16* msrc, const float* w_post, const float* w_pre, int mode) {
    const int gw = GW_ID(F), NGW = GW_N(F), lane = F.lane;
    bf16* XN = (bf16*)(F.ws + WS_XN); bf16* XR = (bf16*)(F.ws + WS_BIG + B_XR);
    v2u pm[4]; f32x4 pxf[4]; v2u pxb[4];
#define RN_LOAD(r_) do { const GAS v2u* mr_ = (const GAS v2u*)(msrc + (size_t)(r_) * D) + lane; \
        _Pragma("unroll") for (int j = 0; j < 4; ++j) { pm[j] = mr_[64 * j]; if (mode == 0) pxf[j] = ((const GAS f32x4*)x_in_row(F, (r_)) + lane)[64 * j]; else pxb[j] = ((const GAS v2u*)(XR + (size_t)(r_) * D) + lane)[64 * j]; } } while (0)
    if (gw < MT) RN_LOAD(gw);
    for (int r = gw; r < MT; r += NGW) {
        f32x4 m[4], x[4]; float s = 0.f;
#pragma unroll
        for (int j = 0; j < 4; ++j) { const v2u mw = pm[j]; m[j] = (f32x4){bflo(mw.x), bfhi(mw.x), bflo(mw.y), bfhi(mw.y)};
            if (mode == 0) x[j] = pxf[j]; else { const v2u xw = pxb[j]; x[j] = (f32x4){bflo(xw.x), bfhi(xw.x), bflo(xw.y), bfhi(xw.y)}; }
            s += (m[j].x * m[j].x + m[j].y * m[j].y) + (m[j].z * m[j].z + m[j].w * m[j].w); }
        if (r + NGW < MT) RN_LOAD(r + NGW);
        const float rs = rsqrtf(wave_sum(s) * (1.f / D) + EPS); float s2 = 0.f;
#pragma unroll
        for (int j = 0; j < 4; ++j) { const f32x4 wp = ((const GAS f32x4*)w_post + lane)[64 * j]; x[j] = x[j] + m[j] * rs * wp;
            if (mode == 2) ((GAS f32x4*)x_res_row(F, r) + lane)[64 * j] = x[j];
            else { v2u o; o.x = pk2(x[j].x, x[j].y); o.y = pk2(x[j].z, x[j].w); ((GAS v2u*)(XR + (size_t)r * D) + lane)[64 * j] = o; }
            s2 += (x[j].x * x[j].x + x[j].y * x[j].y) + (x[j].z * x[j].z + x[j].w * x[j].w); }
        if (mode != 2) { const float rs2 = rsqrtf(wave_sum(s2) * (1.f / D) + EPS); GAS v2u* o8 = (GAS v2u*)(XN + (size_t)r * D) + lane;
#pragma unroll
            for (int j = 0; j < 4; ++j) { const f32x4 ww = ((const GAS f32x4*)w_pre + lane)[64 * j]; v2u o; o.x = pk2(x[j].x * rs2 * ww.x, x[j].y * rs2 * ww.y); o.y = pk2(x[j].z * rs2 * ww.z, x[j].w * rs2 * ww.w); o8[64 * j] = o; } }
    }
#undef RN_LOAD
}
__device__ __forceinline__ bf16* mixed_row(const Frame& F, int r) { return r < MP ? (bf16*)(F.out + O_YP) + (size_t)r * 2048 : (bf16*)(F.ws + WS_MIXS) + (size_t)(r - MP) * 2048; }
constexpr size_t B_HEAD = al256(B_ACT + (size_t)MT * FF * 2), B_TAIL = B_HEAD + (size_t)64 * 2 * FF2 * 4;
static_assert(B_TAIL + (size_t)64 * 2 * FF2 * 4 <= BIG_BYTES, "ffn side buffers");
__device__ __forceinline__ void ffn_fix_rows(Frame& F, int l, int pm) {
    const float* HEAD = (const float*)(F.ws + WS_BIG + B_HEAD); const float* TAIL = (const float*)(F.ws + WS_BIG + B_TAIL); bf16* ACT = (bf16*)(F.ws + WS_BIG + B_ACT);
    const float* cw = F.a->in[I_FCW] + (size_t)l * 3 * FF2; const float* cb = F.a->in[I_FCB] + (size_t)l * FF2;
    for (int c = F.tid; c < FF; c += NTHR) { float r0[2], r1[2];
#pragma unroll
        for (int x = 0; x < 2; ++x) { const int ch = x * FF + c; const float h0 = HEAD[((size_t)pm * 2) * FF2 + ch], h1 = HEAD[((size_t)pm * 2 + 1) * FF2 + ch];
            const float t0 = (pm & 7) ? TAIL[((size_t)(pm - 1) * 2) * FF2 + ch] : 0.f, t1 = (pm & 7) ? TAIL[((size_t)(pm - 1) * 2 + 1) * FF2 + ch] : 0.f;
            const float w0 = cw[ch], w1 = cw[FF2 + ch], w2 = cw[2 * FF2 + ch], bb = cb[ch];
            r0[x] = bb + w0 * t0 + w1 * t1 + w2 * h0; r1[x] = bb + w0 * t1 + w1 * h0 + w2 * h1; }
        ACT[(size_t)(256 * pm) * FF + c] = (bf16)f2bf(r0[0] * siluf_(r0[1])); ACT[(size_t)(256 * pm + 1) * FF + c] = (bf16)f2bf(r1[0] * siluf_(r1[1])); }
}
struct SkConvGate { bf16* ACTs; const float* cw; const float* cb; const float* st; float* sfc;
    __device__ __forceinline__ void operator()(int row, int col, const float (&v)[2]) const {
        const float* s0 = st + ((size_t)row * 2) * FF2; const float* s1 = s0 + FF2; float* p = sfc + (size_t)row * 2 * FF2; const int chv = col, chg = FF + col;
        const float v0 = s0[chv], v1 = s1[chv], g0 = s0[chg], g1 = s1[chg];
        const float vc = cb[chv] + cw[chv] * v0 + cw[FF2 + chv] * v1 + cw[2 * FF2 + chv] * v[0];
        const float gc = cb[chg] + cw[chg] * g0 + cw[FF2 + chg] * g1 + cw[2 * FF2 + chg] * v[1];
        ACTs[(size_t)row * FF + col] = (bf16)f2bf(vc * siluf_(gc)); p[chv] = v1; p[chg] = g1; p[FF2 + chv] = v[0]; p[FF2 + chg] = v[1]; } };

constexpr size_t B_HB = al256(B_PROJA + (size_t)MT * NA * 2);
static_assert(B_HB + (size_t)8 * 64 * 16 * 4096 * 2 <= BIG_BYTES, "ssd state buffer");
typedef float f32x2_t __attribute__((ext_vector_type(2)));

__device__ __forceinline__ void ssd_conv4(const Frame& F, const bf16* PA, int b, int t, int ch0, float (&out)[8][4]) {
    const float* cw = F.a->in[I_CONVW] + ch0; const float* cbias = F.a->in[I_CONVB] + ch0;
    float raw[7][8];
#pragma unroll
    for (int rr = 0; rr < 7; ++rr) { const int tt = t - 3 + rr;
        if (tt >= 0) { const v4u q = *(const GAS v4u*)(PA + (size_t)(b * SEQ + tt) * NA + 1024 + ch0);
            raw[rr][0] = bflo(q.x); raw[rr][1] = bfhi(q.x); raw[rr][2] = bflo(q.y); raw[rr][3] = bfhi(q.y); raw[rr][4] = bflo(q.z); raw[rr][5] = bfhi(q.z); raw[rr][6] = bflo(q.w); raw[rr][7] = bfhi(q.w); }
        else {
#pragma unroll
            for (int e = 0; e < 8; ++e) raw[rr][e] = 0.f; } }
    float w[4][8], bs[8];
#pragma unroll
    for (int k = 0; k < 4; ++k) { const f32x4 a = *(const GAS f32x4*)(cw + k * XBC), c = *(const GAS f32x4*)(cw + k * XBC + 4);
        w[k][0] = a.x; w[k][1] = a.y; w[k][2] = a.z; w[k][3] = a.w; w[k][4] = c.x; w[k][5] = c.y; w[k][6] = c.z; w[k][7] = c.w; }
    { const f32x4 a = *(const GAS f32x4*)cbias, c = *(const GAS f32x4*)(cbias + 4); bs[0] = a.x; bs[1] = a.y; bs[2] = a.z; bs[3] = a.w; bs[4] = c.x; bs[5] = c.y; bs[6] = c.z; bs[7] = c.w; }
#pragma unroll
    for (int e = 0; e < 8; ++e)
#pragma unroll
        for (int j = 0; j < 4; ++j) { float v = bs[e];
#pragma unroll
            for (int k = 0; k < 4; ++k) v += w[k][e] * raw[j + k][e];
            out[e][j] = siluf_(v); }
}

__device__ __forceinline__ void ssd_state_item(Frame& F, int b, int h) {
    const bf16* PA = (const bf16*)(F.ws + WS_BIG + B_PROJA); bf16* HB = (bf16*)(F.ws + WS_BIG + B_HB);
    constexpr int TP = 80, TBUF = 128 * TP;
    LAS unsigned char* T0 = F.lds; LAS float* WG = (LAS float*)(F.lds + 2 * TBUF); LAS float* DEC = WG + SEQ;
    int tid = F.tid; asm volatile("" : "+v"(tid));
    const int lane = tid & 63, wave = __builtin_amdgcn_readfirstlane(tid >> 6), g = h >> 3, r = lane & 31, hh = lane >> 5;
    { const float A = -__expf(F.a->in[I_ALOG][h]), dtb = F.a->in[I_DTB][h];
      float dt[4], cum[4]; float run = 0.f;
#pragma unroll
      for (int j = 0; j < 4; ++j) { dt[j] = softplusf_(bf2f(PA[(size_t)(b * SEQ + 4 * tid + j) * NA + 2304 + h]) + dtb); run += dt[j] * A; cum[j] = run; }
      float incl = run;
      const int ln_ = lane_op_();
#pragma unroll
      for (int off = 1; off < 8; off <<= 1) { const float v = shup_(incl, off, 8, ln_); if ((tid & 7) >= off) incl += v; }
      const float excl = incl - run, last = shidx_(incl, 7, 8, ln_);
#pragma unroll
      for (int j = 0; j < 4; ++j) WG[4 * tid + j] = dt[j] * __expf(last - (excl + cum[j]));
      if ((tid & 7) == 0) DEC[tid >> 3] = __expf(last); }
    __syncthreads();
    if (wave < 4) {
        const int o = tid >> 4, tp = tid & 15, ch0 = o < 8 ? h * 64 + 8 * o : 1024 + g * 64 + 8 * (o - 8);
        float w[4][8], bs[8];
        { const float* cw = F.a->in[I_CONVW] + ch0; const float* cbias = F.a->in[I_CONVB] + ch0;
#pragma unroll
          for (int k = 0; k < 4; ++k) { const f32x4 a = *(const GAS f32x4*)(cw + k * XBC), c4 = *(const GAS f32x4*)(cw + k * XBC + 4);
              w[k][0] = a.x; w[k][1] = a.y; w[k][2] = a.z; w[k][3] = a.w; w[k][4] = c4.x; w[k][5] = c4.y; w[k][6] = c4.z; w[k][7] = c4.w; }
          const f32x4 a = *(const GAS f32x4*)cbias, c4 = *(const GAS f32x4*)(cbias + 4); bs[0] = a.x; bs[1] = a.y; bs[2] = a.z; bs[3] = a.w; bs[4] = c4.x; bs[5] = c4.y; bs[6] = c4.z; bs[7] = c4.w; }
        const bf16* xrow = PA + (size_t)(b * SEQ + 2 * tp) * NA + 1024 + ch0;
        v4u pre[5];
#pragma unroll
        for (int k = 0; k < 5; ++k) { const int rr = 2 * tp - 3 + k < 0 ? 0 : 2 * tp - 3 + k; pre[k] = *(const GAS v4u*)(xrow + (ptrdiff_t)(rr - 2 * tp) * NA); }
        for (int c = 0; c < 64; ++c) {
            LAS unsigned char* T = T0 + (c & 1) * TBUF;
            v4u cur[5];
#pragma unroll
            for (int k = 0; k < 5; ++k) cur[k] = pre[k];
            if (c + 1 < 64) { const bf16* xn = xrow + (size_t)(32 * (c + 1)) * NA;
#pragma unroll
                for (int k = 0; k < 5; ++k) pre[k] = *(const GAS v4u*)(xn + (ptrdiff_t)(k - 3) * NA); }
            const f32x2_t wq = *(const LAS f32x2_t*)(WG + 32 * c + 2 * tp);
            const float w0 = o < 8 ? wq.x : 1.0f, w1 = o < 8 ? wq.y : 1.0f;
            float x8[5][8];
#pragma unroll
            for (int k = 0; k < 5; ++k) { const v4u qv = cur[k]; const float mk = (c == 0 && 2 * tp - 3 + k < 0) ? 0.f : 1.f;
                x8[k][0] = bflo(qv.x) * mk; x8[k][1] = bfhi(qv.x) * mk; x8[k][2] = bflo(qv.y) * mk; x8[k][3] = bfhi(qv.y) * mk; x8[k][4] = bflo(qv.z) * mk; x8[k][5] = bfhi(qv.z) * mk; x8[k][6] = bflo(qv.w) * mk; x8[k][7] = bfhi(qv.w) * mk; }
#pragma unroll
            for (int e = 0; e < 8; ++e) { float v0 = bs[e], v1 = bs[e];
#pragma unroll
                for (int k = 0; k < 4; ++k) { v0 += w[k][e] * x8[k][e]; v1 += w[k][e] * x8[k + 1][e]; }
                *(LAS unsigned*)(T + (8 * o + e) * TP + 4 * tp) = pk2(siluf_(v0) * w0, siluf_(v1) * w1); }
            asm volatile("s_waitcnt lgkmcnt(0)" ::: "memory"); __builtin_amdgcn_s_barrier(); asm volatile("" ::: "memory");
        }
    } else {
        f32x16 acc;
#pragma unroll
        for (int i = 0; i < 16; ++i) acc[i] = 0.f;
        const int q = wave - 4, pt = q >> 1, nt = q & 1;
        for (int c = 0; c < 64; ++c) {
            LAS unsigned char* T = T0 + (c & 1) * TBUF;
            bf16* hb = HB + ((((size_t)b * 64 + c) * 16 + h) * 64 + pt * 32) * 64 + nt * 32 + r;
#pragma unroll
            for (int i = 0; i < 16; ++i) hb[(size_t)((i & 3) + 8 * (i >> 2) + 4 * hh) * 64] = (bf16)f2bf(acc[i]);
            const float dec = DEC[c];
#pragma unroll
            for (int i = 0; i < 16; ++i) acc[i] *= dec;
            asm volatile("s_waitcnt lgkmcnt(0)" ::: "memory"); __builtin_amdgcn_s_barrier(); asm volatile("" ::: "memory");
#pragma unroll
            for (int ks = 0; ks < 2; ++ks) { const bf16x8 a = *(const LAS bf16x8*)(T + (pt * 32 + r) * TP + 32 * ks + 16 * hh), bb = *(const LAS bf16x8*)(T + (64 + nt * 32 + r) * TP + 32 * ks + 16 * hh);
                acc = __builtin_amdgcn_mfma_f32_32x32x16_bf16(a, bb, acc, 0, 0, 0); }
        }
        float* ps = F.out + O_PSSM + ((size_t)(b * 16 + h) * 64 + pt * 32) * 64 + nt * 32 + r;
#pragma unroll
        for (int i = 0; i < 16; ++i) ps[(size_t)((i & 3) + 8 * (i >> 2) + 4 * hh) * 64] = acc[i];
    }
    { float* pc = F.out + O_PSCONV + (size_t)b * 3 * XBC;
      for (int e = tid; e < 3 * 192; e += NTHR) { const int k = e / 192, cc = e % 192; if (cc >= 64 && (h & 7) != 0) continue;
          const int ch = cc < 64 ? h * 64 + cc : (cc < 128 ? 1024 + g * 64 + (cc - 64) : 1152 + g * 64 + (cc - 128));
          pc[k * XBC + ch] = bf2f(PA[(size_t)(b * SEQ + SEQ - 3 + k) * NA + 1024 + ch]); } }
    __syncthreads();
}

__device__ __forceinline__ void ssd_sample_item(Frame& F, int j) {
    const bf16* PA = (const bf16*)(F.ws + WS_BIG + B_PROJA) + (size_t)(MP + j) * NA; bf16* MX = (bf16*)(F.ws + WS_MIXS) + (size_t)j * 2048;
    LAS float* act = (LAS float*)F.lds;
    LAS float* dts = act + XBC;
    LAS float* y2 = dts + 32;
    LAS float* red = y2 + 1024;
    const int tid = F.tid;
    const float* cw = F.a->in[I_CONVW]; const float* cbias = F.a->in[I_CONVB]; const float* st = F.a->in[I_SSCONV] + (size_t)j * 3 * XBC; float* so = F.out + O_SSCONV + (size_t)j * 3 * XBC;
    for (int ch = tid; ch < XBC; ch += NTHR) { const float nw = bf2f(PA[1024 + ch]); const float s0 = st[ch], s1 = st[XBC + ch], s2 = st[2 * XBC + ch];
        act[ch] = siluf_(cbias[ch] + cw[ch] * s0 + cw[XBC + ch] * s1 + cw[2 * XBC + ch] * s2 + cw[3 * XBC + ch] * nw);
        so[ch] = s1; so[XBC + ch] = s2; so[2 * XBC + ch] = nw; }
    if (tid < 16) { const float d = softplusf_(bf2f(PA[2304 + tid]) + F.a->in[I_DTB][tid]); dts[tid] = d; dts[16 + tid] = __expf(-__expf(F.a->in[I_ALOG][tid]) * d); }
    __syncthreads();
    const float* S0 = F.a->in[I_SSSM] + (size_t)j * 65536; float* S1 = F.out + O_SSSM + (size_t)j * 65536;
    float ssq = 0.f;
#pragma unroll 1
    for (int it8 = 0; it8 < 4; ++it8) { f32x4 sv[8];
#pragma unroll
      for (int u = 0; u < 8; ++u) sv[u] = *(const GAS f32x4*)(S0 + (size_t)((it8 * 8 + u) * NTHR + tid) * 4);
#pragma unroll
      for (int u = 0; u < 8; ++u) { const int it = it8 * 8 + u; const int v = it * NTHR + tid, n4 = v & 15, p = (v >> 4) & 63, h = v >> 10, g = h >> 3;
        const f32x4 s = sv[u];
        const f32x4 bb = *(const LAS f32x4*)(act + 1024 + g * 64 + 4 * n4), cc = *(const LAS f32x4*)(act + 1152 + g * 64 + 4 * n4);
        const float x = act[h * 64 + p], dtx = dts[h] * x, dec = dts[16 + h];
        f32x4 nn; float a = 0.f;
#pragma unroll
        for (int i = 0; i < 4; ++i) { nn[i] = dec * s[i] + dtx * bb[i]; a += nn[i] * cc[i]; }
        *(GAS f32x4*)(S1 + (size_t)v * 4) = nn;
        a = row16_sum(a);
        if (n4 == 0) { const float yy = (a + F.a->in[I_SSMD][h] * x) * siluf_(bf2f(PA[h * 64 + p])); y2[h * 64 + p] = yy; ssq += yy * yy; } } }
    ssq = wave_sum(ssq); if (F.lane == 0) red[F.wave] = ssq;
    __syncthreads();
    float tot = 0.f;
#pragma unroll
    for (int w = 0; w < 8; ++w) tot += red[w];
    const float rs = rsqrtf(tot * (1.f / D) + EPS);
    for (int c = tid; c < 1024; c += NTHR) MX[c] = (bf16)f2bf(y2[c] * rs * F.a->in[I_SSMNW][c]);
    __syncthreads();
}
__device__ __forceinline__ void ssd_state_phase(Frame& F) {
    for (int it = F.vcu; it < 128 + MS; it += F.G) { if (it < 128) ssd_state_item(F, it >> 4, it & 15); else ssd_sample_item(F, it - 128); }
    PSEG_B(5, F.lds);
    if (F.G > 128 && F.vcu >= 128) { __syncthreads(); wconv_items(F, WC_EARLY, WC_ALL, (F.vcu - 128) * NWAVES + F.wave, (F.G - 128) * NWAVES); }
    PSEG_E(5, F.lds);
}

__device__ __forceinline__ void ssd_rows7(const bf16* PA, int b, int t, int ch0, v4u (&rw)[7]) {
#pragma unroll
    for (int rr = 0; rr < 7; ++rr) { const int tt = t - 3 + rr < 0 ? 0 : t - 3 + rr; rw[rr] = *(const GAS v4u*)(PA + (size_t)(b * SEQ + tt) * NA + 1024 + ch0); }
}
__device__ __forceinline__ void ssd_conv4_lds(const v4u (&rw)[7], const LAS float* CWL, int t, int ch0, float (&out)[8][4]) {
    float raw[7][8];
#pragma unroll
    for (int rr = 0; rr < 7; ++rr) { const v4u q = rw[rr]; const float mk = (t - 3 + rr >= 0) ? 1.f : 0.f;
        raw[rr][0] = bflo(q.x) * mk; raw[rr][1] = bfhi(q.x) * mk; raw[rr][2] = bflo(q.y) * mk; raw[rr][3] = bfhi(q.y) * mk; raw[rr][4] = bflo(q.z) * mk; raw[rr][5] = bfhi(q.z) * mk; raw[rr][6] = bflo(q.w) * mk; raw[rr][7] = bfhi(q.w) * mk; }
    float w[4][8], bs[8];
#pragma unroll
    for (int k = 0; k < 5; ++k) { const f32x4 a = *(const LAS f32x4*)(CWL + k * XBC + ch0), c = *(const LAS f32x4*)(CWL + k * XBC + ch0 + 4);
        if (k < 4) { w[k < 4 ? k : 0][0] = a.x; w[k < 4 ? k : 0][1] = a.y; w[k < 4 ? k : 0][2] = a.z; w[k < 4 ? k : 0][3] = a.w; w[k < 4 ? k : 0][4] = c.x; w[k < 4 ? k : 0][5] = c.y; w[k < 4 ? k : 0][6] = c.z; w[k < 4 ? k : 0][7] = c.w; }
        else { bs[0] = a.x; bs[1] = a.y; bs[2] = a.z; bs[3] = a.w; bs[4] = c.x; bs[5] = c.y; bs[6] = c.z; bs[7] = c.w; } }
#pragma unroll
    for (int e = 0; e < 8; ++e)
#pragma unroll
        for (int j = 0; j < 4; ++j) { float v = bs[e];
#pragma unroll
            for (int k = 0; k < 4; ++k) v += w[k][e] * raw[j + k][e];
            out[e][j] = siluf_(v); }
}
constexpr int SSDO_CWL = 16 * 64 * 80 + 2 * (2 * 32 * 144) + (512 + 512 + 256) * 4;
static_assert(SSDO_CWL + 5 * XBC * 4 <= RING_BYTES, "ssd_out LDS map");
__device__ __forceinline__ void ssd_out_item(Frame& F, int b, int c) {
    const bf16* PA = (const bf16*)(F.ws + WS_BIG + B_PROJA); const bf16* HB = (const bf16*)(F.ws + WS_BIG + B_HB);
    constexpr int XP_ = 80, BP_ = 144;
    LAS unsigned char* XT = F.lds;
    LAS unsigned char* BS = XT + 16 * 64 * XP_;
    LAS unsigned char* CS = BS + 2 * 32 * BP_;
    LAS float* DT = (LAS float*)(CS + 2 * 32 * BP_);
    LAS float* CUM = DT + 512;
    LAS float* SSQ = CUM + 512;
    const LAS float* CWL = (const LAS float*)(F.lds + SSDO_CWL);
    int tid = F.tid; asm volatile("" : "+v"(tid));
    const int t0 = 32 * c;
    v4u zq[8];
#pragma unroll
    for (int q = 0; q < 8; ++q) zq[q] = *(const GAS v4u*)(PA + (size_t)(b * SEQ + t0 + (tid >> 7) + 4 * q) * NA + 8 * (tid & 127));
    v4u rwn[7]; ssd_rows7(PA, b, t0 + 4 * (tid & 7), 8 * (tid >> 3), rwn);
#pragma unroll 1
    for (int task = tid; task < 160 * 8; task += NTHR) { const int o = task >> 3, run = task & 7;
        v4u rwc[7];
#pragma unroll
        for (int rr = 0; rr < 7; ++rr) rwc[rr] = rwn[rr];
        if (task + NTHR < 160 * 8) ssd_rows7(PA, b, t0 + 4 * ((task + NTHR) & 7), 8 * ((task + NTHR) >> 3), rwn);
        float act[8][4]; ssd_conv4_lds(rwc, CWL, t0 + 4 * run, 8 * o, act);
        if (o < 128) { const int h = o >> 3, p0 = (o & 7) * 8;
#pragma unroll
            for (int e = 0; e < 8; ++e) { v2u pk; pk.x = pk2(act[e][0], act[e][1]); pk.y = pk2(act[e][2], act[e][3]); *(LAS v2u*)(XT + (h * 64 + p0 + e) * XP_ + 8 * run) = pk; } }
        else { const int oo = o - 128, isC = oo >> 4, g = (oo >> 3) & 1, n0 = (oo & 7) * 8; LAS unsigned char* dst = (isC ? CS : BS) + g * 32 * BP_;
#pragma unroll
            for (int jx = 0; jx < 4; ++jx) { v4u pk; pk.x = pk2(act[0][jx], act[1][jx]); pk.y = pk2(act[2][jx], act[3][jx]); pk.z = pk2(act[4][jx], act[5][jx]); pk.w = pk2(act[6][jx], act[7][jx]);
                *(LAS v4u*)(dst + (4 * run + jx) * BP_ + 2 * n0) = pk; } }
    }
    { const int h = tid >> 5, t = tid & 31;
      const float dt = softplusf_(bf2f(PA[(size_t)(b * SEQ + t0 + t) * NA + 2304 + h]) + F.a->in[I_DTB][h]);
      float cum = -__expf(F.a->in[I_ALOG][h]) * dt;
      const int ln_ = lane_op_();
#pragma unroll
      for (int off = 1; off < 32; off <<= 1) { const float v = shup_(cum, off, 32, ln_); if (t >= off) cum += v; }
      DT[tid] = dt; CUM[tid] = cum; }
    __syncthreads();
    asm volatile("" : "+v"(tid));
    const int lane = tid & 63, wave = __builtin_amdgcn_readfirstlane(tid >> 6), r = lane & 31, hh = lane >> 5;
    const int g = wave >> 2;
    f32x16 gt;
#pragma unroll
    for (int i = 0; i < 16; ++i) gt[i] = 0.f;
#pragma unroll
    for (int ks = 0; ks < 4; ++ks) { const bf16x8 a = *(const LAS bf16x8*)(BS + (g * 32 + r) * BP_ + 32 * ks + 16 * hh), bb = *(const LAS bf16x8*)(CS + (g * 32 + r) * BP_ + 32 * ks + 16 * hh);
        gt = __builtin_amdgcn_mfma_f32_32x32x16_bf16(a, bb, gt, 0, 0, 0); }
#pragma unroll 1
    for (int hi = 0; hi < 2; ++hi) { const int h = 2 * wave + hi;
        bf16x8 hbf[2][4];
        { const bf16* hb0 = HB + ((((size_t)b * 64 + c) * 16 + h) * 64 + r) * 64 + 8 * hh;
#pragma unroll
          for (int pt = 0; pt < 2; ++pt)
#pragma unroll
              for (int ks = 0; ks < 4; ++ks) hbf[pt][ks] = *(const GAS bf16x8*)(hb0 + (size_t)pt * 32 * 64 + 16 * ks); }
        const float cum_t = CUM[h * 32 + r];
        bf16x8 am[2];
#pragma unroll
        for (int ks = 0; ks < 2; ++ks) { unsigned mf[4];
#pragma unroll
            for (int i2 = 0; i2 < 4; ++i2) { float m2[2];
#pragma unroll
                for (int q = 0; q < 2; ++q) { const int i = 8 * ks + 2 * i2 + q, s = (i & 3) + 8 * (i >> 2) + 4 * hh;
                    const float e_ = gt[i] * __expf(fminf(cum_t - CUM[h * 32 + s], 0.f)) * DT[h * 32 + s]; m2[q] = s <= r ? e_ : 0.f; }
                mf[i2] = pk2(m2[0], m2[1]); }
            v4u t4; t4.x = mf[0]; t4.y = mf[1]; t4.z = mf[2]; t4.w = mf[3]; am[ks] = __builtin_bit_cast(bf16x8, t4); }
        const float dsk = F.a->in[I_SSMD][h];
        f32x16 yv[2];
#pragma unroll
        for (int pt = 0; pt < 2; ++pt) {
            f32x16 yi;
#pragma unroll
            for (int i = 0; i < 16; ++i) { yv[pt][i] = 0.f; yi[i] = 0.f; }
            const LAS unsigned char* xrow = XT + (h * 64 + pt * 32 + r) * XP_;
#pragma unroll
            for (int ks = 0; ks < 2; ++ks) { const v2u lo = *(const LAS v2u*)(xrow + 2 * (16 * ks + 4 * hh)), hi2 = *(const LAS v2u*)(xrow + 2 * (16 * ks + 8 + 4 * hh));
                v4u t4; t4.x = lo.x; t4.y = lo.y; t4.z = hi2.x; t4.w = hi2.y;
                yv[pt] = __builtin_amdgcn_mfma_f32_32x32x16_bf16(am[ks], __builtin_bit_cast(bf16x8, t4), yv[pt], 0, 0, 0); }
#pragma unroll
            for (int ks = 0; ks < 4; ++ks) { const bf16x8 a = *(const LAS bf16x8*)(CS + (g * 32 + r) * BP_ + 32 * ks + 16 * hh), bb = hbf[pt][ks];
                yi = __builtin_amdgcn_mfma_f32_32x32x16_bf16(a, bb, yi, 0, 0, 0); }
#pragma unroll
            for (int i4 = 0; i4 < 4; ++i4) { const int tb = 8 * i4 + 4 * hh; const v2u xv = *(const LAS v2u*)(xrow + 2 * tb);
                const float xs[4] = {bflo(xv.x), bfhi(xv.x), bflo(xv.y), bfhi(xv.y)};
#pragma unroll
                for (int q = 0; q < 4; ++q) { const int i = 4 * i4 + q, t = tb + q; yv[pt][i] = yv[pt][i] + __expf(CUM[h * 32 + t]) * yi[i] + dsk * xs[q]; } }
        }
        LAS unsigned char* yb = XT + h * 64 * XP_;
#pragma unroll
        for (int pt = 0; pt < 2; ++pt)
#pragma unroll
            for (int i = 0; i < 16; ++i) { const int t = (i & 3) + 8 * (i >> 2) + 4 * hh; *(LAS unsigned short*)(yb + t * 128 + 2 * (pt * 32 + r)) = (unsigned short)f2bf(yv[pt][i]); }
    }
    __syncthreads();
    { const int c8 = (tid & 127) * 8, h = c8 >> 6, pp = c8 & 63; float gv[8][8], ss[8];
#pragma unroll
      for (int q = 0; q < 8; ++q) { const int t = (tid >> 7) + 4 * q; const v4u yq = *(const LAS v4u*)(XT + h * 64 * XP_ + t * 128 + 2 * pp); const v4u z = zq[q];
          gv[q][0] = bflo(yq.x) * siluf_(bflo(z.x)); gv[q][1] = bfhi(yq.x) * siluf_(bfhi(z.x)); gv[q][2] = bflo(yq.y) * siluf_(bflo(z.y)); gv[q][3] = bfhi(yq.y) * siluf_(bfhi(z.y));
          gv[q][4] = bflo(yq.z) * siluf_(bflo(z.z)); gv[q][5] = bfhi(yq.z) * siluf_(bfhi(z.z)); gv[q][6] = bflo(yq.w) * siluf_(bflo(z.w)); gv[q][7] = bfhi(yq.w) * siluf_(bfhi(z.w));
          float a = 0.f;
#pragma unroll
          for (int e = 0; e < 8; ++e) a += gv[q][e] * gv[q][e];
          ss[q] = wave_sum(a); }
      if ((tid & 63) == 0) {
#pragma unroll
          for (int q = 0; q < 8; ++q) SSQ[(tid >> 6) * 8 + q] = ss[q]; }
      __syncthreads();
      const f32x4 w0 = *(const GAS f32x4*)(F.a->in[I_SSMNW] + c8), w1 = *(const GAS f32x4*)(F.a->in[I_SSMNW] + c8 + 4);
      bf16* MX = (bf16*)(F.out + O_YP) + (size_t)(b * SEQ + t0) * 2048;
#pragma unroll
      for (int q = 0; q < 8; ++q) { const int t = (tid >> 7) + 4 * q; const float rs = rsqrtf((SSQ[((tid >> 7) * 2) * 8 + q] + SSQ[((tid >> 7) * 2 + 1) * 8 + q]) * (1.f / D) + EPS);
          v4u o; o.x = pk2(gv[q][0] * rs * w0.x, gv[q][1] * rs * w0.y); o.y = pk2(gv[q][2] * rs * w0.z, gv[q][3] * rs * w0.w); o.z = pk2(gv[q][4] * rs * w1.x, gv[q][5] * rs * w1.y); o.w = pk2(gv[q][6] * rs * w1.z, gv[q][7] * rs * w1.w);
          *(GAS v4u*)(MX + (size_t)t * 2048 + c8) = o; } }
    __syncthreads();
}
__device__ __forceinline__ void ssd_out_phase(Frame& F) {
    { LAS float* CWL = (LAS float*)(F.lds + SSDO_CWL);
      for (int e = F.tid; e < 5 * XBC; e += NTHR) CWL[e] = e < 4 * XBC ? F.a->in[I_CONVW][e] : F.a->in[I_CONVB][e - 4 * XBC]; }
    __syncthreads();
    for (int it = F.vcu; it < 8 * 64; it += F.G) ssd_out_item(F, it >> 6, it & 63);
}

constexpr size_t B_SB = 0;
static_assert(B_SB + (size_t)8 * 16 * 8 * 16384 * 2 <= B_PROJB, "hgrn state buffer");
__device__ __forceinline__ float hg_lb(const Frame& F, int c) { return __builtin_amdgcn_rcpf(1.f + __expf(F.a->in[I_HGLB][1024 + c] - F.a->in[I_HGLB][c])); }

__device__ __forceinline__ void hg_state_item(Frame& F, int b, int h, int vq, int sj, int sh) {
    const bf16* PB = (const bf16*)(F.ws + WS_BIG + B_PROJB); bf16* SB = (bf16*)(F.ws + WS_BIG + B_SB);
    constexpr int KP = 272;
    LAS unsigned char* KT0 = F.lds;
    LAS unsigned char* VT0 = KT0 + 2 * 128 * KP;
    LAS unsigned char* RAW = VT0 + 2 * 32 * KP;
    LAS float* EL = (LAS float*)(RAW + 128 * KP);
    LAS float* SEG = EL + 256;
    int tid = F.tid; asm volatile("" : "+v"(tid));
    const int lane = tid & 63, wave = __builtin_amdgcn_readfirstlane(tid >> 6), r = lane & 31, hh = lane >> 5;
    const int kcol = tid & 127, seg = tid >> 7;
    const float lb = hg_lb(F, h * 128 + kcol);
    const int vs = tid >> 2, voc = tid & 3;
    const bf16* fsrc = PB + (size_t)(b * SEQ + (tid >> 4)) * NBH + 1024 + h * 128 + 8 * (tid & 15);
    const bf16* vsrc = PB + (size_t)(b * SEQ + vs) * NBH + 2048 + h * 128 + vq * 32 + 8 * voc;
    v4u pf[4], pv;
#pragma unroll
    for (int q = 0; q < 4; ++q) pf[q] = *(const GAS v4u*)(fsrc + (size_t)(32 * q) * NBH);
    pv = *(const GAS v4u*)vsrc;
    LAS float* SM = (LAS float*)(F.lds + HALO_OFF); LAS float* OW = SM + 1024; LAS float* OH = OW + 1024;
    const bf16* PS = PB + (size_t)(MP + sj) * NBH + 512 * sh;
    const float* S0 = F.a->in[I_SHG] + (size_t)sj * 131072 + (size_t)sh * 65536; float* S1 = F.out + O_SHG + (size_t)sj * 131072 + (size_t)sh * 65536;
    const int ln_ = lane_op_();
    f32x4 oacc = {0.f, 0.f, 0.f, 0.f};
    const int kt = wave - 4;
    f32x16 acc;
#pragma unroll
    for (int i = 0; i < 16; ++i) acc[i] = 0.f;
#pragma unroll 1
    for (int cc = 0; cc < 16; ++cc) {
        LAS unsigned char* KT = KT0 + (cc & 1) * 128 * KP; LAS unsigned char* VT = VT0 + (cc & 1) * 32 * KP;
        const int hl = cc >> 2, si0 = cc * 1024 + tid, si1 = si0 + 512;
        const f32x4 sv0 = *(const GAS f32x4*)(S0 + (size_t)si0 * 4), sv1 = *(const GAS f32x4*)(S0 + (size_t)si1 * 4);
        if ((cc & 3) == 0 && tid < 128) { LAS float* sm = SM + (hl & 1) * 512; const int c = hl * 128 + tid; const float lbs = hg_lb(F, 512 * sh + c), sg = sigmoidf_(bf2f(PS[1024 + c]));
            sm[tid] = lbs + (1.f - lbs) * sg; sm[128 + tid] = (1.f - lbs) * (1.f - sg); sm[256 + tid] = siluf_(bf2f(PS[c])); sm[384 + tid] = bf2f(PS[2048 + c]); }
#pragma unroll
        for (int q = 0; q < 4; ++q) *(LAS v4u*)(RAW + ((tid >> 4) + 32 * q) * KP + 16 * (tid & 15)) = pf[q];
        { const unsigned ww[4] = {pv.x, pv.y, pv.z, pv.w};
#pragma unroll
          for (int e = 0; e < 4; ++e) { *(LAS unsigned short*)(VT + (8 * voc + 2 * e) * KP + 2 * vs) = (unsigned short)(ww[e] & 0xffffu); *(LAS unsigned short*)(VT + (8 * voc + 2 * e + 1) * KP + 2 * vs) = (unsigned short)(ww[e] >> 16); } }
        if (cc + 1 < 16) {
#pragma unroll
            for (int q = 0; q < 4; ++q) pf[q] = *(const GAS v4u*)(fsrc + (size_t)(128 * (cc + 1) + 32 * q) * NBH);
            pv = *(const GAS v4u*)(vsrc + (size_t)(128 * (cc + 1)) * NBH); }
        if (wave >= 4) {
            bf16* sb = SB + ((((size_t)b * 16 + cc) * 8 + h) * 128 + vq * 32) * 128 + kt * 32 + r;
#pragma unroll
            for (int i = 0; i < 16; ++i) sb[(size_t)((i & 3) + 8 * (i >> 2) + 4 * hh) * 128] = (bf16)f2bf(acc[i]); }
        asm volatile("s_waitcnt lgkmcnt(0)" ::: "memory"); __builtin_amdgcn_s_barrier(); asm volatile("" ::: "memory");
        float kp[32];
        { float run = 1.f;
#pragma unroll
          for (int j = 31; j >= 0; --j) { const float sg = sigmoidf_(bf2f(*(const LAS unsigned short*)(RAW + (32 * seg + j) * KP + 2 * kcol))); kp[j] = (1.f - lb) * (1.f - sg) * run; run *= lb + (1.f - lb) * sg; }
          SEG[seg * 128 + kcol] = run; }
        asm volatile("s_waitcnt lgkmcnt(0)" ::: "memory"); __builtin_amdgcn_s_barrier(); asm volatile("" ::: "memory");
        { const float t0 = SEG[kcol], t1 = SEG[128 + kcol], t2 = SEG[256 + kcol], t3 = SEG[384 + kcol];
          const float R = seg == 3 ? 1.f : (seg == 2 ? t3 : (seg == 1 ? t2 * t3 : t1 * t2 * t3));
          if (seg == 0) EL[(cc & 1) * 128 + kcol] = (t0 * t1) * (t2 * t3);
#pragma unroll
          for (int j8 = 0; j8 < 4; ++j8) { v4u p;
              p.x = pk2(kp[8 * j8] * R, kp[8 * j8 + 1] * R); p.y = pk2(kp[8 * j8 + 2] * R, kp[8 * j8 + 3] * R); p.z = pk2(kp[8 * j8 + 4] * R, kp[8 * j8 + 5] * R); p.w = pk2(kp[8 * j8 + 6] * R, kp[8 * j8 + 7] * R);
              *(LAS v4u*)(KT + kcol * KP + 2 * (32 * seg + 8 * j8)) = p; } }
        asm volatile("s_waitcnt lgkmcnt(0)" ::: "memory"); __builtin_amdgcn_s_barrier(); asm volatile("" ::: "memory");
        if (wave >= 4) {
            const float el = EL[(cc & 1) * 128 + kt * 32 + r];
#pragma unroll
            for (int i = 0; i < 16; ++i) acc[i] *= el;
#pragma unroll
            for (int ks = 0; ks < 8; ++ks) { const bf16x8 a = *(const LAS bf16x8*)(VT + r * KP + 32 * ks + 16 * hh), bb = *(const LAS bf16x8*)(KT + (kt * 32 + r) * KP + 32 * ks + 16 * hh);
                acc = __builtin_amdgcn_mfma_f32_32x32x16_bf16(a, bb, acc, 0, 0, 0); }
        }
        { const LAS float* sm = SM + (hl & 1) * 512; const int v4 = (tid & 31) * 4; const f32x4 vv = *(const LAS f32x4*)(sm + 384 + v4);
          const int k0 = (si0 >> 5) & 127, k1 = (si1 >> 5) & 127;
          const f32x4 n0 = sv0 * sm[k0] + vv * sm[128 + k0], n1 = sv1 * sm[k1] + vv * sm[128 + k1];
          *(GAS f32x4*)(S1 + (size_t)si0 * 4) = n0; *(GAS f32x4*)(S1 + (size_t)si1 * 4) = n1;
          oacc += n0 * sm[256 + k0] + n1 * sm[256 + k1];
          if ((cc & 3) == 3) {
              f32x4 t; t[0] = oacc[0] + shx_(oacc[0], 32, ln_); t[1] = oacc[1] + shx_(oacc[1], 32, ln_); t[2] = oacc[2] + shx_(oacc[2], 32, ln_); t[3] = oacc[3] + shx_(oacc[3], 32, ln_);
              if (lane < 32) *(LAS f32x4*)(OW + wave * 128 + v4) = t;
              oacc = (f32x4){0.f, 0.f, 0.f, 0.f}; } }
        if ((cc & 3) == 0 && cc > 0 && tid < 128) { float o = 0.f;
#pragma unroll
            for (int w = 0; w < 8; ++w) o += OW[w * 128 + tid];
            OH[(hl - 1) * 128 + tid] = o; }
    }
    __syncthreads();
    if (tid < 128) { float o = 0.f;
#pragma unroll
        for (int w = 0; w < 8; ++w) o += OW[w * 128 + tid];
        OH[3 * 128 + tid] = o; }
    __syncthreads();
    { const int c = tid; const float o = OH[c]; const float ss = wave_sum(o * o); if (lane == 0) SM[wave] = ss;
      __syncthreads();
      const float rs = rsqrtf((SM[(tid >> 7) * 2] + SM[(tid >> 7) * 2 + 1]) * (1.f / 128.f) + EPS);
      ((bf16*)(F.ws + WS_MIXS) + (size_t)sj * 2048 + 1024 + 512 * sh)[c] = (bf16)f2bf(o * rs * F.a->in[I_HGNW][c & 127] * siluf_(bf2f(PS[3072 + c]))); }
    if (wave >= 4) { float* ps = F.out + O_PHG + ((size_t)(b * 8 + h) * 128 + kt * 32 + r) * 128 + vq * 32;
#pragma unroll
        for (int i = 0; i < 16; ++i) ps[(i & 3) + 8 * (i >> 2) + 4 * hh] = acc[i]; }
    __syncthreads();
}

__device__ __forceinline__ void hg_out_phase(Frame& F) {
    const bf16* PB = (const bf16*)(F.ws + WS_BIG + B_PROJB); const bf16* SB = (const bf16*)(F.ws + WS_BIG + B_SB);
    constexpr int KP = 272, SP = 80, OP = 528;
    LAS unsigned char* QH = F.lds;
    LAS unsigned char* Q1 = QH + 32 * KP;
    LAS unsigned char* KA = Q1 + 16 * KP;
    LAS unsigned char* KB = KA + 16 * KP;
    LAS unsigned char* KHT = KB + 32 * KP;
    LAS unsigned char* VT = KHT + 128 * SP;
    LAS float* CSEG = (LAS float*)(VT + 128 * SP);
    LAS float* EL = CSEG + 512;
    LAS float* SSQ = EL + 128;
    LAS unsigned char* OF = (LAS unsigned char*)(SSQ + 256);
    LAS unsigned char* RQ = OF + 32 * OP;
    LAS unsigned char* RF = RQ + 32 * KP;
    int tid = F.tid; asm volatile("" : "+v"(tid));
    const int lane = tid & 63, wave = __builtin_amdgcn_readfirstlane(tid >> 6), fr = lane & 15, q4 = lane >> 4;
    const int kcol = tid & 127, seg = tid >> 7;
    const int NITEM = 8 * 16 * 8;
    const int nit = F.vcu < NITEM ? (NITEM - 1 - F.vcu) / F.G + 1 : 0, NIT = 4 * nit;
    v4u pq, pf, pv, pg;
#define HG_ROW0(n) ((((F.vcu + ((n) >> 2) * F.G) >> 7) * SEQ) + 128 * (((F.vcu + ((n) >> 2) * F.G) >> 3) & 15) + 32 * ((n) & 3))
#define HG_HEAD(n) ((F.vcu + ((n) >> 2) * F.G) & 7)
#define HG_PREFETCH(n) do { const int T0_ = HG_ROW0(n), h_ = HG_HEAD(n); const bf16* rp_ = PB + (size_t)(T0_ + (tid >> 4)) * NBH + h_ * 128 + 8 * (tid & 15); \
        pq = *(const GAS v4u*)rp_; pf = *(const GAS v4u*)(rp_ + 1024); pv = *(const GAS v4u*)(rp_ + 2048); pg = *(const GAS v4u*)(rp_ + 3072); } while (0)
    if (NIT > 0) HG_PREFETCH(0);
    f32x4 S[8]; v2u psb[8];
    float lb = 0.f;
#pragma unroll 1
    for (int n = 0; n < NIT; ++n) {
        const int item = F.vcu + (n >> 2) * F.G, b = item >> 7, cc = (item >> 3) & 15, h = item & 7, fc = n & 3;
        const int T0 = b * SEQ + 128 * cc + 32 * fc;
        const v4u vv = pv, gv = pg;
        *(LAS v4u*)(RQ + (tid >> 4) * KP + 16 * (tid & 15)) = pq; *(LAS v4u*)(RF + (tid >> 4) * KP + 16 * (tid & 15)) = pf;
        if (n + 1 < NIT) HG_PREFETCH(n + 1);
        if (fc == 0) {
            lb = hg_lb(F, h * 128 + kcol);
            if (n == 0) { const bf16* sb = SB + ((((size_t)b * 16 + cc) * 8 + h) * 128 + 16 * wave + fr) * 128 + 4 * q4;
#pragma unroll
                for (int kt = 0; kt < 8; ++kt) psb[kt] = *(const GAS v2u*)(sb + 16 * kt); }
#pragma unroll
            for (int kt = 0; kt < 8; ++kt) { const v2u u = psb[kt]; S[kt][0] = bflo(u.x); S[kt][1] = bfhi(u.x); S[kt][2] = bflo(u.y); S[kt][3] = bfhi(u.y); } }
        if (fc == 3 && n + 1 < NIT) { const int it2 = F.vcu + ((n + 1) >> 2) * F.G; const bf16* sb = SB + ((((size_t)(it2 >> 7) * 16 + ((it2 >> 3) & 15)) * 8 + (it2 & 7)) * 128 + 16 * wave + fr) * 128 + 4 * q4;
#pragma unroll
            for (int kt = 0; kt < 8; ++kt) psb[kt] = *(const GAS v2u*)(sb + 16 * kt); }
        asm volatile("s_waitcnt lgkmcnt(0)" ::: "memory"); __builtin_amdgcn_s_barrier(); asm volatile("" ::: "memory");
        float cl[8], kk[8], qs[8];
        { float a = 0.f;
#pragma unroll
          for (int j = 0; j < 8; ++j) { const float sg = sigmoidf_(bf2f(*(const LAS unsigned short*)(RF + (8 * seg + j) * KP + 2 * kcol)));
              a += __logf(lb + (1.f - lb) * sg); cl[j] = a; kk[j] = (1.f - lb) * (1.f - sg); qs[j] = siluf_(bf2f(*(const LAS unsigned short*)(RQ + (8 * seg + j) * KP + 2 * kcol))); }
          CSEG[seg * 128 + kcol] = a; }
        { const int s = tid >> 4, oc = tid & 15; const unsigned ww[4] = {vv.x, vv.y, vv.z, vv.w};
#pragma unroll
          for (int e = 0; e < 4; ++e) { *(LAS unsigned short*)(VT + (8 * oc + 2 * e) * SP + 2 * s) = (unsigned short)(ww[e] & 0xffffu); *(LAS unsigned short*)(VT + (8 * oc + 2 * e + 1) * SP + 2 * s) = (unsigned short)(ww[e] >> 16); } }
        asm volatile("s_waitcnt lgkmcnt(0)" ::: "memory"); __builtin_amdgcn_s_barrier(); asm volatile("" ::: "memory");
        { const float t0 = CSEG[kcol], t1 = CSEG[128 + kcol], t2 = CSEG[256 + kcol], t3 = CSEG[384 + kcol];
          const float off = seg == 0 ? 0.f : (seg == 1 ? t0 : (seg == 2 ? t0 + t1 : t0 + t1 + t2)), c15 = t0 + t1, last = (t0 + t1) + (t2 + t3);
          const float el = __expf(last), ec15 = __expf(c15), el15 = __expf(last - c15);
          if (seg == 0) EL[kcol] = el;
#pragma unroll
          for (int j = 0; j < 8; ++j) { const int t = 8 * seg + j; const float cum = off + cl[j];
              const float e = __expf(seg >= 2 ? cum - c15 : cum), ri = __builtin_amdgcn_rcpf(fmaxf(e, 1.8e-35f)), kr = kk[j] * ri;
              if (seg >= 2) { *(LAS unsigned short*)(Q1 + (t - 16) * KP + 2 * kcol) = (unsigned short)f2bf(qs[j] * e); *(LAS unsigned short*)(QH + t * KP + 2 * kcol) = (unsigned short)f2bf(qs[j] * e * ec15);
                  *(LAS unsigned short*)(KB + t * KP + 2 * kcol) = (unsigned short)f2bf(kr); *(LAS unsigned short*)(KHT + kcol * SP + 2 * t) = (unsigned short)f2bf(kr * el15); }
              else { *(LAS unsigned short*)(QH + t * KP + 2 * kcol) = (unsigned short)f2bf(qs[j] * e); *(LAS unsigned short*)(KA + t * KP + 2 * kcol) = (unsigned short)f2bf(kr);
                  *(LAS unsigned short*)(KB + t * KP + 2 * kcol) = (unsigned short)f2bf(kr * ec15); *(LAS unsigned short*)(KHT + kcol * SP + 2 * t) = (unsigned short)f2bf(kr * el); } } }
        asm volatile("s_waitcnt lgkmcnt(0)" ::: "memory"); __builtin_amdgcn_s_barrier(); asm volatile("" ::: "memory");
        f32x4 at00 = {0.f, 0.f, 0.f, 0.f}, at01 = at00, at11 = at00;
#pragma unroll
        for (int ks = 0; ks < 4; ++ks) { const int kb = 64 * ks + 16 * q4;
            const bf16x8 ka = *(const LAS bf16x8*)(KA + fr * KP + kb), kb0 = *(const LAS bf16x8*)(KB + fr * KP + kb), kb1 = *(const LAS bf16x8*)(KB + (16 + fr) * KP + kb);
            const bf16x8 qh = *(const LAS bf16x8*)(QH + fr * KP + kb), q1 = *(const LAS bf16x8*)(Q1 + fr * KP + kb);
            at00 = __builtin_amdgcn_mfma_f32_16x16x32_bf16(ka, qh, at00, 0, 0, 0);
            at01 = __builtin_amdgcn_mfma_f32_16x16x32_bf16(kb0, q1, at01, 0, 0, 0);
            at11 = __builtin_amdgcn_mfma_f32_16x16x32_bf16(kb1, q1, at11, 0, 0, 0); }
#pragma unroll
        for (int e = 0; e < 4; ++e) { const bool keep = (4 * q4 + e) <= fr; at00[e] = keep ? at00[e] : 0.f; at11[e] = keep ? at11[e] : 0.f; }
        v4u pa0, pa1;
        pa0.x = pk2(at00[0], at00[1]); pa0.y = pk2(at00[2], at00[3]); pa0.z = 0u; pa0.w = 0u;
        pa1.x = pk2(at01[0], at01[1]); pa1.y = pk2(at01[2], at01[3]); pa1.z = pk2(at11[0], at11[1]); pa1.w = pk2(at11[2], at11[3]);
        f32x4 o0 = {0.f, 0.f, 0.f, 0.f}, o1 = o0;
        { const LAS unsigned char* vrow = VT + (16 * wave + fr) * SP; const v2u lo = *(const LAS v2u*)(vrow + 8 * q4), hi = *(const LAS v2u*)(vrow + 32 + 8 * q4);
          v4u bv; bv.x = lo.x; bv.y = lo.y; bv.z = hi.x; bv.w = hi.y;
          o0 = __builtin_amdgcn_mfma_f32_16x16x32_bf16(__builtin_bit_cast(bf16x8, pa0), __builtin_bit_cast(bf16x8, bv), o0, 0, 0, 0);
          o1 = __builtin_amdgcn_mfma_f32_16x16x32_bf16(__builtin_bit_cast(bf16x8, pa1), __builtin_bit_cast(bf16x8, bv), o1, 0, 0, 0); }
#pragma unroll
        for (int ks = 0; ks < 4; ++ks) { v4u bs; bs.x = pk2(S[2 * ks][0], S[2 * ks][1]); bs.y = pk2(S[2 * ks][2], S[2 * ks][3]); bs.z = pk2(S[2 * ks + 1][0], S[2 * ks + 1][1]); bs.w = pk2(S[2 * ks + 1][2], S[2 * ks + 1][3]);
            const int kb = 64 * ks + 8 * q4;
            const v2u a0l = *(const LAS v2u*)(QH + fr * KP + kb), a0h = *(const LAS v2u*)(QH + fr * KP + kb + 32), a1l = *(const LAS v2u*)(QH + (16 + fr) * KP + kb), a1h = *(const LAS v2u*)(QH + (16 + fr) * KP + kb + 32);
            v4u a0; a0.x = a0l.x; a0.y = a0l.y; a0.z = a0h.x; a0.w = a0h.y; v4u a1; a1.x = a1l.x; a1.y = a1l.y; a1.z = a1h.x; a1.w = a1h.y;
            o0 = __builtin_amdgcn_mfma_f32_16x16x32_bf16(__builtin_bit_cast(bf16x8, a0), __builtin_bit_cast(bf16x8, bs), o0, 0, 0, 0);
            o1 = __builtin_amdgcn_mfma_f32_16x16x32_bf16(__builtin_bit_cast(bf16x8, a1), __builtin_bit_cast(bf16x8, bs), o1, 0, 0, 0); }
#pragma unroll
        for (int e = 0; e < 4; ++e) { const int t0r = 4 * q4 + e; *(LAS float*)(OF + t0r * OP + 4 * (16 * wave + fr)) = o0[e]; *(LAS float*)(OF + (16 + t0r) * OP + 4 * (16 * wave + fr)) = o1[e];
            const float s0 = row16_sum(o0[e] * o0[e]), s1 = row16_sum(o1[e] * o1[e]);
            if (fr == 0) { SSQ[wave * 32 + t0r] = s0; SSQ[wave * 32 + 16 + t0r] = s1; } }
        { const bf16x8 bv = *(const LAS bf16x8*)(VT + (16 * wave + fr) * SP + 16 * q4);
#pragma unroll
          for (int kt = 0; kt < 8; ++kt) { const f32x4 el = *(const LAS f32x4*)(EL + 16 * kt + 4 * q4); const bf16x8 ak = *(const LAS bf16x8*)(KHT + (16 * kt + fr) * SP + 16 * q4);
              S[kt] = __builtin_amdgcn_mfma_f32_16x16x32_bf16(ak, bv, S[kt] * el, 0, 0, 0); } }
        asm volatile("s_waitcnt lgkmcnt(0)" ::: "memory"); __builtin_amdgcn_s_barrier(); asm volatile("" ::: "memory");
        { const int t = tid >> 4, v8 = (tid & 15) * 8; float tot = 0.f;
#pragma unroll
          for (int w = 0; w < 8; ++w) tot += SSQ[w * 32 + t];
          const float rs = rsqrtf(tot * (1.f / 128.f) + EPS);
          const f32x4 oa = *(const LAS f32x4*)(OF + t * OP + 4 * v8), ob = *(const LAS f32x4*)(OF + t * OP + 4 * v8 + 16);
          const f32x4 wa = *(const GAS f32x4*)(F.a->in[I_HGNW] + v8), wb = *(const GAS f32x4*)(F.a->in[I_HGNW] + v8 + 4);
          v4u o; o.x = pk2(oa.x * rs * wa.x * siluf_(bflo(gv.x)), oa.y * rs * wa.y * siluf_(bfhi(gv.x))); o.y = pk2(oa.z * rs * wa.z * siluf_(bflo(gv.y)), oa.w * rs * wa.w * siluf_(bfhi(gv.y)));
          o.z = pk2(ob.x * rs * wb.x * siluf_(bflo(gv.z)), ob.y * rs * wb.y * siluf_(bfhi(gv.z))); o.w = pk2(ob.z * rs * wb.z * siluf_(bflo(gv.w)), ob.w * rs * wb.w * siluf_(bfhi(gv.w)));
          *(GAS v4u*)((bf16*)(F.out + O_YP) + (size_t)(T0 + t) * 2048 + 1024 + h * 128 + v8) = o; }
    }
#undef HG_ROW0
#undef HG_HEAD
#undef HG_PREFETCH
    __syncthreads();
}

__device__ __forceinline__ void hg_sample_item(Frame& F, int j, int half) {
    const bf16* PB = (const bf16*)(F.ws + WS_BIG + B_PROJB) + (size_t)(MP + j) * NBH + 512 * half; bf16* MX = (bf16*)(F.ws + WS_MIXS) + (size_t)j * 2048 + 1024 + 512 * half;
    LAS float* fS = (LAS float*)F.lds;
    LAS float* kS = fS + 512; LAS float* qS = kS + 512; LAS float* vS = qS + 512; LAS float* oP = vS + 512;
    int tid = F.tid; asm volatile("" : "+v"(tid));
    { const int c = tid; const float lb = hg_lb(F, 512 * half + c), sg = sigmoidf_(bf2f(PB[1024 + c]));
      fS[c] = lb + (1.f - lb) * sg; kS[c] = (1.f - lb) * (1.f - sg); qS[c] = siluf_(bf2f(PB[c])); vS[c] = bf2f(PB[2048 + c]); }
    __syncthreads();
    const int v4 = (tid & 31) * 4, krow = tid >> 5;
    const float* S0 = F.a->in[I_SHG] + (size_t)j * 131072 + (size_t)half * 65536; float* S1 = F.out + O_SHG + (size_t)j * 131072 + (size_t)half * 65536;
#pragma unroll 1
    for (int hl = 0; hl < 4; ++hl) { const f32x4 vv = *(const LAS f32x4*)(vS + hl * 128 + v4); f32x4 a = {0.f, 0.f, 0.f, 0.f};
        f32x4 sv[8];
#pragma unroll
        for (int kb = 0; kb < 8; ++kb) sv[kb] = *(const GAS f32x4*)(S0 + ((size_t)hl * 128 + krow + 16 * kb) * 128 + v4);
#pragma unroll
        for (int kb = 0; kb < 8; ++kb) { const int k = krow + 16 * kb; const f32x4 sn = sv[kb] * fS[hl * 128 + k] + vv * kS[hl * 128 + k];
            *(GAS f32x4*)(S1 + ((size_t)hl * 128 + k) * 128 + v4) = sn; a += sn * qS[hl * 128 + k]; }
        *(LAS f32x4*)(oP + krow * 512 + hl * 128 + v4) = a; }
    __syncthreads();
    { const int c = tid; float o = 0.f;
#pragma unroll
      for (int q = 0; q < 16; ++q) o += oP[q * 512 + c];
      float ss = wave_sum(o * o); if ((tid & 63) == 0) fS[tid >> 6] = ss;
      __syncthreads();
      const float tot = fS[(tid >> 7) * 2] + fS[(tid >> 7) * 2 + 1];
      const float rs = rsqrtf(tot * (1.f / 128.f) + EPS);
      MX[c] = (bf16)f2bf(o * rs * F.a->in[I_HGNW][c & 127] * siluf_(bf2f(PB[3072 + c]))); }
    __syncthreads();
}
__device__ __forceinline__ void hg_state_phase(Frame& F) {
    for (int it = F.vcu; it < 256; it += F.G) hg_state_item(F, it >> 5, (it >> 2) & 7, it & 3, it >> 1, it & 1);
}

__device__ __forceinline__ void s5_lambda(const Frame& F, int g, int n, float& abr, float& abi, float& cfr, float& cfi) {
    const float lr = F.a->in[I_LAMRE][g * 64 + n], li = F.a->in[I_LAMIM][g * 64 + n], step = expf(F.a->in[I_LOGSTEP][g]);
    const float mag = expf(lr * step); float sn, cs; sincosf(li * step, &sn, &cs);
    abr = mag * cs; abi = mag * sn;
    const float den = lr * lr + li * li, nr = abr - 1.0f;
    cfr = (nr * lr + abi * li) / den; cfi = (abi * lr - nr * li) / den;
}
typedef float f32x2 __attribute__((ext_vector_type(2)));
__device__ __forceinline__ void s5_split8(const float (&v)[8], bf16x8& hi, bf16x8& lo) {
    unsigned h[4], l[4];
#pragma unroll
    for (int j = 0; j < 4; ++j) { const unsigned h0 = f2bf(v[2 * j]), h1 = f2bf(v[2 * j + 1]); h[j] = h0 | (h1 << 16);
        l[j] = pk2(v[2 * j] - __builtin_bit_cast(float, h0 << 16), v[2 * j + 1] - __builtin_bit_cast(float, h1 << 16)); }
    v4u a; a.x = h[0]; a.y = h[1]; a.z = h[2]; a.w = h[3]; hi = __builtin_bit_cast(bf16x8, a);
    v4u b; b.x = l[0]; b.y = l[1]; b.z = l[2]; b.w = l[3]; lo = __builtin_bit_cast(bf16x8, b);
}
__device__ __forceinline__ void s5_tables_item(Frame& F, int g, int hf) {
    LAS float* POW = (LAS float*)F.lds;
    LAS float* CC = POW + 17 * 128;
    LAS float* BB = CC + 16 * 128;
    LAS float* BT = BB + 64 * 32;
    LAS float* KS = BT + 16 * 128;
    int tid = F.tid; asm volatile("" : "+v"(tid));
    bf16* KQ = (bf16*)((unsigned char*)(F.out + O_YP) + S5T_KQ) + (size_t)g * 256 * 384; bf16* PM = (bf16*)((unsigned char*)(F.out + O_YP) + S5T_PM) + (size_t)g * 128 * 256;
    if (tid < 64) { const int n = tid; float abr, abi, cfr, cfi; s5_lambda(F, g, n, abr, abi, cfr, cfi);
        const f32x4* br4 = (const f32x4*)(F.a->in[I_BRE] + (size_t)(g * 64 + n) * 16); const f32x4* bi4 = (const f32x4*)(F.a->in[I_BIM] + (size_t)(g * 64 + n) * 16);
        f32x4 brv[4], biv[4];
#pragma unroll
        for (int q = 0; q < 4; ++q) { brv[q] = br4[q]; biv[q] = bi4[q]; }
        float pr = 1.f, pi = 0.f;
        for (int t = 0; t <= 16; ++t) { *(LAS f32x2*)(POW + (t * 64 + n) * 2) = (f32x2){pr, pi}; const float nr = pr * abr - pi * abi, ni = pr * abi + pi * abr; pr = nr; pi = ni; }
        float* gab = (float*)((unsigned char*)(F.out + O_YP) + S5T_AB) + (size_t)(g * 64 + n) * 2; float* gbb = (float*)((unsigned char*)(F.out + O_YP) + S5T_BB) + (size_t)(g * 64 + n) * 32;
        if (hf == 0) { gab[0] = abr; gab[1] = abi; }
#pragma unroll
        for (int c = 0; c < 16; ++c) { const float b_r = brv[c >> 2][c & 3], b_i = biv[c >> 2][c & 3]; const float vr = cfr * b_r - cfi * b_i, vi = cfr * b_i + cfi * b_r;
            *(LAS f32x2*)(BB + (n * 16 + c) * 2) = (f32x2){vr, vi}; *(LAS f32x2*)(BT + (c * 64 + n) * 2) = (f32x2){vr, vi};
            if (hf == 0) *(GAS f32x2*)(gbb + 2 * c) = (f32x2){vr, vi}; } }
    else { for (int e = tid - 64; e < 1024; e += NTHR - 64) { const float cr = F.a->in[I_CRE][(size_t)g * 1024 + e], ci = F.a->in[I_CIM][(size_t)g * 1024 + e]; *(LAS f32x2*)(CC + e * 2) = (f32x2){cr, ci}; } }
    __syncthreads();
    { const int lane = tid & 63, wave = __builtin_amdgcn_readfirstlane(tid >> 6), r = lane & 15, q = lane >> 4;
      f32x4 acc[2];
#pragma unroll
      for (int j = 0; j < 2; ++j) acc[j] = (f32x4){0.f, 0.f, 0.f, 0.f};
#pragma unroll
      for (int nb = 0; nb < 2; ++nb) { const int n0 = 32 * nb + 8 * q;
          float pre[8], pim[8];
#pragma unroll
          for (int j4 = 0; j4 < 4; ++j4) { const f32x4 p = *(const LAS f32x4*)(POW + (r * 64 + n0 + 2 * j4) * 2); pre[2 * j4] = p.x; pim[2 * j4] = p.y; pre[2 * j4 + 1] = p.z; pim[2 * j4 + 1] = p.w; }
          bf16x8 arh, arl, aih, ail; s5_split8(pre, arh, arl); s5_split8(pim, aih, ail);
#pragma unroll
          for (int j = 0; j < 2; ++j) { const int cp = 2 * wave + j; float xr[8], xm[8];
#pragma unroll
              for (int j4 = 0; j4 < 4; ++j4) { const f32x4 cv = *(const LAS f32x4*)(CC + (cp * 64 + n0 + 2 * j4) * 2), bv = *(const LAS f32x4*)(BT + (r * 64 + n0 + 2 * j4) * 2);
                  xr[2 * j4] = cv.x * bv.x - cv.y * bv.y; xm[2 * j4] = -(cv.x * bv.y + cv.y * bv.x); xr[2 * j4 + 1] = cv.z * bv.z - cv.w * bv.w; xm[2 * j4 + 1] = -(cv.z * bv.w + cv.w * bv.z); }
              bf16x8 xrh, xrl, xmh, xml; s5_split8(xr, xrh, xrl); s5_split8(xm, xmh, xml);
              acc[j] = __builtin_amdgcn_mfma_f32_16x16x32_bf16(arl, xrh, acc[j], 0, 0, 0); acc[j] = __builtin_amdgcn_mfma_f32_16x16x32_bf16(arh, xrl, acc[j], 0, 0, 0);
              acc[j] = __builtin_amdgcn_mfma_f32_16x16x32_bf16(ail, xmh, acc[j], 0, 0, 0); acc[j] = __builtin_amdgcn_mfma_f32_16x16x32_bf16(aih, xml, acc[j], 0, 0, 0);
              acc[j] = __builtin_amdgcn_mfma_f32_16x16x32_bf16(arh, xrh, acc[j], 0, 0, 0); acc[j] = __builtin_amdgcn_mfma_f32_16x16x32_bf16(aih, xmh, acc[j], 0, 0, 0); } }
#pragma unroll
      for (int j = 0; j < 2; ++j)
#pragma unroll
          for (int e = 0; e < 4; ++e) KS[(4 * q + e) * 256 + (2 * wave + j) * 16 + r] = acc[j][e]; }
    __syncthreads();
#pragma unroll 2
    for (int p = tid; p < 128 * 32; p += NTHR) { const int row = 128 * hf + (p >> 5), pc = p & 31, t = row >> 4, cp = row & 15, s = pc >> 1, c0 = (pc & 1) * 8;
        f32x4 v0 = (f32x4){0.f, 0.f, 0.f, 0.f}, v1 = v0;
        if (s <= t) { v0 = *(const LAS f32x4*)(KS + (t - s) * 256 + cp * 16 + c0); v1 = *(const LAS f32x4*)(KS + (t - s) * 256 + cp * 16 + c0 + 4); }
        v4u o; o.x = pk2(v0.x, v0.y); o.y = pk2(v0.z, v0.w); o.z = pk2(v1.x, v1.y); o.w = pk2(v1.z, v1.w);
        *(GAS v4u*)(KQ + (size_t)row * 384 + 8 * pc) = o; }
#pragma unroll 2
    for (int p = tid; p < 128 * 16; p += NTHR) { const int row = 128 * hf + (p >> 4), pc = p & 15, t = row >> 4, cp = row & 15, n0 = (pc & 7) * 8; const bool im = pc >= 8; float v[8];
#pragma unroll
        for (int j4 = 0; j4 < 4; ++j4) { const f32x4 pv = *(const LAS f32x4*)(POW + ((t + 1) * 64 + n0 + 2 * j4) * 2), cv = *(const LAS f32x4*)(CC + (cp * 64 + n0 + 2 * j4) * 2);
            v[2 * j4] = im ? -(cv.x * pv.y + cv.y * pv.x) : cv.x * pv.x - cv.y * pv.y; v[2 * j4 + 1] = im ? -(cv.z * pv.w + cv.w * pv.z) : cv.z * pv.z - cv.w * pv.w; }
        v4u o; o.x = pk2(v[0], v[1]); o.y = pk2(v[2], v[3]); o.z = pk2(v[4], v[5]); o.w = pk2(v[6], v[7]);
        *(GAS v4u*)(KQ + (size_t)row * 384 + 256 + 8 * pc) = o; }
#pragma unroll 2
    for (int p = tid; p < 64 * 32; p += NTHR) { const int n = p >> 5, pc = p & 31, s = pc >> 1, c0 = (pc & 1) * 8; const f32x2 pw = *(const LAS f32x2*)(POW + ((15 - s) * 64 + n) * 2); float v[8];
#pragma unroll
        for (int j4 = 0; j4 < 4; ++j4) { const f32x4 bv = *(const LAS f32x4*)(BB + (n * 16 + c0 + 2 * j4) * 2);
            v[2 * j4] = hf ? pw.x * bv.y + pw.y * bv.x : pw.x * bv.x - pw.y * bv.y; v[2 * j4 + 1] = hf ? pw.x * bv.w + pw.y * bv.z : pw.x * bv.z - pw.y * bv.w; }
        v4u o; o.x = pk2(v[0], v[1]); o.y = pk2(v[2], v[3]); o.z = pk2(v[4], v[5]); o.w = pk2(v[6], v[7]);
        *(GAS v4u*)(PM + (size_t)(64 * hf + n) * 256 + 8 * pc) = o; }
    __syncthreads();
}
__device__ __forceinline__ void s5_fused_item(Frame& F, int b, int g) {
    const bf16* HN = (const bf16*)(F.ws + WS_XN); const bf16* PM = (const bf16*)((unsigned char*)(F.out + O_YP) + S5T_PM) + (size_t)g * 128 * 256; const bf16* KQ = (const bf16*)((unsigned char*)(F.out + O_YP) + S5T_KQ) + (size_t)g * 256 * 384;
    bf16* GY = (bf16*)(F.ws + WS_BIG + B_GY);
    constexpr int UP_ = 528, PP = 132, XPP = 272, KQP = 784;
    LAS unsigned char* UL = F.lds;
    LAS unsigned char* XL = UL;
    LAS unsigned char* BL = UL + 128 * XPP;
    LAS float* PL = (LAS float*)BL;
    LAS float* SE = (LAS float*)(BL + 128 * UP_);
    static_assert(64 * UP_ <= 128 * XPP && 128 * PP * 4 <= 128 * UP_ && 64 * KQP <= 128 * UP_ && 128 * XPP + 128 * UP_ + 4096 <= RING_BYTES, "s5 LDS map");
    int tid = F.tid; asm volatile("" : "+v"(tid));
    const int lane = tid & 63, wave = __builtin_amdgcn_readfirstlane(tid >> 6), r = lane & 31, hh = lane >> 5, mt = wave >> 1, ch = wave & 1;
    for (int e = tid; e < 128 * 32; e += NTHR) { const int row = e >> 5, c16 = e & 31; *(LAS v4u*)(BL + row * UP_ + 16 * c16) = *(const GAS v4u*)(PM + (size_t)row * 256 + 8 * c16); }
    bf16x8 au[16];
#pragma unroll
    for (int half = 0; half < 2; ++half) {
        for (int e = tid; e < 64 * 32; e += NTHR) { const int tok = e >> 1, pc = e & 1, m = tok >> 4, s2 = tok & 15;
            *(LAS v4u*)(UL + m * UP_ + 32 * s2 + 16 * pc) = *(const GAS v4u*)(HN + (size_t)(b * SEQ + 1024 * half + tok) * D + 16 * g + 8 * pc); }
        __syncthreads();
        if ((mt >> 1) == half) {
#pragma unroll
            for (int s2 = 0; s2 < 16; ++s2) au[s2] = *(const LAS bf16x8*)(UL + (32 * (mt & 1) + r) * UP_ + 32 * s2 + 16 * hh); }
        __syncthreads();
    }
    { f32x16 acc[2];
#pragma unroll
      for (int nt = 0; nt < 2; ++nt)
#pragma unroll
          for (int i = 0; i < 16; ++i) acc[nt][i] = 0.f;
#pragma unroll
      for (int s2 = 0; s2 < 16; ++s2)
#pragma unroll
          for (int nt = 0; nt < 2; ++nt) { const bf16x8 bb = *(const LAS bf16x8*)(BL + (64 * ch + 32 * nt + r) * UP_ + 32 * s2 + 16 * hh); acc[nt] = __builtin_amdgcn_mfma_f32_32x32x16_bf16(au[s2], bb, acc[nt], 0, 0, 0); }
      __syncthreads();
#pragma unroll
      for (int nt = 0; nt < 2; ++nt)
#pragma unroll
          for (int i = 0; i < 16; ++i) PL[(32 * mt + (i & 3) + 8 * (i >> 2) + 4 * hh) * PP + 64 * ch + 32 * nt + r] = acc[nt][i]; }
    __syncthreads();
    { const int n = lane, seg = wave; float abr, abi, cfr, cfi; s5_lambda(F, g, n, abr, abi, cfr, cfi);
#pragma unroll
      for (int q = 0; q < 4; ++q) { const float nr = abr * abr - abi * abi, ni = 2.f * abr * abi; abr = nr; abi = ni; }
      float yr[16], yi[16];
      { float xr = 0.f, xi = 0.f;
#pragma unroll
        for (int i = 0; i < 16; ++i) { const float pr = PL[(16 * seg + i) * PP + n], pi = PL[(16 * seg + i) * PP + 64 + n]; const float nr = abr * xr - abi * xi + pr, ni = abr * xi + abi * xr + pi; xr = nr; xi = ni; yr[i] = xr; yi[i] = xi; }
        SE[seg * 128 + n] = xr; SE[seg * 128 + 64 + n] = xi; }
      float a16r = abr, a16i = abi;
#pragma unroll
      for (int q = 0; q < 4; ++q) { const float nr = a16r * a16r - a16i * a16i, ni = 2.f * a16r * a16i; a16r = nr; a16i = ni; }
      __syncthreads();
      float cr = 0.f, ci = 0.f;
      for (int s2 = 0; s2 < seg; ++s2) { const float er = SE[s2 * 128 + n], ei = SE[s2 * 128 + 64 + n]; const float nr = a16r * cr - a16i * ci + er, ni = a16r * ci + a16i * cr + ei; cr = nr; ci = ni; }
      float pwr = 1.f, pwi = 0.f;
#pragma unroll
      for (int i = 0; i < 16; ++i) { const float xr = (i == 0 ? 0.f : yr[i == 0 ? 0 : i - 1]) + pwr * cr - pwi * ci, xi = (i == 0 ? 0.f : yi[i == 0 ? 0 : i - 1]) + pwr * ci + pwi * cr;
          *(LAS unsigned short*)(XL + (16 * seg + i) * XPP + 2 * n) = (unsigned short)f2bf(xr); *(LAS unsigned short*)(XL + (16 * seg + i) * XPP + 2 * (64 + n)) = (unsigned short)f2bf(xi);
          const float nr = pwr * abr - pwi * abi, ni = pwr * abi + pwi * abr; pwr = nr; pwi = ni; }
      if (seg == 7) { const float xr = yr[15] + pwr * cr - pwi * ci, xi = yi[15] + pwr * ci + pwi * cr;
          F.out[O_PS5R + (size_t)(b * 64 + g) * 64 + n] = xr; F.out[O_PS5I + (size_t)(b * 64 + g) * 64 + n] = xi; } }
    __syncthreads();
    bf16x8 ax[8];
#pragma unroll
    for (int s2 = 0; s2 < 8; ++s2) ax[s2] = *(const LAS bf16x8*)(XL + (32 * mt + r) * XPP + 32 * s2 + 16 * hh);
    v4u kq[6];
#pragma unroll
    for (int q = 0; q < 6; ++q) { const int e = tid + NTHR * q, row = e / 48, c16 = e % 48; kq[q] = *(const GAS v4u*)(KQ + (size_t)row * 384 + 8 * c16); }
#pragma unroll 1
    for (int p = 0; p < 4; ++p) {
#pragma unroll
        for (int q = 0; q < 6; ++q) { const int e = tid + NTHR * q, row = e / 48, c16 = e % 48; *(LAS v4u*)(BL + row * KQP + 16 * c16) = kq[q]; }
        if (p < 3) {
#pragma unroll
            for (int q = 0; q < 6; ++q) { const int e = tid + NTHR * q, row = e / 48, c16 = e % 48; kq[q] = *(const GAS v4u*)(KQ + (size_t)(64 * (p + 1) + row) * 384 + 8 * c16); } }
        v4u uq[2];
#pragma unroll
        for (int q = 0; q < 2; ++q) { const int e = tid + NTHR * q, m = e >> 3, tl = (e >> 1) & 3, hf = e & 1; uq[q] = *(const GAS v4u*)(HN + (size_t)(b * SEQ + 16 * m + 4 * p + tl) * D + 16 * g + 8 * hf); }
        __syncthreads();
        f32x16 acc;
#pragma unroll
        for (int i = 0; i < 16; ++i) acc[i] = 0.f;
        const LAS unsigned char* brow = BL + (32 * ch + r) * KQP + 16 * hh;
#pragma unroll
        for (int s2 = 0; s2 < 16; ++s2) acc = __builtin_amdgcn_mfma_f32_32x32x16_bf16(au[s2], *(const LAS bf16x8*)(brow + 32 * s2), acc, 0, 0, 0);
#pragma unroll
        for (int s2 = 0; s2 < 8; ++s2) acc = __builtin_amdgcn_mfma_f32_32x32x16_bf16(ax[s2], *(const LAS bf16x8*)(brow + 512 + 32 * s2), acc, 0, 0, 0);
        { LAS float* OL = (LAS float*)XL;
#pragma unroll
          for (int i = 0; i < 16; ++i) OL[(32 * mt + (i & 3) + 8 * (i >> 2) + 4 * hh) * 68 + 32 * ch + r] = acc[i]; }
        __syncthreads();
#pragma unroll
        for (int q = 0; q < 2; ++q) { const int e = tid + NTHR * q, m = e >> 3, tl = (e >> 1) & 3, hf = e & 1; const LAS float* ol = (const LAS float*)XL + m * 68 + 16 * tl + 8 * hf;
            const f32x4 o0 = *(const LAS f32x4*)ol, o1 = *(const LAS f32x4*)(ol + 4);
            const size_t o = (size_t)(b * SEQ + 16 * m + 4 * p + tl) * D + 16 * g + 8 * hf;
            const v4u uu = uq[q]; const f32x4 d0 = *(const GAS f32x4*)(F.a->in[I_S5D] + 16 * g + 8 * hf), d1 = *(const GAS f32x4*)(F.a->in[I_S5D] + 16 * g + 8 * hf + 4);
            v4u w; w.x = pk2(gelu_tanh(o0.x + d0.x * bflo(uu.x)), gelu_tanh(o0.y + d0.y * bfhi(uu.x))); w.y = pk2(gelu_tanh(o0.z + d0.z * bflo(uu.y)), gelu_tanh(o0.w + d0.w * bfhi(uu.y)));
            w.z = pk2(gelu_tanh(o1.x + d1.x * bflo(uu.z)), gelu_tanh(o1.y + d1.y * bfhi(uu.z))); w.w = pk2(gelu_tanh(o1.z + d1.z * bflo(uu.w)), gelu_tanh(o1.w + d1.w * bfhi(uu.w)));
            *(GAS v4u*)(GY + o) = w; }
        __syncthreads();
    }
}
__device__ __forceinline__ void s5_fused_phase(Frame& F) {
    for (int it = F.vcu; it < 8 * 64; it += F.G) s5_fused_item(F, it >> 6, it & 63);
}
__device__ __forceinline__ void s5_sample(Frame& F) {
    const bf16* HN = (const bf16*)(F.ws + WS_XN) + (size_t)MP * D; bf16* GY = (bf16*)(F.ws + WS_BIG + B_GY) + (size_t)MP * D;
    const float* TAB = (const float*)((unsigned char*)(F.out + O_YP) + S5T_AB); const float* TBB = (const float*)((unsigned char*)(F.out + O_YP) + S5T_BB);
    const int n = F.lane;
    for (int task = GW_ID(F); task < MS * 64; task += GW_N(F)) { const int j = task >> 6, g = task & 63;
        const f32x2_t ab = *(const GAS f32x2_t*)(TAB + (size_t)(g * 64 + n) * 2);
        f32x4 bb[8];
#pragma unroll
        for (int q = 0; q < 8; ++q) bb[q] = *(const GAS f32x4*)(TBB + (size_t)(g * 64 + n) * 32 + 4 * q);
        const v4u u0 = *(const GAS v4u*)(HN + (size_t)j * D + 16 * g), u1 = *(const GAS v4u*)(HN + (size_t)j * D + 16 * g + 8);
        const size_t si = ((size_t)j * 64 + g) * 64 + n; const float sr = F.a->in[I_SS5R][si], sim = F.a->in[I_SS5I][si];
        float cr[16], ci[16];
#pragma unroll
        for (int cp = 0; cp < 16; ++cp) { cr[cp] = F.a->in[I_CRE][((size_t)g * 16 + cp) * 64 + n]; ci[cp] = F.a->in[I_CIM][((size_t)g * 16 + cp) * 64 + n]; }
        const float dsk = F.a->in[I_S5D][16 * g + (n & 15)];
        float u[16]; u[0] = bflo(u0.x); u[1] = bfhi(u0.x); u[2] = bflo(u0.y); u[3] = bfhi(u0.y); u[4] = bflo(u0.z); u[5] = bfhi(u0.z); u[6] = bflo(u0.w); u[7] = bfhi(u0.w);
        u[8] = bflo(u1.x); u[9] = bfhi(u1.x); u[10] = bflo(u1.y); u[11] = bfhi(u1.y); u[12] = bflo(u1.z); u[13] = bfhi(u1.z); u[14] = bflo(u1.w); u[15] = bfhi(u1.w);
        float bur = 0.f, bui = 0.f;
#pragma unroll
        for (int q = 0; q < 8; ++q) { bur += bb[q].x * u[2 * q] + bb[q].z * u[2 * q + 1]; bui += bb[q].y * u[2 * q] + bb[q].w * u[2 * q + 1]; }
        const float xr = ab.x * sr - ab.y * sim + bur, xi = ab.x * sim + ab.y * sr + bui;
        F.out[O_SS5R + si] = xr; F.out[O_SS5I + si] = xi;
        float ymine = 0.f, uu = 0.f;
#pragma unroll
        for (int cp = 0; cp < 16; ++cp) { const float tot = wave_sum(cr[cp] * xr - ci[cp] * xi); ymine = (n == cp) ? tot : ymine; uu = (n == cp) ? u[cp] : uu; }
        if (n < 16) GY[(size_t)j * D + 16 * g + n] = (bf16)f2bf(gelu_tanh(ymine + dsk * uu));
    }
}

constexpr int CW_BAR = 4096;

struct SkAny { int mode; void* O; int ld;
    __device__ __forceinline__ void operator()(int row, int col, const float (&v)[1]) const { if (mode == 0) ((bf16*)O)[(size_t)row * ld + col] = (bf16)f2bf(v[0]); else ((float*)O)[(size_t)row * ld + col] = v[0]; } };

__global__ void __launch_bounds__(NTHR, 2) fwd_kernel(Args args) {
    extern __shared__ __attribute__((aligned(16))) unsigned char lds[];
    Frame F;
    F.lds = (LAS unsigned char*)lds;
    F.tid = threadIdx.x;
    F.out = args.out; F.ws = args.ws;
    volatile LAS unsigned* MISC = (volatile LAS unsigned*)(F.lds + MISC_OFF);
    for (int u = F.tid; u < (LDS_BYTES - LDSCTL_OFF) / 4; u += NTHR) ((LAS unsigned*)(F.lds + LDSCTL_OFF))[u] = 0u;
    __syncthreads();
    const int lo = args.ph_lo, hi = args.ph_hi;
    if (hi - lo > 1) (void)xcd_barrier_post((unsigned*)(args.ws + WS_CTL) + CW_BAR + args.li * XCD_BAR_WORDS, MISC + 8);
#if PROBE_T >= 0
    if (blockIdx.x == PROBE_EB && threadIdx.x == 0) { volatile LAS unsigned long long* ST = (volatile LAS unsigned long long*)(F.lds + MISC_OFF + 64); ST[0] = PROBE_E == 2 ? (unsigned long long)__builtin_readcyclecounter() : __builtin_amdgcn_s_memrealtime(); ST[1] = 0ull; ST[2] = 0ull; ST[3] = (lo == PROBE_T) ? 1ull : 0ull; }
#endif
#pragma unroll 1
    for (int ph = lo; ph < hi; ++ph) {
        { int t_ = threadIdx.x; asm volatile("" : "+v"(t_)); F.tid = t_; F.lane = t_ & 63; F.wave = __builtin_amdgcn_readfirstlane(t_ >> 6); }
        { int g_ = gridDim.x, b_ = blockIdx.x; asm volatile("" : "+s"(g_), "+s"(b_)); F.G = g_; F.vcu = (g_ % 8 == 0) ? (b_ % 8) * (g_ / 8) + b_ / 8 : b_; }
        { const CAS Args* ap_ = (const CAS Args*)__builtin_amdgcn_kernarg_segment_ptr(); asm volatile("" : "+s"(ap_)); F.a = ap_; }
        { float* o_ = args.out; unsigned char* w_ = args.ws; asm volatile("" : "+s"(o_), "+s"(w_)); F.out = o_; F.ws = w_; }
        unsigned char* BIG = F.ws + WS_BIG; bf16* XN = (bf16*)(F.ws + WS_XN); bf16* WIN = (bf16*)(F.ws + WS_WIN);
        const bf16* gA = nullptr; const bf16* gAs = nullptr; const bf16* gB = nullptr; int gN = 0, gK = 0, gmode = 0, gld = 0; void* gO = nullptr; void* gOs = nullptr;
        int l = 0, fixl = -1;
        switch (ph) {
            case 0: p0_prologue(F); break;
            case 1: gA = XN; gAs = XN + (size_t)MP * D; gB = WIN; gN = NA; gK = D; gmode = 0; gld = NA; gO = BIG + B_PROJA; gOs = (bf16*)gO + (size_t)MP * NA; break;
            case 2: ssd_state_phase(F); break;
            case 3: ssd_out_phase(F); break;
            case 4: gA = XN; gAs = XN + (size_t)MP * D; gB = WIN + (size_t)NA * D; gN = NBH; gK = D; gmode = 0; gld = NBH; gO = BIG + B_PROJB; gOs = (bf16*)gO + (size_t)MP * NBH; break;
            case 5: hg_state_phase(F); break;
            case 6: hg_out_phase(F); break;
            case 7: gA = (const bf16*)(F.out + O_YP); gAs = (const bf16*)(F.ws + WS_MIXS); gB = (const bf16*)(F.ws + WS_WOUT); gN = D; gK = 2048; gmode = 0; gld = D; gO = BIG + B_M1; gOs = (bf16*)gO + (size_t)MP * D; break;
            case 8: resid_norm_rows(F, (const bf16*)(BIG + B_M1), F.a->in[I_NMPOST], F.a->in[I_NFPRE], 0); break;
            case 15: l = 1; [[fallthrough]];
            case 9: gA = XN; gAs = XN + (size_t)MP * D; gB = (const bf16*)(F.ws + WS_WUP) + (size_t)l * FF2 * D; gN = FF2; gK = D; gmode = 3; gld = FF2; gO = BIG + B_ACT; gOs = BIG + B_ACT; break;
            case 16: l = 1; [[fallthrough]];
            case 10: gA = (const bf16*)(BIG + B_ACT); gAs = gA + (size_t)MP * FF; gB = (const bf16*)(F.ws + WS_WDN) + (size_t)l * D * FF; gN = D; gK = FF; gmode = 0; gld = D; gO = BIG + B_M1; gOs = (bf16*)gO + (size_t)MP * D; fixl = l; break;
            case 11: resid_norm_rows(F, (const bf16*)(BIG + B_M1), F.a->in[I_NFPOST], F.a->in[I_NMPRE] + D, 1); break;
            case 12: s5_fused_phase(F); s5_sample(F); break;
            case 13: gA = (const bf16*)(BIG + B_GY); gAs = gA + (size_t)MP * D; gB = (const bf16*)(F.ws + WS_WGLU); gN = 2048; gK = D; gmode = 2; gld = D; gO = BIG + B_M1G; gOs = (bf16*)gO + (size_t)MP * D; break;
            case 14: resid_norm_rows(F, (const bf16*)(BIG + B_M1G), F.a->in[I_NMPOST] + D, F.a->in[I_NFPRE] + D, 1); break;
            case 17: resid_norm_rows(F, (const bf16*)(BIG + B_M1), F.a->in[I_NFPOST] + D, nullptr, 2); break;
            default: break;
        }
        if (gA) {
            pg8::Gemm g{gA, gB, MP, gN, gK}; pg8::StaticOrder S; S.init(MP, gN, F.G, (int)blockIdx.x);
            PSEG_B(4, F.lds);
            if (fixl >= 0) { pg8::Unit u0; for (int i = 0; S.next(i, u0); ++i) ffn_fix_rows(F, fixl, u0.pm);
                asm volatile("s_waitcnt vmcnt(0)" ::: "memory"); __syncthreads(); }
            PSEG_E(4, F.lds);
            pg8::EpiConvGate cg{(pg8::bf16_t*)(BIG + B_ACT), F.a->in[I_FCW] + (size_t)l * 3 * FF2, F.a->in[I_FCB] + (size_t)l * FF2, (float*)(BIG + B_HEAD), (float*)(BIG + B_TAIL), (PG8_LAS float*)(F.lds + HALO_OFF), F.out + O_PFC + (size_t)l * 8 * 2 * FF2};
            PSEG_B(2, F.lds);
            pg8::gemm_phase<pg8::EpiAny, pg8::StaticOrder, true, true>(F.lds, g, S, pg8::EpiAny{gmode, gmode == 0 || gmode == 3, gO, gld, cg}, F.tid);
            __syncthreads();
            PSEG_E(2, F.lds); PSEG_B(3, F.lds);
            const int nrem = ((MP / 256) * (gN / 256)) % F.G, tb = nrem ? (int)blockIdx.x - nrem : (int)blockIdx.x, tstr = nrem ? F.G - nrem : F.G;
            if (gmode == 2) skinny_gemm<2, true>(F, gAs, gK, gB, gK, D / 32, SkGlu{(bf16*)gOs, gld}, tb, tstr);
            else if (gmode == 3) { if (l == 0 && tb >= 0) { __syncthreads(); for (int g2 = tb; g2 < 128; g2 += tstr) s5_tables_item(F, g2 >> 1, g2 & 1); }
              skinny_gemm<2, true>(F, gAs, gK, gB, gK, FF / 32, SkConvGate{(bf16*)(BIG + B_ACT) + (size_t)MP * FF, F.a->in[I_FCW] + (size_t)l * 3 * FF2, F.a->in[I_FCB] + (size_t)l * FF2, F.a->in[I_SFC] + (size_t)l * MS * 2 * FF2, F.out + O_SFC + (size_t)l * MS * 2 * FF2}, tb, tstr); }
            else skinny_gemm<1, false>(F, gAs, gK, gB, gK, gN / 32, SkAny{gmode, gOs, gld}, tb, tstr);
            PSEG_E(3, F.lds);
        }
#if PROBE_T >= 0
        if (blockIdx.x == PROBE_EB && threadIdx.x == 0 && ph + 1 == hi) { volatile LAS unsigned long long* ST = (volatile LAS unsigned long long*)(F.lds + MISC_OFF + 64);
            const unsigned long long now = __builtin_amdgcn_s_memrealtime(); if (ph == PROBE_T) ST[1] = now - ST[0];
            const unsigned long long tk = PROBE_E == 1 ? ST[2] : PROBE_E == 2 ? (ST[1] >> 7) : ST[1]; while (__builtin_amdgcn_s_memrealtime() - now < 4ull * tk) __builtin_amdgcn_s_sleep(8); }
#endif
        if (ph + 1 < hi) { XcdBarrier b2; b2.bar = (unsigned*)(F.ws + WS_CTL) + CW_BAR + F.a->li * XCD_BAR_WORDS; b2.x = xb_xcc_id(); b2.st = (volatile LAS unsigned*)(F.lds + MISC_OFF) + 8; xcd_barrier(b2);
#if PROBE_T >= 0
            if (blockIdx.x == PROBE_EB && threadIdx.x == 0) { volatile LAS unsigned long long* ST = (volatile LAS unsigned long long*)(F.lds + MISC_OFF + 64);
#if PROBE_E == 2
                const unsigned long long now = __builtin_amdgcn_s_memtime();
#else
                const unsigned long long now = __builtin_amdgcn_s_memrealtime();
#endif
                if (ph == PROBE_T) ST[1] = now - ST[0]; ST[0] = now;
#if PROBE_E == 1
                ST[3] = (ph + 1 == PROBE_T) ? 1ull : 0ull;
#endif
            }
#endif
        }
    }
}

extern "C" void kernel_launch(void* const* d_in, const int* in_sizes, int n_in, void* d_out, int out_size, void* d_ws, size_t ws_size, hipStream_t stream) {
    static int grid = 0;
    if (grid == 0) {
        if (n_in != N_IN || out_size != (int)O_END || ws_size < WS_END) { fprintf(stderr, "kernel_launch: unexpected shapes (n_in %d, out %d, ws %zu)\n", n_in, out_size, ws_size); grid = -1; return; }
        int dev = 0, cus = 0, per_cu = 0;
        if (hipGetDevice(&dev) != hipSuccess || hipDeviceGetAttribute(&cus, hipDeviceAttributeMultiprocessorCount, dev) != hipSuccess) { grid = -1; return; }
        if (hipFuncSetAttribute((const void*)fwd_kernel, hipFuncAttributeMaxDynamicSharedMemorySize, LDS_BYTES) != hipSuccess) { fprintf(stderr, "kernel_launch: hipFuncSetAttribute failed\n"); grid = -1; return; }
        if (hipOccupancyMaxActiveBlocksPerMultiprocessor(&per_cu, (const void*)fwd_kernel, NTHR, LDS_BYTES) != hipSuccess || per_cu < 1) fprintf(stderr, "kernel_launch: occupancy query says %d\n", per_cu);
        (void)hipGetLastError();
        if (per_cu < 1) { fprintf(stderr, "kernel_launch: the kernel does not fit a CU\n"); grid = -1; return; }
        grid = cus;
    }
    if (grid < 0) return;
    (void)hipMemsetAsync((char*)d_ws + WS_CTL, 0, CTL_BYTES, stream);
    Args a{};
    for (int i = 0; i < 35; ++i) a.in[i] = (const float*)d_in[i];
    a.out = (float*)d_out; a.ws = (unsigned char*)d_ws;
#if PROBE_PH >= 0
    a.ph_lo = 0; a.ph_hi = PROBE_PH + 1; a.li = 0; hipLaunchKernelGGL(fwd_kernel, dim3(grid), dim3(NTHR), LDS_BYTES, stream, a);
    for (int rep = 0; rep < PROBE_REPS; ++rep) { a.ph_lo = PROBE_PH; a.ph_hi = PROBE_PH + 1; a.li = 1; hipLaunchKernelGGL(fwd_kernel, dim3(grid), dim3(NTHR), LDS_BYTES, stream, a); }
    if (PROBE_PH + 1 < NPH) { a.ph_lo = PROBE_PH + 1; a.ph_hi = NPH; a.li = 2; hipLaunchKernelGGL(fwd_kernel, dim3(grid), dim3(NTHR), LDS_BYTES, stream, a); }
#elif MK_ONE_LAUNCH
    a.ph_lo = 0; a.ph_hi = NPH; a.li = 0;
    { void* kargs[] = {&a};
      if (hipLaunchCooperativeKernel((const void*)fwd_kernel, dim3(grid), dim3(NTHR), kargs, LDS_BYTES, stream) != hipSuccess) { (void)hipGetLastError(); fprintf(stderr, "kernel_launch: cooperative launch refused\n"); } }
#else
    for (int p = 0; p < NPH; ++p) { a.ph_lo = p; a.ph_hi = p + 1; a.li = 0; hipLaunchKernelGGL(fwd_kernel, dim3(grid), dim3(NTHR), LDS_BYTES, stream, a); }
#endif
}
```

```cpp
#include <hip/hip_runtime.h>
#include <cstdio>
#include <cstdint>

#ifndef PROBE_T
#define PROBE_T -1
#endif
#ifndef PROBE_E
#define PROBE_E 0
#endif
#ifndef PROBE_EB
#define PROBE_EB 0
#endif
#ifndef PROBE_ALL
#define PROBE_ALL 0
#endif
#ifndef PROBE_SEG
#define PROBE_SEG 1
#endif
#if PROBE_E == 1
#define PSEG_B(seg, ldsb) do { if (PROBE_SEG == (seg) && blockIdx.x == PROBE_EB && threadIdx.x == 0) { volatile __attribute__((address_space(3))) unsigned long long* ST_ = (volatile __attribute__((address_space(3))) unsigned long long*)((ldsb) + 131072 + 320 + 64); ST_[4] = __builtin_amdgcn_s_memrealtime(); } } while (0)
#define PSEG_E(seg, ldsb) do { if (PROBE_SEG == (seg) && blockIdx.x == PROBE_EB && threadIdx.x == 0) { volatile __attribute__((address_space(3))) unsigned long long* ST_ = (volatile __attribute__((address_space(3))) unsigned long long*)((ldsb) + 131072 + 320 + 64); if (ST_[3]) ST_[2] += __builtin_amdgcn_s_memrealtime() - ST_[4]; } } while (0)
#else
#define PSEG_B(seg, ldsb) do {} while (0)
#define PSEG_E(seg, ldsb) do {} while (0)
#endif
#ifndef PROBE_PH
#define PROBE_PH -1
#endif
#ifndef PROBE_REPS
#define PROBE_REPS 1
#endif
#ifndef MK_ONE_LAUNCH
#define MK_ONE_LAUNCH 1
#endif

__device__ __forceinline__ float dpp_add_(float v, const int ctrl_sel) {
    const int b = __builtin_bit_cast(int, v); int r;
    if (ctrl_sel == 0) r = __builtin_amdgcn_update_dpp(0, b, 0xB1, 0xf, 0xf, true); else if (ctrl_sel == 1) r = __builtin_amdgcn_update_dpp(0, b, 0x4E, 0xf, 0xf, true);
    else if (ctrl_sel == 2) r = __builtin_amdgcn_update_dpp(0, b, 0x141, 0xf, 0xf, true); else r = __builtin_amdgcn_update_dpp(0, b, 0x140, 0xf, 0xf, true);
    return v + __builtin_bit_cast(float, r); }
__device__ __forceinline__ float row16_sum(float v) { v = dpp_add_(v, 0); v = dpp_add_(v, 1); v = dpp_add_(v, 2); v = dpp_add_(v, 3); return v; }
__device__ __forceinline__ float wave_sum(float v) {
    v = row16_sum(v);
    v += __builtin_bit_cast(float, __builtin_amdgcn_update_dpp(0, __builtin_bit_cast(int, v), 0x142, 0xa, 0xf, false));
    v += __builtin_bit_cast(float, __builtin_amdgcn_update_dpp(0, __builtin_bit_cast(int, v), 0x143, 0xc, 0xf, false));
    return __builtin_bit_cast(float, __builtin_amdgcn_readlane(__builtin_bit_cast(int, v), 63)); }
__device__ __forceinline__ int lane_op_() { int l = (int)threadIdx.x; asm volatile("" : "+v"(l)); return l & 63; }
__device__ __forceinline__ float shx_(float v, int o, int l) { return __builtin_bit_cast(float, __builtin_amdgcn_ds_bpermute((l ^ o) << 2, __builtin_bit_cast(int, v))); }
__device__ __forceinline__ float shup_(float v, int off, int width, int l) { const int src = ((l & (width - 1)) >= off) ? l - off : l; return __builtin_bit_cast(float, __builtin_amdgcn_ds_bpermute(src << 2, __builtin_bit_cast(int, v))); }
__device__ __forceinline__ float shidx_(float v, int src, int width, int l) { return __builtin_bit_cast(float, __builtin_amdgcn_ds_bpermute(((l & ~(width - 1)) + src) << 2, __builtin_bit_cast(int, v))); }
namespace pg8 {
#define PG8_LAS __attribute__((address_space(3)))
typedef unsigned short bf16_t;
typedef short bf16x8 __attribute__((ext_vector_type(8)));
typedef float f32x4 __attribute__((ext_vector_type(4)));
typedef unsigned u32x4 __attribute__((ext_vector_type(4)));
typedef float f32x2 __attribute__((ext_vector_type(2)));
constexpr int BM = 256, BK = 64, HALF = 128, HTB = HALF * BK * 2  , STAGE_BYTES = 8 * HTB, NXCD = 8, WGM = 8;

__host__ __device__ __forceinline__ int lds_byte(int r, int c) { const int st = (r >> 4) * 2 + (c >> 5), rr = r & 15, cc = c & 31, ob = rr * 64 + cc * 2; return st * 1024 + (ob ^ (((ob >> 9) & 1) << 5)); }
__host__ __device__ __forceinline__ void stage_rc(int b, int& R, int& C) { const int st = b / 1024, sb = b % 1024, swz = sb ^ (((sb >> 9) & 1) << 5); R = (st >> 1) * 16 + swz / 64; C = (st & 1) * 32 + (swz % 64) / 2; }
__host__ __device__ __forceinline__ int perm32(int rho) { const int n = rho >> 4, i = rho & 15; return 8 * (i >> 2) + 4 * n + (i & 3); }

struct Unit { int pm, pn; };
struct Gemm { const bf16_t* A; const bf16_t* Bt; int M, N, K; };

struct StaticOrder {
    int nM, nN, nwg, G, c;
    __host__ __device__ void init(int M, int N, int G_, int c_) { nM = M / BM; nN = N / BM; nwg = nM * nN; G = G_; c = c_; }
    __host__ __device__ bool next(int i, Unit& u) const {
        const long L = (long)i * G + c; if (L >= nwg) return false;
        int wgid = (int)L; { const int q = nwg / NXCD, r = nwg % NXCD, xcd = wgid % NXCD, off = wgid / NXCD; wgid = (xcd < r ? xcd * (q + 1) : r * (q + 1) + (xcd - r) * q) + off; }
        const int nig = WGM * nN, gid = wgid / nig, fm = gid * WGM, gsz = (nM - fm) < WGM ? (nM - fm) : WGM;
        u.pm = fm + ((wgid % nig) % gsz); u.pn = (wgid % nig) / gsz; return true;
    }
    __device__ __forceinline__ void a_ready(const Unit&) const {}
    __device__ __forceinline__ void done(const Unit&) const {}
};

__device__ __forceinline__ unsigned cvt_pk_bf16(float lo, float hi) { unsigned r; asm volatile("v_cvt_pk_bf16_f32 %0, %1, %2" : "=v"(r) : "v"(lo), "v"(hi)); return r; }

struct EpiF32 {
    static constexpr bool PERM = false, AFTER_DRAIN = false;
    float* C; int ldc;
    __device__ __forceinline__ void operator()(const f32x4 (&acc)[2][2][4][2], const Unit& u, int wr, int wc, int fr, int fq) const {
        const int row0 = u.pm * BM + wr * 64 + fr, col0 = u.pn * BM + wc * 32 + 4 * fq;
#pragma unroll
        for (int ai = 0; ai < 2; ++ai)
#pragma unroll
            for (int m = 0; m < 4; ++m) { float* rowp = C + (size_t)(row0 + ai * HALF + m * 16) * ldc + col0;
#pragma unroll
                for (int bj = 0; bj < 2; ++bj)
#pragma unroll
                    for (int n = 0; n < 2; ++n) *(f32x4*)(rowp + bj * HALF + n * 16) = acc[ai][bj][m][n]; }
    }
};
struct EpiBf16 {
    static constexpr bool PERM = true, AFTER_DRAIN = false;
    bf16_t* O; int ldc;
    __device__ __forceinline__ void operator()(const f32x4 (&acc)[2][2][4][2], const Unit& u, int wr, int wc, int fr, int fq) const {
        const int row0 = u.pm * BM + wr * 64 + fr, col0 = u.pn * BM + wc * 32 + 8 * fq;
        const auto ors = __builtin_amdgcn_make_buffer_rsrc((void*)O, 0, 0x7fffffff, 0x00020000);
#pragma unroll
        for (int ai = 0; ai < 2; ++ai)
#pragma unroll
            for (int m = 0; m < 4; ++m) { const int ro = ((row0 + ai * HALF + m * 16) * ldc + col0) * 2;
#pragma unroll
                for (int bj = 0; bj < 2; ++bj) { const f32x4 v0 = acc[ai][bj][m][0], v1 = acc[ai][bj][m][1];
                    u32x4 w; w.x = cvt_pk_bf16(v0[0], v0[1]); w.y = cvt_pk_bf16(v0[2], v0[3]); w.z = cvt_pk_bf16(v1[0], v1[1]); w.w = cvt_pk_bf16(v1[2], v1[3]);
                    __builtin_amdgcn_raw_buffer_store_b128(w, ors, ro + bj * HALF * 2, 0, 16); } }
    }
};
struct EpiGlu {
    static constexpr bool PERM = true, AFTER_DRAIN = false;
    bf16_t* C; int ldc;
    __device__ __forceinline__ void operator()(const f32x4 (&acc)[2][2][4][2], const Unit& u, int wr, int wc, int fr, int fq) const {
        const int row0 = u.pm * BM + wr * 64 + fr, col0 = u.pn * HALF + wc * 32 + 8 * fq;
        const auto ors = __builtin_amdgcn_make_buffer_rsrc((void*)C, 0, 0x7fffffff, 0x00020000);
#pragma unroll
        for (int ai = 0; ai < 2; ++ai)
#pragma unroll
            for (int m = 0; m < 4; ++m) { unsigned pkw[4];
#pragma unroll
                for (int n = 0; n < 2; ++n) { const f32x4 v = acc[ai][0][m][n], g = acc[ai][1][m][n]; float o[4];
#pragma unroll
                    for (int j = 0; j < 4; ++j) o[j] = v[j] * __builtin_amdgcn_rcpf(1.0f + __expf(-g[j]));
                    pkw[2 * n] = cvt_pk_bf16(o[0], o[1]); pkw[2 * n + 1] = cvt_pk_bf16(o[2], o[3]); }
                u32x4 w; w.x = pkw[0]; w.y = pkw[1]; w.z = pkw[2]; w.w = pkw[3];
                __builtin_amdgcn_raw_buffer_store_b128(w, ors, ((row0 + ai * HALF + m * 16) * ldc + col0) * 2, 0, 16); }
    }
};


__device__ __forceinline__ float dpp_shr1(float old, float src) { return __builtin_bit_cast(float, __builtin_amdgcn_update_dpp(__builtin_bit_cast(int, old), __builtin_bit_cast(int, src), 0x111, 0xf, 0xf, false)); }
__device__ __forceinline__ float dpp_shr2(float old, float src) { return __builtin_bit_cast(float, __builtin_amdgcn_update_dpp(__builtin_bit_cast(int, old), __builtin_bit_cast(int, src), 0x112, 0xf, 0xf, false)); }
__device__ __forceinline__ float dpp_ror1(float src) { return __builtin_bit_cast(float, __builtin_amdgcn_update_dpp(0, __builtin_bit_cast(int, src), 0x121, 0xf, 0xf, false)); }
__device__ __forceinline__ float dpp_ror2(float src) { return __builtin_bit_cast(float, __builtin_amdgcn_update_dpp(0, __builtin_bit_cast(int, src), 0x122, 0xf, 0xf, false)); }
struct EpiConvGate {
    bf16_t* ACT; const float* cw; const float* cb; float* HEAD; float* TAIL; PG8_LAS float* HALO; float* PFC;
    __device__ __forceinline__ void prefetch(const Unit& u, int wid, int lane, int par) const {
        constexpr int FF_ = 2816, FF2_ = 5632;
        if (wid < 4) { const int c = 4 * lane; const float* src = (wid < 3 ? cw + wid * FF2_ : cb) + (c < 128 ? u.pn * 128 + c : FF_ + u.pn * 128 + (c - 128));
            __builtin_amdgcn_global_load_lds((const unsigned*)src, (PG8_LAS unsigned*)(HALO + 1536 + par * 1024 + wid * 256), 16, 0, 0); }
    }
    __device__ __forceinline__ void operator()(const f32x4 (&acc)[2][2][4][2], const Unit& u, int wr, int wc, int fr, int fq, int par) const {
        constexpr int FF_ = 2816, FF2_ = 5632;
        asm volatile("" : "+v"(fr), "+v"(fq));
        const int colt = wc * 32 + 8 * fq;
        if (fr == 15) {
#pragma unroll
            for (int ai = 0; ai < 2; ++ai)
#pragma unroll
                for (int bj = 0; bj < 2; ++bj)
#pragma unroll
                    for (int n = 0; n < 2; ++n)
#pragma unroll
                        for (int hr = 0; hr < 2; ++hr) { if (!(ai == 1 && wr == 1)) *(PG8_LAS f32x4*)(HALO + ((ai * 2 + wr) * 2 + hr) * 256 + bj * 128 + colt + 4 * n) = acc[ai][bj][2 + hr][n];
                            if (ai == 1 && wr == 1) { *(f32x4*)(TAIL + ((size_t)u.pm * 2 + hr) * FF2_ + bj * FF_ + u.pn * 128 + colt + 4 * n) = acc[1][bj][2 + hr][n];
                                if ((u.pm & 7) == 7) *(f32x4*)(PFC + ((size_t)(u.pm >> 3) * 2 + hr) * FF2_ + bj * FF_ + u.pn * 128 + colt + 4 * n) = acc[1][bj][2 + hr][n]; } } }
        if (fr == 0 && wr == 0) {
#pragma unroll
            for (int bj = 0; bj < 2; ++bj)
#pragma unroll
                for (int n = 0; n < 2; ++n)
#pragma unroll
                    for (int hr = 0; hr < 2; ++hr) *(f32x4*)(HEAD + ((size_t)u.pm * 2 + hr) * FF2_ + bj * FF_ + u.pn * 128 + colt + 4 * n) = acc[0][bj][hr][n]; }
        PSEG_B(12, (PG8_LAS unsigned char*)HALO - 131072 - 1024); asm volatile("s_waitcnt vmcnt(0) lgkmcnt(0)" ::: "memory"); __builtin_amdgcn_s_barrier(); asm volatile("" ::: "memory");
        PSEG_E(12, (PG8_LAS unsigned char*)HALO - 131072 - 1024);
        const PG8_LAS float* WL = HALO + 1536 + par * 1024;
        const auto ars_ = __builtin_amdgcn_make_buffer_rsrc((void*)ACT, 0, 0x7fffffff, 0x00020000);
#pragma unroll
        for (int ai = 0; ai < 2; ++ai) {
            const int pred = wr == 1 ? (ai * 2 + 0) : (0 * 2 + 1);
            const bool nohist = (ai == 0 && wr == 0);
            const int row0 = u.pm * BM + ai * HALF + wr * 64 + 4 * fr;
            unsigned pk[4][2][2];
#pragma unroll
            for (int n = 0; n < 2; ++n)
#pragma unroll
                for (int jp = 0; jp < 2; ++jp) {
                    f32x2 gs[4];
#pragma unroll
                    for (int bj = 1; bj >= 0; --bj) { const int wc_ = bj * 128 + colt + 4 * n + 2 * jp;
                        const f32x2 w0 = *(const PG8_LAS f32x2*)(WL + wc_), w1 = *(const PG8_LAS f32x2*)(WL + 256 + wc_), w2 = *(const PG8_LAS f32x2*)(WL + 512 + wc_), bb = *(const PG8_LAS f32x2*)(WL + 768 + wc_);
                        const f32x2 h0 = *(const PG8_LAS f32x2*)(HALO + (pred * 2 + 0) * 256 + wc_), h1 = *(const PG8_LAS f32x2*)(HALO + (pred * 2 + 1) * 256 + wc_);
                        f32x2 X[4];
#pragma unroll
                        for (int m = 0; m < 4; ++m) X[m] = jp ? (f32x2){acc[ai][bj][m][n][2], acc[ai][bj][m][n][3]} : (f32x2){acc[ai][bj][m][n][0], acc[ai][bj][m][n][1]};
                        const f32x2 P2 = {dpp_shr1(h0[0], X[2][0]), dpp_shr1(h0[1], X[2][1])}, P3 = {dpp_shr1(h1[0], X[3][0]), dpp_shr1(h1[1], X[3][1])};
                        f32x2 r[4];
                        r[0] = bb + w0 * P2 + w1 * P3 + w2 * X[0]; r[1] = bb + w0 * P3 + w1 * X[0] + w2 * X[1]; r[2] = bb + w0 * X[0] + w1 * X[1] + w2 * X[2]; r[3] = bb + w0 * X[1] + w1 * X[2] + w2 * X[3];
#pragma unroll
                        for (int m = 0; m < 4; ++m) {
                            if (bj == 1) { const f32x2 tt = r[m] * (f32x2){-1.44269504f, -1.44269504f}; const f32x2 dd = (f32x2){__builtin_amdgcn_exp2f(tt[0]), __builtin_amdgcn_exp2f(tt[1])} + (f32x2){1.0f, 1.0f};
                                gs[m] = r[m] * (f32x2){__builtin_amdgcn_rcpf(dd[0]), __builtin_amdgcn_rcpf(dd[1])}; }
                            else { const f32x2 ov = r[m] * gs[m]; pk[m][n][jp] = cvt_pk_bf16(ov[0], ov[1]); } }
                    }
                }
#pragma unroll
            for (int m = 0; m < 4; ++m) { if (nohist && fr == 0 && m < 2) continue;
                u32x4 w; w.x = pk[m][0][0]; w.y = pk[m][0][1]; w.z = pk[m][1][0]; w.w = pk[m][1][1]; __builtin_amdgcn_raw_buffer_store_b128(w, ars_, ((row0 + m) * FF_ + u.pn * 128 + colt) * 2, 0, 16); }
            asm volatile("" ::: "memory");
        }
    }
};
struct EpiAny {
    static constexpr bool AFTER_DRAIN = false;
    int mode; bool perm; void* O; int ldc; EpiConvGate cg; bool aperm;
    __device__ __forceinline__ void operator()(const f32x4 (&acc)[2][2][4][2], const Unit& u, int wr, int wc, int fr, int fq, int par) const {
        if (mode == 0) { EpiBf16 e{(bf16_t*)O, ldc}; e(acc, u, wr, wc, fr, fq); }
        else if (mode == 1) { EpiF32 e{(float*)O, ldc}; e(acc, u, wr, wc, fr, fq); }
        else if (mode == 2) { EpiGlu e{(bf16_t*)O, ldc}; e(acc, u, wr, wc, fr, fq); }
        else cg(acc, u, wr, wc, fr, fq, par);
    }
    __device__ __forceinline__ void prefetch(const Unit& u, int wid, int lane, int par) const { if (mode == 3) cg.prefetch(u, wid, lane, par); }
};
template <class Epi, class Sched, bool ALIGN_EPI = false, bool SP2 = false>
__device__ __forceinline__ void gemm_phase(PG8_LAS unsigned char* lds, const Gemm g, const Sched& S, const Epi& E, const int tid) {
    const int wid = __builtin_amdgcn_readfirstlane(tid >> 6), lane = tid & 63, wr = wid >> 2, wc = wid & 3, fr = lane & 15, fq = lane >> 4;
    const int K = g.K, nt = K / BK;
    unsigned voffA[2], voffB[2];
#pragma unroll
    for (int i = 0; i < 2; ++i) { int R, C; stage_rc(tid * 16 + i * 8192, R, C); const int Rb = E.perm ? ((R & ~31) + perm32(R & 31)) : R;
        const int Ra = E.aperm ? ((R & ~63) + 4 * (R & 15) + ((R >> 4) & 3)) : R;
        voffA[i] = (unsigned)(Ra * K + C) * 2u; voffB[i] = (unsigned)(Rb * K + C) * 2u; }
    const size_t kstep = (size_t)(BK * 2);
    const size_t hstep = (size_t)HALF * K * 2;
    const size_t tstep = 2 * hstep;
    const unsigned ldsw = (unsigned)wid * 1024u;
    const int aoff = lds_byte(wr * 64 + fr, fq * 8), boff = lds_byte(wc * 32 + fr, fq * 8);
#define PG8_SA(b, h) (((b) * 2 + (h)) * HTB)
#define PG8_SB(b, h) ((4 + (b) * 2 + (h)) * HTB)
#define PG8_STAGE(bufoff, gbase, voff) do { _Pragma("unroll") for (int _i = 0; _i < 2; ++_i) \
        __builtin_amdgcn_global_load_lds((const unsigned*)((const char*)(gbase) + (voff)[_i]), (PG8_LAS unsigned*)(lds + (bufoff) + ldsw + _i * 8192), 16, 0, 0); } while (0)
#define PG8_LDA(dst, b, h) do { _Pragma("unroll") for (int m = 0; m < 4; ++m) _Pragma("unroll") for (int k = 0; k < 2; ++k) dst[m][k] = *(const PG8_LAS bf16x8*)(lds + PG8_SA(b, h) + aoff + m * 2048 + k * 1024); } while (0)
#define PG8_LDB(dst, b, h) do { _Pragma("unroll") for (int n = 0; n < 2; ++n) _Pragma("unroll") for (int k = 0; k < 2; ++k) dst[n][k] = *(const PG8_LAS bf16x8*)(lds + PG8_SB(b, h) + boff + n * 2048 + k * 1024); } while (0)
#define PG8_MMA(ai, bj, At, Bt) do { __builtin_amdgcn_s_setprio(1); _Pragma("unroll") for (int m = 0; m < 4; ++m) _Pragma("unroll") for (int n = 0; n < 2; ++n) _Pragma("unroll") for (int k = 0; k < 2; ++k) \
        acc[ai][bj][m][n] = __builtin_amdgcn_mfma_f32_16x16x32_bf16(Bt[n][k], At[m][k], acc[ai][bj][m][n], 0, 0, 0); __builtin_amdgcn_s_setprio(0); } while (0)
#define PG8_WAIT_V(n) asm volatile("s_waitcnt vmcnt(" #n ")" ::: "memory")
#define PG8_WAIT_L(n) asm volatile("s_waitcnt lgkmcnt(" #n ")" ::: "memory")
#define PG8_BAR __builtin_amdgcn_s_barrier()
#define PG8_SCHED __builtin_amdgcn_sched_barrier(0)
    Unit cur, nxt; int ui = 0;
    if (!S.next(0, cur)) return;
    f32x4 acc[2][2][4][2];
#pragma unroll
    for (int a = 0; a < 2; ++a)
#pragma unroll
        for (int b = 0; b < 2; ++b)
#pragma unroll
            for (int m = 0; m < 4; ++m)
#pragma unroll
                for (int n = 0; n < 2; ++n) acc[a][b][m][n] = (f32x4){0.f, 0.f, 0.f, 0.f};
    bf16x8 At[4][2], B0[2][2], B1[2][2];
    const char* cA = (const char*)g.A + (size_t)cur.pm * tstep; const char* cB = (const char*)g.Bt + (size_t)cur.pn * tstep;
    S.a_ready(cur);
    if constexpr (SP2) {
        PG8_STAGE(PG8_SB(0, 0), cB, voffB); PG8_STAGE(PG8_SB(0, 1), cB + hstep, voffB); PG8_STAGE(PG8_SA(0, 0), cA, voffA); PG8_STAGE(PG8_SA(0, 1), cA + hstep, voffA);
        if (wr == 1) PG8_BAR;
        PG8_WAIT_V(2); PG8_BAR;
        PG8_STAGE(PG8_SB(1, 0), cB + kstep, voffB); PG8_STAGE(PG8_SA(1, 0), cA + kstep, voffA); PG8_STAGE(PG8_SB(1, 1), cB + hstep + kstep, voffB);
        PG8_WAIT_V(6); PG8_BAR;
    } else {
        PG8_STAGE(PG8_SB(0, 0), cB, voffB); PG8_STAGE(PG8_SA(0, 0), cA, voffA); PG8_STAGE(PG8_SB(0, 1), cB + hstep, voffB); PG8_STAGE(PG8_SA(0, 1), cA + hstep, voffA);
        if (wr == 1) PG8_BAR;
        PG8_WAIT_V(4); PG8_BAR;
        PG8_STAGE(PG8_SB(1, 0), cB + kstep, voffB); PG8_STAGE(PG8_SA(1, 0), cA + kstep, voffA); PG8_STAGE(PG8_SB(1, 1), cB + hstep + kstep, voffB);
        PG8_WAIT_V(6); PG8_BAR;
    }
    E.prefetch(cur, wid, lane, 0);
    for (;;) {
        const bool has_next = S.next(ui + 1, nxt);
        const char* nA = has_next ? (const char*)g.A + (size_t)nxt.pm * tstep : cA; const char* nB = has_next ? (const char*)g.Bt + (size_t)nxt.pn * tstep : cB;
        PSEG_B(11, lds);
        for (int t = 0; t < nt; t += 2) {
            const bool last = (t == nt - 2);
            const char* a1 = cA + (size_t)(t + 1) * kstep;
            const char* a2 = last ? nA : cA + (size_t)(t + 2) * kstep; const char* b2 = last ? nB : cB + (size_t)(t + 2) * kstep;
            const char* a3 = a2 + kstep; const char* b3 = b2 + kstep;
            if (last && has_next) S.a_ready(nxt);
            if constexpr (SP2) {
            PG8_LDB(B0, 0, 0); PG8_LDB(B1, 0, 1); PG8_SCHED; PG8_LDA(At, 0, 0); PG8_STAGE(PG8_SA(1, 1), a1 + hstep, voffA);
            PG8_WAIT_V(8); PG8_WAIT_L(0); PG8_BAR; PG8_MMA(0, 0, At, B0); PG8_MMA(0, 1, At, B1); PG8_BAR; PG8_SCHED;
            PG8_LDA(At, 0, 1); PG8_STAGE(PG8_SB(0, 0), b2, voffB); PG8_STAGE(PG8_SB(0, 1), b2 + hstep, voffB); PG8_STAGE(PG8_SA(0, 0), a2, voffA);
            PG8_WAIT_V(8); PG8_WAIT_L(0); PG8_BAR; PG8_MMA(1, 0, At, B0); PG8_MMA(1, 1, At, B1); PG8_BAR; PG8_SCHED;
            PG8_LDB(B0, 1, 0); PG8_LDB(B1, 1, 1); PG8_SCHED; PG8_LDA(At, 1, 0); PG8_STAGE(PG8_SA(0, 1), a2 + hstep, voffA);
            PG8_WAIT_V(8); PG8_WAIT_L(0); PG8_BAR; PG8_MMA(0, 0, At, B0); PG8_MMA(0, 1, At, B1); PG8_BAR; PG8_SCHED;
            PG8_LDA(At, 1, 1); PG8_STAGE(PG8_SB(1, 0), b3, voffB); PG8_STAGE(PG8_SB(1, 1), b3 + hstep, voffB); PG8_STAGE(PG8_SA(1, 0), a3, voffA);
            PG8_WAIT_V(8); PG8_WAIT_L(0); PG8_BAR; PG8_MMA(1, 0, At, B0); PG8_MMA(1, 1, At, B1); PG8_BAR; PG8_SCHED;
            } else {
            PG8_LDB(B0, 0, 0); PG8_SCHED; PG8_LDA(At, 0, 0); PG8_STAGE(PG8_SA(1, 1), a1 + hstep, voffA);
            PG8_WAIT_L(8); PG8_BAR; PG8_WAIT_L(0); PG8_MMA(0, 0, At, B0); PG8_BAR; PG8_SCHED;
            PG8_LDB(B1, 0, 1); PG8_STAGE(PG8_SB(0, 0), b2, voffB);
            PG8_BAR; PG8_WAIT_L(0); PG8_MMA(0, 1, At, B1); PG8_BAR;
            PG8_LDA(At, 0, 1); PG8_STAGE(PG8_SA(0, 0), a2, voffA);
            PG8_BAR; PG8_WAIT_L(0); PG8_MMA(1, 0, At, B0); PG8_BAR; PG8_SCHED;
            PG8_STAGE(PG8_SB(0, 1), b2 + hstep, voffB);
            PG8_WAIT_V(6); PG8_BAR; PG8_MMA(1, 1, At, B1); PG8_BAR;
            PG8_LDB(B0, 1, 0); PG8_SCHED; PG8_LDA(At, 1, 0); PG8_STAGE(PG8_SA(0, 1), a2 + hstep, voffA);
            PG8_WAIT_L(8); PG8_BAR; PG8_WAIT_L(0); PG8_MMA(0, 0, At, B0); PG8_BAR; PG8_SCHED;
            PG8_LDB(B1, 1, 1); PG8_STAGE(PG8_SB(1, 0), b3, voffB);
            PG8_BAR; PG8_WAIT_L(0); PG8_MMA(0, 1, At, B1); PG8_BAR;
            PG8_LDA(At, 1, 1); PG8_STAGE(PG8_SA(1, 0), a3, voffA);
            PG8_BAR; PG8_WAIT_L(0); PG8_MMA(1, 0, At, B0); PG8_BAR; PG8_SCHED;
            PG8_STAGE(PG8_SB(1, 1), b3 + hstep, voffB);
            PG8_WAIT_V(6); PG8_BAR; PG8_MMA(1, 1, At, B1); PG8_BAR;
            }
        }
        PSEG_E(11, lds);
        if constexpr (ALIGN_EPI) { if (wr == 0) PG8_BAR; }
        PSEG_B(1, lds);
        if constexpr (!Epi::AFTER_DRAIN) { E(acc, cur, wr, wc, fr, fq, ui & 1); S.done(cur); }
        PSEG_E(1, lds);
        if (!has_next) break;
        E.prefetch(nxt, wid, lane, (ui + 1) & 1);
#pragma unroll
        for (int a = 0; a < 2; ++a)
#pragma unroll
            for (int b = 0; b < 2; ++b)
#pragma unroll
                for (int m = 0; m < 4; ++m)
#pragma unroll
                    for (int n = 0; n < 2; ++n) acc[a][b][m][n] = (f32x4){0.f, 0.f, 0.f, 0.f};
        cur = nxt; cA = nA; cB = nB; ++ui;
        if constexpr (ALIGN_EPI) { if (wr == 1) PG8_BAR; }
    }
    PG8_WAIT_V(0);
    if constexpr (!ALIGN_EPI) { if (wr == 0) PG8_BAR; }
    PG8_BAR;
    if constexpr (Epi::AFTER_DRAIN) { E.fused(acc, cur, wr, wc, fr, fq, lds, wid, lane); S.done(cur); }
#undef PG8_SA
#undef PG8_SB
#undef PG8_STAGE
#undef PG8_LDA
#undef PG8_LDB
#undef PG8_MMA
#undef PG8_WAIT_V
#undef PG8_WAIT_L
#undef PG8_BAR
#undef PG8_SCHED
}
}

constexpr int NWAVES = 8, NTHR = 512;
constexpr int D = 1024, NB = 8, SEQ = 2048, MP = NB * SEQ, MS = 128, MT = MP + MS;
constexpr int NA = 2560, NBH = 4096;
constexpr int WIN_ROWS = NA + NBH;
constexpr int XBC = 1280, ABIN = 6416;
constexpr int FF = 2816, FF2 = 5632, NFT = 22;
constexpr float EPS = 1e-6f;
constexpr int NPH = 18;

constexpr size_t O_YP = 0, O_YS = O_YP + (size_t)MP * D, O_PSSM = O_YS + (size_t)MS * D, O_PSCONV = O_PSSM + 8 * 16 * 64 * 64, O_PHG = O_PSCONV + 8 * 3 * XBC,
                 O_PS5R = O_PHG + 8 * 8 * 128 * 128, O_PS5I = O_PS5R + 8 * 64 * 64, O_PFC = O_PS5I + 8 * 64 * 64, O_SSSM = O_PFC + 2 * 8 * 2 * FF2,
                 O_SSCONV = O_SSSM + (size_t)MS * 16 * 64 * 64, O_SHG = O_SSCONV + (size_t)MS * 3 * XBC, O_SS5R = O_SHG + (size_t)MS * 8 * 128 * 128,
                 O_SS5I = O_SS5R + (size_t)MS * 64 * 64, O_SFC = O_SS5I + (size_t)MS * 64 * 64, O_END = O_SFC + (size_t)2 * MS * 2 * FF2;
static_assert(O_END == 48347136, "d_out size");

constexpr size_t al256(size_t x) { return (x + 255) & ~(size_t)255; }
constexpr size_t WS_CTL = 0, CTL_BYTES = 1u << 20;
constexpr size_t WS_WIN = CTL_BYTES;
constexpr size_t WS_WOUT = WS_WIN + (size_t)WIN_ROWS * D * 2;
constexpr size_t WS_WGLU = WS_WOUT + (size_t)D * 2048 * 2;
constexpr size_t WS_WUP = WS_WGLU + (size_t)2048 * D * 2;
constexpr size_t WS_WDN = WS_WUP + (size_t)2 * FF2 * D * 2;
constexpr size_t WS_XN = WS_WDN + (size_t)2 * D * FF * 2;
constexpr size_t WS_MIXS = WS_XN + (size_t)MT * D * 2;
constexpr size_t WS_BIG = al256(WS_MIXS + (size_t)MS * 2048 * 2);
constexpr size_t WS_END = (size_t)256 << 20;
constexpr size_t BIG_BYTES = WS_END - WS_BIG;
constexpr size_t B_PROJA = 0;
constexpr size_t B_Y2 = al256(B_PROJA + (size_t)MT * NA * 2);
constexpr size_t B_ORAW = 0;
constexpr size_t B_PROJB = al256(B_ORAW + (size_t)MT * D * 2);
constexpr size_t B_M1 = 0;
constexpr size_t B_UP = 0;
constexpr size_t B_ACT = al256((size_t)MT * 2048 * 2);
constexpr size_t B_GY = 0;
constexpr size_t B_PC = al256(B_GY + (size_t)MT * D * 2);
constexpr size_t B_XP = al256(B_PC + (size_t)1024 * 8192 * 4);
constexpr size_t B_M1G = (size_t)100 << 20;
constexpr size_t B_S5T = (size_t)120 << 20;
constexpr size_t S5T_KQ = 0, S5T_PM = S5T_KQ + (size_t)64 * 256 * 384 * 2, S5T_AB = S5T_PM + (size_t)64 * 128 * 256 * 2, S5T_BB = S5T_AB + (size_t)64 * 64 * 2 * 4, S5T_END = S5T_BB + (size_t)64 * 64 * 32 * 4;
static_assert(B_Y2 + (size_t)MT * D * 4 <= BIG_BYTES, "ssd stage");
static_assert(B_PROJB + (size_t)MT * NBH * 2 <= BIG_BYTES, "hgrn stage");
static_assert(B_ACT + (size_t)MT * FF * 2 <= BIG_BYTES, "ffn stage");
static_assert(B_XP + (size_t)1024 * 8192 * 2 <= B_S5T && B_M1G + (size_t)MT * D * 4 <= BIG_BYTES && B_S5T + S5T_END <= BIG_BYTES && B_S5T >= B_M1 + (size_t)MT * D * 4, "s5 stage");

#define GAS __attribute__((address_space(1)))
#define LAS __attribute__((address_space(3)))
typedef unsigned short bf16;
typedef unsigned v4u __attribute__((ext_vector_type(4)));
typedef unsigned v2u __attribute__((ext_vector_type(2)));
typedef float f32x4 __attribute__((ext_vector_type(4)));
typedef float f32x16 __attribute__((ext_vector_type(16)));
typedef short bf16x8 __attribute__((ext_vector_type(8)));
typedef GAS unsigned gu32;
__device__ __forceinline__ void st16_wt(const void* base, int byteoff, v4u v) { const auto r_ = __builtin_amdgcn_make_buffer_rsrc((void*)base, 0, 0x7fffffff, 0x00020000); __builtin_amdgcn_raw_buffer_store_b128(v, r_, byteoff, 0, 16); }
#define RLX_AGENT __ATOMIC_RELAXED, __HIP_MEMORY_SCOPE_AGENT
#define LDS_WAIT() asm volatile("s_waitcnt lgkmcnt(0)" ::: "memory")
#define VM_WAIT() asm volatile("s_waitcnt vmcnt(0)" ::: "memory")
__device__ __forceinline__ unsigned f2bf(float f) { unsigned u = __builtin_bit_cast(unsigned, f); return (u + 0x7fffu + ((u >> 16) & 1u)) >> 16; }
__device__ __forceinline__ unsigned pk2(float lo, float hi) { return f2bf(lo) | (f2bf(hi) << 16); }
__device__ __forceinline__ float bf2f(unsigned short b) { return __builtin_bit_cast(float, (unsigned)b << 16); }
__device__ __forceinline__ float bflo(unsigned w) { return __builtin_bit_cast(float, w << 16); }
__device__ __forceinline__ float bfhi(unsigned w) { return __builtin_bit_cast(float, w & 0xffff0000u); }
__device__ __forceinline__ float sigmoidf_(float x) { return __builtin_amdgcn_rcpf(1.0f + __expf(-x)); }
__device__ __forceinline__ float siluf_(float x) { return x * __builtin_amdgcn_rcpf(1.0f + __expf(-x)); }
__device__ __forceinline__ float softplusf_(float x) { return x > 20.f ? x : log1pf(__expf(x)); }
__device__ __forceinline__ float gelu_tanh(float x) { const float u = 0.7978845608028654f * (x + 0.044715f * x * x * x); const float e = __expf(2.f * u); const float th = 1.f - 2.f / (e + 1.f); return 0.5f * x * (1.f + th); }

#define XB_TMO      128
#define XB_XCNT(j)  (256  + 64 * (j))
#define XB_XSUB(j)  (1280 + 64 * (j))
#define XB_XGEN(j)  (2304 + 64 * (j))
#define XB_TOP      3328
#define XB_TOPGEN   3392
#define XCD_BAR_WORDS 3456
#define XB_SPIN_CAP (1u << 18)
__device__ __forceinline__ unsigned xb_ld(unsigned* p)              { return __hip_atomic_load(p, __ATOMIC_RELAXED, __HIP_MEMORY_SCOPE_AGENT); }
__device__ __forceinline__ unsigned xb_add(unsigned* p, unsigned v) { return __hip_atomic_fetch_add(p, v, __ATOMIC_RELAXED, __HIP_MEMORY_SCOPE_AGENT); }
__device__ __forceinline__ unsigned xb_xcc_id() { return (unsigned)__builtin_amdgcn_s_getreg((3 << 11) | 20) & 0xFu; }
#define XB_SPIN(cond, bar) do { unsigned _sp = 0; while (cond) { __builtin_amdgcn_s_sleep(1); \
    if ((++_sp & 255u) == 0u) { if (xb_ld(&(bar)[XB_TMO])) break; if (_sp > XB_SPIN_CAP) { atomicAdd(&(bar)[XB_TMO], 1u); break; } } } } while (0)
struct XcdBarrier { unsigned* bar; unsigned x; volatile LAS unsigned* st; };
__device__ __forceinline__ XcdBarrier xcd_barrier_post(unsigned* bar, volatile LAS unsigned* st) {
    XcdBarrier b; b.bar = bar; b.x = xb_xcc_id(); b.st = st;
    if (threadIdx.x == 0) (void)xb_add(&bar[XB_XCNT(b.x)], 1u);
    return b;
}
__device__ __forceinline__ void xcd_barrier_complete(unsigned* bar, unsigned x, unsigned& nloc, unsigned& nx) {
    const unsigned G = gridDim.x * gridDim.y * gridDim.z;
    unsigned sum, cnt, mine, sp = 0u;
    for (;;) {
        sum = 0u; cnt = 0u; mine = 0u;
#pragma unroll
        for (unsigned j = 0; j < 16; ++j) { const unsigned c = xb_ld(&bar[XB_XCNT(j)]); sum += c; cnt += (c > 0u) ? 1u : 0u; mine = (j == x) ? c : mine; }
        if (sum == G) break;
        __builtin_amdgcn_s_sleep(1);
        if ((++sp & 255u) == 0u) { if (xb_ld(&bar[XB_TMO])) break; if (sp > XB_SPIN_CAP) { atomicAdd(&bar[XB_TMO], 1u); break; } }
    }
    nloc = mine > 0u ? mine : 1u; nx = cnt > 0u ? cnt : 1u;
}
__device__ __forceinline__ void xcd_barrier(const XcdBarrier& b) {
    asm volatile("s_waitcnt vmcnt(0)" ::: "memory");
    __syncthreads();
    if (threadIdx.x == 0) {
        unsigned* bar = b.bar;
        __builtin_amdgcn_s_waitcnt(0);
        unsigned nloc = b.st[0], nx = b.st[1];
        if (nloc == 0u) { xcd_barrier_complete(bar, b.x, nloc, nx); b.st[0] = nloc; b.st[1] = nx; }
        const unsigned old = xb_add(&bar[XB_XSUB(b.x)], 1u);
        const unsigned gen = old / nloc;
        if (old + 1u == (gen + 1u) * nloc) {
            __builtin_amdgcn_fence(__ATOMIC_RELEASE, "agent");
            asm volatile("s_waitcnt vmcnt(0)" ::: "memory");
            const unsigned og = xb_add(&bar[XB_TOP], 1u);
            const unsigned tg = og / nx;
            if (og + 1u == (tg + 1u) * nx) xb_add(&bar[XB_TOPGEN], 1u);
            else XB_SPIN(xb_ld(&bar[XB_TOPGEN]) == tg, bar);
            xb_add(&bar[XB_XGEN(b.x)], 1u);
            __builtin_amdgcn_fence(__ATOMIC_ACQUIRE, "agent");
            asm volatile("s_waitcnt vmcnt(0)" ::: "memory");
        } else {
            XB_SPIN(xb_ld(&bar[XB_XGEN(b.x)]) == gen, bar);
            __builtin_amdgcn_fence(__ATOMIC_ACQUIRE, "agent");
            asm volatile("s_waitcnt vmcnt(0)" ::: "memory");
        }
    }
    __syncthreads();
}

constexpr int RING_BYTES = 131072;
constexpr int LDSCTL_OFF = RING_BYTES, MISC_OFF = LDSCTL_OFF + 320, HALO_OFF = RING_BYTES + 1024;
constexpr int LDS_BYTES = 147456;

struct Args { const float* in[35]; float* out; unsigned char* ws; int ph_lo, ph_hi, li, pad; };
static_assert(sizeof(Args) == 35 * 8 + 8 + 8 + 16, "Args has no padding");
#define CAS __attribute__((address_space(4)))
struct Frame {
    LAS unsigned char* lds;
    int tid, lane, wave, vcu, G;
    const CAS Args* a;
    float* out;
    unsigned char* ws;
};

enum { I_XP = 0, I_XS, I_SSSM, I_SSCONV, I_SHG, I_SS5R, I_SS5I, I_SFC, I_NMPRE, I_NMPOST, I_NFPRE, I_NFPOST, I_WIN, I_CONVW, I_CONVB, I_DTB, I_ALOG, I_SSMD, I_SSMNW,
       I_HGLB, I_HGNW, I_WOUT, I_LAMRE, I_LAMIM, I_LOGSTEP, I_BRE, I_BIM, I_CRE, I_CIM, I_S5D, I_WGLU, I_WUP, I_FCW, I_FCB, I_WDN, N_IN };

#define GW_ID(F) ((F).vcu * NWAVES + (F).wave)
#define GW_N(F) ((F).G * NWAVES)

__device__ __forceinline__ void p0_transpose_item(const float* W, int ldw, int K, int scol0, bf16* WT, int drow0, int kb, LAS float* scr, int lane) {
    const int k0 = 64 * kb;
    f32x4 v[8];
#pragma unroll
    for (int i = 0; i < 8; ++i) v[i] = *(const GAS f32x4*)(W + (size_t)(k0 + (lane >> 3) + 8 * i) * ldw + scol0 + 4 * (lane & 7));
#pragma unroll
    for (int i = 0; i < 8; ++i) { LAS float* d = scr + ((lane >> 3) + 8 * i) * 33 + 4 * (lane & 7); d[0] = v[i].x; d[1] = v[i].y; d[2] = v[i].z; d[3] = v[i].w; }
    LDS_WAIT(); asm volatile("" ::: "memory");
    const int c = lane & 7;
#pragma unroll
    for (int j = 0; j < 4; ++j) { const int n = (lane >> 3) + 8 * j; const LAS float* s = scr + (8 * c) * 33 + n;
        v4u o; o.x = pk2(s[0 * 33], s[1 * 33]); o.y = pk2(s[2 * 33], s[3 * 33]); o.z = pk2(s[4 * 33], s[5 * 33]); o.w = pk2(s[6 * 33], s[7 * 33]);
        st16_wt(WT, ((drow0 + n) * K + k0 + 8 * c) * 2, o); }
    LDS_WAIT(); asm volatile("" ::: "memory");
}
__device__ __forceinline__ void rms_row_to_bf16(const float* xrow, const float* w, bf16* orow, int lane) {
    const GAS f32x4* xr = (const GAS f32x4*)xrow + lane; const GAS f32x4* wr = (const GAS f32x4*)w + lane;
    f32x4 v[4]; float s = 0.f;
#pragma unroll
    for (int j = 0; j < 4; ++j) { v[j] = xr[64 * j]; s += (v[j].x * v[j].x + v[j].y * v[j].y) + (v[j].z * v[j].z + v[j].w * v[j].w); }
    const float rs = rsqrtf(wave_sum(s) * (1.f / D) + EPS);
    GAS v2u* o8 = (GAS v2u*)orow + lane;
#pragma unroll
    for (int j = 0; j < 4; ++j) { const f32x4 ww = wr[64 * j]; v2u o; o.x = pk2(v[j].x * rs * ww.x, v[j].y * rs * ww.y); o.y = pk2(v[j].z * rs * ww.z, v[j].w * rs * ww.w); o8[64 * j] = o; }
}
__device__ __forceinline__ const float* x_in_row(const Frame& F, int r) { return r < MP ? F.a->in[I_XP] + (size_t)r * D : F.a->in[I_XS] + (size_t)(r - MP) * D; }
__device__ __forceinline__ float* x_res_row(const Frame& F, int r) { return r < MP ? F.out + O_YP + (size_t)r * D : F.out + O_YS + (size_t)(r - MP) * D; }

__device__ __forceinline__ void wconv_items(Frame& F, int it_lo, int it_hi, int gw, int NGW) {
    LAS float* scr = (LAS float*)(F.lds + F.wave * 16384);
    bf16* WIN = (bf16*)(F.ws + WS_WIN); bf16* WOUT = (bf16*)(F.ws + WS_WOUT); bf16* WGLU = (bf16*)(F.ws + WS_WGLU); bf16* WUP = (bf16*)(F.ws + WS_WUP); bf16* WDN = (bf16*)(F.ws + WS_WDN);
    constexpr int I_IN = 16 * 200, I_OUT = 32 * 32, I_GLU = 16 * 64, I_UP = 16 * 176, I_DN = 44 * 32;
    constexpr int NITEMS = I_IN + I_OUT + I_GLU + 2 * I_UP + 2 * I_DN;
    (void)NITEMS;
    for (int it = it_lo + gw; it < it_hi; it += NGW) {
        int r = it;
        if (r < I_IN) { int kb, nb; if (r < 16 * 72) { kb = r / 72; nb = r % 72; } else { kb = (r - 16 * 72) >> 7; nb = 72 + ((r - 16 * 72) & 127); }
            const int sc = nb < 72 ? 32 * nb : 2320 + 32 * (nb - 72);
            const int dr = nb < 72 ? 32 * nb : NA + 32 * (nb - 72);
            p0_transpose_item(F.a->in[I_WIN], ABIN, D, sc, WIN, dr, kb, scr, F.lane); continue; }
        r -= I_IN;
        if (r < I_OUT) { p0_transpose_item(F.a->in[I_WOUT], D, 2048, 32 * (r % 32), WOUT, 32 * (r % 32), r / 32, scr, F.lane); continue; }
        r -= I_OUT;
        if (r < I_GLU) { const int kb = r / 64, nb = r % 64, d = 32 * nb, j = d >> 8, bj = (d >> 7) & 1, c = d & 127;
            p0_transpose_item(F.a->in[I_WGLU], 2048, D, 1024 * bj + 128 * j + c, WGLU, d, kb, scr, F.lane); continue; }
        r -= I_GLU;
        if (r < 2 * I_UP) { const int l = r / I_UP; r -= l * I_UP; const int kb = r / 176, nb = r % 176, d = 32 * nb, j = d >> 8, bj = (d >> 7) & 1, c = d & 127;
            p0_transpose_item(F.a->in[I_WUP] + (size_t)l * D * FF2, FF2, D, FF * bj + 128 * j + c, WUP + (size_t)l * FF2 * D, d, kb, scr, F.lane); continue; }
        r -= 2 * I_UP;
        { const int l = r / I_DN; r -= l * I_DN; p0_transpose_item(F.a->in[I_WDN] + (size_t)l * FF * D, D, FF, 32 * (r % 32), WDN + (size_t)l * D * FF, 32 * (r % 32), r / 32, scr, F.lane); }
    }
}
constexpr int WC_EARLY = 16 * 72, WC_ALL = 16 * 200 + 32 * 32 + 16 * 64 + 2 * 16 * 176 + 2 * 44 * 32;
__device__ __forceinline__ void p0_prologue(Frame& F) {
    const int gw = GW_ID(F), NGW = GW_N(F);
    bf16* WIN = (bf16*)(F.ws + WS_WIN);
    wconv_items(F, 0, F.G > 128 ? WC_EARLY : WC_ALL, gw, NGW);
    { const int gt = (F.vcu * NTHR + F.tid), NT = F.G * NTHR;
      for (int i = gt; i < 16 * D; i += NT) { const int n = i >> 10, k = i & 1023; WIN[(size_t)(2304 + n) * D + k] = (bf16)f2bf(F.a->in[I_WIN][(size_t)k * ABIN + 2304 + n]); }
      unsigned z_ = 0u; asm volatile("" : "+v"(z_));
      for (int i = gt; i < 240 * D / 8; i += NT) ((GAS v4u*)(WIN + (size_t)2320 * D))[i] = (v4u){z_, z_, z_, z_}; }
    bf16* XN = (bf16*)(F.ws + WS_XN);
    { const int lane = F.lane; f32x4 nx[2][2];
      f32x4 wv[2][2];
#pragma unroll
      for (int j = 0; j < 2; ++j) { const GAS f32x4* ww_ = (const GAS f32x4*)F.a->in[I_NMPRE] + 2 * lane + 128 * j; wv[j][0] = ww_[0]; wv[j][1] = ww_[1]; }
      if (gw < MT) {
#pragma unroll
          for (int j = 0; j < 2; ++j) { const GAS f32x4* xr_ = (const GAS f32x4*)x_in_row(F, gw) + 2 * lane + 128 * j; nx[j][0] = xr_[0]; nx[j][1] = xr_[1]; } }
      for (int m = gw; m < MT; m += NGW) { f32x4 v[2][2]; float s = 0.f;
#pragma unroll
          for (int j = 0; j < 2; ++j)
#pragma unroll
              for (int hq = 0; hq < 2; ++hq) { v[j][hq] = nx[j][hq]; s += (v[j][hq].x * v[j][hq].x + v[j][hq].y * v[j][hq].y) + (v[j][hq].z * v[j][hq].z + v[j][hq].w * v[j][hq].w); }
          if (m + NGW < MT) {
#pragma unroll
              for (int j = 0; j < 2; ++j) { const GAS f32x4* xr_ = (const GAS f32x4*)x_in_row(F, m + NGW) + 2 * lane + 128 * j; nx[j][0] = xr_[0]; nx[j][1] = xr_[1]; } }
          const float rs = rsqrtf(wave_sum(s) * (1.f / D) + EPS);
#pragma unroll
          for (int j = 0; j < 2; ++j) { const f32x4 w0 = wv[j][0], w1 = wv[j][1]; v4u o;
              o.x = pk2(v[j][0].x * rs * w0.x, v[j][0].y * rs * w0.y); o.y = pk2(v[j][0].z * rs * w0.z, v[j][0].w * rs * w0.w); o.z = pk2(v[j][1].x * rs * w1.x, v[j][1].y * rs * w1.y); o.w = pk2(v[j][1].z * rs * w1.z, v[j][1].w * rs * w1.w);
              st16_wt(XN, (m * D + 8 * (lane + 64 * j)) * 2, o); } } }
}

template <int NT, bool GLU, class Epi>
__device__ __forceinline__ void skinny_gemm(Frame& F, const bf16* A, int lda, const bf16* Bt, int K, int ncb, const Epi& epi, int tb, int tstride) {
    LAS float* red = (LAS float*)F.lds;
    const int lane = F.lane, r = lane & 31, h = lane >> 5, w = F.wave;
    const int kper = K >> 3, kbeg = w * kper;
    const int ntask = 4 * ncb;
    if (tb < 0) return;
    for (int task = tb; task < ntask; task += tstride) {
        const int rt = task & 3, ct = task >> 2;
        const int brow = GLU ? (256 * (ct >> 2) + 32 * (ct & 3)) : 32 * ct;
        const bf16* ap = A + (size_t)(rt * 32 + r) * lda + kbeg + 8 * h;
        const bf16* bp = Bt + (size_t)(brow + r) * K + kbeg + 8 * h;
        f32x16 acc[NT];
#pragma unroll
        for (int nt = 0; nt < NT; ++nt)
#pragma unroll
            for (int i = 0; i < 16; ++i) acc[nt][i] = 0.f;
#pragma unroll 8
        for (int k = 0; k < kper; k += 16) {
            const bf16x8 a = *(const bf16x8*)(ap + k);
#pragma unroll
            for (int nt = 0; nt < NT; ++nt) { const bf16x8 b = *(const bf16x8*)(bp + (size_t)nt * 128 * K + k); acc[nt] = __builtin_amdgcn_mfma_f32_32x32x16_bf16(a, b, acc[nt], 0, 0, 0); }
        }
#pragma unroll
        for (int nt = 0; nt < NT; ++nt)
#pragma unroll
            for (int i = 0; i < 16; ++i) red[((w * NT + nt) * 16 + i) * 64 + lane] = acc[nt][i];
        __syncthreads();
#pragma unroll
        for (int e0 = 0; e0 < 2; ++e0) { const int e = F.tid + 512 * e0, i = e >> 6, l = e & 63; float v[NT];
#pragma unroll
            for (int nt = 0; nt < NT; ++nt) { float s = 0.f;
#pragma unroll
                for (int ww = 0; ww < 8; ++ww) s += red[((ww * NT + nt) * 16 + i) * 64 + l];
                v[nt] = s; }
            epi(rt * 32 + (i & 3) + 8 * (i >> 2) + 4 * (l >> 5), ct * 32 + (l & 31), v); }
        __syncthreads();
    }
}
template <int NT, int RT, bool GLU, class Epi>
__device__ __forceinline__ void skinny2(Frame& F, const bf16* A, int lda, const bf16* Bt, int K, int ncb, const Epi& epi, int tb, int tstride) {
    constexpr int RH = RT / 2, KS = 8 / RH, NTL = 8 * NT;
    LAS float* red = (LAS float*)F.lds;
    if (tb < 0) return;
    int tid = F.tid; asm volatile("" : "+v"(tid));
    const int lane = tid & 63, r = lane & 15, q = lane >> 4, w = __builtin_amdgcn_readfirstlane(tid >> 6);
    const int rsel = w % RH, ksel = w / RH, nch = K >> 7, ch0 = nch * ksel / KS, ch1 = nch * (ksel + 1) / KS;
    const int ntask = (RT == 4) ? ncb : 2 * ncb;
    const int j2 = (tid >> 8) & 1, e = (tid >> 6) & 3;
#pragma unroll 1
    for (int task = tb; task < ntask; task += tstride) {
        const int ct = (RT == 4) ? task : task >> 1, rbase = (RT == 4) ? 0 : 64 * (task & 1);
        const int brow = GLU ? (256 * (ct >> 2) + 32 * (ct & 3)) : 32 * ct;
        const auto ars = __builtin_amdgcn_make_buffer_rsrc((void*)(A + (size_t)(rbase + 64 * rsel) * lda), 0, 64 * lda * 2, 0x00020000);
        const auto brs = __builtin_amdgcn_make_buffer_rsrc((void*)(Bt + (size_t)brow * K), 0, (128 * (NT - 1) + 32) * K * 2, 0x00020000);
        const int avo = (r * lda + 8 * q) * 2, bvo = (r * K + 8 * q) * 2;
        const int col = ct * 32 + j2 * 16 + r;
        const typename Epi::W ew = epi.pre(col);
        PSEG_B(8, F.lds);
        f32x4 acc[4][2 * NT];
#pragma unroll
        for (int mt = 0; mt < 4; ++mt)
#pragma unroll
            for (int n2 = 0; n2 < 2 * NT; ++n2) acc[mt][n2] = (f32x4){0.f, 0.f, 0.f, 0.f};
        constexpr int SB = NT == 1 ? 4 : 2;
#pragma unroll 1
        for (int k0 = ch0 << 7; k0 < (ch1 << 7); k0 += 32 * SB) {
            v4u a[SB][4], b[SB][2 * NT];
#pragma unroll
            for (int s4 = 0; s4 < SB; ++s4) {
#pragma unroll
                for (int mt = 0; mt < 4; ++mt) a[s4][mt] = __builtin_amdgcn_raw_buffer_load_b128(ars, avo, (16 * mt * lda + k0 + 32 * s4) * 2, 0);
#pragma unroll
                for (int n2 = 0; n2 < 2 * NT; ++n2) b[s4][n2] = __builtin_amdgcn_raw_buffer_load_b128(brs, bvo, (((n2 >> 1) * 128 + (n2 & 1) * 16) * K + k0 + 32 * s4) * 2, 0); }
            __builtin_amdgcn_sched_barrier(0);
#pragma unroll
            for (int s4 = 0; s4 < SB; ++s4)
#pragma unroll
                for (int mt = 0; mt < 4; ++mt)
#pragma unroll
                    for (int n2 = 0; n2 < 2 * NT; ++n2) acc[mt][n2] = __builtin_amdgcn_mfma_f32_16x16x32_bf16(__builtin_bit_cast(bf16x8, a[s4][mt]), __builtin_bit_cast(bf16x8, b[s4][n2]), acc[mt][n2], 0, 0, 0);
            __builtin_amdgcn_sched_barrier(0);
        }
        PSEG_E(8, F.lds);
        typename Epi::S es[2 * RT];
#pragma unroll
        for (int e0 = 0; e0 < 2 * RT; ++e0) es[e0] = epi.rows(rbase + 16 * e0 + 4 * q + e, col);
#pragma unroll
        for (int mt = 0; mt < 4; ++mt)
#pragma unroll
            for (int n2 = 0; n2 < 2 * NT; ++n2)
#pragma unroll
                for (int i = 0; i < 4; ++i) red[((w * NTL + mt * 2 * NT + n2) * 4 + i) * 64 + lane] = acc[mt][n2][i];
        __syncthreads();
#pragma unroll
        for (int e0 = 0; e0 < 2 * RT; ++e0) { const int rs_ = e0 >> 2, mt = e0 & 3; float v[NT];
#pragma unroll
            for (int nt = 0; nt < NT; ++nt) { float s_ = 0.f;
#pragma unroll
                for (int ks = 0; ks < KS; ++ks) s_ += red[(((ks * RH + rs_) * NTL + mt * 2 * NT + nt * 2 + j2) * 4 + e) * 64 + lane];
                v[nt] = s_; }
            epi.fin(rbase + 16 * e0 + 4 * q + e, col, v, ew, es[e0]); }
        __syncthreads();
    }
}
template <int NT, int MAXS, bool GLU, class Epi>
__device__ __forceinline__ void skinny1(Frame& F, const bf16* A, int lda, const bf16* Bt, int K, int ncol, const Epi& epi, int tb, int tstride) {
    LAS float* red = (LAS float*)F.lds;
    if (tb < 0) return;
    int tid = F.tid; asm volatile("" : "+v"(tid));
    const int lane = tid & 63, r = lane & 15, q = lane >> 4, w = __builtin_amdgcn_readfirstlane(tid >> 6);
    const int nks = K >> 5, s0 = nks * w / 8, ns = nks * (w + 1) / 8 - s0;
    const int ntask = 4 * (ncol >> 4);
    const int e = (tid >> 6) & 3, mtt = tid >> 8;
#pragma unroll 1
    for (int task = tb; task < ntask; task += tstride) {
        const int rt = task & 3, c0 = (task >> 2) << 4;
        const int brow = GLU ? (256 * (c0 >> 7) + (c0 & 127)) : c0;
        const auto ars = __builtin_amdgcn_make_buffer_rsrc((void*)(A + (size_t)(rt * 32) * lda), 0, 32 * lda * 2, 0x00020000);
        const auto brs = __builtin_amdgcn_make_buffer_rsrc((void*)(Bt + (size_t)brow * K), 0, (128 * (NT - 1) + 16) * K * 2, 0x00020000);
        const int avo = (r * lda + 8 * q + 32 * s0) * 2, bvo = (r * K + 8 * q + 32 * s0) * 2;
        const int row = rt * 32 + 16 * mtt + 4 * q + e, col = c0 + r;
        const typename Epi::W ew = epi.pre(col); const typename Epi::S es = epi.rows(row, col);
        v4u a[MAXS][2], b[MAXS][NT];
#pragma unroll
        for (int s4 = 0; s4 < MAXS; ++s4) if (s4 < ns) {
#pragma unroll
            for (int mt = 0; mt < 2; ++mt) a[s4][mt] = __builtin_amdgcn_raw_buffer_load_b128(ars, avo, (16 * mt * lda + 32 * s4) * 2, 0);
#pragma unroll
            for (int nt = 0; nt < NT; ++nt) b[s4][nt] = __builtin_amdgcn_raw_buffer_load_b128(brs, bvo, (nt * 128 * K + 32 * s4) * 2, 0); }
        __builtin_amdgcn_sched_barrier(0);
        f32x4 acc[2][NT];
#pragma unroll
        for (int mt = 0; mt < 2; ++mt)
#pragma unroll
            for (int nt = 0; nt < NT; ++nt) acc[mt][nt] = (f32x4){0.f, 0.f, 0.f, 0.f};
#pragma unroll
        for (int s4 = 0; s4 < MAXS; ++s4) if (s4 < ns) {
#pragma unroll
            for (int mt = 0; mt < 2; ++mt)
#pragma unroll
                for (int nt = 0; nt < NT; ++nt) acc[mt][nt] = __builtin_amdgcn_mfma_f32_16x16x32_bf16(__builtin_bit_cast(bf16x8, a[s4][mt]), __builtin_bit_cast(bf16x8, b[s4][nt]), acc[mt][nt], 0, 0, 0); }
#pragma unroll
        for (int mt = 0; mt < 2; ++mt)
#pragma unroll
            for (int nt = 0; nt < NT; ++nt)
#pragma unroll
                for (int i = 0; i < 4; ++i) red[((w * 2 * NT + mt * NT + nt) * 4 + i) * 64 + lane] = acc[mt][nt][i];
        __syncthreads();
        { float v[NT];
#pragma unroll
          for (int nt = 0; nt < NT; ++nt) { float s_ = 0.f;
#pragma unroll
              for (int ww = 0; ww < 8; ++ww) s_ += red[((ww * 2 * NT + mtt * NT + nt) * 4 + e) * 64 + lane];
              v[nt] = s_; }
          epi.fin(row, col, v, ew, es); }
        __syncthreads();
    }
}
struct SkNone {};
struct SkBf16 { bf16* O; int ld; __device__ __forceinline__ void operator()(int row, int col, const float (&v)[1]) const { O[(size_t)row * ld + col] = (bf16)f2bf(v[0]); } };
struct SkF32 { float* O; int ld; __device__ __forceinline__ void operator()(int row, int col, const float (&v)[1]) const { O[(size_t)row * ld + col] = v[0]; } };
struct SkGlu { bf16* O; int ld; __device__ __forceinline__ void operator()(int row, int col, const float (&v)[2]) const { O[(size_t)row * ld + col] = (bf16)f2bf(v[0] * sigmoidf_(v[1])); }
    typedef SkNone W; typedef SkNone S; __device__ __forceinline__ W pre(int) const { return W{}; } __device__ __forceinline__ S rows(int, int) const { return S{}; }
    __device__ __forceinline__ void fin(int row, int col, const float (&v)[2], const W&, const S&) const { (*this)(row, col, v); } };

constexpr size_t B_XR = al256((size_t)MT * D * 2);
__device__ __forceinline__ void resid_norm_rows(Frame& F, const bf16* msrc, const float* w_post, const float* w_pre, int mode) {
    const int gw = GW_ID(F), NGW = GW_N(F), lane = F.lane;
    bf16* XN = (bf16*)(F.ws + WS_XN); bf16* XR = (bf16*)(F.ws + WS_BIG + B_XR);
    v4u pm[2]; f32x4 pxf[2][2]; v4u pxb[2];
#define RN_LOAD(r_) do { const GAS v4u* mr_ = (const GAS v4u*)(msrc + (size_t)(r_) * D) + lane; \
        _Pragma("unroll") for (int j = 0; j < 2; ++j) { pm[j] = mr_[64 * j]; \
            if (mode == 0) { const GAS f32x4* xr_ = (const GAS f32x4*)x_in_row(F, (r_)) + 2 * lane + 128 * j; pxf[j][0] = xr_[0]; pxf[j][1] = xr_[1]; } \
            else pxb[j] = ((const GAS v4u*)(XR + (size_t)(r_) * D) + lane)[64 * j]; } } while (0)
#define RN_UNPK(dst, w_) do { dst[0] = bflo(w_.x); dst[1] = bfhi(w_.x); dst[2] = bflo(w_.y); dst[3] = bfhi(w_.y); dst[4] = bflo(w_.z); dst[5] = bfhi(w_.z); dst[6] = bflo(w_.w); dst[7] = bfhi(w_.w); } while (0)
    f32x4 wpv[2][2], wwv[2][2];
#pragma unroll
    for (int j = 0; j < 2; ++j) { const GAS f32x4* wp_ = (const GAS f32x4*)w_post + 2 * lane + 128 * j; wpv[j][0] = wp_[0]; wpv[j][1] = wp_[1];
        if (mode != 2) { const GAS f32x4* ww_ = (const GAS f32x4*)w_pre + 2 * lane + 128 * j; wwv[j][0] = ww_[0]; wwv[j][1] = ww_[1]; } else { wwv[j][0] = wpv[j][0]; wwv[j][1] = wpv[j][1]; } }
    if (gw < MT) RN_LOAD(gw);
    for (int r = gw; r < MT; r += NGW) {
        float m[2][8], x[2][8]; float s = 0.f;
#pragma unroll
        for (int j = 0; j < 2; ++j) { const v4u mw = pm[j]; RN_UNPK(m[j], mw);
            if (mode == 0) {
#pragma unroll
                for (int e = 0; e < 4; ++e) { x[j][e] = pxf[j][0][e]; x[j][4 + e] = pxf[j][1][e]; } }
            else { const v4u xw = pxb[j]; RN_UNPK(x[j], xw); }
#pragma unroll
            for (int e = 0; e < 8; ++e) s += m[j][e] * m[j][e]; }
        if (r + NGW < MT) RN_LOAD(r + NGW);
        const float rs = rsqrtf(wave_sum(s) * (1.f / D) + EPS); float s2 = 0.f;
#pragma unroll
        for (int j = 0; j < 2; ++j) { const f32x4 wp0 = wpv[j][0], wp1 = wpv[j][1];
#pragma unroll
            for (int e = 0; e < 4; ++e) { x[j][e] += m[j][e] * rs * wp0[e]; x[j][4 + e] += m[j][4 + e] * rs * wp1[e]; }
            if (mode == 2) { GAS f32x4* yo = (GAS f32x4*)x_res_row(F, r) + 2 * lane + 128 * j; yo[0] = (f32x4){x[j][0], x[j][1], x[j][2], x[j][3]}; yo[1] = (f32x4){x[j][4], x[j][5], x[j][6], x[j][7]}; }
            else { v4u o; o.x = pk2(x[j][0], x[j][1]); o.y = pk2(x[j][2], x[j][3]); o.z = pk2(x[j][4], x[j][5]); o.w = pk2(x[j][6], x[j][7]); st16_wt(XR, (r * D + 8 * (lane + 64 * j)) * 2, o); }
#pragma unroll
            for (int e = 0; e < 8; ++e) s2 += x[j][e] * x[j][e]; }
        if (mode != 2) { const float rs2 = rsqrtf(wave_sum(s2) * (1.f / D) + EPS);
#pragma unroll
            for (int j = 0; j < 2; ++j) { const f32x4 ww0 = wwv[j][0], ww1 = wwv[j][1];
                v4u o; o.x = pk2(x[j][0] * rs2 * ww0[0], x[j][1] * rs2 * ww0[1]); o.y = pk2(x[j][2] * rs2 * ww0[2], x[j][3] * rs2 * ww0[3]);
                o.z = pk2(x[j][4] * rs2 * ww1[0], x[j][5] * rs2 * ww1[1]); o.w = pk2(x[j][6] * rs2 * ww1[2], x[j][7] * rs2 * ww1[3]);
                st16_wt(XN, (r * D + 8 * (lane + 64 * j)) * 2, o); } }
    }
#undef RN_LOAD
#undef RN_UNPK
}
__device__ __forceinline__ bf16* mixed_row(const Frame& F, int r) { return r < MP ? (bf16*)(F.out + O_YP) + (size_t)r * 2048 : (bf16*)(F.ws + WS_MIXS) + (size_t)(r - MP) * 2048; }
constexpr size_t B_HEAD = al256(B_ACT + (size_t)MT * FF * 2), B_TAIL = B_HEAD + (size_t)64 * 2 * FF2 * 4;
static_assert(B_TAIL + (size_t)64 * 2 * FF2 * 4 <= BIG_BYTES, "ffn side buffers");
__device__ __forceinline__ void ffn_fix_rows(Frame& F, int l, int pm) {
    const float* HEAD = (const float*)(F.ws + WS_BIG + B_HEAD); const float* TAIL = (const float*)(F.ws + WS_BIG + B_TAIL); bf16* ACT = (bf16*)(F.ws + WS_BIG + B_ACT);
    const float* cw = F.a->in[I_FCW] + (size_t)l * 3 * FF2; const float* cb = F.a->in[I_FCB] + (size_t)l * FF2;
    typedef float f32x2_ __attribute__((ext_vector_type(2)));
    int tid = F.tid; asm volatile("" : "+v"(tid));
    f32x2_ h0[3][2], h1[3][2], t0[3][2], t1[3][2], w0[3][2], w1[3][2], w2[3][2], bb[3][2];
    const bool hist = (pm & 7) != 0;
#pragma unroll
    for (int i = 0; i < 3; ++i) { const int c = 2 * (tid + NTHR * i); if (c < FF) {
#pragma unroll
        for (int x = 0; x < 2; ++x) { const int ch = x * FF + c;
            h0[i][x] = *(const GAS f32x2_*)(HEAD + ((size_t)pm * 2) * FF2 + ch); h1[i][x] = *(const GAS f32x2_*)(HEAD + ((size_t)pm * 2 + 1) * FF2 + ch);
            t0[i][x] = hist ? *(const GAS f32x2_*)(TAIL + ((size_t)(pm - 1) * 2) * FF2 + ch) : (f32x2_){0.f, 0.f}; t1[i][x] = hist ? *(const GAS f32x2_*)(TAIL + ((size_t)(pm - 1) * 2 + 1) * FF2 + ch) : (f32x2_){0.f, 0.f};
            w0[i][x] = *(const GAS f32x2_*)(cw + ch); w1[i][x] = *(const GAS f32x2_*)(cw + FF2 + ch); w2[i][x] = *(const GAS f32x2_*)(cw + 2 * FF2 + ch); bb[i][x] = *(const GAS f32x2_*)(cb + ch); } } }
    __builtin_amdgcn_sched_barrier(0);
#pragma unroll
    for (int i = 0; i < 3; ++i) { const int c = 2 * (tid + NTHR * i); if (c < FF) { f32x2_ r0[2], r1[2];
#pragma unroll
        for (int x = 0; x < 2; ++x) { r0[x] = bb[i][x] + w0[i][x] * t0[i][x] + w1[i][x] * t1[i][x] + w2[i][x] * h0[i][x]; r1[x] = bb[i][x] + w0[i][x] * t1[i][x] + w1[i][x] * h0[i][x] + w2[i][x] * h1[i][x]; }
        *(GAS unsigned*)(ACT + (size_t)(256 * pm) * FF + c) = pk2(r0[0][0] * siluf_(r0[1][0]), r0[0][1] * siluf_(r0[1][1]));
        *(GAS unsigned*)(ACT + (size_t)(256 * pm + 1) * FF + c) = pk2(r1[0][0] * siluf_(r1[1][0]), r1[0][1] * siluf_(r1[1][1])); } }
}
struct SkConvGate { bf16* ACTs; const float* cw; const float* cb; const float* st; float* sfc;
    __device__ __forceinline__ void operator()(int row, int col, const float (&v)[2]) const {
        const float* s0 = st + ((size_t)row * 2) * FF2; const float* s1 = s0 + FF2; float* p = sfc + (size_t)row * 2 * FF2; const int chv = col, chg = FF + col;
        const float v0 = s0[chv], v1 = s1[chv], g0 = s0[chg], g1 = s1[chg];
        const float vc = cb[chv] + cw[chv] * v0 + cw[FF2 + chv] * v1 + cw[2 * FF2 + chv] * v[0];
        const float gc = cb[chg] + cw[chg] * g0 + cw[FF2 + chg] * g1 + cw[2 * FF2 + chg] * v[1];
        ACTs[(size_t)row * FF + col] = (bf16)f2bf(vc * siluf_(gc)); p[chv] = v1; p[chg] = g1; p[FF2 + chv] = v[0]; p[FF2 + chg] = v[1]; }
    struct W { float w[8]; }; struct S { float s[4]; };
    __device__ __forceinline__ W pre(int col) const { W o; const int chv = col, chg = FF + col; o.w[0] = cb[chv]; o.w[1] = cw[chv]; o.w[2] = cw[FF2 + chv]; o.w[3] = cw[2 * FF2 + chv]; o.w[4] = cb[chg]; o.w[5] = cw[chg]; o.w[6] = cw[FF2 + chg]; o.w[7] = cw[2 * FF2 + chg]; return o; }
    __device__ __forceinline__ S rows(int row, int col) const { S o; const float* s0 = st + ((size_t)row * 2) * FF2; o.s[0] = s0[col]; o.s[1] = s0[FF2 + col]; o.s[2] = s0[FF + col]; o.s[3] = s0[FF2 + FF + col]; return o; }
    __device__ __forceinline__ void fin(int row, int col, const float (&v)[2], const W& ww, const S& ss) const {
        float* p = sfc + (size_t)row * 2 * FF2; const int chv = col, chg = FF + col;
        const float vc = ww.w[0] + ww.w[1] * ss.s[0] + ww.w[2] * ss.s[1] + ww.w[3] * v[0];
        const float gc = ww.w[4] + ww.w[5] * ss.s[2] + ww.w[6] * ss.s[3] + ww.w[7] * v[1];
        ACTs[(size_t)row * FF + col] = (bf16)f2bf(vc * siluf_(gc)); p[chv] = ss.s[1]; p[chg] = ss.s[3]; p[FF2 + chv] = v[0]; p[FF2 + chg] = v[1]; } };

constexpr size_t B_HB = al256(B_PROJA + (size_t)MT * NA * 2);
static_assert(B_HB + (size_t)8 * 64 * 16 * 4096 * 2 <= BIG_BYTES, "ssd state buffer");
typedef float f32x2_t __attribute__((ext_vector_type(2)));

__device__ __forceinline__ void ssd_conv4(const Frame& F, const bf16* PA, int b, int t, int ch0, float (&out)[8][4]) {
    const float* cw = F.a->in[I_CONVW] + ch0; const float* cbias = F.a->in[I_CONVB] + ch0;
    float raw[7][8];
#pragma unroll
    for (int rr = 0; rr < 7; ++rr) { const int tt = t - 3 + rr;
        if (tt >= 0) { const v4u q = *(const GAS v4u*)(PA + (size_t)(b * SEQ + tt) * NA + 1024 + ch0);
            raw[rr][0] = bflo(q.x); raw[rr][1] = bfhi(q.x); raw[rr][2] = bflo(q.y); raw[rr][3] = bfhi(q.y); raw[rr][4] = bflo(q.z); raw[rr][5] = bfhi(q.z); raw[rr][6] = bflo(q.w); raw[rr][7] = bfhi(q.w); }
        else {
#pragma unroll
            for (int e = 0; e < 8; ++e) raw[rr][e] = 0.f; } }
    float w[4][8], bs[8];
#pragma unroll
    for (int k = 0; k < 4; ++k) { const f32x4 a = *(const GAS f32x4*)(cw + k * XBC), c = *(const GAS f32x4*)(cw + k * XBC + 4);
        w[k][0] = a.x; w[k][1] = a.y; w[k][2] = a.z; w[k][3] = a.w; w[k][4] = c.x; w[k][5] = c.y; w[k][6] = c.z; w[k][7] = c.w; }
    { const f32x4 a = *(const GAS f32x4*)cbias, c = *(const GAS f32x4*)(cbias + 4); bs[0] = a.x; bs[1] = a.y; bs[2] = a.z; bs[3] = a.w; bs[4] = c.x; bs[5] = c.y; bs[6] = c.z; bs[7] = c.w; }
#pragma unroll
    for (int e = 0; e < 8; ++e)
#pragma unroll
        for (int j = 0; j < 4; ++j) { float v = bs[e];
#pragma unroll
            for (int k = 0; k < 4; ++k) v += w[k][e] * raw[j + k][e];
            out[e][j] = siluf_(v); }
}

__device__ __forceinline__ void ssd_state_item(Frame& F, int b, int h) {
    const bf16* PA = (const bf16*)(F.ws + WS_BIG + B_PROJA); bf16* HB = (bf16*)(F.ws + WS_BIG + B_HB);
    constexpr int TP = 80, TBUF = 128 * TP;
    LAS unsigned char* T0 = F.lds; LAS float* WG = (LAS float*)(F.lds + 2 * TBUF); LAS float* DEC = WG + SEQ;
    int tid = F.tid; asm volatile("" : "+v"(tid));
    const int lane = tid & 63, wave = __builtin_amdgcn_readfirstlane(tid >> 6), g = h >> 3, r = lane & 31, hh = lane >> 5;
    { const float A = -__expf(F.a->in[I_ALOG][h]), dtb = F.a->in[I_DTB][h];
      float dt[4], cum[4]; float run = 0.f;
#pragma unroll
      for (int j = 0; j < 4; ++j) { dt[j] = softplusf_(bf2f(PA[(size_t)(b * SEQ + 4 * tid + j) * NA + 2304 + h]) + dtb); run += dt[j] * A; cum[j] = run; }
      float incl = run;
      const int ln_ = lane_op_();
#pragma unroll
      for (int off = 1; off < 8; off <<= 1) { const float v = shup_(incl, off, 8, ln_); if ((tid & 7) >= off) incl += v; }
      const float excl = incl - run, last = shidx_(incl, 7, 8, ln_);
#pragma unroll
      for (int j = 0; j < 4; ++j) WG[4 * tid + j] = dt[j] * __expf(last - (excl + cum[j]));
      if ((tid & 7) == 0) DEC[tid >> 3] = __expf(last); }
    __syncthreads();
    if (wave < 4) {
        const int o = tid >> 4, tp = tid & 15, ch0 = o < 8 ? h * 64 + 8 * o : 1024 + g * 64 + 8 * (o - 8);
        float w[4][8], bs[8];
        { const float* cw = F.a->in[I_CONVW] + ch0; const float* cbias = F.a->in[I_CONVB] + ch0;
#pragma unroll
          for (int k = 0; k < 4; ++k) { const f32x4 a = *(const GAS f32x4*)(cw + k * XBC), c4 = *(const GAS f32x4*)(cw + k * XBC + 4);
              w[k][0] = a.x; w[k][1] = a.y; w[k][2] = a.z; w[k][3] = a.w; w[k][4] = c4.x; w[k][5] = c4.y; w[k][6] = c4.z; w[k][7] = c4.w; }
          const f32x4 a = *(const GAS f32x4*)cbias, c4 = *(const GAS f32x4*)(cbias + 4); bs[0] = a.x; bs[1] = a.y; bs[2] = a.z; bs[3] = a.w; bs[4] = c4.x; bs[5] = c4.y; bs[6] = c4.z; bs[7] = c4.w; }
        const bf16* xrow = PA + (size_t)(b * SEQ + 2 * tp) * NA + 1024 + ch0;
        v4u pre[5];
#pragma unroll
        for (int k = 0; k < 5; ++k) { const int rr = 2 * tp - 3 + k < 0 ? 0 : 2 * tp - 3 + k; pre[k] = *(const GAS v4u*)(xrow + (ptrdiff_t)(rr - 2 * tp) * NA); }
        for (int c = 0; c < 64; ++c) {
            LAS unsigned char* T = T0 + (c & 1) * TBUF;
            v4u cur[5];
#pragma unroll
            for (int k = 0; k < 5; ++k) cur[k] = pre[k];
            if (c + 1 < 64) { const bf16* xn = xrow + (size_t)(32 * (c + 1)) * NA;
#pragma unroll
                for (int k = 0; k < 5; ++k) pre[k] = *(const GAS v4u*)(xn + (ptrdiff_t)(k - 3) * NA); }
            const f32x2_t wq = *(const LAS f32x2_t*)(WG + 32 * c + 2 * tp);
            const float w0 = o < 8 ? wq.x : 1.0f, w1 = o < 8 ? wq.y : 1.0f;
            float x8[5][8];
#pragma unroll
            for (int k = 0; k < 5; ++k) { const v4u qv = cur[k]; const float mk = (c == 0 && 2 * tp - 3 + k < 0) ? 0.f : 1.f;
                x8[k][0] = bflo(qv.x) * mk; x8[k][1] = bfhi(qv.x) * mk; x8[k][2] = bflo(qv.y) * mk; x8[k][3] = bfhi(qv.y) * mk; x8[k][4] = bflo(qv.z) * mk; x8[k][5] = bfhi(qv.z) * mk; x8[k][6] = bflo(qv.w) * mk; x8[k][7] = bfhi(qv.w) * mk; }
#pragma unroll
            for (int e = 0; e < 8; ++e) { float v0 = bs[e], v1 = bs[e];
#pragma unroll
                for (int k = 0; k < 4; ++k) { v0 += w[k][e] * x8[k][e]; v1 += w[k][e] * x8[k + 1][e]; }
                *(LAS unsigned*)(T + (8 * o + e) * TP + 4 * tp) = pk2(siluf_(v0) * w0, siluf_(v1) * w1); }
            asm volatile("s_waitcnt lgkmcnt(0)" ::: "memory"); __builtin_amdgcn_s_barrier(); asm volatile("" ::: "memory");
        }
    } else {
        f32x16 acc;
#pragma unroll
        for (int i = 0; i < 16; ++i) acc[i] = 0.f;
        const int q = wave - 4, pt = q >> 1, nt = q & 1;
        for (int c = 0; c < 64; ++c) {
            LAS unsigned char* T = T0 + (c & 1) * TBUF;
            bf16* hb = HB + ((((size_t)b * 64 + c) * 16 + h) * 64 + pt * 32) * 64 + nt * 32 + r;
#pragma unroll
            for (int i = 0; i < 16; ++i) hb[(size_t)((i & 3) + 8 * (i >> 2) + 4 * hh) * 64] = (bf16)f2bf(acc[i]);
            const float dec = DEC[c];
#pragma unroll
            for (int i = 0; i < 16; ++i) acc[i] *= dec;
            asm volatile("s_waitcnt lgkmcnt(0)" ::: "memory"); __builtin_amdgcn_s_barrier(); asm volatile("" ::: "memory");
#pragma unroll
            for (int ks = 0; ks < 2; ++ks) { const bf16x8 a = *(const LAS bf16x8*)(T + (pt * 32 + r) * TP + 32 * ks + 16 * hh), bb = *(const LAS bf16x8*)(T + (64 + nt * 32 + r) * TP + 32 * ks + 16 * hh);
                acc = __builtin_amdgcn_mfma_f32_32x32x16_bf16(a, bb, acc, 0, 0, 0); }
        }
        float* ps = F.out + O_PSSM + ((size_t)(b * 16 + h) * 64 + pt * 32) * 64 + nt * 32 + r;
#pragma unroll
        for (int i = 0; i < 16; ++i) ps[(size_t)((i & 3) + 8 * (i >> 2) + 4 * hh) * 64] = acc[i];
    }
    { float* pc = F.out + O_PSCONV + (size_t)b * 3 * XBC;
      for (int e = tid; e < 3 * 192; e += NTHR) { const int k = e / 192, cc = e % 192; if (cc >= 64 && (h & 7) != 0) continue;
          const int ch = cc < 64 ? h * 64 + cc : (cc < 128 ? 1024 + g * 64 + (cc - 64) : 1152 + g * 64 + (cc - 128));
          pc[k * XBC + ch] = bf2f(PA[(size_t)(b * SEQ + SEQ - 3 + k) * NA + 1024 + ch]); } }
    __syncthreads();
}

__device__ __forceinline__ void ssd_sample_item(Frame& F, int j) {
    const bf16* PA = (const bf16*)(F.ws + WS_BIG + B_PROJA) + (size_t)(MP + j) * NA; bf16* MX = (bf16*)(F.ws + WS_MIXS) + (size_t)j * 2048;
    LAS float* act = (LAS float*)F.lds;
    LAS float* dts = act + XBC;
    LAS float* y2 = dts + 32;
    LAS float* red = y2 + 1024;
    const int tid = F.tid;
    const float* cw = F.a->in[I_CONVW]; const float* cbias = F.a->in[I_CONVB]; const float* st = F.a->in[I_SSCONV] + (size_t)j * 3 * XBC; float* so = F.out + O_SSCONV + (size_t)j * 3 * XBC;
    for (int ch = tid; ch < XBC; ch += NTHR) { const float nw = bf2f(PA[1024 + ch]); const float s0 = st[ch], s1 = st[XBC + ch], s2 = st[2 * XBC + ch];
        act[ch] = siluf_(cbias[ch] + cw[ch] * s0 + cw[XBC + ch] * s1 + cw[2 * XBC + ch] * s2 + cw[3 * XBC + ch] * nw);
        so[ch] = s1; so[XBC + ch] = s2; so[2 * XBC + ch] = nw; }
    if (tid < 16) { const float d = softplusf_(bf2f(PA[2304 + tid]) + F.a->in[I_DTB][tid]); dts[tid] = d; dts[16 + tid] = __expf(-__expf(F.a->in[I_ALOG][tid]) * d); }
    __syncthreads();
    const float* S0 = F.a->in[I_SSSM] + (size_t)j * 65536; float* S1 = F.out + O_SSSM + (size_t)j * 65536;
    float ssq = 0.f;
#pragma unroll 1
    for (int it8 = 0; it8 < 4; ++it8) { f32x4 sv[8];
#pragma unroll
      for (int u = 0; u < 8; ++u) sv[u] = *(const GAS f32x4*)(S0 + (size_t)((it8 * 8 + u) * NTHR + tid) * 4);
#pragma unroll
      for (int u = 0; u < 8; ++u) { const int it = it8 * 8 + u; const int v = it * NTHR + tid, n4 = v & 15, p = (v >> 4) & 63, h = v >> 10, g = h >> 3;
        const f32x4 s = sv[u];
        const f32x4 bb = *(const LAS f32x4*)(act + 1024 + g * 64 + 4 * n4), cc = *(const LAS f32x4*)(act + 1152 + g * 64 + 4 * n4);
        const float x = act[h * 64 + p], dtx = dts[h] * x, dec = dts[16 + h];
        f32x4 nn; float a = 0.f;
#pragma unroll
        for (int i = 0; i < 4; ++i) { nn[i] = dec * s[i] + dtx * bb[i]; a += nn[i] * cc[i]; }
        *(GAS f32x4*)(S1 + (size_t)v * 4) = nn;
        a = row16_sum(a);
        if (n4 == 0) { const float yy = (a + F.a->in[I_SSMD][h] * x) * siluf_(bf2f(PA[h * 64 + p])); y2[h * 64 + p] = yy; ssq += yy * yy; } } }
    ssq = wave_sum(ssq); if (F.lane == 0) red[F.wave] = ssq;
    __syncthreads();
    float tot = 0.f;
#pragma unroll
    for (int w = 0; w < 8; ++w) tot += red[w];
    const float rs = rsqrtf(tot * (1.f / D) + EPS);
    for (int c = tid; c < 1024; c += NTHR) MX[c] = (bf16)f2bf(y2[c] * rs * F.a->in[I_SSMNW][c]);
    __syncthreads();
}
__device__ __forceinline__ void ssd_state_phase(Frame& F) {
    for (int it = F.vcu; it < 128 + MS; it += F.G) { if (it < 128) ssd_state_item(F, it >> 4, it & 15); else ssd_sample_item(F, it - 128); }
    PSEG_B(5, F.lds);
    if (F.G > 128 && F.vcu >= 128) { __syncthreads(); wconv_items(F, WC_EARLY, WC_ALL, (F.vcu - 128) * NWAVES + F.wave, (F.G - 128) * NWAVES); }
    PSEG_E(5, F.lds);
}

__device__ __forceinline__ void ssd_rows7(const bf16* PA, int b, int t, int ch0, v4u (&rw)[7]) {
#pragma unroll
    for (int rr = 0; rr < 7; ++rr) { const int tt = t - 3 + rr < 0 ? 0 : t - 3 + rr; rw[rr] = *(const GAS v4u*)(PA + (size_t)(b * SEQ + tt) * NA + 1024 + ch0); }
}
__device__ __forceinline__ void ssd_conv4_lds(const v4u (&rw)[7], const LAS float* CWL, int t, int ch0, float (&out)[8][4]) {
    float raw[7][8];
#pragma unroll
    for (int rr = 0; rr < 7; ++rr) { const v4u q = rw[rr]; const float mk = (t - 3 + rr >= 0) ? 1.f : 0.f;
        raw[rr][0] = bflo(q.x) * mk; raw[rr][1] = bfhi(q.x) * mk; raw[rr][2] = bflo(q.y) * mk; raw[rr][3] = bfhi(q.y) * mk; raw[rr][4] = bflo(q.z) * mk; raw[rr][5] = bfhi(q.z) * mk; raw[rr][6] = bflo(q.w) * mk; raw[rr][7] = bfhi(q.w) * mk; }
    float w[4][8], bs[8];
#pragma unroll
    for (int k = 0; k < 5; ++k) { const f32x4 a = *(const LAS f32x4*)(CWL + k * XBC + ch0), c = *(const LAS f32x4*)(CWL + k * XBC + ch0 + 4);
        if (k < 4) { w[k < 4 ? k : 0][0] = a.x; w[k < 4 ? k : 0][1] = a.y; w[k < 4 ? k : 0][2] = a.z; w[k < 4 ? k : 0][3] = a.w; w[k < 4 ? k : 0][4] = c.x; w[k < 4 ? k : 0][5] = c.y; w[k < 4 ? k : 0][6] = c.z; w[k < 4 ? k : 0][7] = c.w; }
        else { bs[0] = a.x; bs[1] = a.y; bs[2] = a.z; bs[3] = a.w; bs[4] = c.x; bs[5] = c.y; bs[6] = c.z; bs[7] = c.w; } }
#pragma unroll
    for (int e = 0; e < 8; ++e)
#pragma unroll
        for (int j = 0; j < 4; ++j) { float v = bs[e];
#pragma unroll
            for (int k = 0; k < 4; ++k) v += w[k][e] * raw[j + k][e];
            out[e][j] = siluf_(v); }
}
constexpr int SSDO_CWL = 16 * 64 * 80 + 2 * (2 * 32 * 144) + (512 + 512 + 256) * 4;
static_assert(SSDO_CWL + 5 * XBC * 4 <= RING_BYTES, "ssd_out LDS map");
__device__ __forceinline__ void ssd_out_item(Frame& F, int b, int c) {
    const bf16* PA = (const bf16*)(F.ws + WS_BIG + B_PROJA); const bf16* HB = (const bf16*)(F.ws + WS_BIG + B_HB);
    constexpr int XP_ = 80, BP_ = 144;
    LAS unsigned char* XT = F.lds;
    LAS unsigned char* BS = XT + 16 * 64 * XP_;
    LAS unsigned char* CS = BS + 2 * 32 * BP_;
    LAS float* DT = (LAS float*)(CS + 2 * 32 * BP_);
    LAS float* CUM = DT + 512;
    LAS float* SSQ = CUM + 512;
    const LAS float* CWL = (const LAS float*)(F.lds + SSDO_CWL);
    int tid = F.tid; asm volatile("" : "+v"(tid));
    const int t0 = 32 * c;
    PSEG_B(30, F.lds);
    const f32x4 nw0 = *(const GAS f32x4*)(F.a->in[I_SSMNW] + (tid & 127) * 8), nw1 = *(const GAS f32x4*)(F.a->in[I_SSMNW] + (tid & 127) * 8 + 4);
    const unsigned short dtr_ = PA[(size_t)(b * SEQ + t0 + (tid & 31)) * NA + 2304 + (tid >> 5)]; const float dtb_ = F.a->in[I_DTB][tid >> 5], alog_ = F.a->in[I_ALOG][tid >> 5];
    v4u zq[8];
#pragma unroll
    for (int q = 0; q < 8; ++q) zq[q] = *(const GAS v4u*)(PA + (size_t)(b * SEQ + t0 + (tid >> 7) + 4 * q) * NA + 8 * (tid & 127));
    v4u rwn[7]; ssd_rows7(PA, b, t0 + 4 * (tid & 7), 8 * (tid >> 3), rwn);
#pragma unroll 1
    for (int task = tid; task < 160 * 8; task += NTHR) { const int o = task >> 3, run = task & 7;
        v4u rwc[7];
#pragma unroll
        for (int rr = 0; rr < 7; ++rr) rwc[rr] = rwn[rr];
        if (task + NTHR < 160 * 8) ssd_rows7(PA, b, t0 + 4 * ((task + NTHR) & 7), 8 * ((task + NTHR) >> 3), rwn);
        float act[8][4]; ssd_conv4_lds(rwc, CWL, t0 + 4 * run, 8 * o, act);
        if (o < 128) { const int h = o >> 3, p0 = (o & 7) * 8;
#pragma unroll
            for (int e = 0; e < 8; ++e) { v2u pk; pk.x = pk2(act[e][0], act[e][1]); pk.y = pk2(act[e][2], act[e][3]); *(LAS v2u*)(XT + (h * 64 + p0 + e) * XP_ + 8 * run) = pk; } }
        else { const int oo = o - 128, isC = oo >> 4, g = (oo >> 3) & 1, n0 = (oo & 7) * 8; LAS unsigned char* dst = (isC ? CS : BS) + g * 32 * BP_;
#pragma unroll
            for (int jx = 0; jx < 4; ++jx) { v4u pk; pk.x = pk2(act[0][jx], act[1][jx]); pk.y = pk2(act[2][jx], act[3][jx]); pk.z = pk2(act[4][jx], act[5][jx]); pk.w = pk2(act[6][jx], act[7][jx]);
                *(LAS v4u*)(dst + (4 * run + jx) * BP_ + 2 * n0) = pk; } }
    }
    { const int h = tid >> 5, t = tid & 31;
      const float dt = softplusf_(bf2f(dtr_) + dtb_);
      float cum = -__expf(alog_) * dt;
      const int ln_ = lane_op_();
#pragma unroll
      for (int off = 1; off < 32; off <<= 1) { const float v = shup_(cum, off, 32, ln_); if (t >= off) cum += v; }
      DT[tid] = dt; CUM[tid] = cum; }
    __syncthreads();
    PSEG_E(30, F.lds); PSEG_B(31, F.lds);
    asm volatile("" : "+v"(tid));
    const int lane = tid & 63, wave = __builtin_amdgcn_readfirstlane(tid >> 6), r = lane & 31, hh = lane >> 5;
    const int g = wave >> 2;
    f32x16 gt;
#pragma unroll
    for (int i = 0; i < 16; ++i) gt[i] = 0.f;
#pragma unroll
    for (int ks = 0; ks < 4; ++ks) { const bf16x8 a = *(const LAS bf16x8*)(BS + (g * 32 + r) * BP_ + 32 * ks + 16 * hh), bb = *(const LAS bf16x8*)(CS + (g * 32 + r) * BP_ + 32 * ks + 16 * hh);
        gt = __builtin_amdgcn_mfma_f32_32x32x16_bf16(a, bb, gt, 0, 0, 0); }
#pragma unroll 1
    for (int hi = 0; hi < 2; ++hi) { const int h = 2 * wave + hi;
        bf16x8 hbf[2][4];
        { const bf16* hb0 = HB + ((((size_t)b * 64 + c) * 16 + h) * 64 + r) * 64 + 8 * hh;
#pragma unroll
          for (int pt = 0; pt < 2; ++pt)
#pragma unroll
              for (int ks = 0; ks < 4; ++ks) hbf[pt][ks] = *(const GAS bf16x8*)(hb0 + (size_t)pt * 32 * 64 + 16 * ks); }
        const float cum_t = CUM[h * 32 + r];
        bf16x8 am[2];
#pragma unroll
        for (int ks = 0; ks < 2; ++ks) { unsigned mf[4];
#pragma unroll
            for (int i2 = 0; i2 < 4; ++i2) { float m2[2];
#pragma unroll
                for (int q = 0; q < 2; ++q) { const int i = 8 * ks + 2 * i2 + q, s = (i & 3) + 8 * (i >> 2) + 4 * hh;
                    const float e_ = gt[i] * __expf(fminf(cum_t - CUM[h * 32 + s], 0.f)) * DT[h * 32 + s]; m2[q] = s <= r ? e_ : 0.f; }
                mf[i2] = pk2(m2[0], m2[1]); }
            v4u t4; t4.x = mf[0]; t4.y = mf[1]; t4.z = mf[2]; t4.w = mf[3]; am[ks] = __builtin_bit_cast(bf16x8, t4); }
        const float dsk = F.a->in[I_SSMD][h];
        f32x16 yv[2];
#pragma unroll
        for (int pt = 0; pt < 2; ++pt) {
            f32x16 yi;
#pragma unroll
            for (int i = 0; i < 16; ++i) { yv[pt][i] = 0.f; yi[i] = 0.f; }
            const LAS unsigned char* xrow = XT + (h * 64 + pt * 32 + r) * XP_;
#pragma unroll
            for (int ks = 0; ks < 2; ++ks) { const v2u lo = *(const LAS v2u*)(xrow + 2 * (16 * ks + 4 * hh)), hi2 = *(const LAS v2u*)(xrow + 2 * (16 * ks + 8 + 4 * hh));
                v4u t4; t4.x = lo.x; t4.y = lo.y; t4.z = hi2.x; t4.w = hi2.y;
                yv[pt] = __builtin_amdgcn_mfma_f32_32x32x16_bf16(am[ks], __builtin_bit_cast(bf16x8, t4), yv[pt], 0, 0, 0); }
#pragma unroll
            for (int ks = 0; ks < 4; ++ks) { const bf16x8 a = *(const LAS bf16x8*)(CS + (g * 32 + r) * BP_ + 32 * ks + 16 * hh), bb = hbf[pt][ks];
                yi = __builtin_amdgcn_mfma_f32_32x32x16_bf16(a, bb, yi, 0, 0, 0); }
#pragma unroll
            for (int i4 = 0; i4 < 4; ++i4) { const int tb = 8 * i4 + 4 * hh; const v2u xv = *(const LAS v2u*)(xrow + 2 * tb);
                const float xs[4] = {bflo(xv.x), bfhi(xv.x), bflo(xv.y), bfhi(xv.y)};
#pragma unroll
                for (int q = 0; q < 4; ++q) { const int i = 4 * i4 + q, t = tb + q; yv[pt][i] = yv[pt][i] + __expf(CUM[h * 32 + t]) * yi[i] + dsk * xs[q]; } }
        }
        LAS unsigned char* yb = XT + h * 64 * XP_;
#pragma unroll
        for (int pt = 0; pt < 2; ++pt)
#pragma unroll
            for (int i = 0; i < 16; ++i) { const int t = (i & 3) + 8 * (i >> 2) + 4 * hh; *(LAS unsigned short*)(yb + t * 128 + 2 * (pt * 32 + r)) = (unsigned short)f2bf(yv[pt][i]); }
    }
    asm volatile("s_waitcnt lgkmcnt(0)" ::: "memory"); __builtin_amdgcn_s_barrier(); asm volatile("" ::: "memory");
    PSEG_E(31, F.lds); PSEG_B(32, F.lds);
    { const int c8 = (tid & 127) * 8, h = c8 >> 6, pp = c8 & 63; float gv[8][8], ss[8];
#pragma unroll
      for (int q = 0; q < 8; ++q) { const int t = (tid >> 7) + 4 * q; const v4u yq = *(const LAS v4u*)(XT + h * 64 * XP_ + t * 128 + 2 * pp); const v4u z = zq[q];
          gv[q][0] = bflo(yq.x) * siluf_(bflo(z.x)); gv[q][1] = bfhi(yq.x) * siluf_(bfhi(z.x)); gv[q][2] = bflo(yq.y) * siluf_(bflo(z.y)); gv[q][3] = bfhi(yq.y) * siluf_(bfhi(z.y));
          gv[q][4] = bflo(yq.z) * siluf_(bflo(z.z)); gv[q][5] = bfhi(yq.z) * siluf_(bfhi(z.z)); gv[q][6] = bflo(yq.w) * siluf_(bflo(z.w)); gv[q][7] = bfhi(yq.w) * siluf_(bfhi(z.w));
          float a = 0.f;
#pragma unroll
          for (int e = 0; e < 8; ++e) a += gv[q][e] * gv[q][e];
          ss[q] = wave_sum(a); }
      if ((tid & 63) == 0) {
#pragma unroll
          for (int q = 0; q < 8; ++q) SSQ[(tid >> 6) * 8 + q] = ss[q]; }
      asm volatile("s_waitcnt lgkmcnt(0)" ::: "memory"); __builtin_amdgcn_s_barrier(); asm volatile("" ::: "memory");
      const f32x4 w0 = nw0, w1 = nw1;
      bf16* MX = (bf16*)(F.out + O_YP) + (size_t)(b * SEQ + t0) * 2048;
#pragma unroll
      for (int q = 0; q < 8; ++q) { const int t = (tid >> 7) + 4 * q; const float rs = rsqrtf((SSQ[((tid >> 7) * 2) * 8 + q] + SSQ[((tid >> 7) * 2 + 1) * 8 + q]) * (1.f / D) + EPS);
          v4u o; o.x = pk2(gv[q][0] * rs * w0.x, gv[q][1] * rs * w0.y); o.y = pk2(gv[q][2] * rs * w0.z, gv[q][3] * rs * w0.w); o.z = pk2(gv[q][4] * rs * w1.x, gv[q][5] * rs * w1.y); o.w = pk2(gv[q][6] * rs * w1.z, gv[q][7] * rs * w1.w);
          st16_wt(F.out + O_YP, ((b * SEQ + t0 + t) * 2048 + c8) * 2, o); } }
    asm volatile("s_waitcnt lgkmcnt(0)" ::: "memory"); __builtin_amdgcn_s_barrier(); asm volatile("" ::: "memory");
    PSEG_E(32, F.lds);
}
__device__ __forceinline__ void ssd_out_phase(Frame& F) {
    { LAS float* CWL = (LAS float*)(F.lds + SSDO_CWL);
      f32x4 t4[4];
#pragma unroll
      for (int i = 0; i < 4; ++i) { const int e4 = F.tid + NTHR * i; if (e4 < 5 * XBC / 4) t4[i] = e4 < XBC ? *(const GAS f32x4*)(F.a->in[I_CONVW] + 4 * e4) : *(const GAS f32x4*)(F.a->in[I_CONVB] + 4 * (e4 - XBC)); }
      __builtin_amdgcn_sched_barrier(0);
#pragma unroll
      for (int i = 0; i < 4; ++i) { const int e4 = F.tid + NTHR * i; if (e4 < 5 * XBC / 4) *(LAS f32x4*)(CWL + 4 * e4) = t4[i]; } }
    __syncthreads();
    for (int it = F.vcu; it < 8 * 64; it += F.G) ssd_out_item(F, it >> 6, it & 63);
}

constexpr size_t B_SB = 0;
static_assert(B_SB + (size_t)8 * 16 * 8 * 16384 * 2 <= B_PROJB, "hgrn state buffer");
__device__ __forceinline__ float hg_lb(const Frame& F, int c) { return __builtin_amdgcn_rcpf(1.f + __expf(F.a->in[I_HGLB][1024 + c] - F.a->in[I_HGLB][c])); }

__device__ __forceinline__ void hg_state_item(Frame& F, int b, int h, int kq, int sj, int sh) {
    const bf16* PB = (const bf16*)(F.ws + WS_BIG + B_PROJB); bf16* SB = (bf16*)(F.ws + WS_BIG + B_SB);
    constexpr int KP = 272, RP = 80;
    LAS unsigned char* KT0 = F.lds;
    LAS unsigned char* VT0 = KT0 + 2 * 32 * KP;
    LAS unsigned char* RAW = VT0 + 2 * 128 * KP;
    LAS float* EL = (LAS float*)(RAW + 128 * RP);
    LAS float* SEG = EL + 64;
    int tid = F.tid; asm volatile("" : "+v"(tid));
    const int lane = tid & 63, wave = __builtin_amdgcn_readfirstlane(tid >> 6), r = lane & 31, hh = lane >> 5;
    const int kcol = tid & 31, seg = tid >> 5;
    const float lb = hg_lb(F, h * 128 + 32 * kq + kcol);
    const int vs = tid >> 2, voc = tid & 3;
    const bf16* fsrc = PB + (size_t)(b * SEQ + vs) * NBH + 1024 + h * 128 + 32 * kq + 8 * voc;
    const bf16* vsrc = PB + (size_t)(b * SEQ + vs) * NBH + 2048 + h * 128 + 8 * voc;
    v4u pf, pv[4];
    pf = *(const GAS v4u*)fsrc;
#pragma unroll
    for (int q = 0; q < 4; ++q) pv[q] = *(const GAS v4u*)(vsrc + 32 * q);
    LAS float* SM = (LAS float*)(F.lds + HALO_OFF); LAS float* OW = SM + 1024; LAS float* OH = OW + 1024;
    const bf16* PS = PB + (size_t)(MP + sj) * NBH + 512 * sh;
    const float* S0 = F.a->in[I_SHG] + (size_t)sj * 131072 + (size_t)sh * 65536; float* S1 = F.out + O_SHG + (size_t)sj * 131072 + (size_t)sh * 65536;
    const int ln_ = lane_op_();
    f32x4 oacc = {0.f, 0.f, 0.f, 0.f};
    const int vt = wave - 4;
    f32x16 acc;
#pragma unroll
    for (int i = 0; i < 16; ++i) acc[i] = 0.f;
#pragma unroll 1
    for (int cc = 0; cc < 16; ++cc) {
        LAS unsigned char* KT = KT0 + (cc & 1) * 32 * KP; LAS unsigned char* VT = VT0 + (cc & 1) * 128 * KP;
        const int hl = cc >> 2, si0 = cc * 1024 + tid, si1 = si0 + 512;
        const f32x4 sv0 = *(const GAS f32x4*)(S0 + (size_t)si0 * 4), sv1 = *(const GAS f32x4*)(S0 + (size_t)si1 * 4);
        if ((cc & 3) == 0 && tid < 128) { LAS float* sm = SM + (hl & 1) * 512; const int c = hl * 128 + tid; const float lbs = hg_lb(F, 512 * sh + c), sg = sigmoidf_(bf2f(PS[1024 + c]));
            sm[tid] = lbs + (1.f - lbs) * sg; sm[128 + tid] = (1.f - lbs) * (1.f - sg); sm[256 + tid] = siluf_(bf2f(PS[c])); sm[384 + tid] = bf2f(PS[2048 + c]); }
        *(LAS v4u*)(RAW + vs * RP + 16 * voc) = pf;
#pragma unroll
        for (int q = 0; q < 4; ++q) { const unsigned ww[4] = {pv[q].x, pv[q].y, pv[q].z, pv[q].w};
#pragma unroll
          for (int e = 0; e < 4; ++e) { const int wi = (int)ww[e];
              const unsigned pu = (unsigned)__builtin_amdgcn_update_dpp(0, wi, 0x104, 0xf, 0xf, false), pd = (unsigned)__builtin_amdgcn_update_dpp(0, wi, 0x114, 0xf, 0xf, false);
              const unsigned outw = (vs & 1) ? ((pd >> 16) | (ww[e] & 0xffff0000u)) : ((ww[e] & 0xffffu) | (pu << 16));
              *(LAS unsigned*)(VT + (8 * (voc + 4 * q) + 2 * e + (vs & 1)) * KP + 2 * (vs & ~1)) = outw; } }
        if (cc + 1 < 16) {
            pf = *(const GAS v4u*)(fsrc + (size_t)(128 * (cc + 1)) * NBH);
#pragma unroll
            for (int q = 0; q < 4; ++q) pv[q] = *(const GAS v4u*)(vsrc + (size_t)(128 * (cc + 1)) * NBH + 32 * q); }
        if (wave >= 4) {
            bf16* sb = SB + ((((size_t)b * 16 + cc) * 8 + h) * 128 + vt * 32) * 128 + kq * 32 + r;
#pragma unroll
            for (int i = 0; i < 16; ++i) sb[(size_t)((i & 3) + 8 * (i >> 2) + 4 * hh) * 128] = (bf16)f2bf(acc[i]); }
        asm volatile("s_waitcnt lgkmcnt(0)" ::: "memory"); __builtin_amdgcn_s_barrier(); asm volatile("" ::: "memory");
        float kp[8];
        { float run = 1.f;
#pragma unroll
          for (int j = 7; j >= 0; --j) { const float sg = sigmoidf_(bf2f(*(const LAS unsigned short*)(RAW + (8 * seg + j) * RP + 2 * kcol))); kp[j] = (1.f - lb) * (1.f - sg) * run; run *= lb + (1.f - lb) * sg; }
          SEG[seg * 32 + kcol] = run; }
        asm volatile("s_waitcnt lgkmcnt(0)" ::: "memory"); __builtin_amdgcn_s_barrier(); asm volatile("" ::: "memory");
        { float R = 1.f, tot = 1.f;
#pragma unroll
          for (int s2 = 15; s2 >= 0; --s2) { const float t_ = SEG[s2 * 32 + kcol]; R = (s2 == seg) ? tot : R; tot *= t_; }
          if (seg == 0) EL[(cc & 1) * 32 + kcol] = tot;
          v4u p; p.x = pk2(kp[0] * R, kp[1] * R); p.y = pk2(kp[2] * R, kp[3] * R); p.z = pk2(kp[4] * R, kp[5] * R); p.w = pk2(kp[6] * R, kp[7] * R);
          *(LAS v4u*)(KT + kcol * KP + 16 * seg) = p; }
        asm volatile("s_waitcnt lgkmcnt(0)" ::: "memory"); __builtin_amdgcn_s_barrier(); asm volatile("" ::: "memory");
        if (wave >= 4) {
            const float el = EL[(cc & 1) * 32 + r];
#pragma unroll
            for (int i = 0; i < 16; ++i) acc[i] *= el;
#pragma unroll
            for (int ks = 0; ks < 8; ++ks) { const bf16x8 a = *(const LAS bf16x8*)(VT + (vt * 32 + r) * KP + 32 * ks + 16 * hh), bb = *(const LAS bf16x8*)(KT + r * KP + 32 * ks + 16 * hh);
                acc = __builtin_amdgcn_mfma_f32_32x32x16_bf16(a, bb, acc, 0, 0, 0); }
        }
        { const LAS float* sm = SM + (hl & 1) * 512; const int v4 = (tid & 31) * 4; const f32x4 vv = *(const LAS f32x4*)(sm + 384 + v4);
          const int k0 = (si0 >> 5) & 127, k1 = (si1 >> 5) & 127;
          const f32x4 n0 = sv0 * sm[k0] + vv * sm[128 + k0], n1 = sv1 * sm[k1] + vv * sm[128 + k1];
          *(GAS f32x4*)(S1 + (size_t)si0 * 4) = n0; *(GAS f32x4*)(S1 + (size_t)si1 * 4) = n1;
          oacc += n0 * sm[256 + k0] + n1 * sm[256 + k1];
          if ((cc & 3) == 3) {
              f32x4 t; t[0] = oacc[0] + shx_(oacc[0], 32, ln_); t[1] = oacc[1] + shx_(oacc[1], 32, ln_); t[2] = oacc[2] + shx_(oacc[2], 32, ln_); t[3] = oacc[3] + shx_(oacc[3], 32, ln_);
              if (lane < 32) *(LAS f32x4*)(OW + wave * 128 + v4) = t;
              oacc = (f32x4){0.f, 0.f, 0.f, 0.f}; } }
        if ((cc & 3) == 0 && cc > 0 && tid < 128) { float o = 0.f;
#pragma unroll
            for (int w = 0; w < 8; ++w) o += OW[w * 128 + tid];
            OH[(hl - 1) * 128 + tid] = o; }
    }
    __syncthreads();
    if (tid < 128) { float o = 0.f;
#pragma unroll
        for (int w = 0; w < 8; ++w) o += OW[w * 128 + tid];
        OH[3 * 128 + tid] = o; }
    __syncthreads();
    { const int c = tid; const float o = OH[c]; const float ss = wave_sum(o * o); if (lane == 0) SM[wave] = ss;
      __syncthreads();
      const float rs = rsqrtf((SM[(tid >> 7) * 2] + SM[(tid >> 7) * 2 + 1]) * (1.f / 128.f) + EPS);
      ((bf16*)(F.ws + WS_MIXS) + (size_t)sj * 2048 + 1024 + 512 * sh)[c] = (bf16)f2bf(o * rs * F.a->in[I_HGNW][c & 127] * siluf_(bf2f(PS[3072 + c]))); }
    if (wave >= 4) { float* ps = F.out + O_PHG + ((size_t)(b * 8 + h) * 128 + kq * 32 + r) * 128 + vt * 32;
#pragma unroll
        for (int i = 0; i < 16; ++i) ps[(i & 3) + 8 * (i >> 2) + 4 * hh] = acc[i]; }
    __syncthreads();
}

__device__ __forceinline__ void hg_out_phase(Frame& F) {
    const bf16* PB = (const bf16*)(F.ws + WS_BIG + B_PROJB); const bf16* SB = (const bf16*)(F.ws + WS_BIG + B_SB);
    constexpr int KP = 272, SP = 80, OP = 528;
    LAS unsigned char* QH = F.lds;
    LAS unsigned char* Q1 = QH + 32 * KP;
    LAS unsigned char* KA = Q1 + 16 * KP;
    LAS unsigned char* KB = KA + 16 * KP;
    LAS unsigned char* KHT = KB + 32 * KP;
    LAS unsigned char* VT = KHT + 128 * SP;
    LAS float* CSEG = (LAS float*)(VT + 128 * SP);
    LAS float* EL = CSEG + 512;
    LAS float* SSQ = EL + 128;
    LAS unsigned char* OF = (LAS unsigned char*)(SSQ + 256);
    LAS unsigned char* RQ = OF + 32 * OP;
    LAS unsigned char* RF = RQ + 32 * KP;
    int tid = F.tid; asm volatile("" : "+v"(tid));
    const int lane = tid & 63, wave = __builtin_amdgcn_readfirstlane(tid >> 6), fr = lane & 15, q4 = lane >> 4;
    const int kcol = tid & 127, seg = tid >> 7;
    const int NITEM = 8 * 16 * 8;
    const int nit = F.vcu < NITEM ? (NITEM - 1 - F.vcu) / F.G + 1 : 0, NIT = 4 * nit;
    v4u pv, pg;
    unsigned short pqs[8], pfs[8];
#define HG_ROW0(n) ((((F.vcu + ((n) >> 2) * F.G) >> 7) * SEQ) + 128 * (((F.vcu + ((n) >> 2) * F.G) >> 3) & 15) + 32 * ((n) & 3))
#define HG_HEAD(n) ((F.vcu + ((n) >> 2) * F.G) & 7)
#define HG_PREFETCH(n) do { const int T0_ = HG_ROW0(n), h_ = HG_HEAD(n); const bf16* rp_ = PB + (size_t)(T0_ + (tid >> 4)) * NBH + h_ * 128 + 8 * (tid & 15); \
        pv = *(const GAS v4u*)(rp_ + 2048); pg = *(const GAS v4u*)(rp_ + 3072); \
        const auto qrs_ = __builtin_amdgcn_make_buffer_rsrc((void*)(PB + (size_t)T0_ * NBH + h_ * 128), 0, 32 * NBH * 2, 0x00020000); const int vo_ = (8 * seg * NBH + kcol) * 2; \
        _Pragma("unroll") for (int j = 0; j < 8; ++j) { pqs[j] = __builtin_amdgcn_raw_buffer_load_b16(qrs_, vo_, j * NBH * 2, 0); pfs[j] = __builtin_amdgcn_raw_buffer_load_b16(qrs_, vo_, (j * NBH + 1024) * 2, 0); } } while (0)
    if (NIT > 0) HG_PREFETCH(0);
    f32x4 S[8]; v2u psb[8];
    float lb = 0.f, lbr0 = 0.f, lbr1 = 0.f;
    if (NIT > 0) { lbr0 = F.a->in[I_HGLB][HG_HEAD(0) * 128 + kcol]; lbr1 = F.a->in[I_HGLB][1024 + HG_HEAD(0) * 128 + kcol]; }
    const f32x4 wa = *(const GAS f32x4*)(F.a->in[I_HGNW] + (tid & 15) * 8), wb = *(const GAS f32x4*)(F.a->in[I_HGNW] + (tid & 15) * 8 + 4);
#pragma unroll 1
    for (int n = 0; n < NIT; ++n) {
        const int item = F.vcu + (n >> 2) * F.G, b = item >> 7, cc = (item >> 3) & 15, h = item & 7, fc = n & 3;
        PSEG_B(20, F.lds);
        const int T0 = b * SEQ + 128 * cc + 32 * fc;
        const v4u vv = pv, gv = pg; unsigned short cq[8], cf[8];
#pragma unroll
        for (int j = 0; j < 8; ++j) { cq[j] = pqs[j]; cf[j] = pfs[j]; }
        if (n + 1 < NIT) HG_PREFETCH(n + 1);
        if (fc == 0) {
            lb = __builtin_amdgcn_rcpf(1.f + __expf(lbr1 - lbr0));
            if (n == 0) { const bf16* sb = SB + ((((size_t)b * 16 + cc) * 8 + h) * 128 + 16 * wave + fr) * 128 + 4 * q4;
#pragma unroll
                for (int kt = 0; kt < 8; ++kt) psb[kt] = *(const GAS v2u*)(sb + 16 * kt); }
#pragma unroll
            for (int kt = 0; kt < 8; ++kt) { const v2u u = psb[kt]; S[kt][0] = bflo(u.x); S[kt][1] = bfhi(u.x); S[kt][2] = bflo(u.y); S[kt][3] = bfhi(u.y); } }
        if (fc == 3 && n + 1 < NIT) { const int it2 = F.vcu + ((n + 1) >> 2) * F.G; lbr0 = F.a->in[I_HGLB][(it2 & 7) * 128 + kcol]; lbr1 = F.a->in[I_HGLB][1024 + (it2 & 7) * 128 + kcol]; const bf16* sb = SB + ((((size_t)(it2 >> 7) * 16 + ((it2 >> 3) & 15)) * 8 + (it2 & 7)) * 128 + 16 * wave + fr) * 128 + 4 * q4;
#pragma unroll
            for (int kt = 0; kt < 8; ++kt) psb[kt] = *(const GAS v2u*)(sb + 16 * kt); }
        PSEG_E(20, F.lds); PSEG_B(21, F.lds);
        float cl[8], kk[8], qs[8];
        { float a = 0.f;
#pragma unroll
          for (int j = 0; j < 8; ++j) { const float sg = sigmoidf_(bf2f(cf[j]));
              a += __logf(lb + (1.f - lb) * sg); cl[j] = a; kk[j] = (1.f - lb) * (1.f - sg); qs[j] = siluf_(bf2f(cq[j])); }
          CSEG[seg * 128 + kcol] = a; }
        { const int s = tid >> 4, oc = tid & 15; const unsigned ww[4] = {vv.x, vv.y, vv.z, vv.w};
#pragma unroll
          for (int e = 0; e < 4; ++e) { *(LAS unsigned short*)(VT + (8 * oc + 2 * e) * SP + 2 * s) = (unsigned short)(ww[e] & 0xffffu); *(LAS unsigned short*)(VT + (8 * oc + 2 * e + 1) * SP + 2 * s) = (unsigned short)(ww[e] >> 16); } }
        asm volatile("s_waitcnt lgkmcnt(0)" ::: "memory"); __builtin_amdgcn_s_barrier(); asm volatile("" ::: "memory");
        PSEG_E(21, F.lds); PSEG_B(22, F.lds);
        { const float t0 = CSEG[kcol], t1 = CSEG[128 + kcol], t2 = CSEG[256 + kcol], t3 = CSEG[384 + kcol];
          const float off = seg == 0 ? 0.f : (seg == 1 ? t0 : (seg == 2 ? t0 + t1 : t0 + t1 + t2)), c15 = t0 + t1, last = (t0 + t1) + (t2 + t3);
          const float el = __expf(last), ec15 = __expf(c15), el15 = __expf(last - c15);
          if (seg == 0) EL[kcol] = el;
          float kh[8];
#pragma unroll
          for (int j = 0; j < 8; ++j) { const int t = 8 * seg + j; const float cum = off + cl[j];
              const float e = __expf(seg >= 2 ? cum - c15 : cum), ri = __builtin_amdgcn_rcpf(fmaxf(e, 1.8e-35f)), kr = kk[j] * ri;
              if (seg >= 2) { *(LAS unsigned short*)(Q1 + (t - 16) * KP + 2 * kcol) = (unsigned short)f2bf(qs[j] * e); *(LAS unsigned short*)(QH + t * KP + 2 * kcol) = (unsigned short)f2bf(qs[j] * e * ec15);
                  *(LAS unsigned short*)(KB + t * KP + 2 * kcol) = (unsigned short)f2bf(kr); kh[j] = kr * el15; }
              else { *(LAS unsigned short*)(QH + t * KP + 2 * kcol) = (unsigned short)f2bf(qs[j] * e); *(LAS unsigned short*)(KA + t * KP + 2 * kcol) = (unsigned short)f2bf(kr);
                  *(LAS unsigned short*)(KB + t * KP + 2 * kcol) = (unsigned short)f2bf(kr * ec15); kh[j] = kr * el; } }
          { v4u w; w.x = pk2(kh[0], kh[1]); w.y = pk2(kh[2], kh[3]); w.z = pk2(kh[4], kh[5]); w.w = pk2(kh[6], kh[7]); *(LAS v4u*)(KHT + kcol * SP + 16 * seg) = w; } }
        asm volatile("s_waitcnt lgkmcnt(0)" ::: "memory"); __builtin_amdgcn_s_barrier(); asm volatile("" ::: "memory");
        PSEG_E(22, F.lds); PSEG_B(23, F.lds);
        f32x4 at00 = {0.f, 0.f, 0.f, 0.f}, at01 = at00, at11 = at00;
#pragma unroll
        for (int ks = 0; ks < 4; ++ks) { const int kb = 64 * ks + 16 * q4;
            const bf16x8 ka = *(const LAS bf16x8*)(KA + fr * KP + kb), kb0 = *(const LAS bf16x8*)(KB + fr * KP + kb), kb1 = *(const LAS bf16x8*)(KB + (16 + fr) * KP + kb);
            const bf16x8 qh = *(const LAS bf16x8*)(QH + fr * KP + kb), q1 = *(const LAS bf16x8*)(Q1 + fr * KP + kb);
            at00 = __builtin_amdgcn_mfma_f32_16x16x32_bf16(ka, qh, at00, 0, 0, 0);
            at01 = __builtin_amdgcn_mfma_f32_16x16x32_bf16(kb0, q1, at01, 0, 0, 0);
            at11 = __builtin_amdgcn_mfma_f32_16x16x32_bf16(kb1, q1, at11, 0, 0, 0); }
#pragma unroll
        for (int e = 0; e < 4; ++e) { const bool keep = (4 * q4 + e) <= fr; at00[e] = keep ? at00[e] : 0.f; at11[e] = keep ? at11[e] : 0.f; }
        v4u pa0, pa1;
        pa0.x = pk2(at00[0], at00[1]); pa0.y = pk2(at00[2], at00[3]); pa0.z = 0u; pa0.w = 0u;
        pa1.x = pk2(at01[0], at01[1]); pa1.y = pk2(at01[2], at01[3]); pa1.z = pk2(at11[0], at11[1]); pa1.w = pk2(at11[2], at11[3]);
        f32x4 o0 = {0.f, 0.f, 0.f, 0.f}, o1 = o0;
        { const LAS unsigned char* vrow = VT + (16 * wave + fr) * SP; const v2u lo = *(const LAS v2u*)(vrow + 8 * q4), hi = *(const LAS v2u*)(vrow + 32 + 8 * q4);
          v4u bv; bv.x = lo.x; bv.y = lo.y; bv.z = hi.x; bv.w = hi.y;
          o0 = __builtin_amdgcn_mfma_f32_16x16x32_bf16(__builtin_bit_cast(bf16x8, pa0), __builtin_bit_cast(bf16x8, bv), o0, 0, 0, 0);
          o1 = __builtin_amdgcn_mfma_f32_16x16x32_bf16(__builtin_bit_cast(bf16x8, pa1), __builtin_bit_cast(bf16x8, bv), o1, 0, 0, 0); }
#pragma unroll
        for (int ks = 0; ks < 4; ++ks) { v4u bs; bs.x = pk2(S[2 * ks][0], S[2 * ks][1]); bs.y = pk2(S[2 * ks][2], S[2 * ks][3]); bs.z = pk2(S[2 * ks + 1][0], S[2 * ks + 1][1]); bs.w = pk2(S[2 * ks + 1][2], S[2 * ks + 1][3]);
            const int kb = 64 * ks + 8 * q4;
            const v2u a0l = *(const LAS v2u*)(QH + fr * KP + kb), a0h = *(const LAS v2u*)(QH + fr * KP + kb + 32), a1l = *(const LAS v2u*)(QH + (16 + fr) * KP + kb), a1h = *(const LAS v2u*)(QH + (16 + fr) * KP + kb + 32);
            v4u a0; a0.x = a0l.x; a0.y = a0l.y; a0.z = a0h.x; a0.w = a0h.y; v4u a1; a1.x = a1l.x; a1.y = a1l.y; a1.z = a1h.x; a1.w = a1h.y;
            o0 = __builtin_amdgcn_mfma_f32_16x16x32_bf16(__builtin_bit_cast(bf16x8, a0), __builtin_bit_cast(bf16x8, bs), o0, 0, 0, 0);
            o1 = __builtin_amdgcn_mfma_f32_16x16x32_bf16(__builtin_bit_cast(bf16x8, a1), __builtin_bit_cast(bf16x8, bs), o1, 0, 0, 0); }
#pragma unroll
        for (int e = 0; e < 4; ++e) { const int t0r = 4 * q4 + e; *(LAS float*)(OF + t0r * OP + 4 * (16 * wave + fr)) = o0[e]; *(LAS float*)(OF + (16 + t0r) * OP + 4 * (16 * wave + fr)) = o1[e];
            const float s0 = row16_sum(o0[e] * o0[e]), s1 = row16_sum(o1[e] * o1[e]);
            if (fr == 0) { SSQ[wave * 32 + t0r] = s0; SSQ[wave * 32 + 16 + t0r] = s1; } }
        { const bf16x8 bv = *(const LAS bf16x8*)(VT + (16 * wave + fr) * SP + 16 * q4);
#pragma unroll
          for (int kt = 0; kt < 8; ++kt) { const f32x4 el = *(const LAS f32x4*)(EL + 16 * kt + 4 * q4); const bf16x8 ak = *(const LAS bf16x8*)(KHT + (16 * kt + fr) * SP + 16 * q4);
              S[kt] = __builtin_amdgcn_mfma_f32_16x16x32_bf16(ak, bv, S[kt] * el, 0, 0, 0); } }
        asm volatile("s_waitcnt lgkmcnt(0)" ::: "memory"); __builtin_amdgcn_s_barrier(); asm volatile("" ::: "memory");
        PSEG_E(23, F.lds); PSEG_B(24, F.lds);
        { const int t = tid >> 4, v8 = (tid & 15) * 8; float tot = 0.f;
#pragma unroll
          for (int w = 0; w < 8; ++w) tot += SSQ[w * 32 + t];
          const float rs = rsqrtf(tot * (1.f / 128.f) + EPS);
          const f32x4 oa = *(const LAS f32x4*)(OF + t * OP + 4 * v8), ob = *(const LAS f32x4*)(OF + t * OP + 4 * v8 + 16);
          v4u o; o.x = pk2(oa.x * rs * wa.x * siluf_(bflo(gv.x)), oa.y * rs * wa.y * siluf_(bfhi(gv.x))); o.y = pk2(oa.z * rs * wa.z * siluf_(bflo(gv.y)), oa.w * rs * wa.w * siluf_(bfhi(gv.y)));
          o.z = pk2(ob.x * rs * wb.x * siluf_(bflo(gv.z)), ob.y * rs * wb.y * siluf_(bfhi(gv.z))); o.w = pk2(ob.z * rs * wb.z * siluf_(bflo(gv.w)), ob.w * rs * wb.w * siluf_(bfhi(gv.w)));
          st16_wt(F.out + O_YP, ((T0 + t) * 2048 + 1024 + h * 128 + v8) * 2, o); }
        PSEG_E(24, F.lds);
    }
#undef HG_ROW0
#undef HG_HEAD
#undef HG_PREFETCH
    __syncthreads();
}

__device__ __forceinline__ void hg_sample_item(Frame& F, int j, int half) {
    const bf16* PB = (const bf16*)(F.ws + WS_BIG + B_PROJB) + (size_t)(MP + j) * NBH + 512 * half; bf16* MX = (bf16*)(F.ws + WS_MIXS) + (size_t)j * 2048 + 1024 + 512 * half;
    LAS float* fS = (LAS float*)F.lds;
    LAS float* kS = fS + 512; LAS float* qS = kS + 512; LAS float* vS = qS + 512; LAS float* oP = vS + 512;
    int tid = F.tid; asm volatile("" : "+v"(tid));
    { const int c = tid; const float lb = hg_lb(F, 512 * half + c), sg = sigmoidf_(bf2f(PB[1024 + c]));
      fS[c] = lb + (1.f - lb) * sg; kS[c] = (1.f - lb) * (1.f - sg); qS[c] = siluf_(bf2f(PB[c])); vS[c] = bf2f(PB[2048 + c]); }
    __syncthreads();
    const int v4 = (tid & 31) * 4, krow = tid >> 5;
    const float* S0 = F.a->in[I_SHG] + (size_t)j * 131072 + (size_t)half * 65536; float* S1 = F.out + O_SHG + (size_t)j * 131072 + (size_t)half * 65536;
#pragma unroll 1
    for (int hl = 0; hl < 4; ++hl) { const f32x4 vv = *(const LAS f32x4*)(vS + hl * 128 + v4); f32x4 a = {0.f, 0.f, 0.f, 0.f};
        f32x4 sv[8];
#pragma unroll
        for (int kb = 0; kb < 8; ++kb) sv[kb] = *(const GAS f32x4*)(S0 + ((size_t)hl * 128 + krow + 16 * kb) * 128 + v4);
#pragma unroll
        for (int kb = 0; kb < 8; ++kb) { const int k = krow + 16 * kb; const f32x4 sn = sv[kb] * fS[hl * 128 + k] + vv * kS[hl * 128 + k];
            *(GAS f32x4*)(S1 + ((size_t)hl * 128 + k) * 128 + v4) = sn; a += sn * qS[hl * 128 + k]; }
        *(LAS f32x4*)(oP + krow * 512 + hl * 128 + v4) = a; }
    __syncthreads();
    { const int c = tid; float o = 0.f;
#pragma unroll
      for (int q = 0; q < 16; ++q) o += oP[q * 512 + c];
      float ss = wave_sum(o * o); if ((tid & 63) == 0) fS[tid >> 6] = ss;
      __syncthreads();
      const float tot = fS[(tid >> 7) * 2] + fS[(tid >> 7) * 2 + 1];
      const float rs = rsqrtf(tot * (1.f / 128.f) + EPS);
      MX[c] = (bf16)f2bf(o * rs * F.a->in[I_HGNW][c & 127] * siluf_(bf2f(PB[3072 + c]))); }
    __syncthreads();
}
__device__ __forceinline__ void hg_state_phase(Frame& F) {
    for (int it = F.vcu; it < 256; it += F.G) hg_state_item(F, it >> 5, (it >> 2) & 7, it & 3, it >> 1, it & 1);
}

__device__ __forceinline__ void s5_lambda(const Frame& F, int g, int n, float& abr, float& abi, float& cfr, float& cfi) {
    const float lr = F.a->in[I_LAMRE][g * 64 + n], li = F.a->in[I_LAMIM][g * 64 + n], step = expf(F.a->in[I_LOGSTEP][g]);
    const float mag = expf(lr * step); float sn, cs; sincosf(li * step, &sn, &cs);
    abr = mag * cs; abi = mag * sn;
    const float den = lr * lr + li * li, nr = abr - 1.0f;
    cfr = (nr * lr + abi * li) / den; cfi = (abi * lr - nr * li) / den;
}
typedef float f32x2 __attribute__((ext_vector_type(2)));
__device__ __forceinline__ void s5_split8(const float (&v)[8], bf16x8& hi, bf16x8& lo) {
    unsigned h[4], l[4];
#pragma unroll
    for (int j = 0; j < 4; ++j) { const unsigned h0 = f2bf(v[2 * j]), h1 = f2bf(v[2 * j + 1]); h[j] = h0 | (h1 << 16);
        l[j] = pk2(v[2 * j] - __builtin_bit_cast(float, h0 << 16), v[2 * j + 1] - __builtin_bit_cast(float, h1 << 16)); }
    v4u a; a.x = h[0]; a.y = h[1]; a.z = h[2]; a.w = h[3]; hi = __builtin_bit_cast(bf16x8, a);
    v4u b; b.x = l[0]; b.y = l[1]; b.z = l[2]; b.w = l[3]; lo = __builtin_bit_cast(bf16x8, b);
}
__device__ __forceinline__ void s5_tables_item(Frame& F, int g, int hf) {
    LAS float* POW = (LAS float*)F.lds;
    LAS float* CC = POW + 17 * 128;
    LAS float* BB = CC + 16 * 128;
    LAS float* BT = BB + 64 * 32;
    LAS float* KS = BT + 16 * 128;
    int tid = F.tid; asm volatile("" : "+v"(tid));
    PSEG_B(50, F.lds);
    bf16* KQ = (bf16*)((unsigned char*)(F.out + O_YP) + S5T_KQ) + (size_t)g * 256 * 384; bf16* PM = (bf16*)((unsigned char*)(F.out + O_YP) + S5T_PM) + (size_t)g * 128 * 256;
    if (tid < 64) { const int n = tid; float abr, abi, cfr, cfi; s5_lambda(F, g, n, abr, abi, cfr, cfi);
        const f32x4* br4 = (const f32x4*)(F.a->in[I_BRE] + (size_t)(g * 64 + n) * 16); const f32x4* bi4 = (const f32x4*)(F.a->in[I_BIM] + (size_t)(g * 64 + n) * 16);
        f32x4 brv[4], biv[4];
#pragma unroll
        for (int q = 0; q < 4; ++q) { brv[q] = br4[q]; biv[q] = bi4[q]; }
        float pr = 1.f, pi = 0.f; asm volatile("" : "+v"(pr), "+v"(pi));
        for (int t = 0; t <= 16; ++t) { *(LAS f32x2*)(POW + (t * 64 + n) * 2) = (f32x2){pr, pi}; const float nr = pr * abr - pi * abi, ni = pr * abi + pi * abr; pr = nr; pi = ni; }
        float* gab = (float*)((unsigned char*)(F.out + O_YP) + S5T_AB) + (size_t)(g * 64 + n) * 2; float* gbb = (float*)((unsigned char*)(F.out + O_YP) + S5T_BB) + (size_t)(g * 64 + n) * 32;
        if (hf == 0) { gab[0] = abr; gab[1] = abi; }
#pragma unroll
        for (int c = 0; c < 16; ++c) { const float b_r = brv[c >> 2][c & 3], b_i = biv[c >> 2][c & 3]; const float vr = cfr * b_r - cfi * b_i, vi = cfr * b_i + cfi * b_r;
            *(LAS f32x2*)(BB + (n * 16 + c) * 2) = (f32x2){vr, vi}; *(LAS f32x2*)(BT + (c * 64 + n) * 2) = (f32x2){vr, vi};
            if (hf == 0) *(GAS f32x2*)(gbb + 2 * c) = (f32x2){vr, vi}; } }
    else { for (int e = tid - 64; e < 1024; e += NTHR - 64) { const float cr = F.a->in[I_CRE][(size_t)g * 1024 + e], ci = F.a->in[I_CIM][(size_t)g * 1024 + e]; *(LAS f32x2*)(CC + e * 2) = (f32x2){cr, ci}; } }
    __syncthreads();
    PSEG_E(50, F.lds); PSEG_B(51, F.lds);
    { const int lane = tid & 63, wave = __builtin_amdgcn_readfirstlane(tid >> 6), r = lane & 15, q = lane >> 4;
      f32x4 acc[2];
#pragma unroll
      for (int j = 0; j < 2; ++j) acc[j] = (f32x4){0.f, 0.f, 0.f, 0.f};
#pragma unroll
      for (int nb = 0; nb < 2; ++nb) { const int n0 = 32 * nb + 8 * q;
          float pre[8], pim[8];
#pragma unroll
          for (int j4 = 0; j4 < 4; ++j4) { const f32x4 p = *(const LAS f32x4*)(POW + (r * 64 + n0 + 2 * j4) * 2); pre[2 * j4] = p.x; pim[2 * j4] = p.y; pre[2 * j4 + 1] = p.z; pim[2 * j4 + 1] = p.w; }
          bf16x8 arh, arl, aih, ail; s5_split8(pre, arh, arl); s5_split8(pim, aih, ail);
#pragma unroll
          for (int j = 0; j < 2; ++j) { const int cp = 2 * wave + j; float xr[8], xm[8];
#pragma unroll
              for (int j4 = 0; j4 < 4; ++j4) { const f32x4 cv = *(const LAS f32x4*)(CC + (cp * 64 + n0 + 2 * j4) * 2), bv = *(const LAS f32x4*)(BT + (r * 64 + n0 + 2 * j4) * 2);
                  xr[2 * j4] = cv.x * bv.x - cv.y * bv.y; xm[2 * j4] = -(cv.x * bv.y + cv.y * bv.x); xr[2 * j4 + 1] = cv.z * bv.z - cv.w * bv.w; xm[2 * j4 + 1] = -(cv.z * bv.w + cv.w * bv.z); }
              bf16x8 xrh, xrl, xmh, xml; s5_split8(xr, xrh, xrl); s5_split8(xm, xmh, xml);
              acc[j] = __builtin_amdgcn_mfma_f32_16x16x32_bf16(arl, xrh, acc[j], 0, 0, 0); acc[j] = __builtin_amdgcn_mfma_f32_16x16x32_bf16(arh, xrl, acc[j], 0, 0, 0);
              acc[j] = __builtin_amdgcn_mfma_f32_16x16x32_bf16(ail, xmh, acc[j], 0, 0, 0); acc[j] = __builtin_amdgcn_mfma_f32_16x16x32_bf16(aih, xml, acc[j], 0, 0, 0);
              acc[j] = __builtin_amdgcn_mfma_f32_16x16x32_bf16(arh, xrh, acc[j], 0, 0, 0); acc[j] = __builtin_amdgcn_mfma_f32_16x16x32_bf16(aih, xmh, acc[j], 0, 0, 0); } }
#pragma unroll
      for (int j = 0; j < 2; ++j)
#pragma unroll
          for (int e = 0; e < 4; ++e) KS[(4 * q + e) * 256 + (2 * wave + j) * 16 + r] = acc[j][e]; }
    __syncthreads();
    PSEG_E(51, F.lds); PSEG_B(52, F.lds);
#pragma unroll 2
    for (int p = tid; p < 128 * 32; p += NTHR) { const int row = 128 * hf + (p >> 5), pc = p & 31, t = row >> 4, cp = row & 15, s = pc >> 1, c0 = (pc & 1) * 8;
        f32x4 v0 = (f32x4){0.f, 0.f, 0.f, 0.f}, v1 = v0;
        if (s <= t) { v0 = *(const LAS f32x4*)(KS + (t - s) * 256 + cp * 16 + c0); v1 = *(const LAS f32x4*)(KS + (t - s) * 256 + cp * 16 + c0 + 4); }
        v4u o; o.x = pk2(v0.x, v0.y); o.y = pk2(v0.z, v0.w); o.z = pk2(v1.x, v1.y); o.w = pk2(v1.z, v1.w);
        *(GAS v4u*)(KQ + (size_t)row * 384 + 8 * pc) = o; }
#pragma unroll 2
    for (int p = tid; p < 128 * 16; p += NTHR) { const int row = 128 * hf + (p >> 4), pc = p & 15, t = row >> 4, cp = row & 15, n0 = (pc & 7) * 8; const bool im = pc >= 8; float v[8];
#pragma unroll
        for (int j4 = 0; j4 < 4; ++j4) { const f32x4 pv = *(const LAS f32x4*)(POW + ((t + 1) * 64 + n0 + 2 * j4) * 2), cv = *(const LAS f32x4*)(CC + (cp * 64 + n0 + 2 * j4) * 2);
            v[2 * j4] = im ? -(cv.x * pv.y + cv.y * pv.x) : cv.x * pv.x - cv.y * pv.y; v[2 * j4 + 1] = im ? -(cv.z * pv.w + cv.w * pv.z) : cv.z * pv.z - cv.w * pv.w; }
        v4u o; o.x = pk2(v[0], v[1]); o.y = pk2(v[2], v[3]); o.z = pk2(v[4], v[5]); o.w = pk2(v[6], v[7]);
        *(GAS v4u*)(KQ + (size_t)row * 384 + 256 + 8 * pc) = o; }
#pragma unroll 2
    for (int p = tid; p < 64 * 32; p += NTHR) { const int n = p >> 5, pc = p & 31, s = pc >> 1, c0 = (pc & 1) * 8; const f32x2 pw = *(const LAS f32x2*)(POW + ((15 - s) * 64 + n) * 2); float v[8];
#pragma unroll
        for (int j4 = 0; j4 < 4; ++j4) { const f32x4 bv = *(const LAS f32x4*)(BB + (n * 16 + c0 + 2 * j4) * 2);
            v[2 * j4] = hf ? pw.x * bv.y + pw.y * bv.x : pw.x * bv.x - pw.y * bv.y; v[2 * j4 + 1] = hf ? pw.x * bv.w + pw.y * bv.z : pw.x * bv.z - pw.y * bv.w; }
        v4u o; o.x = pk2(v[0], v[1]); o.y = pk2(v[2], v[3]); o.z = pk2(v[4], v[5]); o.w = pk2(v[6], v[7]);
        *(GAS v4u*)(PM + (size_t)(64 * hf + n) * 256 + 8 * pc) = o; }
    __syncthreads();
    PSEG_E(52, F.lds);
}
__device__ __forceinline__ void s5_fused_item(Frame& F, int b, int g) {
    const bf16* HN = (const bf16*)(F.ws + WS_XN); const bf16* PM = (const bf16*)((unsigned char*)(F.out + O_YP) + S5T_PM) + (size_t)g * 128 * 256; const bf16* KQ = (const bf16*)((unsigned char*)(F.out + O_YP) + S5T_KQ) + (size_t)g * 256 * 384;
    bf16* GY = (bf16*)(F.ws + WS_BIG + B_GY);
    constexpr int UP_ = 528, PP = 132, XPP = 272, KQP = 784;
    LAS unsigned char* UL = F.lds;
    LAS unsigned char* XL = UL;
    LAS unsigned char* BL = UL + 128 * XPP;
    LAS float* PL = (LAS float*)BL;
    LAS float* SE = (LAS float*)(BL + 128 * UP_);
    static_assert(64 * UP_ <= 128 * XPP && 128 * PP * 4 <= 128 * UP_ && 64 * KQP <= 128 * UP_ && 128 * XPP + 128 * UP_ + 4096 <= RING_BYTES, "s5 LDS map");
    int tid = F.tid; asm volatile("" : "+v"(tid));
    const int lane = tid & 63, wave = __builtin_amdgcn_readfirstlane(tid >> 6), r = lane & 31, hh = lane >> 5, mt = wave >> 1, ch = wave & 1;
    const f32x2 lbar = *(const GAS f32x2*)((const float*)((unsigned char*)(F.out + O_YP) + S5T_AB) + (size_t)(g * 64 + lane) * 2);
    v4u tu[2][4];
    { v4u t8[8];
#pragma unroll
      for (int i = 0; i < 8; ++i) { const int e = tid + NTHR * i, row = e >> 5, c16 = e & 31; t8[i] = *(const GAS v4u*)(PM + (size_t)row * 256 + 8 * c16); }
#pragma unroll
      for (int hf2 = 0; hf2 < 2; ++hf2)
#pragma unroll
          for (int i = 0; i < 4; ++i) { const int e = tid + NTHR * i, tok = e >> 1, pc = e & 1; tu[hf2][i] = *(const GAS v4u*)(HN + (size_t)(b * SEQ + 1024 * hf2 + tok) * D + 16 * g + 8 * pc); }
      __builtin_amdgcn_sched_barrier(0);
#pragma unroll
      for (int i = 0; i < 8; ++i) { const int e = tid + NTHR * i, row = e >> 5, c16 = e & 31; *(LAS v4u*)(BL + row * UP_ + 16 * c16) = t8[i]; } }
    bf16x8 au[16];
#pragma unroll
    for (int half = 0; half < 2; ++half) {
        {
#pragma unroll
          for (int i = 0; i < 4; ++i) { const int e = tid + NTHR * i, tok = e >> 1, pc = e & 1, m = tok >> 4, s2 = tok & 15; *(LAS v4u*)(UL + m * UP_ + 32 * s2 + 16 * pc) = tu[half][i]; } }
        __syncthreads();
        if ((mt >> 1) == half) {
#pragma unroll
            for (int s2 = 0; s2 < 16; ++s2) au[s2] = *(const LAS bf16x8*)(UL + (32 * (mt & 1) + r) * UP_ + 32 * s2 + 16 * hh); }
        __syncthreads();
    }
    { f32x16 acc[2];
#pragma unroll
      for (int nt = 0; nt < 2; ++nt)
#pragma unroll
          for (int i = 0; i < 16; ++i) acc[nt][i] = 0.f;
#pragma unroll
      for (int s2 = 0; s2 < 16; ++s2)
#pragma unroll
          for (int nt = 0; nt < 2; ++nt) { const bf16x8 bb = *(const LAS bf16x8*)(BL + (64 * ch + 32 * nt + r) * UP_ + 32 * s2 + 16 * hh); acc[nt] = __builtin_amdgcn_mfma_f32_32x32x16_bf16(au[s2], bb, acc[nt], 0, 0, 0); }
      __syncthreads();
#pragma unroll
      for (int nt = 0; nt < 2; ++nt)
#pragma unroll
          for (int i = 0; i < 16; ++i) PL[(32 * mt + (i & 3) + 8 * (i >> 2) + 4 * hh) * PP + 64 * ch + 32 * nt + r] = acc[nt][i]; }
    __syncthreads();
    { const int n = lane, seg = wave; float abr = lbar.x, abi = lbar.y;
#pragma unroll
      for (int q = 0; q < 4; ++q) { const float nr = abr * abr - abi * abi, ni = 2.f * abr * abi; abr = nr; abi = ni; }
      float yr[16], yi[16];
      { float xr = 0.f, xi = 0.f;
#pragma unroll
        for (int i = 0; i < 16; ++i) { const float pr = PL[(16 * seg + i) * PP + n], pi = PL[(16 * seg + i) * PP + 64 + n]; const float nr = abr * xr - abi * xi + pr, ni = abr * xi + abi * xr + pi; xr = nr; xi = ni; yr[i] = xr; yi[i] = xi; }
        SE[seg * 128 + n] = xr; SE[seg * 128 + 64 + n] = xi; }
      float a16r = abr, a16i = abi;
#pragma unroll
      for (int q = 0; q < 4; ++q) { const float nr = a16r * a16r - a16i * a16i, ni = 2.f * a16r * a16i; a16r = nr; a16i = ni; }
      __syncthreads();
      float cr = 0.f, ci = 0.f;
      for (int s2 = 0; s2 < seg; ++s2) { const float er = SE[s2 * 128 + n], ei = SE[s2 * 128 + 64 + n]; const float nr = a16r * cr - a16i * ci + er, ni = a16r * ci + a16i * cr + ei; cr = nr; ci = ni; }
      float pwr = 1.f, pwi = 0.f;
#pragma unroll
      for (int i = 0; i < 16; ++i) { const float xr = (i == 0 ? 0.f : yr[i == 0 ? 0 : i - 1]) + pwr * cr - pwi * ci, xi = (i == 0 ? 0.f : yi[i == 0 ? 0 : i - 1]) + pwr * ci + pwi * cr;
          *(LAS unsigned short*)(XL + (16 * seg + i) * XPP + 2 * n) = (unsigned short)f2bf(xr); *(LAS unsigned short*)(XL + (16 * seg + i) * XPP + 2 * (64 + n)) = (unsigned short)f2bf(xi);
          const float nr = pwr * abr - pwi * abi, ni = pwr * abi + pwi * abr; pwr = nr; pwi = ni; }
      if (seg == 7) { const float xr = yr[15] + pwr * cr - pwi * ci, xi = yi[15] + pwr * ci + pwi * cr;
          F.out[O_PS5R + (size_t)(b * 64 + g) * 64 + n] = xr; F.out[O_PS5I + (size_t)(b * 64 + g) * 64 + n] = xi; } }
    __syncthreads();
    bf16x8 ax[8];
#pragma unroll
    for (int s2 = 0; s2 < 8; ++s2) ax[s2] = *(const LAS bf16x8*)(XL + (32 * mt + r) * XPP + 32 * s2 + 16 * hh);
    const f32x4 dsk0 = *(const GAS f32x4*)(F.a->in[I_S5D] + 16 * g + 8 * (tid & 1)), dsk1 = *(const GAS f32x4*)(F.a->in[I_S5D] + 16 * g + 8 * (tid & 1) + 4);
    v4u kq[6];
#pragma unroll
    for (int q = 0; q < 6; ++q) { const int e = tid + NTHR * q, row = e / 48, c16 = e % 48; kq[q] = *(const GAS v4u*)(KQ + (size_t)row * 384 + 8 * c16); }
#pragma unroll 1
    for (int p = 0; p < 4; ++p) {
#pragma unroll
        for (int q = 0; q < 6; ++q) { const int e = tid + NTHR * q, row = e / 48, c16 = e % 48; *(LAS v4u*)(BL + row * KQP + 16 * c16) = kq[q]; }
        if (p < 3) {
#pragma unroll
            for (int q = 0; q < 6; ++q) { const int e = tid + NTHR * q, row = e / 48, c16 = e % 48; kq[q] = *(const GAS v4u*)(KQ + (size_t)(64 * (p + 1) + row) * 384 + 8 * c16); } }
        v4u uq[2];
#pragma unroll
        for (int q = 0; q < 2; ++q) { const int e = tid + NTHR * q, m = e >> 3, tl = (e >> 1) & 3, hf = e & 1; uq[q] = *(const GAS v4u*)(HN + (size_t)(b * SEQ + 16 * m + 4 * p + tl) * D + 16 * g + 8 * hf); }
        __syncthreads();
        f32x16 acc;
#pragma unroll
        for (int i = 0; i < 16; ++i) acc[i] = 0.f;
        const LAS unsigned char* brow = BL + (32 * ch + r) * KQP + 16 * hh;
#pragma unroll
        for (int s2 = 0; s2 < 16; ++s2) acc = __builtin_amdgcn_mfma_f32_32x32x16_bf16(au[s2], *(const LAS bf16x8*)(brow + 32 * s2), acc, 0, 0, 0);
#pragma unroll
        for (int s2 = 0; s2 < 8; ++s2) acc = __builtin_amdgcn_mfma_f32_32x32x16_bf16(ax[s2], *(const LAS bf16x8*)(brow + 512 + 32 * s2), acc, 0, 0, 0);
        { LAS float* OL = (LAS float*)XL;
#pragma unroll
          for (int i = 0; i < 16; ++i) OL[(32 * mt + (i & 3) + 8 * (i >> 2) + 4 * hh) * 68 + 32 * ch + r] = acc[i]; }
        __syncthreads();
#pragma unroll
        for (int q = 0; q < 2; ++q) { const int e = tid + NTHR * q, m = e >> 3, tl = (e >> 1) & 3, hf = e & 1; const LAS float* ol = (const LAS float*)XL + m * 68 + 16 * tl + 8 * hf;
            const f32x4 o0 = *(const LAS f32x4*)ol, o1 = *(const LAS f32x4*)(ol + 4);
            const size_t o = (size_t)(b * SEQ + 16 * m + 4 * p + tl) * D + 16 * g + 8 * hf;
            const v4u uu = uq[q]; const f32x4 d0 = dsk0, d1 = dsk1;
            v4u w; w.x = pk2(gelu_tanh(o0.x + d0.x * bflo(uu.x)), gelu_tanh(o0.y + d0.y * bfhi(uu.x))); w.y = pk2(gelu_tanh(o0.z + d0.z * bflo(uu.y)), gelu_tanh(o0.w + d0.w * bfhi(uu.y)));
            w.z = pk2(gelu_tanh(o1.x + d1.x * bflo(uu.z)), gelu_tanh(o1.y + d1.y * bfhi(uu.z))); w.w = pk2(gelu_tanh(o1.z + d1.z * bflo(uu.w)), gelu_tanh(o1.w + d1.w * bfhi(uu.w)));
            *(GAS v4u*)(GY + o) = w; }
        __syncthreads();
    }
}
__device__ __forceinline__ void s5_fused_phase(Frame& F) {
    for (int it = F.vcu; it < 8 * 64; it += F.G) { const int li = (it & 31) + 32 * (it >> 8); s5_fused_item(F, li >> 3, 8 * ((it >> 5) & 7) + (li & 7)); }
}
__device__ __forceinline__ void s5_sample(Frame& F) {
    const bf16* HN = (const bf16*)(F.ws + WS_XN) + (size_t)MP * D; bf16* GY = (bf16*)(F.ws + WS_BIG + B_GY) + (size_t)MP * D;
    const float* TAB = (const float*)((unsigned char*)(F.out + O_YP) + S5T_AB); const float* TBB = (const float*)((unsigned char*)(F.out + O_YP) + S5T_BB);
    const int n = F.lane;
    for (int task = GW_ID(F); task < MS * 64; task += GW_N(F)) { const int j = task >> 6, g = task & 63;
        const f32x2_t ab = *(const GAS f32x2_t*)(TAB + (size_t)(g * 64 + n) * 2);
        f32x4 bb[8];
#pragma unroll
        for (int q = 0; q < 8; ++q) bb[q] = *(const GAS f32x4*)(TBB + (size_t)(g * 64 + n) * 32 + 4 * q);
        const v4u u0 = *(const GAS v4u*)(HN + (size_t)j * D + 16 * g), u1 = *(const GAS v4u*)(HN + (size_t)j * D + 16 * g + 8);
        const size_t si = ((size_t)j * 64 + g) * 64 + n; const float sr = F.a->in[I_SS5R][si], sim = F.a->in[I_SS5I][si];
        float cr[16], ci[16];
#pragma unroll
        for (int cp = 0; cp < 16; ++cp) { cr[cp] = F.a->in[I_CRE][((size_t)g * 16 + cp) * 64 + n]; ci[cp] = F.a->in[I_CIM][((size_t)g * 16 + cp) * 64 + n]; }
        const float dsk = F.a->in[I_S5D][16 * g + (n & 15)];
        float u[16]; u[0] = bflo(u0.x); u[1] = bfhi(u0.x); u[2] = bflo(u0.y); u[3] = bfhi(u0.y); u[4] = bflo(u0.z); u[5] = bfhi(u0.z); u[6] = bflo(u0.w); u[7] = bfhi(u0.w);
        u[8] = bflo(u1.x); u[9] = bfhi(u1.x); u[10] = bflo(u1.y); u[11] = bfhi(u1.y); u[12] = bflo(u1.z); u[13] = bfhi(u1.z); u[14] = bflo(u1.w); u[15] = bfhi(u1.w);
        float bur = 0.f, bui = 0.f;
#pragma unroll
        for (int q = 0; q < 8; ++q) { bur += bb[q].x * u[2 * q] + bb[q].z * u[2 * q + 1]; bui += bb[q].y * u[2 * q] + bb[q].w * u[2 * q + 1]; }
        const float xr = ab.x * sr - ab.y * sim + bur, xi = ab.x * sim + ab.y * sr + bui;
        F.out[O_SS5R + si] = xr; F.out[O_SS5I + si] = xi;
        float ymine = 0.f, uu = 0.f;
#pragma unroll
        for (int cp = 0; cp < 16; ++cp) { const float tot = wave_sum(cr[cp] * xr - ci[cp] * xi); ymine = (n == cp) ? tot : ymine; uu = (n == cp) ? u[cp] : uu; }
        if (n < 16) GY[(size_t)j * D + 16 * g + n] = (bf16)f2bf(gelu_tanh(ymine + dsk * uu));
    }
}

constexpr int CW_BAR = 4096;

struct SkAny { int mode; void* O; int ld;
    __device__ __forceinline__ void operator()(int row, int col, const float (&v)[1]) const { if (mode == 0) ((bf16*)O)[(size_t)row * ld + col] = (bf16)f2bf(v[0]); else ((float*)O)[(size_t)row * ld + col] = v[0]; }
    typedef SkNone W; typedef SkNone S; __device__ __forceinline__ W pre(int) const { return W{}; } __device__ __forceinline__ S rows(int, int) const { return S{}; }
    __device__ __forceinline__ void fin(int row, int col, const float (&v)[1], const W&, const S&) const { (*this)(row, col, v); } };

__global__ void __launch_bounds__(NTHR, 2) fwd_kernel(Args args) {
    extern __shared__ __attribute__((aligned(16))) unsigned char lds[];
    Frame F;
    F.lds = (LAS unsigned char*)lds;
    F.tid = threadIdx.x;
    F.out = args.out; F.ws = args.ws;
    volatile LAS unsigned* MISC = (volatile LAS unsigned*)(F.lds + MISC_OFF);
    for (int u = F.tid; u < (LDS_BYTES - LDSCTL_OFF) / 4; u += NTHR) ((LAS unsigned*)(F.lds + LDSCTL_OFF))[u] = 0u;
    __syncthreads();
    const int lo = args.ph_lo, hi = args.ph_hi;
    if (hi - lo > 1) (void)xcd_barrier_post((unsigned*)(args.ws + WS_CTL) + CW_BAR + args.li * XCD_BAR_WORDS, MISC + 8);
#if PROBE_T >= 0
    if (blockIdx.x == PROBE_EB && threadIdx.x == 0) { volatile LAS unsigned long long* ST = (volatile LAS unsigned long long*)(F.lds + MISC_OFF + 64); ST[0] = PROBE_E == 2 ? (unsigned long long)__builtin_readcyclecounter() : __builtin_amdgcn_s_memrealtime(); ST[1] = 0ull; ST[2] = 0ull; ST[3] = (lo == PROBE_T || PROBE_ALL) ? 1ull : 0ull; }
#endif
#pragma unroll 1
    for (int ph = lo; ph < hi; ++ph) {
        { int t_ = threadIdx.x; asm volatile("" : "+v"(t_)); F.tid = t_; F.lane = t_ & 63; F.wave = __builtin_amdgcn_readfirstlane(t_ >> 6); }
        { int g_ = gridDim.x, b_ = blockIdx.x; asm volatile("" : "+s"(g_), "+s"(b_)); F.G = g_; F.vcu = (g_ % 8 == 0) ? (b_ % 8) * (g_ / 8) + b_ / 8 : b_; }
        { const CAS Args* ap_ = (const CAS Args*)__builtin_amdgcn_kernarg_segment_ptr(); asm volatile("" : "+s"(ap_)); F.a = ap_; }
        { float* o_ = args.out; unsigned char* w_ = args.ws; asm volatile("" : "+s"(o_), "+s"(w_)); F.out = o_; F.ws = w_; }
        unsigned char* BIG = F.ws + WS_BIG; bf16* XN = (bf16*)(F.ws + WS_XN); bf16* WIN = (bf16*)(F.ws + WS_WIN);
        const bf16* gA = nullptr; const bf16* gAs = nullptr; const bf16* gB = nullptr; int gN = 0, gK = 0, gmode = 0, gld = 0; void* gO = nullptr; void* gOs = nullptr;
        int l = 0, fixl = -1;
        switch (ph) {
            case 0: p0_prologue(F); break;
            case 1: gA = XN; gAs = XN + (size_t)MP * D; gB = WIN; gN = NA; gK = D; gmode = 0; gld = NA; gO = BIG + B_PROJA; gOs = (bf16*)gO + (size_t)MP * NA; break;
            case 2: ssd_state_phase(F); break;
            case 3: ssd_out_phase(F); break;
            case 4: gA = XN; gAs = XN + (size_t)MP * D; gB = WIN + (size_t)NA * D; gN = NBH; gK = D; gmode = 0; gld = NBH; gO = BIG + B_PROJB; gOs = (bf16*)gO + (size_t)MP * NBH; break;
            case 5: hg_state_phase(F); break;
            case 6: hg_out_phase(F); break;
            case 7: gA = (const bf16*)(F.out + O_YP); gAs = (const bf16*)(F.ws + WS_MIXS); gB = (const bf16*)(F.ws + WS_WOUT); gN = D; gK = 2048; gmode = 0; gld = D; gO = BIG + B_M1; gOs = (bf16*)gO + (size_t)MP * D; break;
            case 8: resid_norm_rows(F, (const bf16*)(BIG + B_M1), F.a->in[I_NMPOST], F.a->in[I_NFPRE], 0); break;
            case 15: l = 1; [[fallthrough]];
            case 9: gA = XN; gAs = XN + (size_t)MP * D; gB = (const bf16*)(F.ws + WS_WUP) + (size_t)l * FF2 * D; gN = FF2; gK = D; gmode = 3; gld = FF2; gO = BIG + B_ACT; gOs = BIG + B_ACT; break;
            case 16: l = 1; [[fallthrough]];
            case 10: gA = (const bf16*)(BIG + B_ACT); gAs = gA + (size_t)MP * FF; gB = (const bf16*)(F.ws + WS_WDN) + (size_t)l * D * FF; gN = D; gK = FF; gmode = 0; gld = D; gO = BIG + B_M1; gOs = (bf16*)gO + (size_t)MP * D; fixl = l; break;
            case 11: resid_norm_rows(F, (const bf16*)(BIG + B_M1), F.a->in[I_NFPOST], F.a->in[I_NMPRE] + D, 1); break;
            case 12: s5_fused_phase(F); s5_sample(F); break;
            case 13: gA = (const bf16*)(BIG + B_GY); gAs = gA + (size_t)MP * D; gB = (const bf16*)(F.ws + WS_WGLU); gN = 2048; gK = D; gmode = 2; gld = D; gO = BIG + B_M1G; gOs = (bf16*)gO + (size_t)MP * D; break;
            case 14: resid_norm_rows(F, (const bf16*)(BIG + B_M1G), F.a->in[I_NMPOST] + D, F.a->in[I_NFPRE] + D, 1); break;
            case 17: resid_norm_rows(F, (const bf16*)(BIG + B_M1), F.a->in[I_NFPOST] + D, nullptr, 2); break;
            default: break;
        }
        if (gA) {
            pg8::Gemm g{gA, gB, MP, gN, gK}; pg8::StaticOrder S; S.init(MP, gN, F.G, (int)blockIdx.x);
            PSEG_B(4, F.lds);
            if (fixl >= 0) { pg8::Unit u0; for (int i = 0; S.next(i, u0); ++i) ffn_fix_rows(F, fixl, u0.pm);
                asm volatile("s_waitcnt vmcnt(0)" ::: "memory"); __syncthreads(); }
            PSEG_E(4, F.lds);
            pg8::EpiConvGate cg{(pg8::bf16_t*)(BIG + B_ACT), F.a->in[I_FCW] + (size_t)l * 3 * FF2, F.a->in[I_FCB] + (size_t)l * FF2, (float*)(BIG + B_HEAD), (float*)(BIG + B_TAIL), (PG8_LAS float*)(F.lds + HALO_OFF), F.out + O_PFC + (size_t)l * 8 * 2 * FF2};
            const int nrem = ((MP / 256) * (gN / 256)) % F.G, tb = nrem ? (int)blockIdx.x - nrem : (int)blockIdx.x, tstr = nrem ? F.G - nrem : F.G;
            if (nrem == 0) {
            PSEG_B(3, F.lds);
            if (gmode == 2) skinny1<2, 4, true>(F, gAs, gK, gB, gK, D, SkGlu{(bf16*)gOs, gld}, tb, tstr);
            else if (gN == D) skinny1<1, 11, false>(F, gAs, gK, gB, gK, D, SkAny{gmode, gOs, gld}, tb, tstr);
            else skinny2<1, 2, false>(F, gAs, gK, gB, gK, gN / 32, SkAny{gmode, gOs, gld}, tb, tstr);
            PSEG_E(3, F.lds);
            __syncthreads(); }
            PSEG_B(2, F.lds);
            pg8::gemm_phase<pg8::EpiAny, pg8::StaticOrder, true, true>(F.lds, g, S, pg8::EpiAny{gmode, gmode != 1, gO, gld, cg, gmode == 3}, F.tid);
            __syncthreads();
            PSEG_E(2, F.lds);
#if PROBE_E == 1
            if (PROBE_SEG == 7) { PSEG_B(7, F.lds); asm volatile("s_waitcnt vmcnt(0)" ::: "memory"); PSEG_E(7, F.lds); }
#endif
            if (nrem != 0) {
            if (gmode == 3) { if (l == 0 && tb >= 0) { __syncthreads(); PSEG_B(6, F.lds); for (int g2 = tb; g2 < 128; g2 += tstr) s5_tables_item(F, g2 >> 1, g2 & 1); PSEG_E(6, F.lds); }
              skinny2<2, 4, true>(F, gAs, gK, gB, gK, FF / 32, SkConvGate{(bf16*)(BIG + B_ACT) + (size_t)MP * FF, F.a->in[I_FCW] + (size_t)l * 3 * FF2, F.a->in[I_FCB] + (size_t)l * FF2, F.a->in[I_SFC] + (size_t)l * MS * 2 * FF2, F.out + O_SFC + (size_t)l * MS * 2 * FF2}, tb, tstr); }
            else skinny2<1, 4, false>(F, gAs, gK, gB, gK, gN / 32, SkAny{gmode, gOs, gld}, tb, tstr);
            }
        }
#if PROBE_T >= 0
        if (blockIdx.x == PROBE_EB && threadIdx.x == 0 && ph + 1 == hi) { volatile LAS unsigned long long* ST = (volatile LAS unsigned long long*)(F.lds + MISC_OFF + 64);
            const unsigned long long now = __builtin_amdgcn_s_memrealtime(); if (ph == PROBE_T) ST[1] = now - ST[0];
            const unsigned long long tk = PROBE_E == 1 ? ST[2] : PROBE_E == 2 ? (ST[1] >> 7) : ST[1]; while (__builtin_amdgcn_s_memrealtime() - now < 4ull * tk) __builtin_amdgcn_s_sleep(8); }
#endif
        PSEG_B(40, F.lds);
        if (ph + 1 < hi) { XcdBarrier b2; b2.bar = (unsigned*)(F.ws + WS_CTL) + CW_BAR + F.a->li * XCD_BAR_WORDS; b2.x = xb_xcc_id(); b2.st = (volatile LAS unsigned*)(F.lds + MISC_OFF) + 8; xcd_barrier(b2);
            PSEG_E(40, F.lds);
#if PROBE_T >= 0
            if (blockIdx.x == PROBE_EB && threadIdx.x == 0) { volatile LAS unsigned long long* ST = (volatile LAS unsigned long long*)(F.lds + MISC_OFF + 64);
#if PROBE_E == 2
                const unsigned long long now = __builtin_amdgcn_s_memtime();
#else
                const unsigned long long now = __builtin_amdgcn_s_memrealtime();
#endif
                if (ph == PROBE_T) ST[1] = now - ST[0]; ST[0] = now;
#if PROBE_E == 1
                ST[3] = (ph + 1 == PROBE_T || PROBE_ALL) ? 1ull : 0ull;
#endif
            }
#endif
        }
    }
}

extern "C" void kernel_launch(void* const* d_in, const int* in_sizes, int n_in, void* d_out, int out_size, void* d_ws, size_t ws_size, hipStream_t stream) {
    static int grid = 0;
    if (grid == 0) {
        if (n_in != N_IN || out_size != (int)O_END || ws_size < WS_END) { fprintf(stderr, "kernel_launch: unexpected shapes (n_in %d, out %d, ws %zu)\n", n_in, out_size, ws_size); grid = -1; return; }
        int dev = 0, cus = 0, per_cu = 0;
        if (hipGetDevice(&dev) != hipSuccess || hipDeviceGetAttribute(&cus, hipDeviceAttributeMultiprocessorCount, dev) != hipSuccess) { grid = -1; return; }
        if (hipFuncSetAttribute((const void*)fwd_kernel, hipFuncAttributeMaxDynamicSharedMemorySize, LDS_BYTES) != hipSuccess) { fprintf(stderr, "kernel_launch: hipFuncSetAttribute failed\n"); grid = -1; return; }
        if (hipOccupancyMaxActiveBlocksPerMultiprocessor(&per_cu, (const void*)fwd_kernel, NTHR, LDS_BYTES) != hipSuccess || per_cu < 1) fprintf(stderr, "kernel_launch: occupancy query says %d\n", per_cu);
        (void)hipGetLastError();
        if (per_cu < 1) { fprintf(stderr, "kernel_launch: the kernel does not fit a CU\n"); grid = -1; return; }
        grid = cus;
    }
    if (grid < 0) return;
    (void)hipMemsetAsync((char*)d_ws + WS_CTL, 0, CTL_BYTES, stream);
    Args a{};
    for (int i = 0; i < 35; ++i) a.in[i] = (const float*)d_in[i];
    a.out = (float*)d_out; a.ws = (unsigned char*)d_ws;
#if PROBE_PH >= 0
    a.ph_lo = 0; a.ph_hi = PROBE_PH + 1; a.li = 0; hipLaunchKernelGGL(fwd_kernel, dim3(grid), dim3(NTHR), LDS_BYTES, stream, a);
    for (int rep = 0; rep < PROBE_REPS; ++rep) { a.ph_lo = PROBE_PH; a.ph_hi = PROBE_PH + 1; a.li = 1; hipLaunchKernelGGL(fwd_kernel, dim3(grid), dim3(NTHR), LDS_BYTES, stream, a); }
    if (PROBE_PH + 1 < NPH) { a.ph_lo = PROBE_PH + 1; a.ph_hi = NPH; a.li = 2; hipLaunchKernelGGL(fwd_kernel, dim3(grid), dim3(NTHR), LDS_BYTES, stream, a); }
#elif MK_ONE_LAUNCH
    a.ph_lo = 0; a.ph_hi = NPH; a.li = 0;
    { void* kargs[] = {&a};
      if (hipLaunchCooperativeKernel((const void*)fwd_kernel, dim3(grid), dim3(NTHR), kargs, LDS_BYTES, stream) != hipSuccess) { (void)hipGetLastError(); fprintf(stderr, "kernel_launch: cooperative launch refused\n"); } }
#else
    for (int p = 0; p < NPH; ++p) { a.ph_lo = p; a.ph_hi = p + 1; a.li = 0; hipLaunchKernelGGL(fwd_kernel, dim3(grid), dim3(NTHR), LDS_BYTES, stream, a); }
#endif
}
```
